# Optimizing an MI355X kernel written in HIP

```python
import jax
import jax.numpy as jnp
from jax import lax
import numpy as np


D_MODEL = 1024
BATCH = 4
SEQ = 8192
DEPTH = 2

GRID_W = 64
CTX_LEN = 256
HEAD_DIM = 64
D_MIX = D_MODEL
GROUP_WIDTH = D_MIX // 4
A_HQ = GROUP_WIDTH // HEAD_DIM
A_HKV = A_HQ // 2
A_WIN = 128
A_BLK = 128
B_H = GROUP_WIDTH // HEAD_DIM
NAT_KR_MAX = 8
NAT_KC = 16
NAT_QC = 16
NAT_KCB = 2 * NAT_KC
C_H = GROUP_WIDTH // HEAD_DIM
C_CHUNK = 64
C_CONV = 3
D_H = GROUP_WIDTH // HEAD_DIM
MLA_Q_LORA = 192
MLA_KV_LORA = 128
MLA_NOPE = 64
MLA_ROPE = 32
MLA_V = GROUP_WIDTH // D_H
MLA_BLK = 128
N_EXP = 32
TOP_K = 4
D_FF = D_MODEL
SWIGLU_LIMIT = 7.0
SWIGLU_ALPHA = 1.702
MOE_BLK = 128
ROPE_BASE = 10000.0
EPS = 1e-6
IN_SIZES = (A_HQ * HEAD_DIM, A_HKV * HEAD_DIM, A_HKV * HEAD_DIM,
            B_H * HEAD_DIM, B_H * HEAD_DIM, B_H * HEAD_DIM,
            2 * C_H * HEAD_DIM, C_H * HEAD_DIM, C_H * HEAD_DIM, 4 * C_H,
            MLA_Q_LORA, MLA_KV_LORA, MLA_ROPE)
IN_COLS = sum(IN_SIZES)

kernel_name = 'hybrid_parallel_heads_dit_block'


def rms_norm(x, g):
    xf = x.astype(jnp.float32)
    y = xf * lax.rsqrt(jnp.mean(xf * xf, axis=-1, keepdims=True) + EPS)
    return (y * g.astype(jnp.float32)).astype(x.dtype)


def split_cols(p, sizes):
    return jnp.split(p, np.cumsum(sizes)[:-1].tolist(), axis=-1)


def axial_rope_tables(n, rot_dim):
    t = jnp.arange(n, dtype=jnp.int32)
    rows = (t // GRID_W).astype(jnp.float32)
    cols = (t % GRID_W).astype(jnp.float32)
    d_ax = rot_dim // 2
    inv = ROPE_BASE ** (-jnp.arange(0, d_ax, 2, dtype=jnp.float32) / d_ax)
    ang = jnp.concatenate([rows[:, None] * inv, cols[:, None] * inv], axis=-1)
    return jnp.cos(ang), jnp.sin(ang)


def apply_rope(x, cos, sin):
    half = x.shape[-1] // 2
    x1 = x[..., :half].astype(jnp.float32)
    x2 = x[..., half:].astype(jnp.float32)
    c = cos[None, :, None, :]
    s = sin[None, :, None, :]
    return jnp.concatenate([x1 * c - x2 * s, x2 * c + x1 * s], axis=-1).astype(x.dtype)


def ctx_self_attention(qc, kc, vc, sink=None):
    bn, n, hq, dq = qc.shape
    hkv = kc.shape[2]
    g = hq // hkv
    s = jnp.einsum('bqhgd,bkhd->bhgqk', qc.reshape(bn, n, hkv, g, dq), kc).astype(jnp.float32) * dq ** -0.5
    if sink is not None:
        snk = jnp.broadcast_to(sink.astype(jnp.float32).reshape(1, hkv, g, 1, 1), s.shape[:-1] + (1,))
        s = jnp.concatenate([s, snk], axis=-1)
    p = jax.nn.softmax(s, axis=-1)[..., :n].astype(vc.dtype)
    return jnp.einsum('bhgqk,bkhd->bqhgd', p, vc).reshape(bn, n, hq * vc.shape[-1])


def mixer_a(pl, pc, sink, cos, sin, need_ctx):
    bn, S = pl[0].shape[:2]
    nc = pc[0].shape[1]
    g = A_HQ // A_HKV
    nb = S // A_BLK
    kw = 3 * A_BLK
    scale = HEAD_DIM ** -0.5
    q = apply_rope(pl[0].reshape(bn, S, A_HQ, HEAD_DIM), cos, sin)
    k = apply_rope(pl[1].reshape(bn, S, A_HKV, HEAD_DIM), cos, sin)
    v = pl[2].reshape(bn, S, A_HKV, HEAD_DIM)
    qc = pc[0].reshape(bn, nc, A_HQ, HEAD_DIM)
    kc = pc[1].reshape(bn, nc, A_HKV, HEAD_DIM)
    vc = pc[2].reshape(bn, nc, A_HKV, HEAD_DIM)
    qb = q.reshape(bn, nb, A_BLK, A_HKV, g, HEAD_DIM)

    def band(a):
        ap = jnp.pad(a, ((0, 0), (A_BLK, A_BLK), (0, 0), (0, 0))).reshape(bn, nb + 2, A_BLK, A_HKV, HEAD_DIM)
        return jnp.concatenate([ap[:, :-2], ap[:, 1:-1], ap[:, 2:]], axis=2)

    kb, vb = band(k), band(v)
    qpos = jnp.arange(S).reshape(nb, A_BLK)
    kpos = (jnp.arange(nb)[:, None] - 1) * A_BLK + jnp.arange(kw)[None, :]
    ok = ((jnp.abs(qpos[:, :, None] - kpos[:, None, :]) <= A_WIN)
          & (kpos[:, None, :] >= 0) & (kpos[:, None, :] < S))
    s_loc = jnp.einsum('bnqhgd,bnkhd->bnhgqk', qb, kb).astype(jnp.float32) * scale
    s_loc = jnp.where(ok[None, :, None, None], s_loc, -jnp.inf)
    s_ctx = jnp.einsum('bnqhgd,bchd->bnhgqc', qb, kc).astype(jnp.float32) * scale
    s_snk = jnp.broadcast_to(sink.astype(jnp.float32).reshape(1, 1, A_HKV, g, 1, 1), s_ctx.shape[:-1] + (1,))
    p = jax.nn.softmax(jnp.concatenate([s_loc, s_ctx, s_snk], axis=-1), axis=-1).astype(v.dtype)
    o = (jnp.einsum('bnhgqk,bnkhd->bnqhgd', p[..., :kw], vb)
         + jnp.einsum('bnhgqc,bchd->bnqhgd', p[..., kw:kw + nc], vc))
    o = o.reshape(bn, S, A_HQ * HEAD_DIM)
    oc = ctx_self_attention(qc, kc, vc, sink) if need_ctx else None
    return o, oc


def mixer_b(pl, pc, rpb, need_ctx):
    bn, S = pl[0].shape[:2]
    heads = lambda a: a.reshape(a.shape[0], a.shape[1], B_H, HEAD_DIM)
    q, k, v = heads(pl[0]), heads(pl[1]), heads(pl[2])
    qc, kc, vc = heads(pc[0]), heads(pc[1]), heads(pc[2])
    rows = S // GRID_W
    kr = min(NAT_KR_MAX, rows)
    ncb = GRID_W // NAT_QC
    nk = kr * NAT_KCB
    scale = HEAD_DIM ** -0.5
    qcol = jnp.arange(ncb)[:, None] * NAT_QC + jnp.arange(NAT_QC)[None, :]
    cs = jnp.clip(qcol - NAT_KC // 2, 0, GRID_W - NAT_KC)
    a0 = jnp.clip(jnp.arange(ncb) * NAT_QC - NAT_KC // 2, 0, GRID_W - NAT_KCB)
    krow_off = jnp.repeat(jnp.arange(kr), NAT_KCB)
    kcol = (a0[:, None, None] + jnp.zeros((1, kr, 1), jnp.int32)
            + jnp.arange(NAT_KCB)[None, None, :]).reshape(ncb, nk)
    col_ok = (kcol[:, None, :] >= cs[:, :, None]) & (kcol[:, None, :] < cs[:, :, None] + NAT_KC)
    dc_idx = jnp.clip(kcol[:, None, :] - qcol[:, :, None] + NAT_KC - 1, 0, 2 * NAT_KC - 2)
    q_rows = jnp.moveaxis(q.reshape(bn, rows, ncb, NAT_QC, B_H, HEAD_DIM), 1, 0)

    def row_block(args):
        qr, r = args
        r0 = jnp.clip(r - kr // 2, 0, rows - kr)
        krow = r0 + krow_off
        kidx = krow[None, :] * GRID_W + kcol
        kg, vg = k[:, kidx], v[:, kidx]
        dr_idx = jnp.broadcast_to(krow - r + NAT_KR_MAX - 1, dc_idx.shape)
        bias = rpb[:, dr_idx, dc_idx].astype(jnp.float32)
        s_loc = jnp.einsum('bmqhd,bmkhd->bhmqk', qr, kg).astype(jnp.float32) * scale + bias[None]
        s_loc = jnp.where(col_ok[None, None], s_loc, -jnp.inf)
        s_ctx = jnp.einsum('bmqhd,bchd->bhmqc', qr, kc).astype(jnp.float32) * scale
        p = jax.nn.softmax(jnp.concatenate([s_loc, s_ctx], axis=-1), axis=-1).astype(v.dtype)
        return (jnp.einsum('bhmqk,bmkhd->bmqhd', p[..., :nk], vg)
                + jnp.einsum('bhmqc,bchd->bmqhd', p[..., nk:], vc))

    o = lax.map(row_block, (q_rows, jnp.arange(rows)))
    o = jnp.moveaxis(o, 0, 1).reshape(bn, S, B_H * HEAD_DIM)
    oc = ctx_self_attention(qc, kc, vc) if need_ctx else None
    return o, oc


def short_conv_silu(u, w):
    K = w.shape[0]
    p = K // 2
    n = u.shape[1]
    up = jnp.pad(u, ((0, 0), (p, p), (0, 0)))
    return jax.nn.silu(sum(up[:, j:j + n] * w[j] for j in range(K)))


def mlstm_chunkwise(q, k, v, ig, lf, state):
    bn, h, n, d = q.shape
    L = C_CHUNK
    nc = n // L
    to_chunks = lambda a: jnp.moveaxis(a.reshape(a.shape[:2] + (nc, L) + a.shape[3:]), 2, 0)
    tril = jnp.tril(jnp.ones((L, L), dtype=bool))

    def step(carry, inp):
        cmat, nvec, m = carry
        qc, kc, vc, ic, fc = inp
        b = jnp.cumsum(fc, axis=-1)
        logd = jnp.where(tril, b[..., :, None] - b[..., None, :] + ic[..., None, :], -jnp.inf)
        m_t = jnp.maximum(b + m[..., None], jnp.max(logd, axis=-1))
        dmat = jnp.exp(logd - m_t[..., None])
        inter = jnp.exp(b + m[..., None] - m_t)
        sw = jnp.einsum('bhtd,bhsd->bhts', qc, kc) * dmat
        num = jnp.einsum('bhts,bhsd->bhtd', sw, vc) + inter[..., None] * jnp.einsum('bhtk,bhkv->bhtv', qc, cmat)
        den = jnp.sum(sw, axis=-1) + inter * jnp.einsum('bhtk,bhk->bht', qc, nvec)
        hout = num / jnp.maximum(jnp.abs(den), jnp.exp(-m_t))[..., None]
        b_end = b[..., -1]
        m_new = m_t[..., -1]
        decay = jnp.exp(b_end + m - m_new)
        w = jnp.exp(b_end[..., None] - b + ic - m_new[..., None])
        c_new = decay[..., None, None] * cmat + jnp.einsum('bhs,bhsk,bhsv->bhkv', w, kc, vc)
        n_new = decay[..., None] * nvec + jnp.einsum('bhs,bhsk->bhk', w, kc)
        return (c_new, n_new, m_new), hout

    state, hs = lax.scan(step, state, (to_chunks(q), to_chunks(k), to_chunks(v), to_chunks(ig), to_chunks(lf)))
    return jnp.moveaxis(hs, 0, 2).reshape(bn, h, n, d), state


def mixer_c(pl, pc, conv_w, gate_bias, need_ctx):
    def prep(qk, v, o, g):
        bn, n = qk.shape[:2]
        q, k = jnp.split(short_conv_silu(qk, conv_w), 2, axis=-1)
        heads = lambda a: a.reshape(bn, n, C_H, HEAD_DIM).transpose(0, 2, 1, 3).astype(jnp.float32)
        g = (g.reshape(bn, n, 4, C_H).astype(jnp.float32) + gate_bias.astype(jnp.float32)).transpose(2, 0, 3, 1)
        fwd = (g[0], jax.nn.log_sigmoid(g[1]))
        bwd = (g[2], jax.nn.log_sigmoid(g[3]))
        return heads(q), heads(k) * HEAD_DIM ** -0.5, heads(v), jax.nn.sigmoid(o), fwd, bwd

    def bidir(q, k, v, fwd, bwd, st_f, st_b):
        hf, st_f = mlstm_chunkwise(q, k, v, fwd[0], fwd[1], st_f)
        flip = lambda a: jnp.flip(a, axis=2)
        hb, st_b = mlstm_chunkwise(flip(q), flip(k), flip(v), flip(bwd[0]), flip(bwd[1]), st_b)
        return hf + flip(hb), st_f, st_b

    def merge(hsum, o):
        return (o.astype(jnp.float32) * hsum.transpose(0, 2, 1, 3).reshape(o.shape)).astype(o.dtype)

    qc, kc, vc, oc, fc, bc = prep(*pc)
    bn = qc.shape[0]
    zero = (jnp.zeros((bn, C_H, HEAD_DIM, HEAD_DIM), jnp.float32),
            jnp.zeros((bn, C_H, HEAD_DIM), jnp.float32),
            jnp.zeros((bn, C_H), jnp.float32))
    hc, st_f, st_b = bidir(qc, kc, vc, fc, bc, zero, zero)
    q, k, v, o, fw, bw = prep(*pl)
    hl, _, _ = bidir(q, k, v, fw, bw, st_f, st_b)
    return merge(hl, o), (merge(hc, oc) if need_ctx else None)


def mixer_d(pl, pc, g_q, w_uq, g_kv, w_ukv, cos, sin, need_ctx):
    dq = MLA_NOPE + MLA_ROPE
    scale = dq ** -0.5

    def expand(cq, ckv, kr, rope):
        bn, n = cq.shape[:2]
        qf = (rms_norm(cq, g_q) @ w_uq).reshape(bn, n, D_H, dq)
        kv = (rms_norm(ckv, g_kv) @ w_ukv).reshape(bn, n, D_H, MLA_NOPE + MLA_V)
        q_nope, q_rope = qf[..., :MLA_NOPE], qf[..., MLA_NOPE:]
        k_nope, v = kv[..., :MLA_NOPE], kv[..., MLA_NOPE:]
        k_rope = kr[:, :, None, :]
        if rope:
            q_rope = apply_rope(q_rope, cos, sin)
            k_rope = apply_rope(k_rope, cos, sin)
        q = jnp.concatenate([q_nope, q_rope], axis=-1)
        k = jnp.concatenate([k_nope, jnp.broadcast_to(k_rope, (bn, n, D_H, MLA_ROPE))], axis=-1)
        return q, k, v

    q, k, v = expand(pl[0], pl[1], pl[2], True)
    qc, kc, vc = expand(pc[0], pc[1], pc[2], False)
    bn, S = q.shape[:2]
    nb = S // MLA_BLK
    k_all = jnp.concatenate([k, kc], axis=1)
    v_all = jnp.concatenate([v, vc], axis=1)
    qb = jnp.moveaxis(q.reshape(bn, nb, MLA_BLK, D_H, dq), 1, 0)

    def q_block(qi):
        s = jnp.einsum('bqhd,bkhd->bhqk', qi, k_all).astype(jnp.float32) * scale
        p = jax.nn.softmax(s, axis=-1).astype(v_all.dtype)
        return jnp.einsum('bhqk,bkhd->bqhd', p, v_all)

    o = jnp.moveaxis(lax.map(q_block, qb), 0, 1).reshape(bn, S, D_H * MLA_V)
    oc = ctx_self_attention(qc, kc, vc) if need_ctx else None
    return o, oc


def moe_ffn(h, w_router, b_router, w_gu, b_gu, w_down, b_down):
    T, dm = h.shape
    n_assign = T * TOP_K
    n_blk = (n_assign + N_EXP * (MOE_BLK - 1) + MOE_BLK - 1) // MOE_BLK
    cap = n_blk * MOE_BLK
    logits = (h @ w_router + b_router).astype(jnp.float32)
    top_logit, top_exp = lax.top_k(logits, TOP_K)
    gate = jax.nn.softmax(top_logit, axis=-1).reshape(-1)
    exp_id = top_exp.reshape(-1)
    tok_id = jnp.arange(n_assign, dtype=jnp.int32) // TOP_K
    order = jnp.argsort(exp_id)
    sorted_exp = exp_id[order]
    counts = jnp.bincount(exp_id, length=N_EXP)
    padded = (counts + MOE_BLK - 1) // MOE_BLK * MOE_BLK
    start = jnp.cumsum(counts) - counts
    pad_end = jnp.cumsum(padded)
    pad_start = pad_end - padded
    dest = pad_start[sorted_exp] + jnp.arange(n_assign, dtype=jnp.int32) - start[sorted_exp]
    slot_tok = jnp.full((cap,), T, jnp.int32).at[dest].set(tok_id[order])
    slot_gate = jnp.zeros((cap,), jnp.float32).at[dest].set(gate[order])
    blk_exp = jnp.minimum(jnp.searchsorted(pad_end, jnp.arange(n_blk, dtype=jnp.int32) * MOE_BLK, side='right'), N_EXP - 1)
    h_pad = jnp.concatenate([h, jnp.zeros((1, dm), h.dtype)], axis=0)

    def expert_block(args):
        tok, e = args
        gu = h_pad[tok] @ w_gu[e] + b_gu[e]
        g = jnp.minimum(gu[:, 0::2], SWIGLU_LIMIT)
        u = jnp.clip(gu[:, 1::2], -SWIGLU_LIMIT, SWIGLU_LIMIT)
        return ((u + 1.0) * g * jax.nn.sigmoid(SWIGLU_ALPHA * g)) @ w_down[e] + b_down[e]

    y = lax.map(expert_block, (slot_tok.reshape(n_blk, MOE_BLK), blk_exp))
    y = y.reshape(cap, dm) * slot_gate[:, None].astype(y.dtype)
    return jnp.zeros((T + 1, dm), y.dtype).at[slot_tok].add(y)[:T]


def setup_inputs(seed: int = 0) -> dict:
    key = jax.random.key(seed)
    ks = jax.random.split(key, 32)
    f32 = jnp.float32
    nrm = lambda k, shape, s: jax.random.normal(k, shape, f32) * s
    D = D_MODEL
    f_bias = jnp.linspace(3.0, 6.0, C_H, dtype=f32)
    gate_bias = nrm(ks[9], (DEPTH, 4, C_H), 0.1) + jnp.array([0.0, 1.0, 0.0, 1.0], f32)[None, :, None] * f_bias[None, None, :]
    return {
        'x': nrm(ks[0], (BATCH, SEQ, D), 1.0),
        'c': nrm(ks[1], (BATCH, D), 1.0),
        'ctx': nrm(ks[2], (BATCH, CTX_LEN, D), 1.0),
        'c_ctx': nrm(ks[3], (D,), 1.0),
        'w_ada': nrm(ks[4], (DEPTH, D, 6 * D), 0.5 * D ** -0.5),
        'b_ada': nrm(ks[5], (DEPTH, 6 * D), 0.01),
        'g_norm1': 1.0 + nrm(ks[6], (DEPTH, D), 0.01),
        'g_norm2': 1.0 + nrm(ks[7], (DEPTH, D), 0.01),
        'w_in': nrm(ks[8], (DEPTH, D, IN_COLS), D ** -0.5),
        'attn_sink': nrm(ks[10], (DEPTH, A_HQ), 0.5),
        'nat_rpb': nrm(ks[11], (DEPTH, B_H, 2 * NAT_KR_MAX - 1, 2 * NAT_KC - 1), 0.1),
        'mlstm_conv': nrm(ks[12], (DEPTH, C_CONV, 2 * C_H * HEAD_DIM), C_CONV ** -0.5),
        'mlstm_gate_bias': gate_bias,
        'mla_g_q': 1.0 + nrm(ks[13], (DEPTH, MLA_Q_LORA), 0.01),
        'mla_w_uq': nrm(ks[14], (DEPTH, MLA_Q_LORA, D_H * (MLA_NOPE + MLA_ROPE)), MLA_Q_LORA ** -0.5),
        'mla_g_kv': 1.0 + nrm(ks[15], (DEPTH, MLA_KV_LORA), 0.01),
        'mla_w_ukv': nrm(ks[16], (DEPTH, MLA_KV_LORA, D_H * (MLA_NOPE + MLA_V)), MLA_KV_LORA ** -0.5),
        'w_out': nrm(ks[17], (DEPTH, D_MIX, D), D_MIX ** -0.5),
        'w_router': nrm(ks[18], (DEPTH, D, N_EXP), D ** -0.5),
        'b_router': nrm(ks[19], (DEPTH, N_EXP), 0.01),
        'w_gu': nrm(ks[20], (DEPTH, N_EXP, D, 2 * D_FF), D ** -0.5),
        'b_gu': nrm(ks[21], (DEPTH, N_EXP, 2 * D_FF), 0.01),
        'w_down': nrm(ks[22], (DEPTH, N_EXP, D_FF, D), D_FF ** -0.5),
        'b_down': nrm(ks[23], (DEPTH, N_EXP, D), 0.01),
        'g_final': 1.0 + nrm(ks[24], (D,), 0.01),
    }


def reference(x, c, ctx, c_ctx, w_ada, b_ada, g_norm1, g_norm2, w_in, attn_sink, nat_rpb,
              mlstm_conv, mlstm_gate_bias, mla_g_q, mla_w_uq, mla_g_kv, mla_w_ukv, w_out,
              w_router, b_router, w_gu, b_gu, w_down, b_down, g_final):
    S = x.shape[1]
    dm = x.shape[-1]
    cos_a, sin_a = axial_rope_tables(S, HEAD_DIM)
    cos_d, sin_d = axial_rope_tables(S, MLA_ROPE)
    silu_c = jax.nn.silu(c)
    silu_cc = jax.nn.silu(c_ctx)
    xc = ctx
    for l in range(DEPTH):
        need_ctx = l < DEPTH - 1
        mod = silu_c @ w_ada[l] + b_ada[l]
        mod_c = silu_cc @ w_ada[l] + b_ada[l]
        sh1, sc1, gt1, sh2, sc2, gt2 = jnp.split(mod[:, None, :], 6, axis=-1)
        sh1c, sc1c, gt1c, sh2c, sc2c, gt2c = jnp.split(mod_c, 6, axis=-1)
        h = rms_norm(x, g_norm1[l]) * (1.0 + sc1) + sh1
        hc = rms_norm(xc, g_norm1[l]) * (1.0 + sc1c) + sh1c
        pl = split_cols(h @ w_in[l], IN_SIZES)
        pc = split_cols(hc @ w_in[l], IN_SIZES)
        ya, yac = mixer_a(pl[0:3], pc[0:3], attn_sink[l], cos_a, sin_a, need_ctx)
        yb, ybc = mixer_b(pl[3:6], pc[3:6], nat_rpb[l], need_ctx)
        ym, ymc = mixer_c(pl[6:10], pc[6:10], mlstm_conv[l], mlstm_gate_bias[l], need_ctx)
        yd, ydc = mixer_d(pl[10:13], pc[10:13], mla_g_q[l], mla_w_uq[l], mla_g_kv[l], mla_w_ukv[l], cos_d, sin_d, need_ctx)
        x = x + gt1 * (jnp.concatenate([ya, yb, ym, yd], axis=-1) @ w_out[l])
        h2 = rms_norm(x, g_norm2[l]) * (1.0 + sc2) + sh2
        moe_w = (w_router[l], b_router[l], w_gu[l], b_gu[l], w_down[l], b_down[l])
        if need_ctx:
            xc = xc + gt1c * (jnp.concatenate([yac, ybc, ymc, ydc], axis=-1) @ w_out[l])
            h2c = rms_norm(xc, g_norm2[l]) * (1.0 + sc2c) + sh2c
            n_lat = h2.shape[0] * h2.shape[1]
            f = moe_ffn(jnp.concatenate([h2.reshape(-1, dm), h2c.reshape(-1, dm)], axis=0), *moe_w)
            x = x + gt2 * f[:n_lat].reshape(x.shape)
            xc = xc + gt2c * f[n_lat:].reshape(xc.shape)
        else:
            x = x + gt2 * moe_ffn(h2.reshape(-1, dm), *moe_w).reshape(x.shape)
    return rms_norm(x, g_final)
```

```cpp
#include <hip/hip_runtime.h>
#include <cstdio>
#include <cstdint>

#ifndef MK_LAUNCHES
#define MK_LAUNCHES 0
#endif
#ifndef MK_CHECK
#define MK_CHECK 0
#endif

typedef unsigned short bf16_t;
typedef short bf16x8 __attribute__((ext_vector_type(8)));
typedef short s16x4 __attribute__((ext_vector_type(4)));
typedef float f32x4 __attribute__((ext_vector_type(4)));
typedef float f32x16 __attribute__((ext_vector_type(16)));
typedef unsigned u32x4 __attribute__((ext_vector_type(4)));
typedef unsigned u32x2 __attribute__((ext_vector_type(2)));
#define LAS __attribute__((address_space(3)))

constexpr int NTHR = 512, NWAVE = 8;
constexpr int DM = 1024, NBATCH = 4, SEQ = 8192, CTXL = 256, TL = NBATCH * SEQ, TC = NBATCH * CTXL, TA = TL + TC;
constexpr int NP = 3584;
constexpr int PC_AQ = 0, PC_AK = 256, PC_AV = 384, PC_BQ = 512, PC_BK = 768, PC_BV = 1024, PC_CQK = 1280, PC_CV = 1792, PC_CO = 2048, PC_CG = 2304,
              PC_DCQ = 2320, PC_DCKV = 2512, PC_DKR = 2640, PC_DQF = 2672, PC_DKVF = 3056, PC_END = 3568;
constexpr int INC = 2672;
constexpr int NEXP = 32, MAXSLOT = 143360, MAXTILE = MAXSLOT / 256;
constexpr int NCHUNK = 132;
constexpr int NCU = NBATCH * NCHUNK * 4 * 2;
constexpr float LOG2E = 1.4426950408889634f;
constexpr float EPS = 1e-6f;

constexpr int LDS_BYTES = 147456;
constexpr int LDS_MISC = LDS_BYTES - 256;

constexpr size_t al256(size_t x) { return (x + 255) & ~(size_t)255; }
constexpr size_t WS_CTL = 0, CTL_BYTES = 65536;
constexpr size_t WS_MOD = WS_CTL + CTL_BYTES;
constexpr size_t WS_RA = al256(WS_MOD + (size_t)2 * 5 * 6144 * 4);
constexpr size_t WS_RD = al256(WS_RA + (size_t)SEQ * 32 * 8);
constexpr size_t WS_WIN = al256(WS_RD + (size_t)SEQ * 16 * 8);
constexpr size_t WS_WOUT = al256(WS_WIN + (size_t)2 * NP * 1024 * 2);
constexpr size_t WS_WGU = al256(WS_WOUT + (size_t)2 * 1024 * 1024 * 2);
constexpr size_t WS_WDN = al256(WS_WGU + (size_t)2 * 32 * 2048 * 1024 * 2);
constexpr size_t WS_WRT = al256(WS_WDN + (size_t)2 * 32 * 1024 * 1024 * 2);
constexpr size_t WS_HB = al256(WS_WRT + (size_t)2 * 2 * 32 * 1024 * 2);
constexpr size_t WS_H2B = al256(WS_HB + (size_t)TA * 1024 * 2);
constexpr size_t WS_P = al256(WS_H2B + (size_t)TA * 1024 * 2);
constexpr size_t WS_QA = al256(WS_P + (size_t)TA * NP * 2);
constexpr size_t WS_KA = al256(WS_QA + (size_t)TA * 256 * 2);
constexpr size_t WS_QD = al256(WS_KA + (size_t)TA * 128 * 2);
constexpr size_t WS_KD = al256(WS_QD + (size_t)TA * 384 * 2);
constexpr size_t WS_VD = al256(WS_KD + (size_t)TA * 384 * 2);
constexpr size_t WS_QC = al256(WS_VD + (size_t)TA * 256 * 2);
constexpr size_t WS_KC = al256(WS_QC + (size_t)TA * 256 * 2);
constexpr size_t WS_MIXEND = al256(WS_KC + (size_t)TA * 256 * 2);
constexpr size_t WS_ACT = WS_P;
static_assert(WS_MIXEND - WS_P >= (size_t)MAXSLOT * 1024 * 2, "ACT alias");
constexpr size_t WS_GATES = WS_MIXEND;
constexpr size_t WS_DC = al256(WS_GATES + (size_t)TA * 16 * 4);
constexpr size_t WS_DN = al256(WS_DC + (size_t)NCU * 4096 * 4);
constexpr size_t WS_DFA = al256(WS_DN + (size_t)NCU * 64 * 4);
constexpr size_t WS_CS = al256(WS_DFA + (size_t)NCU * 2 * 4);
constexpr size_t WS_NS = al256(WS_CS + (size_t)NCU * 4096 * 2);
constexpr size_t WS_MS = al256(WS_NS + (size_t)NCU * 64 * 4);
constexpr size_t WS_YMIX = al256(WS_MS + (size_t)NCU * 4);
constexpr size_t WS_XA = al256(WS_YMIX + (size_t)TA * 1024 * 2);
constexpr size_t WS_XB = al256(WS_XA + (size_t)TA * 1024 * 4);
constexpr size_t WS_GATE = al256(WS_XB + (size_t)TA * 1024 * 4);
constexpr size_t WS_LIST = al256(WS_GATE + (size_t)TA * 4 * 4);
constexpr size_t WS_SLOTA = al256(WS_LIST + (size_t)32 * TA * 4 * 4);
constexpr size_t WS_SLOTG = al256(WS_SLOTA + (size_t)MAXSLOT * 4);
constexpr size_t WS_TILEE = al256(WS_SLOTG + (size_t)MAXSLOT * 4);
constexpr size_t WS_XS = al256(WS_TILEE + (size_t)(MAXTILE + 64) * 4);
constexpr size_t WS_Y = WS_XS;
constexpr size_t WS_DBG = al256(WS_XS + (size_t)MAXSLOT * 1024 * 2);
constexpr size_t WS_END = WS_DBG + 65536;

#define CTL_Q(l, q)   (4096 + ((l) * 8 + (q)) * 64)
#define CTL_CNT(l, e) (8192 + (l) * 2048 + (e) * 64)

struct Params {
    const float *x, *c, *ctx, *c_ctx, *w_ada, *b_ada, *g_norm1, *g_norm2, *w_in, *attn_sink, *nat_rpb, *mlstm_conv, *mlstm_gate_bias,
                *mla_g_q, *mla_w_uq, *mla_g_kv, *mla_w_ukv, *w_out, *w_router, *b_router, *w_gu, *b_gu, *w_down, *b_down, *g_final;
    float* out;
    unsigned char* ws;
    int phase_lo, phase_hi, use_bar, pad0;
};

__device__ __forceinline__ int otid(int wv) { int t = wv * 64 + (int)__builtin_amdgcn_mbcnt_hi(~0u, __builtin_amdgcn_mbcnt_lo(~0u, 0u)); asm volatile("" : "+v"(t)); return t; }
__device__ __forceinline__ unsigned char* opq(unsigned char* q) { asm volatile("" : "+s"(q)); return q; }
__device__ __forceinline__ float bf2f(unsigned b) { return __uint_as_float(b << 16); }
__device__ __forceinline__ unsigned pk2(float lo, float hi) { unsigned r; asm("v_cvt_pk_bf16_f32 %0, %1, %2" : "=v"(r) : "v"(lo), "v"(hi)); return r; }
__device__ __forceinline__ unsigned short f2bf(float f) { return (unsigned short)(pk2(f, 0.f) & 0xffffu); }
__device__ __forceinline__ float fexp2(float x) { return __builtin_amdgcn_exp2f(x); }
__device__ __forceinline__ float fexp(float x) { return __builtin_amdgcn_exp2f(x * LOG2E); }
__device__ __forceinline__ float wave_sum(float v) {
#pragma unroll
    for (int d = 32; d >= 1; d >>= 1) v += __shfl_xor(v, d);
    return v;
}
__device__ __forceinline__ float wave_max(float v) {
#pragma unroll
    for (int d = 32; d >= 1; d >>= 1) v = fmaxf(v, __shfl_xor(v, d));
    return v;
}
__device__ __forceinline__ float wave_incl_sum(float v, int lane) {
#pragma unroll
    for (int d = 1; d < 64; d <<= 1) { const float t = __shfl_up(v, d); if (lane >= d) v += t; }
    return v;
}
__device__ __forceinline__ float wave_incl_max(float v, int lane) {
#pragma unroll
    for (int d = 1; d < 64; d <<= 1) { const float t = __shfl_up(v, d); if (lane >= d) v = fmaxf(v, t); }
    return v;
}
__device__ __forceinline__ f32x16 mfma32(bf16x8 a, bf16x8 b, f32x16 c) { return __builtin_amdgcn_mfma_f32_32x32x16_bf16(a, b, c, 0, 0, 0); }
__device__ __forceinline__ f32x16 zero16() { f32x16 z;
#pragma unroll
    for (int i = 0; i < 16; ++i) z[i] = 0.f;
    return z; }
__device__ __forceinline__ s16x4 tr_read(LAS unsigned char* p) { return __builtin_amdgcn_ds_read_tr16_b64_v4i16((LAS s16x4*)p); }
__device__ __forceinline__ bf16x8 cat8(s16x4 a, s16x4 b) { return __builtin_shufflevector(a, b, 0, 1, 2, 3, 4, 5, 6, 7); }
__device__ __forceinline__ bf16x8 as_bf16x8(u32x4 v) { return __builtin_bit_cast(bf16x8, v); }
__device__ __forceinline__ float sigmoidf_(float x) { return 1.0f / (1.0f + fexp(-x)); }
__device__ __forceinline__ float siluf_(float x) { return x * sigmoidf_(x); }

__device__ __forceinline__ void row_load(const float* row, int lane, f32x4 (&v)[4]) {
#pragma unroll
    for (int i = 0; i < 4; ++i) v[i] = *(const f32x4*)(row + i * 256 + lane * 4);
}
__device__ __forceinline__ float row_rstd(const f32x4 (&v)[4]) {
    float s = 0.f;
#pragma unroll
    for (int i = 0; i < 4; ++i) s += v[i][0] * v[i][0] + v[i][1] * v[i][1] + v[i][2] * v[i][2] + v[i][3] * v[i][3];
    s = wave_sum(s);
    return rsqrtf(s * (1.0f / 1024.0f) + EPS);
}
__device__ __forceinline__ void row_modulate(f32x4 (&v)[4], float rstd, const float* g, const float* sc, const float* sh, int lane) {
#pragma unroll
    for (int i = 0; i < 4; ++i) {
        const f32x4 gg = *(const f32x4*)(g + i * 256 + lane * 4), s1 = *(const f32x4*)(sc + i * 256 + lane * 4), s0 = *(const f32x4*)(sh + i * 256 + lane * 4);
#pragma unroll
        for (int j = 0; j < 4; ++j) v[i][j] = (v[i][j] * rstd * gg[j]) * (1.0f + s1[j]) + s0[j];
    }
}
__device__ __forceinline__ void row_store_bf16(bf16_t* row, int lane, const f32x4 (&v)[4]) {
#pragma unroll
    for (int i = 0; i < 4; ++i) { u32x2 w; w.x = pk2(v[i][0], v[i][1]); w.y = pk2(v[i][2], v[i][3]); *(u32x2*)(row + i * 256 + lane * 4) = w; }
}
namespace pg8 {
#define PG8_LAS __attribute__((address_space(3)))
typedef unsigned short bf16_t;
typedef short bf16x8 __attribute__((ext_vector_type(8)));
typedef float f32x4 __attribute__((ext_vector_type(4)));
typedef unsigned u32x4 __attribute__((ext_vector_type(4)));
constexpr int BM = 256, BK = 64, HALF = 128, HTB = HALF * BK * 2  , STAGE_BYTES = 8 * HTB, NXCD = 8, WGM = 8;

__host__ __device__ __forceinline__ int lds_byte(int r, int c) { const int st = (r >> 4) * 2 + (c >> 5), rr = r & 15, cc = c & 31, ob = rr * 64 + cc * 2; return st * 1024 + (ob ^ (((ob >> 9) & 1) << 5)); }
__host__ __device__ __forceinline__ void stage_rc(int b, int& R, int& C) { const int st = b / 1024, sb = b % 1024, swz = sb ^ (((sb >> 9) & 1) << 5); R = (st >> 1) * 16 + swz / 64; C = (st & 1) * 32 + (swz % 64) / 2; }
__host__ __device__ __forceinline__ int perm32(int rho) { const int n = rho >> 4, i = rho & 15; return 8 * (i >> 2) + 4 * n + (i & 3); }

struct Unit { int pm, pn; };
struct Gemm { const bf16_t* A; const bf16_t* Bt; int M, N, K; };

struct StaticOrder {
    int nM, nN, nwg, G, c;
    __host__ __device__ void init(int M, int N, int G_, int c_) { nM = M / BM; nN = N / BM; nwg = nM * nN; G = G_; c = c_; }
    __host__ __device__ bool next(int i, Unit& u) const {
        const long L = (long)i * G + c; if (L >= nwg) return false;
        int wgid = (int)L; { const int q = nwg / NXCD, r = nwg % NXCD, xcd = wgid % NXCD, off = wgid / NXCD; wgid = (xcd < r ? xcd * (q + 1) : r * (q + 1) + (xcd - r) * q) + off; }
        const int nig = WGM * nN, gid = wgid / nig, fm = gid * WGM, gsz = (nM - fm) < WGM ? (nM - fm) : WGM;
        u.pm = fm + ((wgid % nig) % gsz); u.pn = (wgid % nig) / gsz; return true;
    }
    __device__ __forceinline__ void a_ready(const Unit&) const {}
    __device__ __forceinline__ void done(const Unit&) const {}
};
template <class Epi, class Sched, bool STAMP = false>
__device__ __forceinline__ void gemm_phase(int wv, PG8_LAS unsigned char* lds, const Gemm g, const Sched& S, const Epi& E, unsigned long long* stamps) {
    const int tid = otid(wv), wid = __builtin_amdgcn_readfirstlane(tid >> 6), lane = tid & 63, wr = wid >> 2, wc = wid & 3, fr = lane & 15, fq = lane >> 4;
    const int K = g.K, nt = K / BK;
    int ts_lo = 0, ts_hi = 0, nts = 0; const unsigned long long rt_entry = STAMP ? (unsigned long long)wall_clock64() : 0ull;
#define PG8_STAMP() do { if (STAMP && wid == 0 && nts < 64) { const unsigned long long _c = (unsigned long long)clock64(); \
        ts_lo = (lane == nts) ? (int)(unsigned)_c : ts_lo; ts_hi = (lane == nts) ? (int)(unsigned)(_c >> 32) : ts_hi; ++nts; } } while (0)
    PG8_STAMP();
    unsigned voffA[2], voffB[2];
#pragma unroll
    for (int i = 0; i < 2; ++i) { int R, C; stage_rc(tid * 16 + i * 8192, R, C); const int Rb = Epi::PERM ? ((R & ~31) + perm32(R & 31)) : R;
        voffA[i] = (unsigned)(R * K + C) * 2u; voffB[i] = (unsigned)(Rb * K + C) * 2u; }
    const size_t kstep = (size_t)(BK * 2);
    const size_t hstep = (size_t)HALF * K * 2;
    const size_t tstep = 2 * hstep;
    const unsigned ldsw = (unsigned)wid * 1024u;
    const int aoff = lds_byte(wr * 64 + fr, fq * 8), boff = lds_byte(wc * 32 + fr, fq * 8);
#define PG8_SA(b, h) (((b) * 2 + (h)) * HTB)
#define PG8_SB(b, h) ((4 + (b) * 2 + (h)) * HTB)
#define PG8_STAGE(bufoff, gbase, voff) do { _Pragma("unroll") for (int _i = 0; _i < 2; ++_i) \
        __builtin_amdgcn_global_load_lds((const unsigned*)((const char*)(gbase) + (voff)[_i]), (PG8_LAS unsigned*)(lds + (bufoff) + ldsw + _i * 8192), 16, 0, 0); } while (0)
#define PG8_LDA(dst, b, h) do { _Pragma("unroll") for (int m = 0; m < 4; ++m) _Pragma("unroll") for (int k = 0; k < 2; ++k) dst[m][k] = *(const PG8_LAS bf16x8*)(lds + PG8_SA(b, h) + aoff + m * 2048 + k * 1024); } while (0)
#define PG8_LDB(dst, b, h) do { _Pragma("unroll") for (int n = 0; n < 2; ++n) _Pragma("unroll") for (int k = 0; k < 2; ++k) dst[n][k] = *(const PG8_LAS bf16x8*)(lds + PG8_SB(b, h) + boff + n * 2048 + k * 1024); } while (0)
#define PG8_MMA(ai, bj, At, Bt) do { __builtin_amdgcn_s_setprio(1); _Pragma("unroll") for (int m = 0; m < 4; ++m) _Pragma("unroll") for (int n = 0; n < 2; ++n) _Pragma("unroll") for (int k = 0; k < 2; ++k) \
        acc[ai][bj][m][n] = __builtin_amdgcn_mfma_f32_16x16x32_bf16(Bt[n][k], At[m][k], acc[ai][bj][m][n], 0, 0, 0); __builtin_amdgcn_s_setprio(0); } while (0)
#define PG8_WAIT_V(n) asm volatile("s_waitcnt vmcnt(" #n ")" ::: "memory")
#define PG8_WAIT_L(n) asm volatile("s_waitcnt lgkmcnt(" #n ")" ::: "memory")
#define PG8_BAR __builtin_amdgcn_s_barrier()
#define PG8_SCHED __builtin_amdgcn_sched_barrier(0)
    Unit cur, nxt; int ui = 0;
    if (!S.next(0, cur)) return;
    f32x4 acc[2][2][4][2];
#pragma unroll
    for (int a = 0; a < 2; ++a)
#pragma unroll
        for (int b = 0; b < 2; ++b)
#pragma unroll
            for (int m = 0; m < 4; ++m)
#pragma unroll
                for (int n = 0; n < 2; ++n) acc[a][b][m][n] = (f32x4){0.f, 0.f, 0.f, 0.f};
    bf16x8 At[4][2], B0[2][2], B1[2][2];
    const char* cA = (const char*)g.A + (size_t)cur.pm * tstep; const char* cB = (const char*)g.Bt + (size_t)cur.pn * tstep;
    S.a_ready(cur);
    PG8_STAGE(PG8_SB(0, 0), cB, voffB); PG8_STAGE(PG8_SA(0, 0), cA, voffA); PG8_STAGE(PG8_SB(0, 1), cB + hstep, voffB); PG8_STAGE(PG8_SA(0, 1), cA + hstep, voffA);
    if (wr == 1) PG8_BAR;
    PG8_WAIT_V(4); PG8_BAR;
    PG8_STAGE(PG8_SB(1, 0), cB + kstep, voffB); PG8_STAGE(PG8_SA(1, 0), cA + kstep, voffA); PG8_STAGE(PG8_SB(1, 1), cB + hstep + kstep, voffB);
    PG8_WAIT_V(6); PG8_BAR;
    PG8_STAMP();
    for (;;) {
        const bool has_next = S.next(ui + 1, nxt);
        const char* nA = has_next ? (const char*)g.A + (size_t)nxt.pm * tstep : cA; const char* nB = has_next ? (const char*)g.Bt + (size_t)nxt.pn * tstep : cB;
        for (int t = 0; t < nt; t += 2) {
            const bool last = (t == nt - 2);
            const char* a1 = cA + (size_t)(t + 1) * kstep;
            const char* a2 = last ? nA : cA + (size_t)(t + 2) * kstep; const char* b2 = last ? nB : cB + (size_t)(t + 2) * kstep;
            const char* a3 = a2 + kstep; const char* b3 = b2 + kstep;
            if (last && has_next) S.a_ready(nxt);
            PG8_LDB(B0, 0, 0); PG8_SCHED; PG8_LDA(At, 0, 0); PG8_STAGE(PG8_SA(1, 1), a1 + hstep, voffA);
            PG8_WAIT_L(8); PG8_BAR; PG8_WAIT_L(0); PG8_MMA(0, 0, At, B0); PG8_BAR; PG8_SCHED;
            PG8_LDB(B1, 0, 1); PG8_STAGE(PG8_SB(0, 0), b2, voffB);
            PG8_BAR; PG8_WAIT_L(0); PG8_MMA(0, 1, At, B1); PG8_BAR;
            PG8_LDA(At, 0, 1); PG8_STAGE(PG8_SA(0, 0), a2, voffA);
            PG8_BAR; PG8_WAIT_L(0); PG8_MMA(1, 0, At, B0); PG8_BAR; PG8_SCHED;
            PG8_STAGE(PG8_SB(0, 1), b2 + hstep, voffB);
            PG8_WAIT_V(6); PG8_BAR; PG8_MMA(1, 1, At, B1); PG8_BAR;
            PG8_LDB(B0, 1, 0); PG8_SCHED; PG8_LDA(At, 1, 0); PG8_STAGE(PG8_SA(0, 1), a2 + hstep, voffA);
            PG8_WAIT_L(8); PG8_BAR; PG8_WAIT_L(0); PG8_MMA(0, 0, At, B0); PG8_BAR; PG8_SCHED;
            PG8_LDB(B1, 1, 1); PG8_STAGE(PG8_SB(1, 0), b3, voffB);
            PG8_BAR; PG8_WAIT_L(0); PG8_MMA(0, 1, At, B1); PG8_BAR;
            PG8_LDA(At, 1, 1); PG8_STAGE(PG8_SA(1, 0), a3, voffA);
            PG8_BAR; PG8_WAIT_L(0); PG8_MMA(1, 0, At, B0); PG8_BAR; PG8_SCHED;
            PG8_STAGE(PG8_SB(1, 1), b3 + hstep, voffB);
            PG8_WAIT_V(6); PG8_BAR; PG8_MMA(1, 1, At, B1); PG8_BAR;
        }
        PG8_STAMP();
        if constexpr (!Epi::AFTER_DRAIN) { E(acc, cur, wr, wc, fr, fq); S.done(cur); }
        PG8_STAMP();
        if (!has_next) break;
#pragma unroll
        for (int a = 0; a < 2; ++a)
#pragma unroll
            for (int b = 0; b < 2; ++b)
#pragma unroll
                for (int m = 0; m < 4; ++m)
#pragma unroll
                    for (int n = 0; n < 2; ++n) acc[a][b][m][n] = (f32x4){0.f, 0.f, 0.f, 0.f};
        cur = nxt; cA = nA; cB = nB; ++ui;
    }
    PG8_WAIT_V(0);
    if (wr == 0) PG8_BAR;
    PG8_BAR;
    if constexpr (Epi::AFTER_DRAIN) { E.fused(acc, cur, wr, wc, fr, fq, lds, wid, lane); S.done(cur); }
    PG8_STAMP();
    if (STAMP && wid == 0) { stamps[lane] = lane < nts ? (((unsigned long long)(unsigned)ts_hi << 32) | (unsigned)ts_lo) : 0ull;
        if (lane == 62) stamps[62] = rt_entry; if (lane == 63) stamps[63] = (unsigned long long)wall_clock64(); }
#undef PG8_STAMP
#undef PG8_SA
#undef PG8_SB
#undef PG8_STAGE
#undef PG8_LDA
#undef PG8_LDB
#undef PG8_MMA
#undef PG8_WAIT_V
#undef PG8_WAIT_L
#undef PG8_BAR
#undef PG8_SCHED
}
}

struct EpiStoreBf16 {
    static constexpr bool PERM = true, AFTER_DRAIN = false;
    bf16_t* O; int ldc;
    __device__ __forceinline__ void operator()(const f32x4 (&acc)[2][2][4][2], const pg8::Unit& u, int wr, int wc, int fr, int fq) const {
        const int row0 = u.pm * 256 + wr * 64 + fr, col0 = u.pn * 256 + wc * 32 + 8 * fq;
#pragma unroll
        for (int ai = 0; ai < 2; ++ai)
#pragma unroll
            for (int m = 0; m < 4; ++m) { bf16_t* rowp = O + (size_t)(row0 + ai * 128 + m * 16) * ldc + col0;
#pragma unroll
                for (int bj = 0; bj < 2; ++bj) { const f32x4 v0 = acc[ai][bj][m][0], v1 = acc[ai][bj][m][1];
                    u32x4 w; w.x = pk2(v0[0], v0[1]); w.y = pk2(v0[2], v0[3]); w.z = pk2(v1[0], v1[1]); w.w = pk2(v1[2], v1[3]);
                    *(u32x4*)(rowp + bj * 128) = w; } }
    }
};
struct EpiResid {
    static constexpr bool PERM = false, AFTER_DRAIN = false;
    const float* xin_lat; const float* xin_ctx; float* xo; const float* mod_gate;
    __device__ __forceinline__ void operator()(const f32x4 (&acc)[2][2][4][2], const pg8::Unit& u, int wr, int wc, int fr, int fq) const {
        const int row0 = u.pm * 256 + wr * 64 + fr, col0 = u.pn * 256 + wc * 32 + 4 * fq;
        const int mrow = (u.pm < TL / 256) ? (u.pm >> 5) : 4;
        const float* xin = (u.pm < TL / 256) ? xin_lat : (xin_ctx - (size_t)TL * 1024);
        f32x4 gv[2][2];
#pragma unroll
        for (int bj = 0; bj < 2; ++bj)
#pragma unroll
            for (int n = 0; n < 2; ++n) gv[bj][n] = *(const f32x4*)(mod_gate + (size_t)mrow * 6144 + col0 + bj * 128 + n * 16);
#pragma unroll
        for (int ai = 0; ai < 2; ++ai)
#pragma unroll
            for (int m = 0; m < 4; ++m) { const size_t off = (size_t)(row0 + ai * 128 + m * 16) * 1024 + col0;
#pragma unroll
                for (int bj = 0; bj < 2; ++bj)
#pragma unroll
                    for (int n = 0; n < 2; ++n) { const f32x4 xi = *(const f32x4*)(xin + off + bj * 128 + n * 16);
                        *(f32x4*)(xo + off + bj * 128 + n * 16) = xi + gv[bj][n] * acc[ai][bj][m][n]; } }
    }
};
__device__ __forceinline__ float swiglu_(float g, float u) {
    g = fminf(g, 7.0f); u = fminf(fmaxf(u, -7.0f), 7.0f);
    return (u + 1.0f) * g * __builtin_amdgcn_rcpf(1.0f + fexp(-1.702f * g));
}
struct EpiGU {
    static constexpr bool PERM = true, AFTER_DRAIN = false;
    bf16_t* Act; const float* bias;
    __device__ __forceinline__ void operator()(const f32x4 (&acc)[2][2][4][2], const pg8::Unit& u, int wr, int wc, int fr, int fq) const {
        const int e = u.pn >> 3, pnl = u.pn & 7;
        const int row0 = u.pm * 256 + wr * 64 + fr, col0 = pnl * 256 + wc * 32 + 8 * fq;
        f32x4 bv[2][2];
#pragma unroll
        for (int bj = 0; bj < 2; ++bj)
#pragma unroll
            for (int n = 0; n < 2; ++n) bv[bj][n] = *(const f32x4*)(bias + (size_t)e * 2048 + col0 + bj * 128 + 4 * n);
#pragma unroll
        for (int ai = 0; ai < 2; ++ai)
#pragma unroll
            for (int m = 0; m < 4; ++m) { bf16_t* rowp = Act + (size_t)(row0 + ai * 128 + m * 16) * 1024 + (col0 >> 1);
#pragma unroll
                for (int bj = 0; bj < 2; ++bj) { const f32x4 v0 = acc[ai][bj][m][0] + bv[bj][0], v1 = acc[ai][bj][m][1] + bv[bj][1];
                    u32x2 w; w.x = pk2(swiglu_(v0[0], v0[1]), swiglu_(v0[2], v0[3])); w.y = pk2(swiglu_(v1[0], v1[1]), swiglu_(v1[2], v1[3]));
                    *(u32x2*)(rowp + bj * 64) = w; } }
    }
};
struct EpiDown {
    static constexpr bool PERM = true, AFTER_DRAIN = false;
    bf16_t* Y; const float* bias; const int* slot_a; const float* slot_g;
    __device__ __forceinline__ void operator()(const f32x4 (&acc)[2][2][4][2], const pg8::Unit& u, int wr, int wc, int fr, int fq) const {
        const int e = u.pn >> 2, pnl = u.pn & 3;
        const int row0 = u.pm * 256 + wr * 64 + fr, col0 = pnl * 256 + wc * 32 + 8 * fq;
        f32x4 bv[2][2];
#pragma unroll
        for (int bj = 0; bj < 2; ++bj)
#pragma unroll
            for (int n = 0; n < 2; ++n) bv[bj][n] = *(const f32x4*)(bias + (size_t)e * 1024 + col0 + bj * 128 + 4 * n);
#pragma unroll
        for (int ai = 0; ai < 2; ++ai)
#pragma unroll
            for (int m = 0; m < 4; ++m) { const int slot = row0 + ai * 128 + m * 16; const int a = slot_a[slot]; const float gt = slot_g[slot];
                if (a >= 0) { bf16_t* rowp = Y + (size_t)a * 1024 + col0;
#pragma unroll
                    for (int bj = 0; bj < 2; ++bj) { const f32x4 v0 = (acc[ai][bj][m][0] + bv[bj][0]) * gt, v1 = (acc[ai][bj][m][1] + bv[bj][1]) * gt;
                        u32x4 w; w.x = pk2(v0[0], v0[1]); w.y = pk2(v0[2], v0[3]); w.z = pk2(v1[0], v1[1]); w.w = pk2(v1[2], v1[3]);
                        *(u32x4*)(rowp + bj * 128) = w; } } }
    }
};
struct MoeOrder {
    const int* tile_e; int ntiles, nN, G, c;
    __device__ __forceinline__ bool next(int i, pg8::Unit& u) const {
        const int L = i * G + c; if (L >= ntiles * nN) return false;
        const int pm = L / nN, pl = L % nN; u.pm = pm; u.pn = __builtin_amdgcn_readfirstlane(tile_e[pm]) * nN + pl; return true;
    }
    __device__ __forceinline__ void a_ready(const pg8::Unit&) const {}
    __device__ __forceinline__ void done(const pg8::Unit&) const {}
};

__device__ __forceinline__ void transpose_tile(int wv, const float* __restrict__ src, int ldsrc, int k0, int n0, int nmax, bf16_t* __restrict__ dst, int ldd, LAS unsigned char* lds) {
    LAS bf16_t* T = (LAS bf16_t*)lds;
    const int tid = otid(wv), r = tid >> 4, c4 = (tid & 15) * 4;
#pragma unroll
    for (int pass = 0; pass < 2; ++pass) { const int k = r + 32 * pass;
        f32x4 v = (f32x4){0.f, 0.f, 0.f, 0.f};
        if (n0 + c4 < nmax) v = *(const f32x4*)(src + (size_t)(k0 + k) * ldsrc + n0 + c4);
#pragma unroll
        for (int i = 0; i < 4; ++i) T[(c4 + i) * 66 + k] = f2bf(v[i]); }
    __syncthreads();
    { const int n = tid >> 3, kc = (tid & 7) * 8;
      if (n0 + n < nmax) { const LAS unsigned* tp = (const LAS unsigned*)(T + n * 66 + kc); u32x4 w; w.x = tp[0]; w.y = tp[1]; w.z = tp[2]; w.w = tp[3];
          *(u32x4*)(dst + (size_t)(n0 + n) * ldd + k0 + kc) = w; } }
    __syncthreads();
}

__device__ __forceinline__ void phase_prologue(int wv, const Params& p, LAS unsigned char* lds) {
    const int tid = otid(wv), bid = blockIdx.x, nblk = gridDim.x;
    unsigned char* ws = opq(p.ws);
    bf16_t* WGU = (bf16_t*)(ws + WS_WGU); bf16_t* WDN = (bf16_t*)(ws + WS_WDN); bf16_t* WOUT = (bf16_t*)(ws + WS_WOUT); bf16_t* WIN = (bf16_t*)(ws + WS_WIN); bf16_t* WRT = (bf16_t*)(ws + WS_WRT);
    float* MOD = (float*)(ws + WS_MOD); float2* RA = (float2*)(ws + WS_RA); float2* RD = (float2*)(ws + WS_RD);
    constexpr int T_WGU = 64 * 16 * 32, T_WDN = 64 * 16 * 16, T_WOUT = 2 * 256, T_WIN = 2 * 16 * 42, T_FOLD = 2 * 64, T_ADA = 2 * 96, T_ROPE = SEQ * 48 / 512, T_WRT = 2 * 32 * 1024 / 512, T_PAD = 2 * 16 * 1024 / 512;
    constexpr int O_WDN = T_WGU, O_WOUT = O_WDN + T_WDN, O_WIN = O_WOUT + T_WOUT, O_FOLD = O_WIN + T_WIN, O_ADA = O_FOLD + T_FOLD, O_ROPE = O_ADA + T_ADA, O_WRT = O_ROPE + T_ROPE, O_PAD = O_WRT + T_WRT, NTASK = O_PAD + T_PAD;
    for (int task = bid; task < NTASK; task += nblk) {
        if (task < O_WDN) {
            const int mat = task >> 9, t = task & 511, kt = t >> 5, nt = t & 31;
            transpose_tile(wv, p.w_gu + (size_t)mat * 1024 * 2048, 2048, kt * 64, nt * 64, 2048, WGU + (size_t)mat * 2048 * 1024, 1024, lds);
        } else if (task < O_WOUT) {
            const int tt = task - O_WDN, mat = tt >> 8, t = tt & 255, kt = t >> 4, nt = t & 15;
            transpose_tile(wv, p.w_down + (size_t)mat * 1024 * 1024, 1024, kt * 64, nt * 64, 1024, WDN + (size_t)mat * 1024 * 1024, 1024, lds);
        } else if (task < O_WIN) {
            const int tt = task - O_WOUT, mat = tt >> 8, t = tt & 255, kt = t >> 4, nt = t & 15;
            transpose_tile(wv, p.w_out + (size_t)mat * 1024 * 1024, 1024, kt * 64, nt * 64, 1024, WOUT + (size_t)mat * 1024 * 1024, 1024, lds);
        } else if (task < O_FOLD) {
            const int tt = task - O_WIN, mat = tt / (16 * 42), t = tt % (16 * 42), kt = t / 42, nt = t % 42;
            transpose_tile(wv, p.w_in + (size_t)mat * 1024 * INC, INC, kt * 64, nt * 64, INC, WIN + (size_t)mat * NP * 1024, 1024, lds);
        } else if (task < O_ADA) {
            const int tt = task - O_FOLD, l = tt >> 6, k0 = (tt & 63) * 16;
            LAS float* Aq = (LAS float*)lds;
            LAS float* Akv = Aq + 16 * 192;
            for (int i = tid; i < 16 * 192; i += NTHR) { const int r = i / 192, j = i % 192; Aq[i] = p.w_in[((size_t)l * 1024 + k0 + r) * INC + PC_DCQ + j] * p.mla_g_q[l * 192 + j]; }
            for (int i = tid; i < 16 * 128; i += NTHR) { const int r = i / 128, j = i % 128; Akv[i] = p.w_in[((size_t)l * 1024 + k0 + r) * INC + PC_DCKV + j] * p.mla_g_kv[l * 128 + j]; }
            __syncthreads();
            for (int n = tid; n < 896; n += NTHR) {
                float acc[16];
#pragma unroll
                for (int r = 0; r < 16; ++r) acc[r] = 0.f;
                if (n < 384) { const float* W = p.mla_w_uq + (size_t)l * 192 * 384 + n;
                    for (int j = 0; j < 192; ++j) { const float wv = W[(size_t)j * 384];
#pragma unroll
                        for (int r = 0; r < 16; ++r) acc[r] += Aq[r * 192 + j] * wv; }
                } else { const float* W = p.mla_w_ukv + (size_t)l * 128 * 512 + (n - 384);
                    for (int j = 0; j < 128; ++j) { const float wv = W[(size_t)j * 512];
#pragma unroll
                        for (int r = 0; r < 16; ++r) acc[r] += Akv[r * 128 + j] * wv; } }
                u32x4 w0, w1; w0.x = pk2(acc[0], acc[1]); w0.y = pk2(acc[2], acc[3]); w0.z = pk2(acc[4], acc[5]); w0.w = pk2(acc[6], acc[7]);
                w1.x = pk2(acc[8], acc[9]); w1.y = pk2(acc[10], acc[11]); w1.z = pk2(acc[12], acc[13]); w1.w = pk2(acc[14], acc[15]);
                bf16_t* d = WIN + ((size_t)l * NP + PC_DQF + n) * 1024 + k0; *(u32x4*)d = w0; *(u32x4*)(d + 8) = w1;
            }
            __syncthreads();
        } else if (task < O_ROPE) {
            const int tt = task - O_ADA, l = tt / 96, n0 = (tt % 96) * 64;
            LAS float* SC = (LAS float*)lds;
            LAS float* RED = SC + 5 * 1024;
            for (int i = tid; i < 5 * 1024; i += NTHR) { const int r = i >> 10, k = i & 1023; const float v = (r < 4) ? p.c[r * 1024 + k] : p.c_ctx[k]; SC[i] = siluf_(v); }
            __syncthreads();
            { const int kc = tid >> 6, col = tid & 63; float a[5] = {0.f, 0.f, 0.f, 0.f, 0.f};
              const float* W = p.w_ada + ((size_t)l * 1024 + kc * 128) * 6144 + n0 + col;
              for (int k = 0; k < 128; ++k) { const float wv = W[(size_t)k * 6144];
#pragma unroll
                  for (int r = 0; r < 5; ++r) a[r] += SC[r * 1024 + kc * 128 + k] * wv; }
#pragma unroll
              for (int r = 0; r < 5; ++r) RED[(kc * 5 + r) * 64 + col] = a[r]; }
            __syncthreads();
            if (tid < 320) { const int r = tid >> 6, col = tid & 63; float s = p.b_ada[l * 6144 + n0 + col];
#pragma unroll
                for (int kc = 0; kc < 8; ++kc) s += RED[(kc * 5 + r) * 64 + col];
                MOD[((size_t)l * 5 + r) * 6144 + n0 + col] = s; }
            __syncthreads();
        } else if (task < O_WRT) {
            const int idx = (task - O_ROPE) * 512 + tid, t = idx / 48, j = idx % 48;
            if (j < 32) { const int i = j & 15; const float inv = powf(10000.0f, -(float)(2 * i) / 32.0f); const float pos = (j < 16) ? (float)(t >> 6) : (float)(t & 63);
                float s, c; sincosf(pos * inv, &s, &c); RA[t * 32 + j] = make_float2(c, s); }
            else { const int jj = j - 32, i = jj & 7; const float inv = powf(10000.0f, -(float)(2 * i) / 16.0f); const float pos = (jj < 8) ? (float)(t >> 6) : (float)(t & 63);
                float s, c; sincosf(pos * inv, &s, &c); RD[t * 16 + jj] = make_float2(c, s); }
        } else if (task < O_PAD) {
            const int idx = (task - O_WRT) * 512 + tid, l = idx >> 15, e = (idx >> 10) & 31, k = idx & 1023;
            const float w = p.w_router[((size_t)l * 1024 + k) * 32 + e]; const unsigned short hi = f2bf(w); const unsigned short lo = f2bf(w - bf2f(hi));
            WRT[(((size_t)l * 2 + 0) * 32 + e) * 1024 + k] = hi; WRT[(((size_t)l * 2 + 1) * 32 + e) * 1024 + k] = lo;
        } else {
            const int idx = (task - O_PAD) * 512 + tid, l = idx >> 14, r = (idx >> 10) & 15, k = idx & 1023;
            WIN[((size_t)l * NP + PC_END + r) * 1024 + k] = 0;
        }
    }
}

__device__ __forceinline__ void phase_norm1_l0(int wv, const Params& p) {
    const int tid = otid(wv), lane = tid & 63, gw = blockIdx.x * NWAVE + (tid >> 6), nw = gridDim.x * NWAVE;
    const float* MOD = (const float*)(p.ws + WS_MOD); bf16_t* HB = (bf16_t*)(p.ws + WS_HB);
    for (int r = gw; r < TA; r += nw) {
        const float* src = (r < TL) ? p.x + (size_t)r * 1024 : p.ctx + (size_t)(r - TL) * 1024;
        const int mrow = (r < TL) ? (r >> 13) : 4; const float* mod = MOD + (size_t)mrow * 6144;
        f32x4 v[4]; row_load(src, lane, v); const float rstd = row_rstd(v);
        row_modulate(v, rstd, p.g_norm1, mod + 1024, mod, lane);
        row_store_bf16(HB + (size_t)r * 1024, lane, v);
    }
}
__device__ __forceinline__ void phase_combine(int wv, const Params& p, int l) {
    const int tid = otid(wv), lane = tid & 63, gw = blockIdx.x * NWAVE + (tid >> 6), nw = gridDim.x * NWAVE;
    const float* MOD = (const float*)(p.ws + WS_MOD); bf16_t* HB = (bf16_t*)(p.ws + WS_HB); const bf16_t* Y = (const bf16_t*)(p.ws + WS_Y);
    const float* XA = (const float*)(p.ws + WS_XA); float* XB = (float*)(p.ws + WS_XB);
    const int T = (l == 0) ? TA : TL;
    for (int r = gw; r < T; r += nw) {
        const int mrow = (r < TL) ? (r >> 13) : 4; const float* mod = MOD + ((size_t)l * 5 + mrow) * 6144;
        f32x4 v[4]; row_load(XA + (size_t)r * 1024, lane, v);
#pragma unroll
        for (int i = 0; i < 4; ++i) {
            f32x4 s = (f32x4){0.f, 0.f, 0.f, 0.f};
#pragma unroll
            for (int k = 0; k < 4; ++k) { const u32x2 w = *(const u32x2*)(Y + ((size_t)r * 4 + k) * 1024 + i * 256 + lane * 4);
                s[0] += bf2f(w.x & 0xffffu); s[1] += bf2f(w.x >> 16); s[2] += bf2f(w.y & 0xffffu); s[3] += bf2f(w.y >> 16); }
            const f32x4 g2 = *(const f32x4*)(mod + 5 * 1024 + i * 256 + lane * 4);
            v[i] = v[i] + g2 * s;
        }
        const float rstd = row_rstd(v);
        if (l == 0) {
#pragma unroll
            for (int i = 0; i < 4; ++i) *(f32x4*)(XB + (size_t)r * 1024 + i * 256 + lane * 4) = v[i];
            const float* mod1 = MOD + ((size_t)5 + mrow) * 6144;
            row_modulate(v, rstd, p.g_norm1 + 1024, mod1 + 1024, mod1, lane);
            row_store_bf16(HB + (size_t)r * 1024, lane, v);
        } else {
#pragma unroll
            for (int i = 0; i < 4; ++i) { const f32x4 gg = *(const f32x4*)(p.g_final + i * 256 + lane * 4);
                *(f32x4*)(p.out + (size_t)r * 1024 + i * 256 + lane * 4) = v[i] * rstd * gg; }
        }
    }
}

__device__ __forceinline__ int cu_index(int b, int tc, int h, int dir) { return ((b * NCHUNK + tc) * 4 + h) * 2 + dir; }
__device__ __forceinline__ float logsigmoidf_(float x) { return fminf(x, 0.f) - log1pf(__expf(-fabsf(x))); }

__device__ __forceinline__ void phase_prep(int wv, const Params& p, int l, LAS unsigned char* lds) {
    const int tid = otid(wv), lane = tid & 63, w = tid >> 6;
    unsigned char* ws = opq(p.ws);
    const bf16_t* P = (const bf16_t*)(ws + WS_P);
    bf16_t* QA = (bf16_t*)(ws + WS_QA); bf16_t* KA = (bf16_t*)(ws + WS_KA); bf16_t* QD = (bf16_t*)(ws + WS_QD); bf16_t* KD = (bf16_t*)(ws + WS_KD); bf16_t* VD = (bf16_t*)(ws + WS_VD);
    bf16_t* QC = (bf16_t*)(ws + WS_QC); bf16_t* KC = (bf16_t*)(ws + WS_KC); float* GATES = (float*)(ws + WS_GATES);
    float* DC = (float*)(ws + WS_DC); float* DN = (float*)(ws + WS_DN); float* DFA = (float*)(ws + WS_DFA);
    const float2* RA = (const float2*)(ws + WS_RA); const float2* RD = (const float2*)(ws + WS_RD);
    LAS bf16_t* KCL = (LAS bf16_t*)lds;
    LAS float* GL = (LAS float*)(lds + 32768);
    LAS float* WL = (LAS float*)(lds + 36864);
    LAS float* RQ = (LAS float*)(lds + 38912);
    LAS unsigned char* KW = lds + 40960;
    LAS unsigned char* VT = lds + 65536;
    constexpr int NCH = TA / 64;
    for (int ch = blockIdx.x; ch < NCH; ch += gridDim.x) {
        const bool is_ctx = ch >= TL / 64;
        const int cc = ch - TL / 64;
        const int b = is_ctx ? (cc >> 2) : (ch >> 7), tc = is_ctx ? 128 + (cc & 3) : (ch & 127);
        const int row0 = ch * 64, t0 = is_ctx ? (cc & 3) * 64 : (ch & 127) * 64, nseq = is_ctx ? CTXL : SEQ;
        for (int it = tid; it < 64 * 24; it += NTHR) {
            const int i = it / 24, r = it % 24, head = r >> 2, j0 = (r & 3) * 8;
            const size_t prow = (size_t)(row0 + i) * NP;
            const bf16_t* src = P + prow + (head < 4 ? PC_AQ + head * 64 : PC_AK + (head - 4) * 64) + j0;
            const u32x4 a = *(const u32x4*)src, bq = *(const u32x4*)(src + 32);
            u32x4 o1, o2;
            if (is_ctx) { o1 = a; o2 = bq; }
            else { const float2* tab = RA + (size_t)(t0 + i) * 32 + j0;
#pragma unroll
                for (int q = 0; q < 4; ++q) { const float x1a = bf2f(a[q] & 0xffffu), x1b = bf2f(a[q] >> 16), x2a = bf2f(bq[q] & 0xffffu), x2b = bf2f(bq[q] >> 16);
                    const float2 ca = tab[2 * q], cb = tab[2 * q + 1];
                    o1[q] = pk2(x1a * ca.x - x2a * ca.y, x1b * cb.x - x2b * cb.y); o2[q] = pk2(x2a * ca.x + x1a * ca.y, x2b * cb.x + x1b * cb.y); } }
            bf16_t* dst = (head < 4) ? QA + (size_t)(row0 + i) * 256 + head * 64 + j0 : KA + (size_t)(row0 + i) * 128 + (head - 4) * 64 + j0;
            *(u32x4*)dst = o1; *(u32x4*)(dst + 32) = o2;
        }
        for (int i = w; i < 64; i += NWAVE) {
            const bf16_t* pr = P + (size_t)(row0 + i) * NP;
            float sq = 0.f, sk = 0.f;
#pragma unroll
            for (int j = 0; j < 3; ++j) { const float v = bf2f(pr[PC_DCQ + j * 64 + lane]); sq += v * v; }
#pragma unroll
            for (int j = 0; j < 2; ++j) { const float v = bf2f(pr[PC_DCKV + j * 64 + lane]); sk += v * v; }
            sq = wave_sum(sq); sk = wave_sum(sk);
            if (lane == 0) { RQ[i] = rsqrtf(sq * (1.0f / 192.0f) + EPS); RQ[64 + i] = rsqrtf(sk * (1.0f / 128.0f) + EPS); }
        }
        for (int it = tid; it < 64 * 64; it += NTHR) {
            const int i = it >> 6, c0 = (it & 63) * 8, t = t0 + i;
            const bf16_t* src = P + (size_t)(row0 + i) * NP + PC_CQK + c0;
            const u32x4 u1 = *(const u32x4*)src;
            u32x4 u0 = (u32x4){0u, 0u, 0u, 0u}, u2 = (u32x4){0u, 0u, 0u, 0u};
            if (t > 0) u0 = *(const u32x4*)(src - NP);
            if (t + 1 < nseq) u2 = *(const u32x4*)(src + NP);
            const float* cw = p.mlstm_conv + (size_t)l * 3 * 512 + c0;
            const float sc = (c0 >= 256) ? 0.125f : 1.0f;
            u32x4 o;
#pragma unroll
            for (int q = 0; q < 4; ++q) {
                const float ya = cw[2 * q] * bf2f(u0[q] & 0xffffu) + cw[512 + 2 * q] * bf2f(u1[q] & 0xffffu) + cw[1024 + 2 * q] * bf2f(u2[q] & 0xffffu);
                const float yb = cw[2 * q + 1] * bf2f(u0[q] >> 16) + cw[512 + 2 * q + 1] * bf2f(u1[q] >> 16) + cw[1024 + 2 * q + 1] * bf2f(u2[q] >> 16);
                o[q] = pk2(siluf_(ya) * sc, siluf_(yb) * sc); }
            if (c0 < 256) *(u32x4*)(QC + (size_t)(row0 + i) * 256 + c0) = o;
            else { *(u32x4*)(KC + (size_t)(row0 + i) * 256 + (c0 - 256)) = o; *(LAS u32x4*)(KCL + i * 256 + (c0 - 256)) = o; }
        }
        for (int it = tid; it < 64 * 16; it += NTHR) {
            const int i = it >> 4, gi = it & 15;
            float v = bf2f(P[(size_t)(row0 + i) * NP + PC_CG + gi]) + p.mlstm_gate_bias[l * 16 + gi];
            if ((gi >> 2) & 1) v = logsigmoidf_(v);
            GL[it] = v; GATES[(size_t)(row0 + i) * 16 + gi] = v;
        }
        __syncthreads();
        for (int it = tid; it < 64 * 1024; it += NTHR) {
            const int i = it >> 10, c = it & 1023, t = t0 + i;
            const bf16_t* pr = P + (size_t)(row0 + i) * NP;
            if (c < 384) {
                const int h = c / 96, d = c % 96; float v;
                if (d < 64 || is_ctx) v = bf2f(pr[PC_DQF + c]);
                else { const int j = d - 64, jj = j & 15; const float x1 = bf2f(pr[PC_DQF + h * 96 + 64 + jj]), x2 = bf2f(pr[PC_DQF + h * 96 + 80 + jj]); const float2 cs = RD[(size_t)t * 16 + jj];
                    v = (j < 16) ? x1 * cs.x - x2 * cs.y : x2 * cs.x + x1 * cs.y; }
                QD[(size_t)(row0 + i) * 384 + c] = f2bf(v * RQ[i]);
            } else if (c < 768) {
                const int c2 = c - 384, h = c2 / 96, d = c2 % 96; float v;
                if (d < 64) v = bf2f(pr[PC_DKVF + h * 128 + d]) * RQ[64 + i];
                else { const int j = d - 64;
                    if (is_ctx) v = bf2f(pr[PC_DKR + j]);
                    else { const int jj = j & 15; const float x1 = bf2f(pr[PC_DKR + jj]), x2 = bf2f(pr[PC_DKR + 16 + jj]); const float2 cs = RD[(size_t)t * 16 + jj];
                        v = (j < 16) ? x1 * cs.x - x2 * cs.y : x2 * cs.x + x1 * cs.y; } }
                KD[(size_t)(row0 + i) * 384 + c2] = f2bf(v);
            } else {
                const int c2 = c - 768, h = c2 >> 6, d = c2 & 63;
                VD[(size_t)(row0 + i) * 256 + c2] = f2bf(bf2f(pr[PC_DKVF + h * 128 + 64 + d]) * RQ[64 + i]);
            }
        }
        {
            const int dir = w >> 2, hd = w & 3, i = dir ? 63 - lane : lane;
            const float lf = GL[i * 16 + (dir ? 12 : 4) + hd], ig = GL[i * 16 + (dir ? 8 : 0) + hd];
            const float bc = wave_incl_sum(lf, lane), bend = __shfl(bc, 63);
            const float val = bend - bc + ig, a = wave_max(val);
            WL[(dir * 4 + hd) * 64 + i] = fexp(val - a);
            if (lane == 0) { float* fa = DFA + (size_t)cu_index(b, tc, hd, dir) * 2; fa[0] = bend; fa[1] = a; }
        }
        __syncthreads();
        for (int hd = 0; hd < 4; ++hd) {
            {
                const int s = tid >> 3, part = tid & 7;
                const u32x4 kv = *(const LAS u32x4*)(KCL + s * 256 + hd * 64 + part * 8);
#pragma unroll
                for (int dir = 0; dir < 2; ++dir) { const float wt = WL[(dir * 4 + hd) * 64 + s]; u32x4 o;
#pragma unroll
                    for (int q = 0; q < 4; ++q) o[q] = pk2(bf2f(kv[q] & 0xffffu) * wt, bf2f(kv[q] >> 16) * wt);
                    *(LAS u32x4*)(KW + dir * 12288 + s * 192 + part * 16) = o; }
                *(LAS u32x4*)(VT + s * 192 + part * 16) = *(const u32x4*)(P + (size_t)(row0 + s) * NP + PC_CV + hd * 64 + part * 8);
            }
            __syncthreads();
            {
                const int dir = w >> 2, dvb = (w >> 1) & 1, dkb = w & 1, hh = lane >> 5, l31 = lane & 31;
                const int q4 = (lane & 15) >> 2, colo = 16 * ((lane >> 4) & 1) + 4 * (lane & 3);
                f32x16 acc = zero16();
#pragma unroll
                for (int ks = 0; ks < 4; ++ks) {
                    const int r0 = 16 * ks + 8 * hh + q4;
                    const bf16x8 af = cat8(tr_read(VT + r0 * 192 + (32 * dvb + colo) * 2), tr_read(VT + (r0 + 4) * 192 + (32 * dvb + colo) * 2));
                    const bf16x8 bfr = cat8(tr_read(KW + dir * 12288 + r0 * 192 + (32 * dkb + colo) * 2), tr_read(KW + dir * 12288 + (r0 + 4) * 192 + (32 * dkb + colo) * 2));
                    acc = mfma32(af, bfr, acc);
                }
                float* dc = DC + (size_t)cu_index(b, tc, hd, dir) * 4096;
#pragma unroll
                for (int r = 0; r < 16; ++r) { const int dv = 32 * dvb + (r & 3) + 8 * (r >> 2) + 4 * hh; dc[dv * 64 + 32 * dkb + l31] = acc[r]; }
                if (tid < 128) { const int d2 = tid >> 6, dk = tid & 63; float s = 0.f;
                    for (int ss = 0; ss < 64; ++ss) s += bf2f(*(const LAS bf16_t*)(KW + d2 * 12288 + ss * 192 + dk * 2));
                    DN[(size_t)cu_index(b, tc, hd, d2) * 64 + dk] = s; }
            }
            __syncthreads();
        }
    }
}

__device__ __forceinline__ void phase_scan(int wv, const Params& p, LAS unsigned char* lds) {
    const int tid = otid(wv);
    unsigned char* ws = opq(p.ws);
    const float* DC = (const float*)(ws + WS_DC); const float* DN = (const float*)(ws + WS_DN); const float* DFA = (const float*)(ws + WS_DFA);
    bf16_t* CS = (bf16_t*)(ws + WS_CS); float* NS = (float*)(ws + WS_NS); float* MS = (float*)(ws + WS_MS);
    LAS float* FA = (LAS float*)lds;
    LAS float* AL = FA + 2 * NCHUNK;
    LAS float* BE = AL + NCHUNK;
    LAS int* UI = (LAS int*)(BE + NCHUNK);
    for (int u = blockIdx.x; u < 256; u += gridDim.x) {
        const int slice = u & 7, dir = (u >> 3) & 1, h = (u >> 4) & 3, b = u >> 6;
        if (tid < NCHUNK) { const int j = tid; const int tc = dir ? ((j < 4) ? 128 + (3 - j) : 131 - j) : ((j < 4) ? 128 + j : j - 4);
            const int ui = cu_index(b, tc, h, dir); UI[j] = ui; FA[2 * j] = DFA[(size_t)ui * 2]; FA[2 * j + 1] = DFA[(size_t)ui * 2 + 1]; }
        __syncthreads();
        if (tid == 0) { float m = 0.f;
            for (int j = 0; j < NCHUNK; ++j) { const float F = FA[2 * j], a = FA[2 * j + 1]; const float mn = fmaxf(F + m, a);
                AL[j] = fexp(F + m - mn); BE[j] = fexp(a - mn); if (slice == 0) MS[UI[j]] = m; m = mn; } }
        __syncthreads();
        { const int e = slice * 512 + tid; float c = 0.f;
#pragma unroll 4
          for (int j = 0; j < NCHUNK; ++j) { const int ui = UI[j]; CS[(size_t)ui * 4096 + e] = f2bf(c); c = AL[j] * c + BE[j] * DC[(size_t)ui * 4096 + e]; } }
        if (slice == 0 && tid < 64) { float n = 0.f;
            for (int j = 0; j < NCHUNK; ++j) { const int ui = UI[j]; NS[(size_t)ui * 64 + tid] = n; n = AL[j] * n + BE[j] * DN[(size_t)ui * 64 + tid]; } }
        __syncthreads();
    }
}

template <class Pol>
__device__ __forceinline__ void attn_core(int wv, LAS unsigned char* lds, const Pol& pol) {
    constexpr int DQ = Pol::DQ, KS = DQ / 16, KROW = DQ * 2 + 16, VROW = 192, KBUF = 64 * KROW, VBUF = 64 * VROW, KCH = DQ / 8;
    const int tid = otid(wv), lane = tid & 63, hh = lane >> 5, l31 = lane & 31;
    LAS unsigned char* kb = lds; LAS unsigned char* vb = lds + 2 * KBUF;
    bf16x8 qf[KS];
#pragma unroll
    for (int ks = 0; ks < KS; ++ks) { const u32x4 raw = *(const u32x4*)(pol.qrow + 16 * ks + 8 * hh); u32x4 sc;
#pragma unroll
        for (int q = 0; q < 4; ++q) sc[q] = pk2(bf2f(raw[q] & 0xffffu) * pol.qscale, bf2f(raw[q] >> 16) * pol.qscale);
        qf[ks] = as_bf16x8(sc); }
    f32x16 O0 = zero16(), O1 = zero16();
    float m = pol.m0, lsum = (hh == 0) ? pol.l0 : 0.f;
    const int kkey0 = tid / KCH, kpart0 = tid % KCH, c1 = tid + NTHR, kkey1 = c1 / KCH, kpart1 = c1 % KCH; const bool has1 = c1 < 64 * KCH;
    const int vkey = tid >> 3, vpart = tid & 7;
    u32x4 kr0, kr1 = (u32x4){0u, 0u, 0u, 0u}, vr;
    const int q4 = (lane & 15) >> 2, colo = 16 * ((lane >> 4) & 1) + 4 * (lane & 3);
    const int nt = pol.ntiles;
#define ATT_GLOAD(t) do { const bf16_t* kp_; const bf16_t* vp_; int ks_, vs_; pol.tile_ptrs((t), kp_, ks_, vp_, vs_); \
        kr0 = *(const u32x4*)(kp_ + (size_t)kkey0 * ks_ + kpart0 * 8); if (has1) kr1 = *(const u32x4*)(kp_ + (size_t)kkey1 * ks_ + kpart1 * 8); \
        vr = *(const u32x4*)(vp_ + (size_t)vkey * vs_ + vpart * 8); } while (0)
#define ATT_LSTORE(buf) do { *(LAS u32x4*)(kb + (buf) * KBUF + kkey0 * KROW + kpart0 * 16) = kr0; if (has1) *(LAS u32x4*)(kb + (buf) * KBUF + kkey1 * KROW + kpart1 * 16) = kr1; \
        *(LAS u32x4*)(vb + (buf) * VBUF + vkey * VROW + vpart * 16) = vr; } while (0)
    ATT_GLOAD(0); ATT_LSTORE(0); __syncthreads();
    for (int t = 0; t < nt; ++t) {
        const int buf = t & 1;
        if (t + 1 < nt) ATT_GLOAD(t + 1);
        if (pol.wave_active(t)) {
            LAS unsigned char* kt = kb + buf * KBUF; LAS unsigned char* vt = vb + buf * VBUF;
            f32x16 s0 = zero16(), s1 = zero16();
#pragma unroll
            for (int ks = 0; ks < KS; ++ks) {
                const bf16x8 a0 = *(const LAS bf16x8*)(kt + l31 * KROW + (16 * ks + 8 * hh) * 2);
                const bf16x8 a1 = *(const LAS bf16x8*)(kt + (32 + l31) * KROW + (16 * ks + 8 * hh) * 2);
                s0 = mfma32(a0, qf[ks], s0); s1 = mfma32(a1, qf[ks], s1);
            }
            if (pol.tile_masked(t)) {
#pragma unroll
                for (int r = 0; r < 16; ++r) { const int kl = (r & 3) + 8 * (r >> 2) + 4 * hh; s0[r] = pol.score(s0[r], t, kl); s1[r] = pol.score(s1[r], t, 32 + kl); }
            }
            float mx = s0[0];
#pragma unroll
            for (int r = 1; r < 16; ++r) mx = fmaxf(mx, s0[r]);
#pragma unroll
            for (int r = 0; r < 16; ++r) mx = fmaxf(mx, s1[r]);
            mx = fmaxf(mx, __shfl_xor(mx, 32));
            const float mn = fmaxf(m, mx), alpha = fexp2(m - mn); m = mn;
            float ps = 0.f;
#pragma unroll
            for (int r = 0; r < 16; ++r) { s0[r] = fexp2(s0[r] - mn); s1[r] = fexp2(s1[r] - mn); ps += s0[r] + s1[r]; }
            lsum = lsum * alpha + ps;
#pragma unroll
            for (int r = 0; r < 16; ++r) { O0[r] *= alpha; O1[r] *= alpha; }
            bf16x8 pf[2][2];
#pragma unroll
            for (int s = 0; s < 2; ++s) { u32x4 w0, w1;
#pragma unroll
                for (int q = 0; q < 4; ++q) { w0[q] = pk2(s0[8 * s + 2 * q], s0[8 * s + 2 * q + 1]); w1[q] = pk2(s1[8 * s + 2 * q], s1[8 * s + 2 * q + 1]); }
                pf[0][s] = as_bf16x8(w0); pf[1][s] = as_bf16x8(w1); }
#pragma unroll
            for (int kbk = 0; kbk < 2; ++kbk)
#pragma unroll
                for (int s = 0; s < 2; ++s) {
                    const int r0 = 32 * kbk + 16 * s + 4 * hh + q4;
                    const bf16x8 v0 = cat8(tr_read(vt + r0 * VROW + colo * 2), tr_read(vt + (r0 + 8) * VROW + colo * 2));
                    const bf16x8 v1 = cat8(tr_read(vt + r0 * VROW + (32 + colo) * 2), tr_read(vt + (r0 + 8) * VROW + (32 + colo) * 2));
                    O0 = mfma32(v0, pf[kbk][s], O0); O1 = mfma32(v1, pf[kbk][s], O1);
                }
        }
        if (t + 1 < nt) ATT_LSTORE(buf ^ 1);
        __syncthreads();
    }
#undef ATT_GLOAD
#undef ATT_LSTORE
    lsum += __shfl_xor(lsum, 32);
    const float inv = 1.0f / lsum;
#pragma unroll
    for (int g = 0; g < 4; ++g) {
        u32x2 w0, w1;
        w0.x = pk2(O0[4 * g] * inv, O0[4 * g + 1] * inv); w0.y = pk2(O0[4 * g + 2] * inv, O0[4 * g + 3] * inv);
        w1.x = pk2(O1[4 * g] * inv, O1[4 * g + 1] * inv); w1.y = pk2(O1[4 * g + 2] * inv, O1[4 * g + 3] * inv);
        *(u32x2*)(pol.orow + 8 * g + 4 * hh) = w0; *(u32x2*)(pol.orow + 32 + 8 * g + 4 * hh) = w1;
    }
}

constexpr float NEG_INF = -__builtin_inff();
struct PolD {
    static constexpr int DQ = 96;
    const bf16_t *kbase, *vbase, *kctx, *vctx, *qrow; bf16_t* orow; int nloc, ntiles; float qscale, m0, l0;
    __device__ __forceinline__ void tile_ptrs(int t, const bf16_t*& kp, int& ks, const bf16_t*& vp, int& vs) const {
        ks = 384; vs = 256;
        if (t < nloc) { kp = kbase + (size_t)t * 64 * 384; vp = vbase + (size_t)t * 64 * 256; } else { kp = kctx + (size_t)(t - nloc) * 64 * 384; vp = vctx + (size_t)(t - nloc) * 64 * 256; } }
    __device__ __forceinline__ bool wave_active(int) const { return true; }
    __device__ __forceinline__ bool tile_masked(int) const { return false; }
    __device__ __forceinline__ float score(float s, int, int) const { return s; }
};
struct PolA {
    static constexpr int DQ = 64;
    const bf16_t *kbase, *vbase, *kctx, *vctx, *qrow; bf16_t* orow; int nloc, ntiles; float qscale, m0, l0;
    int kp0, q0, qpos;
    __device__ __forceinline__ void tile_ptrs(int t, const bf16_t*& kp, int& ks, const bf16_t*& vp, int& vs) const {
        ks = 128; vs = NP;
        if (t < nloc) { const int k0 = kp0 + 64 * t; kp = kbase + (size_t)k0 * 128; vp = vbase + (size_t)k0 * NP; } else { kp = kctx + (size_t)(t - nloc) * 64 * 128; vp = vctx + (size_t)(t - nloc) * 64 * NP; } }
    __device__ __forceinline__ bool wave_active(int t) const { const int k0 = kp0 + 64 * t; return t >= nloc || (k0 + 63 >= q0 - 128 && k0 <= q0 + 31 + 128); }
    __device__ __forceinline__ bool tile_masked(int t) const { const int k0 = kp0 + 64 * t; return t < nloc && !(k0 >= q0 + 31 - 128 && k0 + 63 <= q0 + 128); }
    __device__ __forceinline__ float score(float s, int t, int kl) const { const int d = qpos - (kp0 + 64 * t + kl); return (d <= 128 && d >= -128) ? s : NEG_INF; }
};
struct PolB {
    static constexpr int DQ = 64;
    const bf16_t *kbase, *vbase, *kctx, *vctx, *qrow; bf16_t* orow; int nloc, ntiles; float qscale, m0, l0;
    int klo, wr0, r, c; const LAS float* rpb;
    __device__ __forceinline__ void tile_ptrs(int t, const bf16_t*& kp, int& ks, const bf16_t*& vp, int& vs) const {
        ks = NP; vs = NP;
        if (t < nloc) { kp = kbase + (size_t)(klo + t) * 64 * NP; vp = vbase + (size_t)(klo + t) * 64 * NP; } else { kp = kctx + (size_t)(t - nloc) * 64 * NP; vp = vctx + (size_t)(t - nloc) * 64 * NP; } }
    __device__ __forceinline__ bool wave_active(int t) const { return t >= nloc || (klo + t >= wr0 && klo + t < wr0 + 8); }
    __device__ __forceinline__ bool tile_masked(int t) const { return t < nloc; }
    __device__ __forceinline__ float score(float s, int t, int kl) const {
        const int cs = min(max(c - 8, 0), 48); const bool ok = (kl >= cs) && (kl < cs + 16);
        const int idx = (klo + t - r + 7) * 31 + min(max(kl - c + 15, 0), 30);
        return ok ? s + rpb[idx] : NEG_INF; }
};

__device__ __forceinline__ int q_next(int tid, unsigned* ctr, LAS int* slot) {
    __syncthreads();
    if (tid == 0) *slot = (int)__hip_atomic_fetch_add(ctr, 1u, __ATOMIC_RELAXED, __HIP_MEMORY_SCOPE_AGENT);
    __syncthreads();
    return *slot;
}

__device__ __forceinline__ void mlstm_out_unit(int wv, const Params& p, LAS unsigned char* lds, int b, int tc, int hd) {
    const int tid = otid(wv), lane = tid & 63, w = tid >> 6, hh = lane >> 5, l31 = lane & 31;
    unsigned char* ws = opq(p.ws);
    const bf16_t* P = (const bf16_t*)(ws + WS_P); const bf16_t* QC = (const bf16_t*)(ws + WS_QC); const bf16_t* KC = (const bf16_t*)(ws + WS_KC);
    const float* GATES = (const float*)(ws + WS_GATES); const bf16_t* CS = (const bf16_t*)(ws + WS_CS); const float* NS = (const float*)(ws + WS_NS); const float* MS = (const float*)(ws + WS_MS);
    bf16_t* YMIX = (bf16_t*)(ws + WS_YMIX);
    LAS unsigned char* VT = lds;
    LAS float* ZU = (LAS float*)(lds + 12288);
    LAS float* ZC = ZU + 128;
    LAS float* ZI = ZC + 128;
    LAS float* ZE = ZI + 128;
    LAS float* ZN = ZE + 128;
    LAS float* ZH = (LAS float*)(lds + 16384);
    const int row0 = (tc < 128) ? b * SEQ + tc * 64 : TL + b * CTXL + (tc - 128) * 64;
    if (w < 2) { const int dir = w, i = dir ? 63 - lane : lane;
        const float lf = GATES[(size_t)(row0 + i) * 16 + (dir ? 12 : 4) + hd], ig = GATES[(size_t)(row0 + i) * 16 + (dir ? 8 : 0) + hd];
        const float bc = wave_incl_sum(lf, lane), u = ig - bc, pm = wave_incl_max(u, lane);
        const float min_ = MS[cu_index(b, tc, hd, dir)], mx = fmaxf(min_, pm);
        ZU[dir * 64 + lane] = u; ZC[dir * 64 + lane] = -mx; ZI[dir * 64 + lane] = fexp(min_ - mx); ZE[dir * 64 + lane] = fexp(-(bc + mx));
    } else if (w < 4) { const int dir = w - 2; ZN[dir * 64 + lane] = NS[(size_t)cu_index(b, tc, hd, dir) * 64 + lane]; }
    { const int s = tid >> 3, part = tid & 7; *(LAS u32x4*)(VT + s * 192 + part * 16) = *(const u32x4*)(P + (size_t)(row0 + s) * NP + PC_CV + hd * 64 + part * 8); }
    __syncthreads();
    const int dir = w >> 2, tb = (w >> 1) & 1, dvb = w & 1;
    const int t = 32 * tb + l31, it = dir ? 63 - t : t;
    bf16x8 qf[4];
#pragma unroll
    for (int ks = 0; ks < 4; ++ks) qf[ks] = *(const bf16x8*)(QC + (size_t)(row0 + it) * 256 + hd * 64 + 16 * ks + 8 * hh);
    f32x16 st[2];
#pragma unroll
    for (int sb = 0; sb < 2; ++sb) { const int s = 32 * sb + l31, is = dir ? 63 - s : s; st[sb] = zero16();
#pragma unroll
        for (int ks = 0; ks < 4; ++ks) { const bf16x8 a = *(const bf16x8*)(KC + (size_t)(row0 + is) * 256 + hd * 64 + 16 * ks + 8 * hh); st[sb] = mfma32(a, qf[ks], st[sb]); } }
    const float ct = ZC[dir * 64 + t];
    float dsum = 0.f;
#pragma unroll
    for (int sb = 0; sb < 2; ++sb)
#pragma unroll
        for (int r = 0; r < 16; ++r) { const int s = 32 * sb + (r & 3) + 8 * (r >> 2) + 4 * hh;
            const float v = (s <= t) ? st[sb][r] * fexp(ZU[dir * 64 + s] + ct) : 0.f; st[sb][r] = v; dsum += v; }
    dsum += __shfl_xor(dsum, 32);
    f32x16 acc = zero16(), acc2 = zero16();
    const int q4 = (lane & 15) >> 2, colo = 16 * ((lane >> 4) & 1) + 4 * (lane & 3);
#pragma unroll
    for (int sb = 0; sb < 2; ++sb)
#pragma unroll
        for (int s2 = 0; s2 < 2; ++s2) { u32x4 wv;
#pragma unroll
            for (int q = 0; q < 4; ++q) wv[q] = pk2(st[sb][8 * s2 + 2 * q], st[sb][8 * s2 + 2 * q + 1]);
            const int sa = 32 * sb + 16 * s2 + 4 * hh + q4, sb8 = sa + 8;
            const int ia = dir ? 63 - sa : sa, ib = dir ? 63 - sb8 : sb8;
            const bf16x8 vf = cat8(tr_read(VT + ia * 192 + (32 * dvb + colo) * 2), tr_read(VT + ib * 192 + (32 * dvb + colo) * 2));
            acc = mfma32(vf, as_bf16x8(wv), acc); }
    const bf16_t* cst = CS + (size_t)cu_index(b, tc, hd, dir) * 4096 + (size_t)(32 * dvb + l31) * 64;
    float qn = 0.f;
#pragma unroll
    for (int ks = 0; ks < 4; ++ks) { const bf16x8 cf = *(const bf16x8*)(cst + 16 * ks + 8 * hh); acc2 = mfma32(cf, qf[ks], acc2);
#pragma unroll
        for (int j = 0; j < 8; ++j) qn += bf2f((unsigned)(unsigned short)qf[ks][j]) * ZN[dir * 64 + 16 * ks + 8 * hh + j]; }
    qn += __shfl_xor(qn, 32);
    const float inter = ZI[dir * 64 + t], den = dsum + inter * qn, rden = 1.0f / fmaxf(fabsf(den), ZE[dir * 64 + t]);
#pragma unroll
    for (int r = 0; r < 16; ++r) acc[r] = (acc[r] + inter * acc2[r]) * rden;
    if (dir == 1) {
#pragma unroll
        for (int r = 0; r < 16; ++r) ZH[it * 65 + 32 * dvb + (r & 3) + 8 * (r >> 2) + 4 * hh] = acc[r];
    }
    __syncthreads();
    if (dir == 0) {
#pragma unroll
        for (int g = 0; g < 4; ++g) { const int dv = 32 * dvb + 8 * g + 4 * hh;
            const u32x2 ov = *(const u32x2*)(P + (size_t)(row0 + it) * NP + PC_CO + hd * 64 + dv);
            const float o0 = sigmoidf_(bf2f(ov.x & 0xffffu)), o1 = sigmoidf_(bf2f(ov.x >> 16)), o2 = sigmoidf_(bf2f(ov.y & 0xffffu)), o3 = sigmoidf_(bf2f(ov.y >> 16));
            const float h0 = acc[4 * g] + ZH[it * 65 + dv], h1 = acc[4 * g + 1] + ZH[it * 65 + dv + 1], h2 = acc[4 * g + 2] + ZH[it * 65 + dv + 2], h3 = acc[4 * g + 3] + ZH[it * 65 + dv + 3];
            u32x2 wv; wv.x = pk2(o0 * h0, o1 * h1); wv.y = pk2(o2 * h2, o3 * h3);
            *(u32x2*)(YMIX + (size_t)(row0 + it) * 1024 + 512 + hd * 64 + dv) = wv; }
    }
    __syncthreads();
}


#define MIX_COMMON \
    const int tid = otid(wv), lane = tid & 63, w = tid >> 6, l31 = lane & 31; \
    unsigned char* ws = opq(p.ws); \
    unsigned* ctl = (unsigned*)(ws + WS_CTL); \
    LAS int* slot = (LAS int*)(lds + LDS_MISC + 64); \
    const bf16_t* P = (const bf16_t*)(ws + WS_P); \
    bf16_t* YMIX = (bf16_t*)(ws + WS_YMIX); \
    const bool need_ctx = (l == 0); (void)lane; (void)P;

__device__ __forceinline__ void mix_D(int wv, const Params& p, int l, LAS unsigned char* lds) {
    MIX_COMMON
    const bf16_t* QD = (const bf16_t*)(ws + WS_QD); const bf16_t* KD = (const bf16_t*)(ws + WS_KD); const bf16_t* VD = (const bf16_t*)(ws + WS_VD);
    const int nlat = 512, nun = nlat + (need_ctx ? 16 : 0);
    for (;;) { const int u = q_next(tid, ctl + CTL_Q(l, 0), slot); if (u >= nun) break;
        PolD pol; int b, h, row;
        if (u < nlat) { b = u >> 7; h = (u >> 5) & 3; row = b * SEQ + (u & 31) * 256 + 32 * w + l31; pol.nloc = 128; }
        else { const int v = u - nlat; b = v >> 2; h = v & 3; row = TL + b * CTXL + 32 * w + l31; pol.nloc = 0; }
        pol.ntiles = pol.nloc + 4;
        pol.kbase = KD + (size_t)b * SEQ * 384 + h * 96; pol.vbase = VD + (size_t)b * SEQ * 256 + h * 64;
        pol.kctx = KD + (size_t)(TL + b * CTXL) * 384 + h * 96; pol.vctx = VD + (size_t)(TL + b * CTXL) * 256 + h * 64;
        pol.qrow = QD + (size_t)row * 384 + h * 96; pol.orow = YMIX + (size_t)row * 1024 + 768 + h * 64;
        pol.qscale = 0.10206207261596575f * LOG2E; pol.m0 = -1e30f; pol.l0 = 0.f;
        attn_core(wv, lds, pol); }
}
__device__ __forceinline__ void mix_B(int wv, const Params& p, int l, LAS unsigned char* lds) {
    MIX_COMMON
    const int nlat = 512, nun = nlat + (need_ctx ? 16 : 0);
    for (;;) { const int u = q_next(tid, ctl + CTL_Q(l, 1), slot); if (u >= nun) break;
        PolB pol; int b, h, row;
        LAS float* rp = (LAS float*)(lds + 49152);
        if (u < nlat) { b = u >> 7; h = (u >> 5) & 3; const int R0 = (u & 31) * 4; pol.r = R0 + (w >> 1); pol.c = 32 * (w & 1) + l31; row = b * SEQ + pol.r * 64 + pol.c;
            pol.klo = min(max(R0 - 4, 0), 120); const int khi = min(max(R0 - 1, 0), 120) + 7; pol.nloc = khi - pol.klo + 1; pol.wr0 = min(max(pol.r - 4, 0), 120); }
        else { const int v = u - nlat; b = v >> 2; h = v & 3; row = TL + b * CTXL + 32 * w + l31; pol.nloc = 0; pol.klo = 0; pol.wr0 = 0; pol.r = 0; pol.c = 0; }
        for (int i = tid; i < 465; i += NTHR) rp[i] = p.nat_rpb[((size_t)l * 4 + h) * 465 + i] * LOG2E;
        pol.rpb = rp; pol.ntiles = pol.nloc + 4;
        pol.kbase = P + (size_t)b * SEQ * NP + PC_BK + h * 64; pol.vbase = P + (size_t)b * SEQ * NP + PC_BV + h * 64;
        pol.kctx = P + (size_t)(TL + b * CTXL) * NP + PC_BK + h * 64; pol.vctx = P + (size_t)(TL + b * CTXL) * NP + PC_BV + h * 64;
        pol.qrow = P + (size_t)row * NP + PC_BQ + h * 64; pol.orow = YMIX + (size_t)row * 1024 + 256 + h * 64;
        pol.qscale = 0.125f * LOG2E; pol.m0 = -1e30f; pol.l0 = 0.f;
        attn_core(wv, lds, pol); }
}
__device__ __forceinline__ void mix_A(int wv, const Params& p, int l, LAS unsigned char* lds) {
    MIX_COMMON
    const bf16_t* QA = (const bf16_t*)(ws + WS_QA); const bf16_t* KA = (const bf16_t*)(ws + WS_KA);
    const int nlat = 512, nun = nlat + (need_ctx ? 16 : 0);
    for (;;) { const int u = q_next(tid, ctl + CTL_Q(l, 2), slot); if (u >= nun) break;
        PolA pol; int b, hkv, head, row;
        if (u < nlat) { b = u >> 7; hkv = (u >> 6) & 1; const int qb = u & 63; head = 2 * hkv + (w >> 2); pol.q0 = qb * 128 + (w & 3) * 32; pol.qpos = pol.q0 + l31; row = b * SEQ + pol.qpos;
            const int tlo = (qb == 0) ? 2 : 0, thi = (qb == 63) ? 4 : 6; pol.nloc = thi - tlo; pol.kp0 = (qb - 1) * 128 + 64 * tlo; }
        else { const int v = u - nlat; b = v >> 2; hkv = (v >> 1) & 1; head = 2 * hkv + (v & 1); row = TL + b * CTXL + 32 * w + l31; pol.nloc = 0; pol.kp0 = 0; pol.q0 = 0; pol.qpos = 0; }
        pol.ntiles = pol.nloc + 4;
        pol.kbase = KA + (size_t)b * SEQ * 128 + hkv * 64; pol.vbase = P + (size_t)b * SEQ * NP + PC_AV + hkv * 64;
        pol.kctx = KA + (size_t)(TL + b * CTXL) * 128 + hkv * 64; pol.vctx = P + (size_t)(TL + b * CTXL) * NP + PC_AV + hkv * 64;
        pol.qrow = QA + (size_t)row * 256 + head * 64; pol.orow = YMIX + (size_t)row * 1024 + head * 64;
        pol.qscale = 0.125f * LOG2E; pol.m0 = p.attn_sink[l * 4 + head] * LOG2E; pol.l0 = 1.0f;
        attn_core(wv, lds, pol); }
}
__device__ __forceinline__ void mix_C(int wv, const Params& p, int l, LAS unsigned char* lds) {
    MIX_COMMON
    (void)w; (void)l31; (void)YMIX;
    const int nun = NBATCH * (need_ctx ? NCHUNK : 128) * 4;
    for (;;) { const int u = q_next(tid, ctl + CTL_Q(l, 3), slot); if (u >= nun) break;
        const int hd = u & 3, v = u >> 2; int b, tc;
        if (need_ctx) { b = v / NCHUNK; tc = v % NCHUNK; } else { b = v >> 7; tc = v & 127; }
        mlstm_out_unit(wv, p, lds, b, tc, hd); }
}
#ifndef MIX_MASK
#define MIX_MASK 15
#endif
__device__ __forceinline__ void phase_mixers(int wv, const Params& p, int l, LAS unsigned char* lds) {
    if (MIX_MASK & 1) mix_D(wv, p, l, lds);
    if (MIX_MASK & 2) mix_B(wv, p, l, lds);
    if (MIX_MASK & 4) mix_A(wv, p, l, lds);
    if (MIX_MASK & 8) mix_C(wv, p, l, lds);
}

__device__ __forceinline__ void phase_router(int wv, const Params& p, int l, LAS unsigned char* lds) {
    const int tid = otid(wv), lane = tid & 63, w = tid >> 6, hh = lane >> 5, l31 = lane & 31;
    unsigned char* ws = opq(p.ws);
    const float* MOD = (const float*)(ws + WS_MOD); const float* XA = (const float*)(ws + WS_XA); bf16_t* H2B = (bf16_t*)(ws + WS_H2B);
    const bf16_t* WRT = (const bf16_t*)(ws + WS_WRT) + (size_t)l * 2 * 32 * 1024;
    float* GATE = (float*)(ws + WS_GATE); int* LIST = (int*)(ws + WS_LIST); unsigned* ctl = (unsigned*)(ws + WS_CTL);
    constexpr int HROW = 1028;
    LAS float* HT = (LAS float*)lds;
    LAS float* RED = (LAS float*)lds;
    LAS int* LCNT = (LAS int*)(lds + 131584);
    LAS int* LBASE = LCNT + 32;
    LAS int* PA = LBASE + 32;
    LAS int* PE = PA + 640;
    const int T = (l == 0) ? TA : TL, ntile = T / 32, NASSIGN = TA * 4;
    if (tid < 32) LCNT[tid] = 0;
    __syncthreads();
    int iter = 0;
    for (int tl = blockIdx.x; tl < ntile; tl += gridDim.x, ++iter) {
        const int r0 = tl * 32;
#pragma unroll 1
        for (int i = 0; i < 4; ++i) { const int rl = 4 * w + i, r = r0 + rl;
            const int mrow = (r < TL) ? (r >> 13) : 4; const float* mod = MOD + ((size_t)l * 5 + mrow) * 6144;
            f32x4 v[4]; row_load(XA + (size_t)r * 1024, lane, v); const float rstd = row_rstd(v);
            row_modulate(v, rstd, p.g_norm2 + l * 1024, mod + 4 * 1024, mod + 3 * 1024, lane);
            row_store_bf16(H2B + (size_t)r * 1024, lane, v);
#pragma unroll
            for (int q = 0; q < 4; ++q) *(LAS f32x4*)(HT + rl * HROW + q * 256 + lane * 4) = v[q]; }
        __syncthreads();
        f32x16 acc = zero16();
#pragma unroll 2
        for (int ks = 0; ks < 8; ++ks) { const int k0 = 128 * w + 16 * ks + 8 * hh;
            const f32x4 x0 = *(const LAS f32x4*)(HT + l31 * HROW + k0), x1 = *(const LAS f32x4*)(HT + l31 * HROW + k0 + 4);
            u32x4 ah, alo; float hf[8] = {x0[0], x0[1], x0[2], x0[3], x1[0], x1[1], x1[2], x1[3]};
#pragma unroll
            for (int q = 0; q < 4; ++q) { const unsigned hp = pk2(hf[2 * q], hf[2 * q + 1]); ah[q] = hp; alo[q] = pk2(hf[2 * q] - bf2f(hp & 0xffffu), hf[2 * q + 1] - bf2f(hp >> 16)); }
            const bf16x8 bh = *(const bf16x8*)(WRT + (size_t)l31 * 1024 + k0), bl = *(const bf16x8*)(WRT + (size_t)(32 + l31) * 1024 + k0);
            acc = mfma32(as_bf16x8(ah), bh, acc); acc = mfma32(as_bf16x8(alo), bh, acc); acc = mfma32(as_bf16x8(ah), bl, acc); }
        __syncthreads();
#pragma unroll
        for (int r = 0; r < 16; ++r) RED[(w * 32 + (r & 3) + 8 * (r >> 2) + 4 * hh) * 33 + l31] = acc[r];
        __syncthreads();
#pragma unroll 1
        for (int i = 0; i < 4; ++i) { const int rl = 4 * w + i, r = r0 + rl;
            float v = NEG_INF;
            if (lane < 32) { v = p.b_router[l * 32 + lane];
#pragma unroll
                for (int ww = 0; ww < 8; ++ww) v += RED[(ww * 32 + rl) * 33 + lane]; }
            float tv[4]; int te[4];
#pragma unroll
            for (int k = 0; k < 4; ++k) { float bv = v; int bi = lane;
#pragma unroll
                for (int d = 32; d >= 1; d >>= 1) { const float ov = __shfl_xor(bv, d); const int oi = __shfl_xor(bi, d); if (ov > bv || (ov == bv && oi < bi)) { bv = ov; bi = oi; } }
                tv[k] = bv; te[k] = bi; if (lane == bi) v = NEG_INF; }
            if (lane < 4) { const float e0 = 1.0f, e1 = fexp(tv[1] - tv[0]), e2 = fexp(tv[2] - tv[0]), e3 = fexp(tv[3] - tv[0]); const float inv = 1.0f / (e0 + e1 + e2 + e3);
                const float g = (lane == 0 ? e0 : lane == 1 ? e1 : lane == 2 ? e2 : e3) * inv; const int e = (lane == 0 ? te[0] : lane == 1 ? te[1] : lane == 2 ? te[2] : te[3]);
                const int a = r * 4 + lane; GATE[a] = g;
                const int lr = __hip_atomic_fetch_add(&LCNT[e], 1, __ATOMIC_RELAXED, __HIP_MEMORY_SCOPE_WORKGROUP); const int pi = iter * 128 + rl * 4 + lane; PA[pi] = a; PE[pi] = (e << 16) | lr; }
        }
        __syncthreads();
    }
    if (tid < 32) LBASE[tid] = (int)__hip_atomic_fetch_add(ctl + CTL_CNT(l, tid), (unsigned)LCNT[tid], __ATOMIC_RELAXED, __HIP_MEMORY_SCOPE_AGENT);
    __syncthreads();
    for (int i = tid; i < iter * 128; i += NTHR) { const int pe = PE[i], e = pe >> 16, lr = pe & 0xffff; LIST[(size_t)e * NASSIGN + LBASE[e] + lr] = PA[i]; }
    __syncthreads();
}

__device__ __forceinline__ void phase_gather(int wv, const Params& p, int l, LAS unsigned char* lds) {
    const int tid = otid(wv), lane = tid & 63, gw = blockIdx.x * NWAVE + (tid >> 6), nw = gridDim.x * NWAVE;
    unsigned char* ws = opq(p.ws);
    const unsigned* ctl = (const unsigned*)(ws + WS_CTL); const bf16_t* H2B = (const bf16_t*)(ws + WS_H2B); bf16_t* XS = (bf16_t*)(ws + WS_XS);
    const int* LIST = (const int*)(ws + WS_LIST); const float* GATE = (const float*)(ws + WS_GATE);
    int* SLOTA = (int*)(ws + WS_SLOTA); float* SLOTG = (float*)(ws + WS_SLOTG); int* TILEE = (int*)(ws + WS_TILEE);
    LAS int* CNT = (LAS int*)lds; LAS int* PST = CNT + 32;
    constexpr int NASSIGN = TA * 4;
    if (tid < 32) CNT[tid] = (int)__hip_atomic_load(ctl + CTL_CNT(l, tid), __ATOMIC_RELAXED, __HIP_MEMORY_SCOPE_AGENT);
    __syncthreads();
    if (tid == 0) { int s = 0; for (int e = 0; e < 32; ++e) { PST[e] = s; s += (CNT[e] + 255) & ~255; } PST[32] = s; }
    __syncthreads();
    const int nslot = PST[32], ntiles = nslot >> 8;
    if (blockIdx.x == 0) { for (int t = tid; t < ntiles; t += NTHR) { int e = 0; for (int j = 1; j < 32; ++j) if (PST[j] <= t * 256) e = j; TILEE[t] = e; } if (tid == 0) TILEE[MAXTILE] = ntiles; }
    for (int s = gw; s < nslot; s += nw) {
        int e = 0;
#pragma unroll
        for (int j = 1; j < 32; ++j) if (PST[j] <= s) e = j;
        const int r = s - PST[e];
        u32x4 v0 = (u32x4){0u, 0u, 0u, 0u}, v1 = v0; int a = -1;
        if (r < CNT[e]) { a = LIST[(size_t)e * NASSIGN + r]; const bf16_t* src = H2B + (size_t)(a >> 2) * 1024; v0 = *(const u32x4*)(src + lane * 8); v1 = *(const u32x4*)(src + 512 + lane * 8); }
        bf16_t* dst = XS + (size_t)s * 1024; *(u32x4*)(dst + lane * 8) = v0; *(u32x4*)(dst + 512 + lane * 8) = v1;
        if (lane == 0) { SLOTA[s] = a; SLOTG[s] = (a >= 0) ? GATE[a] : 0.f; }
    }
}

#define XB_TMO      128
#define XB_XCNT(j)  (256  + 64 * (j))
#define XB_XSUB(j)  (1280 + 64 * (j))
#define XB_XGEN(j)  (2304 + 64 * (j))
#define XB_TOP      3328
#define XB_TOPGEN   3392
#define XCD_BAR_WORDS 3456
#define XB_SPIN_CAP (1u << 18)
__device__ __forceinline__ unsigned xb_ld(unsigned* p)              { return __hip_atomic_load(p, __ATOMIC_RELAXED, __HIP_MEMORY_SCOPE_AGENT); }
__device__ __forceinline__ unsigned xb_add(unsigned* p, unsigned v) { return __hip_atomic_fetch_add(p, v, __ATOMIC_RELAXED, __HIP_MEMORY_SCOPE_AGENT); }
__device__ __forceinline__ unsigned xb_xcc_id() { return (unsigned)__builtin_amdgcn_s_getreg((3 << 11) | 20) & 0xFu; }
#define XB_SPIN(cond, bar) do { unsigned _sp = 0; while (cond) { __builtin_amdgcn_s_sleep(1); \
    if ((++_sp & 255u) == 0u) { if (xb_ld(&(bar)[XB_TMO])) break; if (_sp > XB_SPIN_CAP) { atomicAdd(&(bar)[XB_TMO], 1u); break; } } } } while (0)
struct XcdBarrier { unsigned* bar; unsigned x; volatile LAS unsigned* st; };
__device__ __forceinline__ XcdBarrier xcd_barrier_post(int tid, unsigned* bar, volatile LAS unsigned* st) {
    XcdBarrier b; b.bar = bar; b.x = xb_xcc_id(); b.st = st;
    if (tid == 0) (void)xb_add(&bar[XB_XCNT(b.x)], 1u);
    return b;
}
__device__ __forceinline__ void xcd_barrier_complete(unsigned* bar, unsigned x, unsigned& nloc, unsigned& nx) {
    const unsigned G = gridDim.x * gridDim.y * gridDim.z;
    unsigned sum, cnt, mine, sp = 0u;
    for (;;) {
        sum = 0u; cnt = 0u; mine = 0u;
#pragma unroll
        for (unsigned j = 0; j < 16; ++j) { const unsigned c = xb_ld(&bar[XB_XCNT(j)]); sum += c; cnt += (c > 0u) ? 1u : 0u; mine = (j == x) ? c : mine; }
        if (sum == G) break;
        __builtin_amdgcn_s_sleep(1);
        if ((++sp & 255u) == 0u) { if (xb_ld(&bar[XB_TMO])) break; if (sp > XB_SPIN_CAP) { atomicAdd(&bar[XB_TMO], 1u); break; } }
    }
    nloc = mine > 0u ? mine : 1u; nx = cnt > 0u ? cnt : 1u;
}
__device__ __forceinline__ void xcd_barrier(int wv, const XcdBarrier& b) {
    asm volatile("s_waitcnt vmcnt(0)" ::: "memory");
    __syncthreads();
    if (otid(wv) == 0) {
        unsigned* bar = b.bar;
        __builtin_amdgcn_s_waitcnt(0);
        unsigned nloc = b.st[0], nx = b.st[1];
        if (nloc == 0u) { xcd_barrier_complete(bar, b.x, nloc, nx); b.st[0] = nloc; b.st[1] = nx; }
        const unsigned old = xb_add(&bar[XB_XSUB(b.x)], 1u);
        const unsigned gen = old / nloc;
        if (old + 1u == (gen + 1u) * nloc) {
            __builtin_amdgcn_fence(__ATOMIC_RELEASE, "agent");
            asm volatile("s_waitcnt vmcnt(0)" ::: "memory");
            const unsigned og = xb_add(&bar[XB_TOP], 1u);
            const unsigned tg = og / nx;
            if (og + 1u == (tg + 1u) * nx) xb_add(&bar[XB_TOPGEN], 1u);
            else XB_SPIN(xb_ld(&bar[XB_TOPGEN]) == tg, bar);
            __builtin_amdgcn_fence(__ATOMIC_ACQUIRE, "agent");
            xb_add(&bar[XB_XGEN(b.x)], 1u);
            asm volatile("s_waitcnt vmcnt(0)" ::: "memory");
        } else {
            XB_SPIN(xb_ld(&bar[XB_XGEN(b.x)]) == gen, bar);
            __builtin_amdgcn_fence(__ATOMIC_ACQUIRE, "agent");
            asm volatile("s_waitcnt vmcnt(0)" ::: "memory");
        }
    }
    __syncthreads();
}

constexpr int NPHASE = 23;
extern __shared__ __attribute__((aligned(16))) unsigned char smem_raw[];

#ifndef EN_MASK
#define EN_MASK 0xFFF
#endif
#define EN(k) ((EN_MASK >> (k)) & 1)
#define RUN(id) ((id) >= p.phase_lo && (id) < p.phase_hi)
#define SYNC() do { if (p.use_bar) xcd_barrier(wv, bar); } while (0)
template <int l>
__device__ __forceinline__ void run_layer(int wv, const Params& p, LAS unsigned char* lds, const XcdBarrier& bar) {
    unsigned char* ws = opq(p.ws);
        const int pb = 1 + 11 * l;
        const int T = (l == 0) ? TA : TL;
        if (l == 0) { if (EN(0) && RUN(pb + 0)) phase_norm1_l0(wv, p); SYNC(); }
        if (EN(1) && RUN(pb + 1)) {
            pg8::Gemm g{(const bf16_t*)(ws + WS_HB), (const bf16_t*)(ws + WS_WIN) + (size_t)l * NP * 1024, TA, NP, 1024};
            pg8::StaticOrder S; S.init(TA, NP, gridDim.x, blockIdx.x);
            EpiStoreBf16 E{(bf16_t*)(ws + WS_P), NP};
            pg8::gemm_phase(wv, lds, g, S, E, nullptr);
        }
        SYNC();
        if (EN(2) && RUN(pb + 2)) phase_prep(wv, p, l, lds);
        SYNC();
        if (EN(3) && RUN(pb + 3)) phase_scan(wv, p, lds);
        SYNC();
        if (EN(4) && RUN(pb + 4)) phase_mixers(wv, p, l, lds);
        SYNC();
        if (EN(5) && RUN(pb + 5)) {
            pg8::Gemm g{(const bf16_t*)(ws + WS_YMIX), (const bf16_t*)(ws + WS_WOUT) + (size_t)l * 1024 * 1024, T, 1024, 1024};
            pg8::StaticOrder S; S.init(T, 1024, gridDim.x, blockIdx.x);
            const float* MOD = (const float*)(ws + WS_MOD);
            EpiResid E{l == 0 ? p.x : (const float*)(ws + WS_XB), l == 0 ? p.ctx : (const float*)(ws + WS_XB) + (size_t)TL * 1024, (float*)(ws + WS_XA), MOD + (size_t)l * 5 * 6144 + 2 * 1024};
            pg8::gemm_phase(wv, lds, g, S, E, nullptr);
        }
        SYNC();
        if (EN(6) && RUN(pb + 6)) phase_router(wv, p, l, lds);
        SYNC();
        if (EN(7) && RUN(pb + 7)) phase_gather(wv, p, l, lds);
        SYNC();
        if (EN(8) && RUN(pb + 8)) {
            const int* TILEE = (const int*)(ws + WS_TILEE);
            pg8::Gemm g{(const bf16_t*)(ws + WS_XS), (const bf16_t*)(ws + WS_WGU) + (size_t)l * 32 * 2048 * 1024, MAXSLOT, 32 * 2048, 1024};
            MoeOrder S{TILEE, TILEE[MAXTILE], 8, (int)gridDim.x, (int)blockIdx.x};
            EpiGU E{(bf16_t*)(ws + WS_ACT), p.b_gu + (size_t)l * 32 * 2048};
            pg8::gemm_phase(wv, lds, g, S, E, nullptr);
        }
        SYNC();
        if (EN(9) && RUN(pb + 9)) {
            const int* TILEE = (const int*)(ws + WS_TILEE);
            pg8::Gemm g{(const bf16_t*)(ws + WS_ACT), (const bf16_t*)(ws + WS_WDN) + (size_t)l * 32 * 1024 * 1024, MAXSLOT, 32 * 1024, 1024};
            MoeOrder S{TILEE, TILEE[MAXTILE], 4, (int)gridDim.x, (int)blockIdx.x};
            EpiDown E{(bf16_t*)(ws + WS_Y), p.b_down + (size_t)l * 32 * 1024, (const int*)(ws + WS_SLOTA), (const float*)(ws + WS_SLOTG)};
            pg8::gemm_phase(wv, lds, g, S, E, nullptr);
        }
        SYNC();
        if (EN(10) && RUN(pb + 10)) phase_combine(wv, p, l);
        if (l == 0) SYNC();
    }

__global__ void __launch_bounds__(NTHR, 2) mk_forward(Params p) {
    LAS unsigned char* lds = (LAS unsigned char*)smem_raw;
    const int wv = __builtin_amdgcn_readfirstlane((int)threadIdx.x >> 6);
    { const int t0 = otid(wv); if (t0 < 4) ((LAS unsigned*)(lds + LDS_MISC))[t0] = 0u; }
    __syncthreads();
    unsigned* ctl = (unsigned*)(p.ws + WS_CTL);
    XcdBarrier bar; bar.bar = ctl; bar.x = 0; bar.st = (volatile LAS unsigned*)(lds + LDS_MISC);
    if (p.use_bar) bar = xcd_barrier_post(otid(wv), ctl, (volatile LAS unsigned*)(lds + LDS_MISC));
    if (EN(11) && RUN(0)) phase_prologue(wv, p, lds);
    SYNC();
    run_layer<0>(wv, p, lds, bar);
    run_layer<1>(wv, p, lds, bar);
}
#undef RUN
#undef SYNC

extern "C" void kernel_launch(void* const* d_in, const int* in_sizes, int n_in, void* d_out, int out_size, void* d_ws, size_t ws_size, hipStream_t stream) {
    static int grid = 0;
    if (grid == 0) {
        if (n_in != 25 || ws_size < WS_END) { fprintf(stderr, "kernel_launch: expected 25 inputs and >= %zu bytes of workspace, got %d inputs, %zu bytes; nothing launched\n", (size_t)WS_END, n_in, ws_size); grid = -1; return; }
        int dev = 0, cus = 0, per_cu = 0;
        hipGetDevice(&dev); hipDeviceGetAttribute(&cus, hipDeviceAttributeMultiprocessorCount, dev);
        if (hipFuncSetAttribute((const void*)mk_forward, hipFuncAttributeMaxDynamicSharedMemorySize, LDS_BYTES) != hipSuccess) { fprintf(stderr, "kernel_launch: hipFuncSetAttribute failed\n"); grid = -1; return; }
        hipOccupancyMaxActiveBlocksPerMultiprocessor(&per_cu, (const void*)mk_forward, NTHR, LDS_BYTES);
        if (per_cu < 1) fprintf(stderr, "kernel_launch: occupancy query reports %d workgroups per CU\n", per_cu);
        grid = cus > 0 ? cus : 256;
    }
    if (grid < 0) return;
    Params p{};
    const float** pp = (const float**)&p;
    for (int i = 0; i < 25; ++i) pp[i] = (const float*)d_in[i];
    p.out = (float*)d_out; p.ws = (unsigned char*)d_ws; p.pad0 = 0;
    hipMemsetAsync((unsigned char*)d_ws + WS_CTL, 0, CTL_BYTES, stream);
#if MK_LAUNCHES == 1
    p.phase_lo = 0; p.phase_hi = NPHASE; p.use_bar = 1;
    hipLaunchKernelGGL(mk_forward, dim3(grid), dim3(NTHR), LDS_BYTES, stream, p);
#else
    for (int ph = 0; ph < NPHASE; ++ph) { if (ph == 12) continue;
        p.phase_lo = ph; p.phase_hi = ph + 1; p.use_bar = 0;
        hipLaunchKernelGGL(mk_forward, dim3(grid), dim3(NTHR), LDS_BYTES, stream, p); }
#endif
}
```

```cpp
#include <hip/hip_runtime.h>
#include <cstdio>
#include <cstdint>

#ifndef MK_LAUNCHES
#define MK_LAUNCHES 1
#endif
#ifndef MK_CHECK
#define MK_CHECK 0
#endif

typedef unsigned short bf16_t;
typedef short bf16x8 __attribute__((ext_vector_type(8)));
typedef short s16x4 __attribute__((ext_vector_type(4)));
typedef float f32x4 __attribute__((ext_vector_type(4)));
typedef float f32x16 __attribute__((ext_vector_type(16)));
typedef unsigned u32x4 __attribute__((ext_vector_type(4)));
typedef unsigned u32x2 __attribute__((ext_vector_type(2)));
#define LAS __attribute__((address_space(3)))

constexpr int NTHR = 512, NWAVE = 8;
constexpr int DM = 1024, NBATCH = 4, SEQ = 8192, CTXL = 256, TL = NBATCH * SEQ, TC = NBATCH * CTXL, TA = TL + TC;
constexpr int NP = 3584;
constexpr int PC_AQ = 0, PC_AK = 256, PC_AV = 384, PC_BQ = 512, PC_BK = 768, PC_BV = 1024, PC_CQK = 1280, PC_CV = 1792, PC_CO = 2048, PC_CG = 2304,
              PC_DCQ = 2320, PC_DCKV = 2512, PC_DKR = 2640, PC_DQF = 2672, PC_DKVF = 3056, PC_END = 3568;
constexpr int INC = 2672;
constexpr int NEXP = 32, MAXSLOT = 143360, MAXTILE = MAXSLOT / 256;
constexpr int NCHUNK = 132;
constexpr int NCU = NBATCH * NCHUNK * 4 * 2;
constexpr float LOG2E = 1.4426950408889634f;
constexpr float EPS = 1e-6f;

constexpr int LDS_BYTES = 147456;
constexpr int LDS_MISC = LDS_BYTES - 256;

constexpr size_t al256(size_t x) { return (x + 255) & ~(size_t)255; }
constexpr size_t WS_CTL = 0, CTL_BYTES = 65536;
constexpr size_t WS_MOD = WS_CTL + CTL_BYTES;
constexpr size_t WS_RA = al256(WS_MOD + (size_t)2 * 5 * 6144 * 4);
constexpr size_t WS_RD = al256(WS_RA + (size_t)SEQ * 32 * 8);
constexpr size_t WS_WIN = al256(WS_RD + (size_t)SEQ * 16 * 8);
constexpr size_t WS_WOUT = al256(WS_WIN + (size_t)2 * NP * 1024 * 2);
constexpr size_t WS_WGU = al256(WS_WOUT + (size_t)2 * 1024 * 1024 * 2);
constexpr size_t WS_WDN = al256(WS_WGU + (size_t)2 * 32 * 2048 * 1024 * 2);
constexpr size_t WS_WRT = al256(WS_WDN + (size_t)2 * 32 * 1024 * 1024 * 2);
constexpr size_t WS_HB = al256(WS_WRT + (size_t)2 * 2 * 32 * 1024 * 2);
constexpr size_t WS_H2B = al256(WS_HB + (size_t)TA * 1024 * 2);
constexpr size_t WS_P = al256(WS_H2B + (size_t)TA * 1024 * 2);
constexpr size_t WS_QA = al256(WS_P + (size_t)TA * NP * 2);
constexpr size_t WS_KA = al256(WS_QA + (size_t)TA * 256 * 2);
constexpr size_t WS_QD = al256(WS_KA + (size_t)TA * 128 * 2);
constexpr size_t WS_KD = al256(WS_QD + (size_t)TA * 384 * 2);
constexpr size_t WS_VD = al256(WS_KD + (size_t)TA * 384 * 2);
constexpr size_t WS_QC = al256(WS_VD + (size_t)TA * 256 * 2);
constexpr size_t WS_KC = al256(WS_QC + (size_t)TA * 256 * 2);
constexpr size_t WS_MIXEND = al256(WS_KC + (size_t)TA * 256 * 2);
constexpr size_t WS_ACT = WS_P;
static_assert(WS_MIXEND - WS_P >= (size_t)MAXSLOT * 1024 * 2, "ACT alias");
constexpr size_t WS_GATES = WS_MIXEND;
constexpr size_t WS_DC = al256(WS_GATES + (size_t)TA * 16 * 4);
constexpr size_t WS_DN = al256(WS_DC + (size_t)NCU * 4096 * 4);
constexpr size_t WS_DFA = al256(WS_DN + (size_t)NCU * 64 * 4);
constexpr size_t WS_CS = al256(WS_DFA + (size_t)NCU * 2 * 4);
constexpr size_t WS_NS = al256(WS_CS + (size_t)NCU * 4096 * 2);
constexpr size_t WS_MS = al256(WS_NS + (size_t)NCU * 64 * 4);
constexpr size_t WS_YMIX = al256(WS_MS + (size_t)NCU * 4);
constexpr size_t WS_XA = al256(WS_YMIX + (size_t)TA * 1024 * 2);
constexpr size_t WS_XB = al256(WS_XA + (size_t)TA * 1024 * 4);
constexpr size_t WS_GATE = al256(WS_XB + (size_t)TA * 1024 * 4);
constexpr size_t WS_LIST = al256(WS_GATE + (size_t)TA * 4 * 4);
constexpr size_t WS_SLOTA = al256(WS_LIST + (size_t)32 * TA * 4 * 4);
constexpr size_t WS_SLOTG = al256(WS_SLOTA + (size_t)MAXSLOT * 4);
constexpr size_t WS_SLOTT = al256(WS_SLOTG + (size_t)MAXSLOT * 4);
constexpr size_t WS_TILEE = al256(WS_SLOTT + (size_t)MAXSLOT * 4);
constexpr size_t WS_XS = al256(WS_TILEE + (size_t)(MAXTILE + 64) * 4);
constexpr size_t WS_Y = WS_XS;
constexpr size_t WS_DBG = al256(WS_XS + (size_t)MAXSLOT * 1024 * 2);
constexpr size_t WS_END = WS_DBG + 65536;

#define CTL_Q(l, q, x) (4096 + (((l) * 8 + (q)) * 8 + (x)) * 64)
#define CTL_CNT(l, e) (12288 + (l) * 2048 + (e) * 64)

struct Params {
    const float *x, *c, *ctx, *c_ctx, *w_ada, *b_ada, *g_norm1, *g_norm2, *w_in, *attn_sink, *nat_rpb, *mlstm_conv, *mlstm_gate_bias,
                *mla_g_q, *mla_w_uq, *mla_g_kv, *mla_w_ukv, *w_out, *w_router, *b_router, *w_gu, *b_gu, *w_down, *b_down, *g_final;
    float* out;
    unsigned char* ws;
    int phase_lo, phase_hi, use_bar, pad0;
};

__device__ __forceinline__ int otid(int wv) { int t = wv * 64 + (int)__builtin_amdgcn_mbcnt_hi(~0u, __builtin_amdgcn_mbcnt_lo(~0u, 0u)); asm volatile("" : "+v"(t)); return t; }
__device__ __forceinline__ unsigned char* opq(unsigned char* q) { asm volatile("" : "+s"(q)); return q; }
#ifndef YM_FP8
#define YM_FP8 0
#endif
#if YM_FP8
typedef unsigned char ym_t;
#else
typedef unsigned short ym_t;
#endif
__device__ __forceinline__ float bf2f(unsigned b) { return __uint_as_float(b << 16); }
typedef __bf16 bf16v2_t __attribute__((ext_vector_type(2)));
typedef float f32v2_t __attribute__((ext_vector_type(2)));
__device__ __forceinline__ unsigned pk2(float lo, float hi) { const f32v2_t f = {lo, hi}; const bf16v2_t v = __builtin_convertvector(f, bf16v2_t); return __builtin_bit_cast(unsigned, v); }
__device__ __forceinline__ unsigned pk_fp8x4(float a, float b, float c, float d) { int r = 0; r = __builtin_amdgcn_cvt_pk_fp8_f32(a, b, r, false); r = __builtin_amdgcn_cvt_pk_fp8_f32(c, d, r, true); return (unsigned)r; }
__device__ __forceinline__ unsigned pk_fp8x4(float a, float b, float c, float d);
__device__ __forceinline__ void ym_store4(ym_t* p, float a, float b, float c, float d) {
#if YM_FP8
    *(unsigned*)p = pk_fp8x4(a, b, c, d);
#else
    u32x2 w; w.x = pk2(a, b); w.y = pk2(c, d); *(u32x2*)p = w;
#endif
}
__device__ __forceinline__ unsigned short f2bf(float f) { return (unsigned short)(pk2(f, 0.f) & 0xffffu); }
__device__ __forceinline__ float fexp2(float x) { return __builtin_amdgcn_exp2f(x); }
__device__ __forceinline__ float fexp(float x) { return __builtin_amdgcn_exp2f(x * LOG2E); }
__device__ __forceinline__ float wave_sum(float v) {
#pragma unroll
    for (int d = 32; d >= 1; d >>= 1) v += __shfl_xor(v, d);
    return v;
}
__device__ __forceinline__ float wave_max(float v) {
#pragma unroll
    for (int d = 32; d >= 1; d >>= 1) v = fmaxf(v, __shfl_xor(v, d));
    return v;
}
__device__ __forceinline__ float wave_incl_sum(float v, int lane) {
#pragma unroll
    for (int d = 1; d < 64; d <<= 1) { const float t = __shfl_up(v, d); if (lane >= d) v += t; }
    return v;
}
__device__ __forceinline__ float wave_incl_max(float v, int lane) {
#pragma unroll
    for (int d = 1; d < 64; d <<= 1) { const float t = __shfl_up(v, d); if (lane >= d) v = fmaxf(v, t); }
    return v;
}
__device__ __forceinline__ f32x16 mfma32(bf16x8 a, bf16x8 b, f32x16 c) { return __builtin_amdgcn_mfma_f32_32x32x16_bf16(a, b, c, 0, 0, 0); }
__device__ __forceinline__ f32x16 zero16() { f32x16 z;
#pragma unroll
    for (int i = 0; i < 16; ++i) z[i] = 0.f;
    return z; }
__device__ __forceinline__ s16x4 tr_read(LAS unsigned char* p) { return __builtin_amdgcn_ds_read_tr16_b64_v4i16((LAS s16x4*)p); }
__device__ __forceinline__ bf16x8 cat8(s16x4 a, s16x4 b) { return __builtin_shufflevector(a, b, 0, 1, 2, 3, 4, 5, 6, 7); }
__device__ __forceinline__ bf16x8 as_bf16x8(u32x4 v) { return __builtin_bit_cast(bf16x8, v); }
__device__ __forceinline__ float sigmoidf_(float x) { return 1.0f / (1.0f + fexp(-x)); }
__device__ __forceinline__ float siluf_(float x) { return x * sigmoidf_(x); }

__device__ __forceinline__ void row_load(const float* row, int lane, f32x4 (&v)[4]) {
#pragma unroll
    for (int i = 0; i < 4; ++i) v[i] = *(const f32x4*)(row + i * 256 + lane * 4);
}
__device__ __forceinline__ float row_rstd(const f32x4 (&v)[4]) {
    float s = 0.f;
#pragma unroll
    for (int i = 0; i < 4; ++i) s += v[i][0] * v[i][0] + v[i][1] * v[i][1] + v[i][2] * v[i][2] + v[i][3] * v[i][3];
    s = wave_sum(s);
    return rsqrtf(s * (1.0f / 1024.0f) + EPS);
}
__device__ __forceinline__ void row_modulate(f32x4 (&v)[4], float rstd, const float* g, const float* sc, const float* sh, int lane) {
#pragma unroll
    for (int i = 0; i < 4; ++i) {
        const f32x4 gg = *(const f32x4*)(g + i * 256 + lane * 4), s1 = *(const f32x4*)(sc + i * 256 + lane * 4), s0 = *(const f32x4*)(sh + i * 256 + lane * 4);
#pragma unroll
        for (int j = 0; j < 4; ++j) v[i][j] = (v[i][j] * rstd * gg[j]) * (1.0f + s1[j]) + s0[j];
    }
}
__device__ __forceinline__ void row_store_fp8(unsigned char* row, int lane, const f32x4 (&v)[4]) {
#pragma unroll
    for (int i = 0; i < 4; ++i) *(unsigned*)(row + i * 256 + lane * 4) = pk_fp8x4(v[i][0], v[i][1], v[i][2], v[i][3]);
}
__device__ __forceinline__ void row_store_bf16(bf16_t* row, int lane, const f32x4 (&v)[4]) {
#pragma unroll
    for (int i = 0; i < 4; ++i) { u32x2 w; w.x = pk2(v[i][0], v[i][1]); w.y = pk2(v[i][2], v[i][3]); *(u32x2*)(row + i * 256 + lane * 4) = w; }
}
namespace pg8 {
#define PG8_LAS __attribute__((address_space(3)))
typedef unsigned short bf16_t;
typedef short bf16x8 __attribute__((ext_vector_type(8)));
typedef float f32x4 __attribute__((ext_vector_type(4)));
typedef unsigned u32x4 __attribute__((ext_vector_type(4)));
constexpr int FP8_ONE = 0x7f7f7f7f;
constexpr int BM = 256, BK = 64, HALF = 128, HTB = HALF * BK * 2  , STAGE_BYTES = 8 * HTB, NXCD = 8, WGM = 8;

__host__ __device__ __forceinline__ int lds_byte(int r, int c) { const int st = (r >> 4) * 2 + (c >> 5), rr = r & 15, cc = c & 31, ob = rr * 64 + cc * 2; return st * 1024 + (ob ^ (((ob >> 9) & 1) << 5)); }
__host__ __device__ __forceinline__ void stage_rc(int b, int& R, int& C) { const int st = b / 1024, sb = b % 1024, swz = sb ^ (((sb >> 9) & 1) << 5); R = (st >> 1) * 16 + swz / 64; C = (st & 1) * 32 + (swz % 64) / 2; }
__host__ __device__ __forceinline__ int perm32(int rho) { const int n = rho >> 4, i = rho & 15; return 8 * (i >> 2) + 4 * n + (i & 3); }

struct Unit { int pm, pn; };
struct Gemm { const bf16_t* A; const bf16_t* Bt; int M, N, K; const int* rowmap; };

struct StaticOrder {
    int nM, nN, nwg, G, c;
    __host__ __device__ void init(int M, int N, int G_, int c_) { nM = M / BM; nN = N / BM; nwg = nM * nN; G = G_; c = c_; }
    __host__ __device__ bool next(int i, Unit& u) const {
        const long L = (long)i * G + c; if (L >= nwg) return false;
        int wgid = (int)L; { const int q = nwg / NXCD, r = nwg % NXCD, xcd = wgid % NXCD, off = wgid / NXCD; wgid = (xcd < r ? xcd * (q + 1) : r * (q + 1) + (xcd - r) * q) + off; }
        const int nig = WGM * nN, gid = wgid / nig, fm = gid * WGM, gsz = (nM - fm) < WGM ? (nM - fm) : WGM;
        u.pm = fm + ((wgid % nig) % gsz); u.pn = (wgid % nig) / gsz; return true;
    }
    __device__ __forceinline__ void a_ready(const Unit&) const {}
    __device__ __forceinline__ void done(const Unit&) const {}
};
template <class Epi, class Sched, bool STAMP = false, bool FP8 = false, bool GATHER = false>
__device__ __forceinline__ void gemm_phase(int wv, PG8_LAS unsigned char* lds, const Gemm g, const Sched& S, const Epi& E, unsigned long long* stamps) {
    const int tid = otid(wv), wid = __builtin_amdgcn_readfirstlane(tid >> 6), lane = tid & 63, wr = wid >> 2, wc = wid & 3, fr = lane & 15, fq = lane >> 4;
    const int K = g.K, nt = K / BK;
    int ts_lo = 0, ts_hi = 0, nts = 0; const unsigned long long rt_entry = STAMP ? (unsigned long long)wall_clock64() : 0ull;
#define PG8_STAMP() do { if (STAMP && wid == 0 && nts < 64) { const unsigned long long _c = (unsigned long long)clock64(); \
        ts_lo = (lane == nts) ? (int)(unsigned)_c : ts_lo; ts_hi = (lane == nts) ? (int)(unsigned)(_c >> 32) : ts_hi; ++nts; } } while (0)
    PG8_STAMP();
    unsigned voffA[2], voffB[2];
#pragma unroll
    for (int i = 0; i < 2; ++i) { int R, C; stage_rc(tid * 16 + i * 8192, R, C); const int Rb = Epi::PERM ? ((R & ~31) + perm32(R & 31)) : R;
        voffA[i] = (unsigned)(R * K + C) * 2u; voffB[i] = (unsigned)(Rb * K + C) * 2u; }
    int gR0, gC0; stage_rc(tid * 16, gR0, gC0);
    unsigned vAc[2][2], vAn[2][2];
#define PG8_ROWS(arr, unit) do { _Pragma("unroll") for (int h_ = 0; h_ < 2; ++h_) _Pragma("unroll") for (int i_ = 0; i_ < 2; ++i_) \
        arr[h_][i_] = (unsigned)g.rowmap[(unit).pm * BM + h_ * HALF + i_ * 64 + gR0] * (unsigned)(K * 2) + (unsigned)(gC0 * 2); } while (0)
    const char* const baseA = (const char*)g.A; const char* const baseB = (const char*)g.Bt;
    const __amdgpu_buffer_rsrc_t rsA = __builtin_amdgcn_make_buffer_rsrc((void*)g.A, 0, 0x7ffff000, 0x00020000), rsB = __builtin_amdgcn_make_buffer_rsrc((void*)g.Bt, 0, 0x7ffff000, 0x00020000);
    const unsigned row64 = (unsigned)(64 * K * 2);
    const size_t kstep = (size_t)(BK * 2);
    const size_t hstep = (size_t)HALF * K * 2;
    const size_t tstep = 2 * hstep;
    const unsigned ldsw = (unsigned)wid * 1024u;
    const int aoff = lds_byte(wr * 64 + fr, fq * 8), boff = lds_byte(wc * 32 + fr, fq * 8);
#define PG8_SA(b, h) (((b) * 2 + (h)) * HTB)
#define PG8_SB(b, h) ((4 + (b) * 2 + (h)) * HTB)
#define PG8_STG(bufoff, gbase, W) do { const unsigned so_ = (unsigned)__builtin_amdgcn_readfirstlane((int)((const char*)(gbase) - base##W)); _Pragma("unroll") for (int _i = 0; _i < 2; ++_i) \
        __builtin_amdgcn_raw_ptr_buffer_load_lds(rs##W, (PG8_LAS unsigned*)(lds + (bufoff) + ldsw + _i * 8192), 16, voff##W[_i], so_, 0, 0); } while (0)
#define PG8_STGA(b, h, kptr, arr) do { if constexpr (GATHER) { const unsigned so_ = (unsigned)__builtin_amdgcn_readfirstlane((int)((const char*)(kptr) - baseA)); _Pragma("unroll") for (int _i = 0; _i < 2; ++_i) \
        __builtin_amdgcn_raw_ptr_buffer_load_lds(rsA, (PG8_LAS unsigned*)(lds + PG8_SA(b, h) + ldsw + _i * 8192), 16, arr[h][_i], so_, 0, 0); } \
    else { PG8_STG(PG8_SA(b, h), (kptr) + (h) * hstep, A); } } while (0)
#define PG8_LDA(dst, b, h) do { _Pragma("unroll") for (int m = 0; m < 4; ++m) _Pragma("unroll") for (int k = 0; k < 2; ++k) dst[m][k] = *(const PG8_LAS bf16x8*)(lds + PG8_SA(b, h) + aoff + m * 2048 + k * 1024); } while (0)
#define PG8_LDB(dst, b, h) do { _Pragma("unroll") for (int n = 0; n < 2; ++n) _Pragma("unroll") for (int k = 0; k < 2; ++k) dst[n][k] = *(const PG8_LAS bf16x8*)(lds + PG8_SB(b, h) + boff + n * 2048 + k * 1024); } while (0)
#define PG8_MMA(ai, bj, At, Bt) do { __builtin_amdgcn_s_setprio(1); _Pragma("unroll") for (int m = 0; m < 4; ++m) _Pragma("unroll") for (int n = 0; n < 2; ++n) { \
        if constexpr (FP8) { typedef int i32x8_ __attribute__((ext_vector_type(8))); typedef int i32x4_ __attribute__((ext_vector_type(4))); \
            const i32x8_ bw = __builtin_shufflevector(__builtin_bit_cast(i32x4_, Bt[n][0]), __builtin_bit_cast(i32x4_, Bt[n][1]), 0, 1, 2, 3, 4, 5, 6, 7); \
            const i32x8_ aw = __builtin_shufflevector(__builtin_bit_cast(i32x4_, At[m][0]), __builtin_bit_cast(i32x4_, At[m][1]), 0, 1, 2, 3, 4, 5, 6, 7); \
            asm volatile("v_mfma_scale_f32_16x16x128_f8f6f4 %0, %1, %2, %0, %3, %3 op_sel_hi:[0,0,0]" : "+v"(acc[ai][bj][m][n]) : "v"(bw), "v"(aw), "v"(fp8_one)); } \
        else { _Pragma("unroll") for (int k = 0; k < 2; ++k) acc[ai][bj][m][n] = __builtin_amdgcn_mfma_f32_16x16x32_bf16(Bt[n][k], At[m][k], acc[ai][bj][m][n], 0, 0, 0); } } \
        __builtin_amdgcn_s_setprio(0); } while (0)
#define PG8_WAIT_V(n) asm volatile("s_waitcnt vmcnt(" #n ")" ::: "memory")
#define PG8_WAIT_L(n) asm volatile("s_waitcnt lgkmcnt(" #n ")" ::: "memory")
#define PG8_BAR __builtin_amdgcn_s_barrier()
#define PG8_SCHED __builtin_amdgcn_sched_barrier(0)
    Unit cur, nxt; int ui = 0;
    if (!S.next(0, cur)) return;
    f32x4 acc[2][2][4][2];
#pragma unroll
    for (int a = 0; a < 2; ++a)
#pragma unroll
        for (int b = 0; b < 2; ++b)
#pragma unroll
            for (int m = 0; m < 4; ++m)
#pragma unroll
                for (int n = 0; n < 2; ++n) acc[a][b][m][n] = (f32x4){0.f, 0.f, 0.f, 0.f};
    int fp8_one = FP8_ONE; asm volatile("" : "+v"(fp8_one));
    typedef int i32x8_ __attribute__((ext_vector_type(8))); typedef int i32x4_ __attribute__((ext_vector_type(4)));
    bf16x8 At[4][2], B0[2][2], B1[2][2];
    const char* cA = (const char*)g.A + (GATHER ? (size_t)0 : (size_t)cur.pm * tstep); const char* cB = (const char*)g.Bt + (size_t)cur.pn * tstep;
    if constexpr (GATHER) PG8_ROWS(vAc, cur);
    S.a_ready(cur);
    PG8_STG(PG8_SB(0, 0), cB, B); PG8_STGA(0, 0, cA, vAc); PG8_STG(PG8_SB(0, 1), cB + hstep, B); PG8_STGA(0, 1, cA, vAc);
    if (wr == 1) PG8_BAR;
    PG8_WAIT_V(4); PG8_BAR;
    PG8_STG(PG8_SB(1, 0), cB + kstep, B); PG8_STGA(1, 0, cA + kstep, vAc); PG8_STG(PG8_SB(1, 1), cB + hstep + kstep, B);
    PG8_WAIT_V(6); PG8_BAR;
    PG8_STAMP();
    for (;;) {
        const bool has_next = S.next(ui + 1, nxt);
        const char* nA = (has_next && !GATHER) ? (const char*)g.A + (size_t)nxt.pm * tstep : cA; const char* nB = has_next ? (const char*)g.Bt + (size_t)nxt.pn * tstep : cB;
        if constexpr (GATHER) { if (has_next) PG8_ROWS(vAn, nxt); else { _Pragma("unroll") for (int h_ = 0; h_ < 2; ++h_) _Pragma("unroll") for (int i_ = 0; i_ < 2; ++i_) vAn[h_][i_] = vAc[h_][i_]; } }
        for (int t = 0; t < nt; t += 2) {
            const bool last = (t == nt - 2);
            const char* a1 = cA + (size_t)(t + 1) * kstep;
            const char* a2 = last ? nA : cA + (size_t)(t + 2) * kstep; const char* b2 = last ? nB : cB + (size_t)(t + 2) * kstep;
            const char* a3 = a2 + kstep; const char* b3 = b2 + kstep;
            if (last && has_next) S.a_ready(nxt);
            PG8_LDB(B0, 0, 0); PG8_SCHED; PG8_LDA(At, 0, 0); PG8_STGA(1, 1, a1, vAc);
            PG8_WAIT_L(8); PG8_BAR; PG8_WAIT_L(0); PG8_MMA(0, 0, At, B0); PG8_BAR; PG8_SCHED;
            PG8_LDB(B1, 0, 1); PG8_STG(PG8_SB(0, 0), b2, B);
            PG8_BAR; PG8_WAIT_L(0); PG8_MMA(0, 1, At, B1); PG8_BAR;
            PG8_LDA(At, 0, 1); if (GATHER && last) PG8_STGA(0, 0, a2, vAn); else PG8_STGA(0, 0, a2, vAc);
            PG8_BAR; PG8_WAIT_L(0); PG8_MMA(1, 0, At, B0); PG8_BAR; PG8_SCHED;
            PG8_STG(PG8_SB(0, 1), b2 + hstep, B);
            PG8_WAIT_V(6); PG8_BAR; PG8_MMA(1, 1, At, B1); PG8_BAR;
            PG8_LDB(B0, 1, 0); PG8_SCHED; PG8_LDA(At, 1, 0); if (GATHER && last) PG8_STGA(0, 1, a2, vAn); else PG8_STGA(0, 1, a2, vAc);
            PG8_WAIT_L(8); PG8_BAR; PG8_WAIT_L(0); PG8_MMA(0, 0, At, B0); PG8_BAR; PG8_SCHED;
            PG8_LDB(B1, 1, 1); PG8_STG(PG8_SB(1, 0), b3, B);
            PG8_BAR; PG8_WAIT_L(0); PG8_MMA(0, 1, At, B1); PG8_BAR;
            PG8_LDA(At, 1, 1); if (GATHER && last) PG8_STGA(1, 0, a3, vAn); else PG8_STGA(1, 0, a3, vAc);
            PG8_BAR; PG8_WAIT_L(0); PG8_MMA(1, 0, At, B0); PG8_BAR; PG8_SCHED;
            PG8_STG(PG8_SB(1, 1), b3 + hstep, B);
            PG8_WAIT_V(6); PG8_BAR; PG8_MMA(1, 1, At, B1); PG8_BAR;
        }
        PG8_STAMP();
        if constexpr (FP8) asm volatile("s_nop 15\n\ts_nop 15\n\ts_nop 15" ::: "memory");
        if constexpr (!Epi::AFTER_DRAIN) { __builtin_amdgcn_sched_barrier(0); E(acc, cur, wr, wc, fr, fq); S.done(cur); __builtin_amdgcn_sched_barrier(0); }
        PG8_STAMP();
        if (!has_next) break;
#pragma unroll
        for (int a = 0; a < 2; ++a)
#pragma unroll
            for (int b = 0; b < 2; ++b)
#pragma unroll
                for (int m = 0; m < 4; ++m)
#pragma unroll
                    for (int n = 0; n < 2; ++n) acc[a][b][m][n] = (f32x4){0.f, 0.f, 0.f, 0.f};
        cur = nxt; cA = nA; cB = nB; ++ui;
        if constexpr (GATHER) { _Pragma("unroll") for (int h_ = 0; h_ < 2; ++h_) _Pragma("unroll") for (int i_ = 0; i_ < 2; ++i_) vAc[h_][i_] = vAn[h_][i_]; }
    }
    PG8_WAIT_V(0);
    if (wr == 0) PG8_BAR;
    PG8_BAR;
    if constexpr (Epi::AFTER_DRAIN) { E.fused(acc, cur, wr, wc, fr, fq, lds, wid, lane); S.done(cur); }
    PG8_STAMP();
    if (STAMP && wid == 0) { stamps[lane] = lane < nts ? (((unsigned long long)(unsigned)ts_hi << 32) | (unsigned)ts_lo) : 0ull;
        if (lane == 62) stamps[62] = rt_entry; if (lane == 63) stamps[63] = (unsigned long long)wall_clock64(); }
#undef PG8_STAMP
#undef PG8_SA
#undef PG8_SB
#undef PG8_STG
#undef PG8_STGA
#undef PG8_ROWS
#undef PG8_LDA
#undef PG8_LDB
#undef PG8_MMA
#undef PG8_WAIT_V
#undef PG8_WAIT_L
#undef PG8_BAR
#undef PG8_SCHED
}
}

__device__ __forceinline__ void epi_lane(int& fr, int& fq) { int l = (int)__builtin_amdgcn_mbcnt_hi(~0u, __builtin_amdgcn_mbcnt_lo(~0u, 0u)); asm volatile("" : "+v"(l)); fr = l & 15; fq = l >> 4; }
struct EpiStoreBf16 {
    static constexpr bool PERM = true, AFTER_DRAIN = false;
    bf16_t* O; int ldc;
    __device__ __forceinline__ void operator()(const f32x4 (&acc)[2][2][4][2], const pg8::Unit& u, int wr, int wc, int fr_, int fq_) const {
        int fr, fq; epi_lane(fr, fq); (void)fr_; (void)fq_;
        const int row0 = u.pm * 256 + wr * 64 + fr, col0 = u.pn * 256 + wc * 32 + 8 * fq;
#pragma unroll
        for (int ai = 0; ai < 2; ++ai)
#pragma unroll
            for (int m = 0; m < 4; ++m) { bf16_t* rowp = O + (size_t)(row0 + ai * 128 + m * 16) * ldc + col0;
#pragma unroll
                for (int bj = 0; bj < 2; ++bj) { const f32x4 v0 = acc[ai][bj][m][0], v1 = acc[ai][bj][m][1];
                    u32x4 w; w.x = pk2(v0[0], v0[1]); w.y = pk2(v0[2], v0[3]); w.z = pk2(v1[0], v1[1]); w.w = pk2(v1[2], v1[3]);
                    *(u32x4*)(rowp + bj * 128) = w; } }
    }
};
struct EpiResid {
    static constexpr bool PERM = false, AFTER_DRAIN = false;
    const float* xin_lat; const float* xin_ctx; float* xo; const float* mod_gate; float wscale;
    __device__ __forceinline__ void operator()(const f32x4 (&acc)[2][2][4][2], const pg8::Unit& u, int wr, int wc, int fr_, int fq_) const {
        int fr, fq; epi_lane(fr, fq); (void)fr_; (void)fq_;
        const int row0 = u.pm * 256 + wr * 64 + fr, col0 = u.pn * 256 + wc * 32 + 4 * fq;
        const int mrow = (u.pm < TL / 256) ? (u.pm >> 5) : 4;
        const float* xin = (u.pm < TL / 256) ? xin_lat : (xin_ctx - (size_t)TL * 1024);
        f32x4 gv[2][2];
#pragma unroll
        for (int bj = 0; bj < 2; ++bj)
#pragma unroll
            for (int n = 0; n < 2; ++n) gv[bj][n] = *(const f32x4*)(mod_gate + (size_t)mrow * 6144 + col0 + bj * 128 + n * 16) * wscale;
#pragma unroll
        for (int ai = 0; ai < 2; ++ai)
#pragma unroll
            for (int m = 0; m < 4; ++m) { const size_t off = (size_t)(row0 + ai * 128 + m * 16) * 1024 + col0;
#pragma unroll
                for (int bj = 0; bj < 2; ++bj)
#pragma unroll
                    for (int n = 0; n < 2; ++n) { const f32x4 xi = *(const f32x4*)(xin + off + bj * 128 + n * 16);
                        *(f32x4*)(xo + off + bj * 128 + n * 16) = xi + gv[bj][n] * acc[ai][bj][m][n]; } }
    }
};
__device__ __forceinline__ float swiglu_(float g, float u) {
    g = fminf(g, 7.0f); u = fminf(fmaxf(u, -7.0f), 7.0f);
    return (u + 1.0f) * g * __builtin_amdgcn_rcpf(1.0f + fexp(-1.702f * g));
}
struct EpiGU {
    static constexpr bool PERM = true, AFTER_DRAIN = false;
    unsigned char* Act; const float* bias;
    __device__ __forceinline__ void operator()(const f32x4 (&acc)[2][2][4][2], const pg8::Unit& u, int wr, int wc, int fr_, int fq_) const {
        int fr, fq; epi_lane(fr, fq); (void)fr_; (void)fq_;
        const int e = u.pn >> 3, pnl = u.pn & 7;
        const int row0 = u.pm * 256 + wr * 64 + fr, col0 = pnl * 256 + wc * 32 + 8 * fq;
        f32x4 bv[2][2];
#pragma unroll
        for (int bj = 0; bj < 2; ++bj)
#pragma unroll
            for (int n = 0; n < 2; ++n) bv[bj][n] = *(const f32x4*)(bias + (size_t)e * 2048 + col0 + bj * 128 + 4 * n);
#pragma unroll
        for (int ai = 0; ai < 2; ++ai)
#pragma unroll
            for (int m = 0; m < 4; ++m) { unsigned char* rowp = Act + (size_t)(row0 + ai * 128 + m * 16) * 1024 + (col0 >> 1);
#pragma unroll
                for (int bj = 0; bj < 2; ++bj) { const f32x4 v0 = acc[ai][bj][m][0] * 0.03125f + bv[bj][0], v1 = acc[ai][bj][m][1] * 0.03125f + bv[bj][1];
                    *(unsigned*)(rowp + bj * 64) = pk_fp8x4(swiglu_(v0[0], v0[1]), swiglu_(v0[2], v0[3]), swiglu_(v1[0], v1[1]), swiglu_(v1[2], v1[3])); }
                __builtin_amdgcn_sched_barrier(0); }
    }
};
struct EpiDown {
    static constexpr bool PERM = true, AFTER_DRAIN = false;
    bf16_t* Y; const float* bias; const int* slot_a; const float* slot_g;
    __device__ __forceinline__ void operator()(const f32x4 (&acc)[2][2][4][2], const pg8::Unit& u, int wr, int wc, int fr_, int fq_) const {
        int fr, fq; epi_lane(fr, fq); (void)fr_; (void)fq_;
        const int e = u.pn >> 2, pnl = u.pn & 3;
        const int row0 = u.pm * 256 + wr * 64 + fr, col0 = pnl * 256 + wc * 32 + 8 * fq;
        f32x4 bv[2][2];
#pragma unroll
        for (int bj = 0; bj < 2; ++bj)
#pragma unroll
            for (int n = 0; n < 2; ++n) bv[bj][n] = *(const f32x4*)(bias + (size_t)e * 1024 + col0 + bj * 128 + 4 * n);
#pragma unroll
        for (int ai = 0; ai < 2; ++ai)
#pragma unroll
            for (int m = 0; m < 4; ++m) { const int slot = row0 + ai * 128 + m * 16; const int a = slot_a[slot]; const float gt = slot_g[slot];
                if (a >= 0) { bf16_t* rowp = Y + (size_t)a * 1024 + col0;
#pragma unroll
                    for (int bj = 0; bj < 2; ++bj) { const f32x4 v0 = (acc[ai][bj][m][0] * 0.03125f + bv[bj][0]) * gt, v1 = (acc[ai][bj][m][1] * 0.03125f + bv[bj][1]) * gt;
                        u32x4 w; w.x = pk2(v0[0], v0[1]); w.y = pk2(v0[2], v0[3]); w.z = pk2(v1[0], v1[1]); w.w = pk2(v1[2], v1[3]);
                        *(u32x4*)(rowp + bj * 128) = w; } } }
    }
};
struct MoeOrder {
    const int* tile_e; int ntiles, nN, G, c;
    __device__ __forceinline__ bool next(int i, pg8::Unit& u) const {
        const int x = c & 7, r = c >> 3, j = i * (G >> 3) + r;
        const int pm = x + 8 * (j / nN), pl = j % nN; if (pm >= ntiles) return false;
        u.pm = pm; u.pn = __builtin_amdgcn_readfirstlane(tile_e[pm]) * nN + pl; return true;
    }
    __device__ __forceinline__ void a_ready(const pg8::Unit&) const {}
    __device__ __forceinline__ void done(const pg8::Unit&) const {}
};

__device__ __forceinline__ void transpose_tile(int wv, const float* __restrict__ src, int ldsrc, int k0, int n0, int nmax, bf16_t* __restrict__ dst, int ldd, LAS unsigned char* lds) {
    LAS bf16_t* T = (LAS bf16_t*)lds;
    const int tid = otid(wv), r = tid >> 4, c4 = (tid & 15) * 4;
#pragma unroll
    for (int pass = 0; pass < 2; ++pass) { const int k = r + 32 * pass;
        f32x4 v = (f32x4){0.f, 0.f, 0.f, 0.f};
        if (n0 + c4 < nmax) v = *(const f32x4*)(src + (size_t)(k0 + k) * ldsrc + n0 + c4);
#pragma unroll
        for (int i = 0; i < 4; ++i) T[(c4 + i) * 66 + k] = f2bf(v[i]); }
    __syncthreads();
    { const int n = tid >> 3, kc = (tid & 7) * 8;
      if (n0 + n < nmax) { const LAS unsigned* tp = (const LAS unsigned*)(T + n * 66 + kc); u32x4 w; w.x = tp[0]; w.y = tp[1]; w.z = tp[2]; w.w = tp[3];
          *(u32x4*)(dst + (size_t)(n0 + n) * ldd + k0 + kc) = w; } }
    __syncthreads();
}

__device__ __forceinline__ void transpose_tile_fp8(int wv, const float* __restrict__ src, int ldsrc, int k0, int n0, unsigned char* __restrict__ dst, int ldd, LAS unsigned char* lds) {
    LAS float* T = (LAS float*)lds;
    const int tid = otid(wv), r = tid >> 4, c4 = (tid & 15) * 4;
#pragma unroll
    for (int pass = 0; pass < 2; ++pass) { const int k = r + 32 * pass;
        const f32x4 v = *(const f32x4*)(src + (size_t)(k0 + k) * ldsrc + n0 + c4);
#pragma unroll
        for (int i = 0; i < 4; ++i) T[(c4 + i) * 65 + k] = v[i] * 32.0f; }
    __syncthreads();
    { const int n = tid >> 3, kc = (tid & 7) * 8; const LAS float* tp = T + n * 65 + kc;
      u32x2 w; w.x = pk_fp8x4(tp[0], tp[1], tp[2], tp[3]); w.y = pk_fp8x4(tp[4], tp[5], tp[6], tp[7]);
      *(u32x2*)(dst + (size_t)(n0 + n) * ldd + k0 + kc) = w; }
    __syncthreads();
}

__device__ __forceinline__ void phase_prologue(int wv, const Params& p, LAS unsigned char* lds) {
    const int tid = otid(wv), bid = blockIdx.x, nblk = gridDim.x;
    unsigned char* ws = opq(p.ws);
    unsigned char* WGU = ws + WS_WGU; unsigned char* WDN = ws + WS_WDN; bf16_t* WOUT = (bf16_t*)(ws + WS_WOUT); bf16_t* WIN = (bf16_t*)(ws + WS_WIN); bf16_t* WRT = (bf16_t*)(ws + WS_WRT);
    float* MOD = (float*)(ws + WS_MOD); float2* RA = (float2*)(ws + WS_RA); float2* RD = (float2*)(ws + WS_RD);
    constexpr int T_WGU = 64 * 16 * 32, T_WDN = 64 * 16 * 16, T_WOUT = 2 * 256, T_WIN = 2 * 16 * 42, T_FOLD = 2 * 64, T_ADA = 2 * 96, T_ROPE = SEQ * 48 / 512, T_WRT = 2 * 32 * 1024 / 512, T_PAD = 2 * 16 * 1024 / 512;
    constexpr int O_WDN = T_WGU, O_WOUT = O_WDN + T_WDN, O_WIN = O_WOUT + T_WOUT, O_FOLD = O_WIN + T_WIN, O_ADA = O_FOLD + T_FOLD, O_ROPE = O_ADA + T_ADA, O_WRT = O_ROPE + T_ROPE, O_PAD = O_WRT + T_WRT, NTASK = O_PAD + T_PAD;
    {
        constexpr int NT_GU = 64 * 8 * 32, NT_DN = 64 * 8 * 16, NT_WO = YM_FP8 ? 2 * 8 * 16 : 0, NT_ALL = NT_GU + NT_DN + NT_WO;
        const int tid = otid(wv), r = tid >> 4, c4 = (tid & 15) * 4, on = tid >> 3, okc = (tid & 7) * 16;
        f32x4 v[4];
        auto tile_src = [&](int tt, const float*& src, int& ldsrc, unsigned char*& dst) {
            if (tt < NT_GU) { const int mat = tt >> 8, t = tt & 255, kt = t >> 5, nt = t & 31; src = p.w_gu + (size_t)mat * 1024 * 2048 + (size_t)kt * 128 * 2048 + nt * 64; ldsrc = 2048; dst = WGU + (size_t)mat * 2048 * 1024 + (size_t)nt * 64 * 1024 + kt * 128; }
            else if (tt >= NT_GU + NT_DN) { const int u = tt - NT_GU - NT_DN, mat = u >> 7, t = u & 127, kt = t >> 4, nt = t & 15; src = p.w_out + (size_t)mat * 1024 * 1024 + (size_t)kt * 128 * 1024 + nt * 64; ldsrc = 1024; dst = (unsigned char*)WOUT + (size_t)mat * 1024 * 1024 + (size_t)nt * 64 * 1024 + kt * 128; }
            else { const int u = tt - NT_GU, mat = u >> 7, t = u & 127, kt = t >> 4, nt = t & 15; src = p.w_down + (size_t)mat * 1024 * 1024 + (size_t)kt * 128 * 1024 + nt * 64; ldsrc = 1024; dst = WDN + (size_t)mat * 1024 * 1024 + (size_t)nt * 64 * 1024 + kt * 128; } };
        int tt = bid; int buf = 0;
        if (tt < NT_ALL) { const float* src; int ld; unsigned char* dst; tile_src(tt, src, ld, dst);
#pragma unroll
            for (int ps = 0; ps < 4; ++ps) v[ps] = *(const f32x4*)(src + (size_t)(r + 32 * ps) * ld + c4); }
        for (; tt < NT_ALL; tt += nblk) {
            LAS float* T = (LAS float*)(lds + buf * 33280);
#pragma unroll
            for (int ps = 0; ps < 4; ++ps)
#pragma unroll
                for (int i = 0; i < 4; ++i) T[(c4 + i) * 130 + r + 32 * ps] = v[ps][i] * 32.0f;
            __syncthreads();
            const float* src; int ld; unsigned char* dst; tile_src(tt, src, ld, dst);
            if (tt + nblk < NT_ALL) { const float* s2; int ld2; unsigned char* d2; tile_src(tt + nblk, s2, ld2, d2);
#pragma unroll
                for (int ps = 0; ps < 4; ++ps) v[ps] = *(const f32x4*)(s2 + (size_t)(r + 32 * ps) * ld2 + c4); }
            const LAS float* tp = T + on * 130 + okc;
            u32x4 w; w.x = pk_fp8x4(tp[0], tp[1], tp[2], tp[3]); w.y = pk_fp8x4(tp[4], tp[5], tp[6], tp[7]); w.z = pk_fp8x4(tp[8], tp[9], tp[10], tp[11]); w.w = pk_fp8x4(tp[12], tp[13], tp[14], tp[15]);
            *(u32x4*)(dst + (size_t)on * 1024 + okc) = w;
            buf ^= 1;
        }
        __syncthreads();
    }
    for (int task = bid + O_WOUT; task < NTASK; task += nblk) {
        if (task < O_WDN) {
            const int mat = task >> 9, t = task & 511, kt = t >> 5, nt = t & 31;
            transpose_tile_fp8(wv, p.w_gu + (size_t)mat * 1024 * 2048, 2048, kt * 64, nt * 64, WGU + (size_t)mat * 2048 * 1024, 1024, lds);
        } else if (task < O_WOUT) {
            const int tt = task - O_WDN, mat = tt >> 8, t = tt & 255, kt = t >> 4, nt = t & 15;
            transpose_tile_fp8(wv, p.w_down + (size_t)mat * 1024 * 1024, 1024, kt * 64, nt * 64, WDN + (size_t)mat * 1024 * 1024, 1024, lds);
        } else if (task < O_WIN) {
            if (YM_FP8) continue;
            const int tt = task - O_WOUT, mat = tt >> 8, t = tt & 255, kt = t >> 4, nt = t & 15;
            transpose_tile(wv, p.w_out + (size_t)mat * 1024 * 1024, 1024, kt * 64, nt * 64, 1024, WOUT + (size_t)mat * 1024 * 1024, 1024, lds);
        } else if (task < O_FOLD) {
            const int tt = task - O_WIN, mat = tt / (16 * 42), t = tt % (16 * 42), kt = t / 42, nt = t % 42;
            transpose_tile(wv, p.w_in + (size_t)mat * 1024 * INC, INC, kt * 64, nt * 64, INC, WIN + (size_t)mat * NP * 1024, 1024, lds);
        } else if (task < O_ADA) {
            const int tt = task - O_FOLD, l = tt >> 6, k0 = (tt & 63) * 16;
            LAS float* Aq = (LAS float*)lds;
            LAS float* Akv = Aq + 16 * 192;
            for (int i = tid; i < 16 * 192; i += NTHR) { const int r = i / 192, j = i % 192; Aq[i] = p.w_in[((size_t)l * 1024 + k0 + r) * INC + PC_DCQ + j] * p.mla_g_q[l * 192 + j]; }
            for (int i = tid; i < 16 * 128; i += NTHR) { const int r = i / 128, j = i % 128; Akv[i] = p.w_in[((size_t)l * 1024 + k0 + r) * INC + PC_DCKV + j] * p.mla_g_kv[l * 128 + j]; }
            __syncthreads();
            for (int n = tid; n < 896; n += NTHR) {
                float acc[16];
#pragma unroll
                for (int r = 0; r < 16; ++r) acc[r] = 0.f;
                if (n < 384) { const float* W = p.mla_w_uq + (size_t)l * 192 * 384 + n;
                    for (int j = 0; j < 192; ++j) { const float wv = W[(size_t)j * 384];
#pragma unroll
                        for (int r = 0; r < 16; ++r) acc[r] += Aq[r * 192 + j] * wv; }
                } else { const float* W = p.mla_w_ukv + (size_t)l * 128 * 512 + (n - 384);
                    for (int j = 0; j < 128; ++j) { const float wv = W[(size_t)j * 512];
#pragma unroll
                        for (int r = 0; r < 16; ++r) acc[r] += Akv[r * 128 + j] * wv; } }
                u32x4 w0, w1; w0.x = pk2(acc[0], acc[1]); w0.y = pk2(acc[2], acc[3]); w0.z = pk2(acc[4], acc[5]); w0.w = pk2(acc[6], acc[7]);
                w1.x = pk2(acc[8], acc[9]); w1.y = pk2(acc[10], acc[11]); w1.z = pk2(acc[12], acc[13]); w1.w = pk2(acc[14], acc[15]);
                bf16_t* d = WIN + ((size_t)l * NP + PC_DQF + n) * 1024 + k0; *(u32x4*)d = w0; *(u32x4*)(d + 8) = w1;
            }
            __syncthreads();
        } else if (task < O_ROPE) {
            const int tt = task - O_ADA, l = tt / 96, n0 = (tt % 96) * 64;
            LAS float* SC = (LAS float*)lds;
            LAS float* RED = SC + 5 * 1024;
            for (int i = tid; i < 5 * 1024; i += NTHR) { const int r = i >> 10, k = i & 1023; const float v = (r < 4) ? p.c[r * 1024 + k] : p.c_ctx[k]; SC[i] = siluf_(v); }
            __syncthreads();
            { const int kc = tid >> 6, col = tid & 63; float a[5] = {0.f, 0.f, 0.f, 0.f, 0.f};
              const float* W = p.w_ada + ((size_t)l * 1024 + kc * 128) * 6144 + n0 + col;
              for (int k = 0; k < 128; ++k) { const float wv = W[(size_t)k * 6144];
#pragma unroll
                  for (int r = 0; r < 5; ++r) a[r] += SC[r * 1024 + kc * 128 + k] * wv; }
#pragma unroll
              for (int r = 0; r < 5; ++r) RED[(kc * 5 + r) * 64 + col] = a[r]; }
            __syncthreads();
            if (tid < 320) { const int r = tid >> 6, col = tid & 63; float s = p.b_ada[l * 6144 + n0 + col];
#pragma unroll
                for (int kc = 0; kc < 8; ++kc) s += RED[(kc * 5 + r) * 64 + col];
                MOD[((size_t)l * 5 + r) * 6144 + n0 + col] = s; }
            __syncthreads();
        } else if (task < O_WRT) {
            const int idx = (task - O_ROPE) * 512 + tid, t = idx / 48, j = idx % 48;
            if (j < 32) { const int i = j & 15; const float inv = powf(10000.0f, -(float)(2 * i) / 32.0f); const float pos = (j < 16) ? (float)(t >> 6) : (float)(t & 63);
                float s, c; sincosf(pos * inv, &s, &c); RA[t * 32 + j] = make_float2(c, s); }
            else { const int jj = j - 32, i = jj & 7; const float inv = powf(10000.0f, -(float)(2 * i) / 16.0f); const float pos = (jj < 8) ? (float)(t >> 6) : (float)(t & 63);
                float s, c; sincosf(pos * inv, &s, &c); RD[t * 16 + jj] = make_float2(c, s); }
        } else if (task < O_PAD) {
            const int idx = (task - O_WRT) * 512 + tid, l = idx >> 15, e = (idx >> 10) & 31, k = idx & 1023;
            const float w = p.w_router[((size_t)l * 1024 + k) * 32 + e]; const unsigned short hi = f2bf(w); const unsigned short lo = f2bf(w - bf2f(hi));
            WRT[(((size_t)l * 2 + 0) * 32 + e) * 1024 + k] = hi; WRT[(((size_t)l * 2 + 1) * 32 + e) * 1024 + k] = lo;
        } else {
            const int idx = (task - O_PAD) * 512 + tid, l = idx >> 14, r = (idx >> 10) & 15, k = idx & 1023;
            WIN[((size_t)l * NP + PC_END + r) * 1024 + k] = 0;
        }
    }
}

__device__ __forceinline__ void phase_norm1_l0(int wv, const Params& p) {
    const int tid = otid(wv), lane = tid & 63, gw = blockIdx.x * NWAVE + (tid >> 6), nw = gridDim.x * NWAVE;
    const float* MOD = (const float*)(p.ws + WS_MOD); bf16_t* HB = (bf16_t*)(p.ws + WS_HB);
    for (int r = gw; r < TA; r += nw) {
        const float* src = (r < TL) ? p.x + (size_t)r * 1024 : p.ctx + (size_t)(r - TL) * 1024;
        const int mrow = (r < TL) ? (r >> 13) : 4; const float* mod = MOD + (size_t)mrow * 6144;
        f32x4 v[4]; row_load(src, lane, v); const float rstd = row_rstd(v);
        row_modulate(v, rstd, p.g_norm1, mod + 1024, mod, lane);
        row_store_bf16(HB + (size_t)r * 1024, lane, v);
    }
}
__device__ __forceinline__ void phase_combine(int wv, const Params& p, int l) {
    const int tid = otid(wv), lane = tid & 63, gw = blockIdx.x * NWAVE + (tid >> 6), nw = gridDim.x * NWAVE;
    const float* MOD = (const float*)(p.ws + WS_MOD); bf16_t* HB = (bf16_t*)(p.ws + WS_HB); const bf16_t* Y = (const bf16_t*)(p.ws + WS_Y);
    const float* XA = (const float*)(p.ws + WS_XA); float* XB = (float*)(p.ws + WS_XB);
    const int T = (l == 0) ? TA : TL;
    for (int r = gw; r < T; r += nw) {
        const int mrow = (r < TL) ? (r >> 13) : 4; const float* mod = MOD + ((size_t)l * 5 + mrow) * 6144;
        f32x4 v[4]; row_load(XA + (size_t)r * 1024, lane, v);
#pragma unroll
        for (int i = 0; i < 4; ++i) {
            f32x4 s = (f32x4){0.f, 0.f, 0.f, 0.f};
#pragma unroll
            for (int k = 0; k < 4; ++k) { const u32x2 w = *(const u32x2*)(Y + ((size_t)r * 4 + k) * 1024 + i * 256 + lane * 4);
                s[0] += bf2f(w.x & 0xffffu); s[1] += bf2f(w.x >> 16); s[2] += bf2f(w.y & 0xffffu); s[3] += bf2f(w.y >> 16); }
            const f32x4 g2 = *(const f32x4*)(mod + 5 * 1024 + i * 256 + lane * 4);
            v[i] = v[i] + g2 * s;
        }
        const float rstd = row_rstd(v);
        if (l == 0) {
#pragma unroll
            for (int i = 0; i < 4; ++i) *(f32x4*)(XB + (size_t)r * 1024 + i * 256 + lane * 4) = v[i];
            const float* mod1 = MOD + ((size_t)5 + mrow) * 6144;
            row_modulate(v, rstd, p.g_norm1 + 1024, mod1 + 1024, mod1, lane);
            row_store_bf16(HB + (size_t)r * 1024, lane, v);
        } else {
#pragma unroll
            for (int i = 0; i < 4; ++i) { const f32x4 gg = *(const f32x4*)(p.g_final + i * 256 + lane * 4);
                *(f32x4*)(p.out + (size_t)r * 1024 + i * 256 + lane * 4) = v[i] * rstd * gg; }
        }
    }
}

__device__ __forceinline__ int cu_index(int b, int tc, int h, int dir) { return ((b * NCHUNK + tc) * 4 + h) * 2 + dir; }
__device__ __forceinline__ float logsigmoidf_(float x) { return fminf(x, 0.f) - log1pf(__expf(-fabsf(x))); }

__device__ __forceinline__ void prep_elem(int wv, const Params& p, int l, LAS unsigned char* lds) {
    const int tid = otid(wv);
    unsigned char* ws = opq(p.ws);
    const bf16_t* P = (const bf16_t*)(ws + WS_P);
    bf16_t* QA = (bf16_t*)(ws + WS_QA); bf16_t* KA = (bf16_t*)(ws + WS_KA); bf16_t* QD = (bf16_t*)(ws + WS_QD); bf16_t* KD = (bf16_t*)(ws + WS_KD); bf16_t* VD = (bf16_t*)(ws + WS_VD);
    bf16_t* QC = (bf16_t*)(ws + WS_QC); bf16_t* KC = (bf16_t*)(ws + WS_KC); float* GATES = (float*)(ws + WS_GATES);
    const float2* RA = (const float2*)(ws + WS_RA); const float2* RD = (const float2*)(ws + WS_RD);
    LAS float* RQ = (LAS float*)lds;
    const int per = (TA + gridDim.x - 1) / gridDim.x, rbeg = blockIdx.x * per, rend = min(rbeg + per, TA);
    for (int row0 = rbeg; row0 < rend; row0 += 32) {
        const int nr = min(32, rend - row0);
        { const int i = tid >> 4, sub = tid & 15; float sq = 0.f, sk = 0.f;
          if (i < nr) { const bf16_t* pr = P + (size_t)(row0 + i) * NP + PC_DCQ;
              const u32x4 c0 = *(const u32x4*)(pr + sub * 8), c1 = *(const u32x4*)(pr + (sub + 16) * 8); u32x4 c2 = (u32x4){0u, 0u, 0u, 0u}; if (sub < 8) c2 = *(const u32x4*)(pr + (sub + 32) * 8);
#pragma unroll
              for (int q = 0; q < 4; ++q) { const float a0 = bf2f(c0[q] & 0xffffu), a1 = bf2f(c0[q] >> 16), b0 = bf2f(c1[q] & 0xffffu), b1 = bf2f(c1[q] >> 16), d0 = bf2f(c2[q] & 0xffffu), d1 = bf2f(c2[q] >> 16);
                  sq += a0 * a0 + a1 * a1; const float t1 = b0 * b0 + b1 * b1; if (sub < 8) sq += t1; else sk += t1; sk += d0 * d0 + d1 * d1; } }
#pragma unroll
          for (int d = 8; d >= 1; d >>= 1) { sq += __shfl_xor(sq, d); sk += __shfl_xor(sk, d); }
          if (sub == 0 && i < nr) { RQ[i] = rsqrtf(sq * (1.0f / 192.0f) + EPS); RQ[32 + i] = rsqrtf(sk * (1.0f / 128.0f) + EPS); } }
        for (int it = tid; it < nr * 24; it += NTHR) {
            const int i = it / 24, r = it % 24, head = r >> 2, j0 = (r & 3) * 8, row = row0 + i;
            const bf16_t* src = P + (size_t)row * NP + (head < 4 ? PC_AQ + head * 64 : PC_AK + (head - 4) * 64) + j0;
            const u32x4 a = *(const u32x4*)src, bq = *(const u32x4*)(src + 32);
            u32x4 o1, o2;
            if (row >= TL) { o1 = a; o2 = bq; }
            else { const float2* tab = RA + (size_t)(row & (SEQ - 1)) * 32 + j0;
#pragma unroll
                for (int q = 0; q < 4; ++q) { const float x1a = bf2f(a[q] & 0xffffu), x1b = bf2f(a[q] >> 16), x2a = bf2f(bq[q] & 0xffffu), x2b = bf2f(bq[q] >> 16);
                    const float2 ca = tab[2 * q], cb = tab[2 * q + 1];
                    o1[q] = pk2(x1a * ca.x - x2a * ca.y, x1b * cb.x - x2b * cb.y); o2[q] = pk2(x2a * ca.x + x1a * ca.y, x2b * cb.x + x1b * cb.y); } }
            bf16_t* dst = (head < 4) ? QA + (size_t)row * 256 + head * 64 + j0 : KA + (size_t)row * 128 + (head - 4) * 64 + j0;
            *(u32x4*)dst = o1; *(u32x4*)(dst + 32) = o2;
        }
        for (int it = tid; it < nr * 64; it += NTHR) {
            const int i = it >> 6, c0 = (it & 63) * 8, row = row0 + i;
            const bool isc = row >= TL; const int t = isc ? ((row - TL) & (CTXL - 1)) : (row & (SEQ - 1)), nseq = isc ? CTXL : SEQ;
            const bf16_t* src = P + (size_t)row * NP + PC_CQK + c0;
            const u32x4 u1 = *(const u32x4*)src;
            u32x4 u0 = (u32x4){0u, 0u, 0u, 0u}, u2 = (u32x4){0u, 0u, 0u, 0u};
            if (t > 0) u0 = *(const u32x4*)(src - NP);
            if (t + 1 < nseq) u2 = *(const u32x4*)(src + NP);
            const float* cw = p.mlstm_conv + (size_t)l * 3 * 512 + c0;
            const float sc = (c0 >= 256) ? 0.125f : 1.0f;
            u32x4 o;
#pragma unroll
            for (int q = 0; q < 4; ++q) {
                const float ya = cw[2 * q] * bf2f(u0[q] & 0xffffu) + cw[512 + 2 * q] * bf2f(u1[q] & 0xffffu) + cw[1024 + 2 * q] * bf2f(u2[q] & 0xffffu);
                const float yb = cw[2 * q + 1] * bf2f(u0[q] >> 16) + cw[512 + 2 * q + 1] * bf2f(u1[q] >> 16) + cw[1024 + 2 * q + 1] * bf2f(u2[q] >> 16);
                o[q] = pk2(siluf_(ya) * sc, siluf_(yb) * sc); }
            if (c0 < 256) *(u32x4*)(QC + (size_t)row * 256 + c0) = o; else *(u32x4*)(KC + (size_t)row * 256 + (c0 - 256)) = o;
        }
        { const int i = tid >> 4, gi = tid & 15;
          if (i < nr) { float v = bf2f(P[(size_t)(row0 + i) * NP + PC_CG + gi]) + p.mlstm_gate_bias[l * 16 + gi];
              if ((gi >> 2) & 1) v = logsigmoidf_(v);
              GATES[(size_t)(row0 + i) * 16 + gi] = v; } }
        __syncthreads();
        for (int it = tid; it < nr * 128; it += NTHR) {
            const int i = it >> 7, g = it & 127, row = row0 + i; const bool is_ctx = row >= TL; const int t = row & (SEQ - 1);
            const bf16_t* pr = P + (size_t)row * NP;
            const float rq = RQ[i], rkv = RQ[32 + i];
            u32x4 o;
            if (g < 96) {
                const bool isq = g < 48; const int g2 = isq ? g : g - 48, h = g2 / 12, gg = g2 % 12;
                const float sc = isq ? rq : ((gg < 8) ? rkv : 1.0f);
                const bf16_t* base = isq ? pr + PC_DQF + h * 96 : (gg < 8 ? pr + PC_DKVF + h * 128 : pr + PC_DKR - 64);
                if (gg < 8 || is_ctx) { const u32x4 a = *(const u32x4*)(base + gg * 8);
#pragma unroll
                    for (int q = 0; q < 4; ++q) o[q] = pk2(bf2f(a[q] & 0xffffu) * sc, bf2f(a[q] >> 16) * sc);
                } else { const int jj = (gg & 1) * 8;
                    const u32x4 x1 = *(const u32x4*)(base + 64 + jj), x2 = *(const u32x4*)(base + 80 + jj); const float2* tab = RD + (size_t)t * 16 + jj; const bool first = gg < 10;
#pragma unroll
                    for (int q = 0; q < 4; ++q) { const float x1a = bf2f(x1[q] & 0xffffu), x1b = bf2f(x1[q] >> 16), x2a = bf2f(x2[q] & 0xffffu), x2b = bf2f(x2[q] >> 16); const float2 ca = tab[2 * q], cb = tab[2 * q + 1];
                        const float ra = first ? x1a * ca.x - x2a * ca.y : x2a * ca.x + x1a * ca.y, rb = first ? x1b * cb.x - x2b * cb.y : x2b * cb.x + x1b * cb.y;
                        o[q] = pk2(ra * sc, rb * sc); } }
                bf16_t* dst = (isq ? QD : KD) + (size_t)row * 384 + h * 96 + gg * 8; *(u32x4*)dst = o;
            } else { const int g2 = g - 96, h = g2 >> 3, gg = g2 & 7;
                const u32x4 a = *(const u32x4*)(pr + PC_DKVF + h * 128 + 64 + gg * 8);
#pragma unroll
                for (int q = 0; q < 4; ++q) o[q] = pk2(bf2f(a[q] & 0xffffu) * rkv, bf2f(a[q] >> 16) * rkv);
                *(u32x4*)(VD + (size_t)row * 256 + h * 64 + gg * 8) = o; }
        }
        __syncthreads();
    }
}
__device__ __forceinline__ void prep_state(int wv, const Params& p, int l, LAS unsigned char* lds) {
    const int tid = otid(wv), lane = tid & 63, w = tid >> 6;
    unsigned char* ws = opq(p.ws);
    const bf16_t* P = (const bf16_t*)(ws + WS_P);
    float* DC = (float*)(ws + WS_DC); float* DN = (float*)(ws + WS_DN); float* DFA = (float*)(ws + WS_DFA);
    LAS unsigned char* KW = lds;
    LAS unsigned char* VT = lds + 24576;
    LAS float* KF = (LAS float*)(lds + 36864);
    LAS float* WL = (LAS float*)(lds + 53504);
    constexpr int NU = (TA / 64) * 4;
    for (int un = blockIdx.x; un < NU; un += gridDim.x) {
        const int ch = un >> 2, hd = un & 3;
        const bool is_ctx = ch >= TL / 64; const int cc = ch - TL / 64;
        const int b = is_ctx ? (cc >> 2) : (ch >> 7), tc = is_ctx ? 128 + (cc & 3) : (ch & 127);
        const int row0 = ch * 64, t0 = is_ctx ? (cc & 3) * 64 : (ch & 127) * 64, nseq = is_ctx ? CTXL : SEQ;
        {
            const int s = tid >> 3, part = tid & 7, c0 = 256 + hd * 64 + part * 8, t = t0 + s;
            const bf16_t* src = P + (size_t)(row0 + s) * NP + PC_CQK + c0;
            const u32x4 u1 = *(const u32x4*)src;
            u32x4 u0 = (u32x4){0u, 0u, 0u, 0u}, u2 = (u32x4){0u, 0u, 0u, 0u};
            if (t > 0) u0 = *(const u32x4*)(src - NP);
            if (t + 1 < nseq) u2 = *(const u32x4*)(src + NP);
            const float* cw = p.mlstm_conv + (size_t)l * 3 * 512 + c0;
#pragma unroll
            for (int q = 0; q < 4; ++q) {
                const float ya = cw[2 * q] * bf2f(u0[q] & 0xffffu) + cw[512 + 2 * q] * bf2f(u1[q] & 0xffffu) + cw[1024 + 2 * q] * bf2f(u2[q] & 0xffffu);
                const float yb = cw[2 * q + 1] * bf2f(u0[q] >> 16) + cw[512 + 2 * q + 1] * bf2f(u1[q] >> 16) + cw[1024 + 2 * q + 1] * bf2f(u2[q] >> 16);
                const unsigned pk = pk2(siluf_(ya) * 0.125f, siluf_(yb) * 0.125f);
                KF[s * 65 + part * 8 + 2 * q] = bf2f(pk & 0xffffu); KF[s * 65 + part * 8 + 2 * q + 1] = bf2f(pk >> 16); }
            *(LAS u32x4*)(VT + s * 192 + part * 16) = *(const u32x4*)(P + (size_t)(row0 + s) * NP + PC_CV + hd * 64 + part * 8);
        }
        if (w < 2) {
            const int dir = w, i = dir ? 63 - lane : lane;
            const bf16_t* pg = P + (size_t)(row0 + i) * NP + PC_CG;
            const float ig = bf2f(pg[(dir ? 8 : 0) + hd]) + p.mlstm_gate_bias[l * 16 + (dir ? 8 : 0) + hd];
            const float lf = logsigmoidf_(bf2f(pg[(dir ? 12 : 4) + hd]) + p.mlstm_gate_bias[l * 16 + (dir ? 12 : 4) + hd]);
            const float bc = wave_incl_sum(lf, lane), bend = __shfl(bc, 63);
            const float val = bend - bc + ig, a = wave_max(val);
            WL[dir * 64 + i] = fexp(val - a);
            if (lane == 0) { float* fa = DFA + (size_t)cu_index(b, tc, hd, dir) * 2; fa[0] = bend; fa[1] = a; }
        }
        __syncthreads();
        {
            const int s = tid >> 3, part = tid & 7;
#pragma unroll
            for (int dir = 0; dir < 2; ++dir) { const float wt = WL[dir * 64 + s]; u32x4 o;
#pragma unroll
                for (int q = 0; q < 4; ++q) o[q] = pk2(KF[s * 65 + part * 8 + 2 * q] * wt, KF[s * 65 + part * 8 + 2 * q + 1] * wt);
                *(LAS u32x4*)(KW + dir * 12288 + s * 192 + part * 16) = o; }
        }
        __syncthreads();
        {
            const int dir = w >> 2, dvb = (w >> 1) & 1, dkb = w & 1, hh = lane >> 5, l31 = lane & 31;
            const int q4 = (lane & 15) >> 2, colo = 16 * ((lane >> 4) & 1) + 4 * (lane & 3);
            f32x16 acc = zero16();
#pragma unroll
            for (int ks = 0; ks < 4; ++ks) {
                const int r0 = 16 * ks + 8 * hh + q4;
                const bf16x8 af = cat8(tr_read(VT + r0 * 192 + (32 * dvb + colo) * 2), tr_read(VT + (r0 + 4) * 192 + (32 * dvb + colo) * 2));
                const bf16x8 bfr = cat8(tr_read(KW + dir * 12288 + r0 * 192 + (32 * dkb + colo) * 2), tr_read(KW + dir * 12288 + (r0 + 4) * 192 + (32 * dkb + colo) * 2));
                acc = mfma32(af, bfr, acc);
            }
            float* dc = DC + (size_t)cu_index(b, tc, hd, dir) * 4096;
#pragma unroll
            for (int r = 0; r < 16; ++r) { const int dv = 32 * dvb + (r & 3) + 8 * (r >> 2) + 4 * hh; dc[dv * 64 + 32 * dkb + l31] = acc[r]; }
            { const int d2 = tid >> 8, dk = (tid >> 2) & 63, part = tid & 3; float sm = 0.f;
#pragma unroll 4
              for (int ss = 0; ss < 16; ++ss) sm += bf2f(*(const LAS bf16_t*)(KW + d2 * 12288 + (part * 16 + ss) * 192 + dk * 2));
              sm += __shfl_xor(sm, 1); sm += __shfl_xor(sm, 2);
              if (part == 0) DN[(size_t)cu_index(b, tc, hd, d2) * 64 + dk] = sm; }
        }
        __syncthreads();
    }
}
__device__ __forceinline__ void phase_prep(int wv, const Params& p, int l, LAS unsigned char* lds) {
    prep_elem(wv, p, l, lds);
    __syncthreads();
    prep_state(wv, p, l, lds);
}

__device__ __forceinline__ void phase_scan(int wv, const Params& p, LAS unsigned char* lds) {
    const int tid = otid(wv);
    unsigned char* ws = opq(p.ws);
    const float* DC = (const float*)(ws + WS_DC); const float* DN = (const float*)(ws + WS_DN); const float* DFA = (const float*)(ws + WS_DFA);
    bf16_t* CS = (bf16_t*)(ws + WS_CS); float* NS = (float*)(ws + WS_NS); float* MS = (float*)(ws + WS_MS);
    LAS float* FA = (LAS float*)lds;
    LAS float* AL = FA + 2 * NCHUNK;
    LAS float* BE = AL + NCHUNK;
    LAS int* UI = (LAS int*)(BE + NCHUNK);
    for (int u = blockIdx.x; u < 256; u += gridDim.x) {
        const int slice = u & 7, dir = (u >> 3) & 1, h = (u >> 4) & 3, b = u >> 6;
        if (tid < NCHUNK) { const int j = tid; const int tc = dir ? ((j < 4) ? 128 + (3 - j) : 131 - j) : ((j < 4) ? 128 + j : j - 4);
            const int ui = cu_index(b, tc, h, dir); UI[j] = ui; FA[2 * j] = DFA[(size_t)ui * 2]; FA[2 * j + 1] = DFA[(size_t)ui * 2 + 1]; }
        __syncthreads();
        if (tid == 0) { float m = 0.f;
            for (int j = 0; j < NCHUNK; ++j) { const float F = FA[2 * j], a = FA[2 * j + 1]; const float mn = fmaxf(F + m, a);
                AL[j] = fexp(F + m - mn); BE[j] = fexp(a - mn); if (slice == 0) MS[UI[j]] = m; m = mn; } }
        __syncthreads();
        { const int e = slice * 512 + tid; float c = 0.f;
#pragma unroll 1
          for (int j0 = 0; j0 < NCHUNK; j0 += 12) { float d[12];
#pragma unroll
              for (int jj = 0; jj < 12; ++jj) d[jj] = DC[(size_t)UI[j0 + jj] * 4096 + e];
#pragma unroll
              for (int jj = 0; jj < 12; ++jj) { const int j = j0 + jj; CS[(size_t)UI[j] * 4096 + e] = f2bf(c); c = AL[j] * c + BE[j] * d[jj]; } } }
        if (slice == 0 && tid < 64) { float n = 0.f;
#pragma unroll 1
            for (int j0 = 0; j0 < NCHUNK; j0 += 12) { float d[12];
#pragma unroll
                for (int jj = 0; jj < 12; ++jj) d[jj] = DN[(size_t)UI[j0 + jj] * 64 + tid];
#pragma unroll
                for (int jj = 0; jj < 12; ++jj) { const int j = j0 + jj; NS[(size_t)UI[j] * 64 + tid] = n; n = AL[j] * n + BE[j] * d[jj]; } } }
        __syncthreads();
    }
}

template <int QB, class Pol>
__device__ __forceinline__ void attn_core(int wv, LAS unsigned char* lds, const Pol& pol, int q2off = 0, int o2off = 0) {
    constexpr int DQ = Pol::DQ, KS = DQ / 16, NDMA = (DQ == 96) ? 3 : 2;
    constexpr int KN_OFF = 0, KR_OFF = 8192, V_OFF = (DQ == 96) ? 12288 : 8192, STAGE = V_OFF + 8192;
    const int tid = otid(wv), lane = tid & 63, hh = lane >> 5, l31 = lane & 31;
    bf16x8 qf[QB][KS];
#pragma unroll
    for (int qb = 0; qb < QB; ++qb)
#pragma unroll
        for (int ks = 0; ks < KS; ++ks) { const u32x4 raw = *(const u32x4*)(pol.qrow + (size_t)qb * q2off + 16 * ks + 8 * hh); u32x4 sc;
#pragma unroll
            for (int q = 0; q < 4; ++q) sc[q] = pk2(bf2f(raw[q] & 0xffffu) * pol.qscale, bf2f(raw[q] >> 16) * pol.qscale);
            qf[qb][ks] = as_bf16x8(sc); }
    f32x16 O[QB][2]; float m[QB], lsum[QB];
#pragma unroll
    for (int qb = 0; qb < QB; ++qb) { O[qb][0] = zero16(); O[qb][1] = zero16(); m[qb] = pol.m0; lsum[qb] = (hh == 0) ? pol.l0 : 0.f; }
    const int drow = 8 * wv + (lane >> 3), dpos = lane & 7;
    const int kn_src = ((dpos ^ ((drow >> 1) & 7)) * 8), v_src = ((dpos ^ (((drow >> 1) & 1) << 2)) * 8);
    const int rrow = 16 * (wv & 3) + (lane >> 2), rpos = lane & 3, kr_src = 64 + ((rpos ^ ((rrow >> 2) & 3)) * 8);
    int kn_rd[2], kr_rd[2];
#pragma unroll
    for (int kbk = 0; kbk < 2; ++kbk) { const int key = 32 * kbk + l31; kn_rd[kbk] = KN_OFF + key * 128 + ((hh ^ ((key >> 1) & 7)) * 16); kr_rd[kbk] = KR_OFF + key * 64 + ((hh ^ ((key >> 2) & 3)) * 16); }
    const int q4 = (lane & 15) >> 2;
    const int vchunk = 2 * ((lane >> 4) & 1) + ((lane & 3) >> 1), vsw = ((q4 >> 1) & 1) << 2;
    const int v_rd0 = V_OFF + (4 * hh + q4) * 128 + (((vchunk) ^ vsw) * 16) + 8 * (lane & 1);
    const int v_rd1 = V_OFF + (4 * hh + q4) * 128 + (((vchunk + 4) ^ vsw) * 16) + 8 * (lane & 1);
    const int nt = pol.ntiles;
#define ATT_DMA(t, st) do { const bf16_t* kp_; const bf16_t* vp_; int ks_, vs_; pol.tile_ptrs((t), kp_, ks_, vp_, vs_); LAS unsigned char* sb_ = lds + (st) * STAGE; \
        __builtin_amdgcn_global_load_lds((const unsigned*)(kp_ + (size_t)drow * ks_ + kn_src), (LAS unsigned*)(sb_ + KN_OFF + wv * 1024), 16, 0, 0); \
        __builtin_amdgcn_global_load_lds((const unsigned*)(vp_ + (size_t)drow * vs_ + v_src), (LAS unsigned*)(sb_ + V_OFF + wv * 1024), 16, 0, 0); \
        if (DQ == 96 && wv < 4) __builtin_amdgcn_global_load_lds((const unsigned*)(kp_ + (size_t)rrow * ks_ + kr_src), (LAS unsigned*)(sb_ + KR_OFF + wv * 1024), 16, 0, 0); } while (0)
    asm volatile("s_waitcnt vmcnt(0)" ::: "memory");
    ATT_DMA(0, 0); ATT_DMA(nt > 1 ? 1 : 0, 1);
    int st = 0;
    for (int t = 0; t < nt; ++t) {
        if (NDMA == 3 && wv < 4) asm volatile("s_waitcnt vmcnt(3)" ::: "memory"); else asm volatile("s_waitcnt vmcnt(2)" ::: "memory");
        __builtin_amdgcn_s_barrier(); asm volatile("" ::: "memory");
        { const int tn = (t + 2 < nt) ? t + 2 : nt - 1; const int sn = (st == 0) ? 2 : st - 1; ATT_DMA(tn, sn); }
        if (pol.wave_active(t)) {
            LAS unsigned char* sb = lds + st * STAGE;
            f32x16 s[QB][2];
#pragma unroll
            for (int qb = 0; qb < QB; ++qb) { s[qb][0] = zero16(); s[qb][1] = zero16(); }
#pragma unroll
            for (int ks = 0; ks < KS; ++ks) {
                bf16x8 a0, a1;
                if (ks < 4) { a0 = *(const LAS bf16x8*)(sb + (kn_rd[0] ^ (ks * 32))); a1 = *(const LAS bf16x8*)(sb + (kn_rd[1] ^ (ks * 32))); }
                else { a0 = *(const LAS bf16x8*)(sb + (kr_rd[0] ^ ((ks - 4) * 32))); a1 = *(const LAS bf16x8*)(sb + (kr_rd[1] ^ ((ks - 4) * 32))); }
#pragma unroll
                for (int qb = 0; qb < QB; ++qb) { s[qb][0] = mfma32(a0, qf[qb][ks], s[qb][0]); s[qb][1] = mfma32(a1, qf[qb][ks], s[qb][1]); }
            }
            if (QB == 1 && pol.tile_masked(t)) {
#pragma unroll
                for (int r = 0; r < 16; ++r) { const int e0 = (r & 3) + 8 * (r >> 2); s[0][0][r] = pol.score(s[0][0][r], t, e0, hh); s[0][1][r] = pol.score(s[0][1][r], t, 32 + e0, hh); }
            }
            bf16x8 pf[QB][2][2];
#pragma unroll
            for (int qb = 0; qb < QB; ++qb) {
                float mx = s[qb][0][0];
#pragma unroll
                for (int r = 1; r < 16; ++r) mx = fmaxf(mx, s[qb][0][r]);
#pragma unroll
                for (int r = 0; r < 16; ++r) mx = fmaxf(mx, s[qb][1][r]);
                mx = fmaxf(mx, __shfl_xor(mx, 32));
                if (__any(mx > m[qb])) {
                    const float mn = fmaxf(m[qb], mx), alpha = fexp2(m[qb] - mn); m[qb] = mn; lsum[qb] *= alpha;
#pragma unroll
                    for (int r = 0; r < 16; ++r) { O[qb][0][r] *= alpha; O[qb][1][r] *= alpha; }
                }
                const float mc = m[qb]; float ps = 0.f;
#pragma unroll
                for (int r = 0; r < 16; ++r) { s[qb][0][r] = fexp2(s[qb][0][r] - mc); s[qb][1][r] = fexp2(s[qb][1][r] - mc); ps += s[qb][0][r] + s[qb][1][r]; }
                lsum[qb] += ps;
#pragma unroll
                for (int sx = 0; sx < 2; ++sx) { u32x4 w0, w1;
#pragma unroll
                    for (int q = 0; q < 4; ++q) { w0[q] = pk2(s[qb][0][8 * sx + 2 * q], s[qb][0][8 * sx + 2 * q + 1]); w1[q] = pk2(s[qb][1][8 * sx + 2 * q], s[qb][1][8 * sx + 2 * q + 1]); }
                    pf[qb][0][sx] = as_bf16x8(w0); pf[qb][1][sx] = as_bf16x8(w1); }
            }
            {
                LAS unsigned char* va = sb + v_rd0; LAS unsigned char* vbp = sb + v_rd1;
                u32x2 x0, x1, x2, x3, x4, x5, x6, x7;
#define TRR8(o0, o1, o2, o3, o4, o5, o6, o7) asm volatile( \
                    "ds_read_b64_tr_b16 %0, %8 offset:" #o0 "\n\tds_read_b64_tr_b16 %1, %8 offset:" #o1 "\n\tds_read_b64_tr_b16 %2, %9 offset:" #o2 "\n\tds_read_b64_tr_b16 %3, %9 offset:" #o3 "\n\t" \
                    "ds_read_b64_tr_b16 %4, %8 offset:" #o4 "\n\tds_read_b64_tr_b16 %5, %8 offset:" #o5 "\n\tds_read_b64_tr_b16 %6, %9 offset:" #o6 "\n\tds_read_b64_tr_b16 %7, %9 offset:" #o7 "\n\t" \
                    "s_waitcnt lgkmcnt(0)" \
                    : "=&v"(x0), "=&v"(x1), "=&v"(x2), "=&v"(x3), "=&v"(x4), "=&v"(x5), "=&v"(x6), "=&v"(x7) : "v"(va), "v"(vbp) : "memory")
#define V8(a, b) as_bf16x8((u32x4){(a).x, (a).y, (b).x, (b).y})
                TRR8(0, 1024, 0, 1024, 2048, 3072, 2048, 3072);
#pragma unroll
                for (int qb = 0; qb < QB; ++qb) { O[qb][0] = mfma32(V8(x0, x1), pf[qb][0][0], O[qb][0]); O[qb][1] = mfma32(V8(x2, x3), pf[qb][0][0], O[qb][1]);
                                                  O[qb][0] = mfma32(V8(x4, x5), pf[qb][0][1], O[qb][0]); O[qb][1] = mfma32(V8(x6, x7), pf[qb][0][1], O[qb][1]); }
                TRR8(4096, 5120, 4096, 5120, 6144, 7168, 6144, 7168);
#pragma unroll
                for (int qb = 0; qb < QB; ++qb) { O[qb][0] = mfma32(V8(x0, x1), pf[qb][1][0], O[qb][0]); O[qb][1] = mfma32(V8(x2, x3), pf[qb][1][0], O[qb][1]);
                                                  O[qb][0] = mfma32(V8(x4, x5), pf[qb][1][1], O[qb][0]); O[qb][1] = mfma32(V8(x6, x7), pf[qb][1][1], O[qb][1]); }
#undef V8
#undef TRR8
            }
        }
        st = (st == 2) ? 0 : st + 1;
    }
#undef ATT_DMA
    asm volatile("s_waitcnt vmcnt(0)" ::: "memory");
    __builtin_amdgcn_s_barrier(); asm volatile("" ::: "memory");
#pragma unroll
    for (int qb = 0; qb < QB; ++qb) {
        float ls = lsum[qb]; ls += __shfl_xor(ls, 32);
        const float inv = 1.0f / ls; ym_t* orow = pol.orow + (size_t)qb * o2off;
#pragma unroll
        for (int g = 0; g < 4; ++g) {
            ym_store4(orow + 8 * g + 4 * hh, O[qb][0][4 * g] * inv, O[qb][0][4 * g + 1] * inv, O[qb][0][4 * g + 2] * inv, O[qb][0][4 * g + 3] * inv);
            ym_store4(orow + 32 + 8 * g + 4 * hh, O[qb][1][4 * g] * inv, O[qb][1][4 * g + 1] * inv, O[qb][1][4 * g + 2] * inv, O[qb][1][4 * g + 3] * inv);
        }
    }
}

template <int QB, class Pol>
__device__ __forceinline__ void attn_pp(int wv, LAS unsigned char* lds, const Pol& pol, int q2off = 0, int o2off = 0) {
    constexpr int DQ = Pol::DQ, KS = DQ / 16, NDMA = (DQ == 96) ? 3 : 2;
    constexpr int KN_OFF = 0, KR_OFF = 8192, V_OFF = (DQ == 96) ? 12288 : 8192, STAGE = V_OFF + 8192;
    const int tid = otid(wv), lane = tid & 63, hh = lane >> 5, l31 = lane & 31;
    const int grp = wv >> 2;
    bf16x8 qf[QB][KS];
#pragma unroll
    for (int qb = 0; qb < QB; ++qb)
#pragma unroll
        for (int ks = 0; ks < KS; ++ks) { const u32x4 raw = *(const u32x4*)(pol.qrow + (size_t)qb * q2off + 16 * ks + 8 * hh); u32x4 sc;
#pragma unroll
            for (int q = 0; q < 4; ++q) sc[q] = pk2(bf2f(raw[q] & 0xffffu) * pol.qscale, bf2f(raw[q] >> 16) * pol.qscale);
            qf[qb][ks] = as_bf16x8(sc); }
    f32x16 O[QB][2]; float m[QB], lsum[QB];
#pragma unroll
    for (int qb = 0; qb < QB; ++qb) { O[qb][0] = zero16(); O[qb][1] = zero16(); m[qb] = pol.m0; lsum[qb] = (hh == 0) ? pol.l0 : 0.f; }
    const int drow = 8 * wv + (lane >> 3), dpos = lane & 7;
    const int kn_src = ((dpos ^ ((drow >> 1) & 7)) * 8), v_src = ((dpos ^ (((drow >> 1) & 1) << 2)) * 8);
    const int rrow = 16 * (wv & 3) + (lane >> 2), rpos = lane & 3, kr_src = 64 + ((rpos ^ ((rrow >> 2) & 3)) * 8);
    int kn_rd[2], kr_rd[2];
#pragma unroll
    for (int kbk = 0; kbk < 2; ++kbk) { const int key = 32 * kbk + l31; kn_rd[kbk] = KN_OFF + key * 128 + ((hh ^ ((key >> 1) & 7)) * 16); kr_rd[kbk] = KR_OFF + key * 64 + ((hh ^ ((key >> 2) & 3)) * 16); }
    const int q4 = (lane & 15) >> 2;
    const int vchunk = 2 * ((lane >> 4) & 1) + ((lane & 3) >> 1), vsw = ((q4 >> 1) & 1) << 2;
    const int v_rd0 = V_OFF + (4 * hh + q4) * 128 + (((vchunk) ^ vsw) * 16) + 8 * (lane & 1);
    const int v_rd1 = V_OFF + (4 * hh + q4) * 128 + (((vchunk + 4) ^ vsw) * 16) + 8 * (lane & 1);
    const int nt = pol.ntiles;
#define ATT_DMA(t, st) do { const bf16_t* kp_; const bf16_t* vp_; int ks_, vs_; pol.tile_ptrs((t), kp_, ks_, vp_, vs_); LAS unsigned char* sb_ = lds + (st) * STAGE; \
        __builtin_amdgcn_global_load_lds((const unsigned*)(kp_ + (size_t)drow * ks_ + kn_src), (LAS unsigned*)(sb_ + KN_OFF + wv * 1024), 16, 0, 0); \
        __builtin_amdgcn_global_load_lds((const unsigned*)(vp_ + (size_t)drow * vs_ + v_src), (LAS unsigned*)(sb_ + V_OFF + wv * 1024), 16, 0, 0); \
        if (DQ == 96 && wv < 4) __builtin_amdgcn_global_load_lds((const unsigned*)(kp_ + (size_t)rrow * ks_ + kr_src), (LAS unsigned*)(sb_ + KR_OFF + wv * 1024), 16, 0, 0); } while (0)
#define ATT_WAIT1() do { if (NDMA == 3 && wv < 4) asm volatile("s_waitcnt vmcnt(3)" ::: "memory"); else asm volatile("s_waitcnt vmcnt(2)" ::: "memory"); } while (0)
#define ATT_BAR() do { asm volatile("" ::: "memory"); __builtin_amdgcn_s_barrier(); asm volatile("" ::: "memory"); } while (0)
    asm volatile("s_waitcnt vmcnt(0)" ::: "memory");
    ATT_DMA(0, 0); ATT_DMA(nt > 1 ? 1 : 0, 1);
    ATT_WAIT1();
    if (grp == 1) ATT_BAR();
    f32x16 s[QB][2]; bf16x8 pf[QB][2][2];
    bool act_prev = false;
#pragma unroll
    for (int qb = 0; qb < QB; ++qb) { s[qb][0] = zero16(); s[qb][1] = zero16();
#pragma unroll
        for (int a = 0; a < 2; ++a)
#pragma unroll
            for (int b = 0; b < 2; ++b) pf[qb][a][b] = as_bf16x8((u32x4){0u, 0u, 0u, 0u}); }
    for (int t = 0; t <= nt; ++t) {
        ATT_BAR();
        { const int tn = (t + 2 < nt) ? t + 2 : nt - 1; ATT_DMA(tn, (t + 2) & 3); }
        if (t > 0 && act_prev) {
            LAS unsigned char* sb = lds + ((t - 1) & 3) * STAGE;
            LAS unsigned char* va = sb + v_rd0; LAS unsigned char* vbp = sb + v_rd1;
            u32x2 x0, x1, x2, x3, x4, x5, x6, x7;
#define TRR8(o0, o1, o2, o3, o4, o5, o6, o7) asm volatile( \
                "ds_read_b64_tr_b16 %0, %8 offset:" #o0 "\n\tds_read_b64_tr_b16 %1, %8 offset:" #o1 "\n\tds_read_b64_tr_b16 %2, %9 offset:" #o2 "\n\tds_read_b64_tr_b16 %3, %9 offset:" #o3 "\n\t" \
                "ds_read_b64_tr_b16 %4, %8 offset:" #o4 "\n\tds_read_b64_tr_b16 %5, %8 offset:" #o5 "\n\tds_read_b64_tr_b16 %6, %9 offset:" #o6 "\n\tds_read_b64_tr_b16 %7, %9 offset:" #o7 "\n\t" \
                "s_waitcnt lgkmcnt(0)" \
                : "=&v"(x0), "=&v"(x1), "=&v"(x2), "=&v"(x3), "=&v"(x4), "=&v"(x5), "=&v"(x6), "=&v"(x7) : "v"(va), "v"(vbp) : "memory")
#define V8(a, b) as_bf16x8((u32x4){(a).x, (a).y, (b).x, (b).y})
            TRR8(0, 1024, 0, 1024, 2048, 3072, 2048, 3072);
#pragma unroll
            for (int qb = 0; qb < QB; ++qb) { O[qb][0] = mfma32(V8(x0, x1), pf[qb][0][0], O[qb][0]); O[qb][1] = mfma32(V8(x2, x3), pf[qb][0][0], O[qb][1]);
                                              O[qb][0] = mfma32(V8(x4, x5), pf[qb][0][1], O[qb][0]); O[qb][1] = mfma32(V8(x6, x7), pf[qb][0][1], O[qb][1]); }
            TRR8(4096, 5120, 4096, 5120, 6144, 7168, 6144, 7168);
#pragma unroll
            for (int qb = 0; qb < QB; ++qb) { O[qb][0] = mfma32(V8(x0, x1), pf[qb][1][0], O[qb][0]); O[qb][1] = mfma32(V8(x2, x3), pf[qb][1][0], O[qb][1]);
                                              O[qb][0] = mfma32(V8(x4, x5), pf[qb][1][1], O[qb][0]); O[qb][1] = mfma32(V8(x6, x7), pf[qb][1][1], O[qb][1]); }
#undef V8
#undef TRR8
        }
        const bool act = (t < nt) && pol.wave_active(t);
        if (act) {
            LAS unsigned char* sb = lds + (t & 3) * STAGE;
#pragma unroll
            for (int qb = 0; qb < QB; ++qb) { s[qb][0] = zero16(); s[qb][1] = zero16(); }
#pragma unroll
            for (int ks = 0; ks < KS; ++ks) {
                bf16x8 a0, a1;
                if (ks < 4) { a0 = *(const LAS bf16x8*)(sb + (kn_rd[0] ^ (ks * 32))); a1 = *(const LAS bf16x8*)(sb + (kn_rd[1] ^ (ks * 32))); }
                else { a0 = *(const LAS bf16x8*)(sb + (kr_rd[0] ^ ((ks - 4) * 32))); a1 = *(const LAS bf16x8*)(sb + (kr_rd[1] ^ ((ks - 4) * 32))); }
#pragma unroll
                for (int qb = 0; qb < QB; ++qb) { s[qb][0] = mfma32(a0, qf[qb][ks], s[qb][0]); s[qb][1] = mfma32(a1, qf[qb][ks], s[qb][1]); }
            }
        }
        ATT_WAIT1();
        ATT_BAR();
        if (act) {
            if (QB == 1 && pol.tile_masked(t)) {
#pragma unroll
                for (int r = 0; r < 16; ++r) { const int e0 = (r & 3) + 8 * (r >> 2); s[0][0][r] = pol.score(s[0][0][r], t, e0, hh); s[0][1][r] = pol.score(s[0][1][r], t, 32 + e0, hh); }
            }
#pragma unroll
            for (int qb = 0; qb < QB; ++qb) {
                float mx = s[qb][0][0];
#pragma unroll
                for (int r = 1; r < 16; ++r) mx = fmaxf(mx, s[qb][0][r]);
#pragma unroll
                for (int r = 0; r < 16; ++r) mx = fmaxf(mx, s[qb][1][r]);
                mx = fmaxf(mx, __shfl_xor(mx, 32));
                if (__any(mx > m[qb])) {
                    const float mn = fmaxf(m[qb], mx), alpha = fexp2(m[qb] - mn); m[qb] = mn; lsum[qb] *= alpha;
#pragma unroll
                    for (int r = 0; r < 16; ++r) { O[qb][0][r] *= alpha; O[qb][1][r] *= alpha; }
                }
                const float mc = m[qb]; float ps = 0.f;
#pragma unroll
                for (int r = 0; r < 16; ++r) { s[qb][0][r] = fexp2(s[qb][0][r] - mc); s[qb][1][r] = fexp2(s[qb][1][r] - mc); ps += s[qb][0][r] + s[qb][1][r]; }
                lsum[qb] += ps;
#pragma unroll
                for (int sx = 0; sx < 2; ++sx) { u32x4 w0, w1;
#pragma unroll
                    for (int q = 0; q < 4; ++q) { w0[q] = pk2(s[qb][0][8 * sx + 2 * q], s[qb][0][8 * sx + 2 * q + 1]); w1[q] = pk2(s[qb][1][8 * sx + 2 * q], s[qb][1][8 * sx + 2 * q + 1]); }
                    pf[qb][0][sx] = as_bf16x8(w0); pf[qb][1][sx] = as_bf16x8(w1); }
            }
        }
        act_prev = act;
    }
    if (grp == 0) ATT_BAR();
#undef ATT_DMA
#undef ATT_WAIT1
    asm volatile("s_waitcnt vmcnt(0)" ::: "memory");
    ATT_BAR();
#undef ATT_BAR
#pragma unroll
    for (int qb = 0; qb < QB; ++qb) {
        float ls = lsum[qb]; ls += __shfl_xor(ls, 32);
        const float inv = 1.0f / ls; ym_t* orow = pol.orow + (size_t)qb * o2off;
#pragma unroll
        for (int g = 0; g < 4; ++g) {
            ym_store4(orow + 8 * g + 4 * hh, O[qb][0][4 * g] * inv, O[qb][0][4 * g + 1] * inv, O[qb][0][4 * g + 2] * inv, O[qb][0][4 * g + 3] * inv);
            ym_store4(orow + 32 + 8 * g + 4 * hh, O[qb][1][4 * g] * inv, O[qb][1][4 * g + 1] * inv, O[qb][1][4 * g + 2] * inv, O[qb][1][4 * g + 3] * inv);
        }
    }
}

template <int QB, class Pol>
__device__ __forceinline__ void attn_core_old(int wv, LAS unsigned char* lds, const Pol& pol, int q2off = 0, int o2off = 0) {
    constexpr int DQ = Pol::DQ, KS = DQ / 16, KROW = DQ * 2 + 16, VROW = 192, KBUF = 64 * KROW, VBUF = 64 * VROW, KCH = DQ / 8;
    const int tid = otid(wv), lane = tid & 63, hh = lane >> 5, l31 = lane & 31;
    LAS unsigned char* kb = lds; LAS unsigned char* vb = lds + 2 * KBUF;
    bf16x8 qf[QB][KS];
#pragma unroll
    for (int qb = 0; qb < QB; ++qb)
#pragma unroll
        for (int ks = 0; ks < KS; ++ks) { const u32x4 raw = *(const u32x4*)(pol.qrow + (size_t)qb * q2off + 16 * ks + 8 * hh); u32x4 sc;
#pragma unroll
            for (int q = 0; q < 4; ++q) sc[q] = pk2(bf2f(raw[q] & 0xffffu) * pol.qscale, bf2f(raw[q] >> 16) * pol.qscale);
            qf[qb][ks] = as_bf16x8(sc); }
    f32x16 O[QB][2]; float m[QB], lsum[QB];
#pragma unroll
    for (int qb = 0; qb < QB; ++qb) { O[qb][0] = zero16(); O[qb][1] = zero16(); m[qb] = pol.m0; lsum[qb] = (hh == 0) ? pol.l0 : 0.f; }
    const int kkey0 = tid / KCH, kpart0 = tid % KCH, c1 = tid + NTHR, kkey1 = c1 / KCH, kpart1 = c1 % KCH; const bool has1 = c1 < 64 * KCH;
    const int vkey = tid >> 3, vpart = tid & 7;
    u32x4 kr0, kr1 = (u32x4){0u, 0u, 0u, 0u}, vr;
    const int q4 = (lane & 15) >> 2, colo = 16 * ((lane >> 4) & 1) + 4 * (lane & 3);
    const int nt = pol.ntiles;
#define ATT_GLOAD(t) do { const bf16_t* kp_; const bf16_t* vp_; int ks_, vs_; pol.tile_ptrs((t), kp_, ks_, vp_, vs_); \
        kr0 = *(const u32x4*)(kp_ + (size_t)kkey0 * ks_ + kpart0 * 8); if (has1) kr1 = *(const u32x4*)(kp_ + (size_t)kkey1 * ks_ + kpart1 * 8); \
        vr = *(const u32x4*)(vp_ + (size_t)vkey * vs_ + vpart * 8); } while (0)
#define ATT_LSTORE(buf) do { *(LAS u32x4*)(kb + (buf) * KBUF + kkey0 * KROW + kpart0 * 16) = kr0; if (has1) *(LAS u32x4*)(kb + (buf) * KBUF + kkey1 * KROW + kpart1 * 16) = kr1; \
        *(LAS u32x4*)(vb + (buf) * VBUF + vkey * VROW + vpart * 16) = vr; } while (0)
    ATT_GLOAD(0); ATT_LSTORE(0); __syncthreads();
    for (int t = 0; t < nt; ++t) {
        const int buf = t & 1;
        if (t + 1 < nt) ATT_GLOAD(t + 1);
        if (pol.wave_active(t)) {
            LAS unsigned char* kt = kb + buf * KBUF; LAS unsigned char* vt = vb + buf * VBUF;
            f32x16 s[QB][2];
#pragma unroll
            for (int qb = 0; qb < QB; ++qb) { s[qb][0] = zero16(); s[qb][1] = zero16(); }
#pragma unroll
            for (int ks = 0; ks < KS; ++ks) {
                const bf16x8 a0 = *(const LAS bf16x8*)(kt + l31 * KROW + (16 * ks + 8 * hh) * 2);
                const bf16x8 a1 = *(const LAS bf16x8*)(kt + (32 + l31) * KROW + (16 * ks + 8 * hh) * 2);
#pragma unroll
                for (int qb = 0; qb < QB; ++qb) { s[qb][0] = mfma32(a0, qf[qb][ks], s[qb][0]); s[qb][1] = mfma32(a1, qf[qb][ks], s[qb][1]); }
            }
            if (QB == 1 && pol.tile_masked(t)) {
#pragma unroll
                for (int r = 0; r < 16; ++r) { const int e0 = (r & 3) + 8 * (r >> 2); s[0][0][r] = pol.score(s[0][0][r], t, e0, hh); s[0][1][r] = pol.score(s[0][1][r], t, 32 + e0, hh); }
            }
            bf16x8 pf[QB][2][2];
#pragma unroll
            for (int qb = 0; qb < QB; ++qb) {
                float mx = s[qb][0][0];
#pragma unroll
                for (int r = 1; r < 16; ++r) mx = fmaxf(mx, s[qb][0][r]);
#pragma unroll
                for (int r = 0; r < 16; ++r) mx = fmaxf(mx, s[qb][1][r]);
                mx = fmaxf(mx, __shfl_xor(mx, 32));
                if (__any(mx > m[qb])) {
                    const float mn = fmaxf(m[qb], mx), alpha = fexp2(m[qb] - mn); m[qb] = mn; lsum[qb] *= alpha;
#pragma unroll
                    for (int r = 0; r < 16; ++r) { O[qb][0][r] *= alpha; O[qb][1][r] *= alpha; }
                }
                const float mc = m[qb]; float ps = 0.f;
#pragma unroll
                for (int r = 0; r < 16; ++r) { s[qb][0][r] = fexp2(s[qb][0][r] - mc); s[qb][1][r] = fexp2(s[qb][1][r] - mc); ps += s[qb][0][r] + s[qb][1][r]; }
                lsum[qb] += ps;
#pragma unroll
                for (int sx = 0; sx < 2; ++sx) { u32x4 w0, w1;
#pragma unroll
                    for (int q = 0; q < 4; ++q) { w0[q] = pk2(s[qb][0][8 * sx + 2 * q], s[qb][0][8 * sx + 2 * q + 1]); w1[q] = pk2(s[qb][1][8 * sx + 2 * q], s[qb][1][8 * sx + 2 * q + 1]); }
                    pf[qb][0][sx] = as_bf16x8(w0); pf[qb][1][sx] = as_bf16x8(w1); }
            }
#pragma unroll
            for (int kbk = 0; kbk < 2; ++kbk)
#pragma unroll
                for (int sx = 0; sx < 2; ++sx) {
                    const int r0 = 32 * kbk + 16 * sx + 4 * hh + q4;
                    const bf16x8 v0 = cat8(tr_read(vt + r0 * VROW + colo * 2), tr_read(vt + (r0 + 8) * VROW + colo * 2));
                    const bf16x8 v1 = cat8(tr_read(vt + r0 * VROW + (32 + colo) * 2), tr_read(vt + (r0 + 8) * VROW + (32 + colo) * 2));
#pragma unroll
                    for (int qb = 0; qb < QB; ++qb) { O[qb][0] = mfma32(v0, pf[qb][kbk][sx], O[qb][0]); O[qb][1] = mfma32(v1, pf[qb][kbk][sx], O[qb][1]); }
                }
        }
        if (t + 1 < nt) ATT_LSTORE(buf ^ 1);
        __syncthreads();
    }
#undef ATT_GLOAD
#undef ATT_LSTORE
#pragma unroll
    for (int qb = 0; qb < QB; ++qb) {
        float ls = lsum[qb]; ls += __shfl_xor(ls, 32);
        const float inv = 1.0f / ls; ym_t* orow = pol.orow + (size_t)qb * o2off;
#pragma unroll
        for (int g = 0; g < 4; ++g) {
            ym_store4(orow + 8 * g + 4 * hh, O[qb][0][4 * g] * inv, O[qb][0][4 * g + 1] * inv, O[qb][0][4 * g + 2] * inv, O[qb][0][4 * g + 3] * inv);
            ym_store4(orow + 32 + 8 * g + 4 * hh, O[qb][1][4 * g] * inv, O[qb][1][4 * g + 1] * inv, O[qb][1][4 * g + 2] * inv, O[qb][1][4 * g + 3] * inv);
        }
    }
}

constexpr float NEG_INF = -__builtin_inff();
struct PolD {
    static constexpr int DQ = 96;
    const bf16_t *kbase, *vbase, *kctx, *vctx, *qrow; ym_t* orow; int nloc, ntiles; float qscale, m0, l0;
    __device__ __forceinline__ void tile_ptrs(int t, const bf16_t*& kp, int& ks, const bf16_t*& vp, int& vs) const {
        ks = 384; vs = 256;
        if (t < nloc) { kp = kbase + (size_t)t * 64 * 384; vp = vbase + (size_t)t * 64 * 256; } else { kp = kctx + (size_t)(t - nloc) * 64 * 384; vp = vctx + (size_t)(t - nloc) * 64 * 256; } }
    __device__ __forceinline__ bool wave_active(int) const { return true; }
    __device__ __forceinline__ bool tile_masked(int) const { return false; }
    __device__ __forceinline__ float score(float s, int, int, int) const { return s; }
};
struct PolA {
    static constexpr int DQ = 64;
    const bf16_t *kbase, *vbase, *kctx, *vctx, *qrow; ym_t* orow; int nloc, ntiles; float qscale, m0, l0;
    int kp0, q0, qpos;
    __device__ __forceinline__ void tile_ptrs(int t, const bf16_t*& kp, int& ks, const bf16_t*& vp, int& vs) const {
        ks = 128; vs = NP;
        if (t < nloc) { const int k0 = kp0 + 64 * t; kp = kbase + (size_t)k0 * 128; vp = vbase + (size_t)k0 * NP; } else { kp = kctx + (size_t)(t - nloc) * 64 * 128; vp = vctx + (size_t)(t - nloc) * 64 * NP; } }
    __device__ __forceinline__ bool wave_active(int t) const { const int k0 = kp0 + 64 * t; return t >= nloc || (k0 + 63 >= q0 - 128 && k0 <= q0 + 31 + 128); }
    __device__ __forceinline__ bool tile_masked(int t) const { const int k0 = kp0 + 64 * t; return t < nloc && !(k0 >= q0 + 31 - 128 && k0 + 63 <= q0 + 128); }
    __device__ __forceinline__ float score(float s, int t, int e0, int hh) const { const int d = qpos - (kp0 + 64 * t + e0 + 4 * hh); return (d <= 128 && d >= -128) ? s : NEG_INF; }
};
struct PolB {
    static constexpr int DQ = 64;
    const bf16_t *kbase, *vbase, *kctx, *vctx, *qrow; ym_t* orow; int nloc, ntiles; float qscale, m0, l0;
    int klo, wr0, r, c; const LAS float* rpb;
    unsigned mlo, mhi; int bbase;
    __device__ __forceinline__ void set_lane(int hh) { const int cs = min(max(c - 8, 0), 48); const unsigned long long m = (0xffffull << cs) >> (4 * hh); mlo = (unsigned)m; mhi = (unsigned)(m >> 32); bbase = 15 - c + 4 * hh; }
    __device__ __forceinline__ void tile_ptrs(int t, const bf16_t*& kp, int& ks, const bf16_t*& vp, int& vs) const {
        ks = NP; vs = NP;
        if (t < nloc) { kp = kbase + (size_t)(klo + t) * 64 * NP; vp = vbase + (size_t)(klo + t) * 64 * NP; } else { kp = kctx + (size_t)(t - nloc) * 64 * NP; vp = vctx + (size_t)(t - nloc) * 64 * NP; } }
    __device__ __forceinline__ bool wave_active(int t) const { return t >= nloc || (klo + t >= wr0 && klo + t < wr0 + 8); }
    __device__ __forceinline__ bool tile_masked(int t) const { return t < nloc; }
    __device__ __forceinline__ float score(float s, int t, int e0, int) const {
        const bool ok = ((e0 < 32 ? (mlo >> e0) : (mhi >> (e0 - 32))) & 1u) != 0u;
        const float bias = rpb[(klo + t - r + 7) * 31 + bbase + e0];
        return ok ? s + bias : NEG_INF; }
};

struct XQ { unsigned* heads; int x, per; int dx; };
__device__ __forceinline__ int q_next(int tid, XQ& q, LAS int* slot) {
    for (;;) {
        if (q.dx >= 8) return -1;
        const int xx = (q.x + q.dx) & 7;
        __syncthreads();
        if (tid == 0) *slot = (int)__hip_atomic_fetch_add(q.heads + xx * 64, 1u, __ATOMIC_RELAXED, __HIP_MEMORY_SCOPE_AGENT);
        __syncthreads();
        const int j = *slot;
        if (j < q.per) return xx * q.per + j;
        ++q.dx;
    }
}

__device__ __forceinline__ void mlstm_out_pair(int wv, const Params& p, LAS unsigned char* lds, int l, int u0, int u1) {
    const int tid = otid(wv), lane = tid & 63, w = tid >> 6, hh = lane >> 5, l31 = lane & 31;
    const int half = w >> 2, wl = w & 3;
    unsigned char* ws = opq(p.ws);
    const bf16_t* P = (const bf16_t*)(ws + WS_P); const bf16_t* QC = (const bf16_t*)(ws + WS_QC); const bf16_t* KC = (const bf16_t*)(ws + WS_KC);
    const float* GATES = (const float*)(ws + WS_GATES); const bf16_t* CS = (const bf16_t*)(ws + WS_CS); const float* NS = (const float*)(ws + WS_NS); const float* MS = (const float*)(ws + WS_MS);
    ym_t* YMIX = (ym_t*)(ws + WS_YMIX);
    const bool need_ctx = (l == 0);
    const int u = half ? u1 : u0; const bool valid = u >= 0;
    const int hd = u & 3, v = u >> 2; int b, tc;
    if (need_ctx) { b = v / NCHUNK; tc = v % NCHUNK; } else { b = v >> 7; tc = v & 127; }
    LAS unsigned char* hb = lds + half * 36864;
    LAS unsigned char* VT = hb;
    LAS float* ZU = (LAS float*)(hb + 12288);
    LAS float* ZC = ZU + 128;
    LAS float* ZI = ZC + 128;
    LAS float* ZE = ZI + 128;
    LAS float* ZN = ZE + 128;
    LAS float* ZH = (LAS float*)(hb + 16384);
    const int row0 = (tc < 128) ? b * SEQ + tc * 64 : TL + b * CTXL + (tc - 128) * 64;
    if (valid) {
        if (wl < 2) { const int dir = wl, i = dir ? 63 - lane : lane;
            const float lf = GATES[(size_t)(row0 + i) * 16 + (dir ? 12 : 4) + hd], ig = GATES[(size_t)(row0 + i) * 16 + (dir ? 8 : 0) + hd];
            const float bc = wave_incl_sum(lf, lane), uu = ig - bc, pm = wave_incl_max(uu, lane);
            const float min_ = MS[cu_index(b, tc, hd, dir)], mx = fmaxf(min_, pm);
            ZU[dir * 64 + lane] = uu; ZC[dir * 64 + lane] = -mx; ZI[dir * 64 + lane] = fexp(min_ - mx); ZE[dir * 64 + lane] = fexp(-(bc + mx));
        } else { const int dir = wl - 2; ZN[dir * 64 + lane] = NS[(size_t)cu_index(b, tc, hd, dir) * 64 + lane]; }
        { const int t4 = wl * 64 + lane;
#pragma unroll
          for (int ps = 0; ps < 2; ++ps) { const int c = t4 + 256 * ps, s = c >> 3, part = c & 7; *(LAS u32x4*)(VT + s * 192 + part * 16) = *(const u32x4*)(P + (size_t)(row0 + s) * NP + PC_CV + hd * 64 + part * 8); } }
    }
    __syncthreads();
    const int dir = wl >> 1, tb = wl & 1;
    const int t = 32 * tb + l31, it = dir ? 63 - t : t;
    f32x16 acc[2], acc2[2]; float inter = 0.f, rden = 0.f;
    if (valid) {
        bf16x8 qf[4];
#pragma unroll
        for (int ks = 0; ks < 4; ++ks) qf[ks] = *(const bf16x8*)(QC + (size_t)(row0 + it) * 256 + hd * 64 + 16 * ks + 8 * hh);
        f32x16 st[2];
#pragma unroll
        for (int sb = 0; sb < 2; ++sb) { const int s = 32 * sb + l31, is = dir ? 63 - s : s; st[sb] = zero16();
#pragma unroll
            for (int ks = 0; ks < 4; ++ks) { const bf16x8 a = *(const bf16x8*)(KC + (size_t)(row0 + is) * 256 + hd * 64 + 16 * ks + 8 * hh); st[sb] = mfma32(a, qf[ks], st[sb]); } }
        const float ct = ZC[dir * 64 + t];
        float dsum = 0.f;
#pragma unroll
        for (int sb = 0; sb < 2; ++sb)
#pragma unroll
            for (int r = 0; r < 16; ++r) { const int s = 32 * sb + (r & 3) + 8 * (r >> 2) + 4 * hh;
                const float vv = (s <= t) ? st[sb][r] * fexp(ZU[dir * 64 + s] + ct) : 0.f; st[sb][r] = vv; dsum += vv; }
        dsum += __shfl_xor(dsum, 32);
        acc[0] = zero16(); acc[1] = zero16(); acc2[0] = zero16(); acc2[1] = zero16();
        const int q4 = (lane & 15) >> 2, colo = 16 * ((lane >> 4) & 1) + 4 * (lane & 3);
#pragma unroll
        for (int sb = 0; sb < 2; ++sb)
#pragma unroll
            for (int s2 = 0; s2 < 2; ++s2) { u32x4 wvv;
#pragma unroll
                for (int q = 0; q < 4; ++q) wvv[q] = pk2(st[sb][8 * s2 + 2 * q], st[sb][8 * s2 + 2 * q + 1]);
                const int sa = 32 * sb + 16 * s2 + 4 * hh + q4, sb8 = sa + 8;
                const int ia = dir ? 63 - sa : sa, ib = dir ? 63 - sb8 : sb8;
#pragma unroll
                for (int dvb = 0; dvb < 2; ++dvb) { const bf16x8 vf = cat8(tr_read(VT + ia * 192 + (32 * dvb + colo) * 2), tr_read(VT + ib * 192 + (32 * dvb + colo) * 2));
                    acc[dvb] = mfma32(vf, as_bf16x8(wvv), acc[dvb]); } }
        float qn = 0.f;
#pragma unroll
        for (int ks = 0; ks < 4; ++ks) {
#pragma unroll
            for (int dvb = 0; dvb < 2; ++dvb) { const bf16x8 cf = *(const bf16x8*)(CS + (size_t)cu_index(b, tc, hd, dir) * 4096 + (size_t)(32 * dvb + l31) * 64 + 16 * ks + 8 * hh); acc2[dvb] = mfma32(cf, qf[ks], acc2[dvb]); }
#pragma unroll
            for (int j = 0; j < 8; ++j) qn += bf2f((unsigned)(unsigned short)qf[ks][j]) * ZN[dir * 64 + 16 * ks + 8 * hh + j]; }
        qn += __shfl_xor(qn, 32);
        inter = ZI[dir * 64 + t]; const float den = dsum + inter * qn; rden = 1.0f / fmaxf(fabsf(den), ZE[dir * 64 + t]);
#pragma unroll
        for (int dvb = 0; dvb < 2; ++dvb)
#pragma unroll
            for (int r = 0; r < 16; ++r) acc[dvb][r] = (acc[dvb][r] + inter * acc2[dvb][r]) * rden;
        if (dir == 1) {
#pragma unroll
            for (int dvb = 0; dvb < 2; ++dvb)
#pragma unroll
                for (int r = 0; r < 16; ++r) ZH[it * 65 + 32 * dvb + (r & 3) + 8 * (r >> 2) + 4 * hh] = acc[dvb][r];
        }
    }
    __syncthreads();
    if (valid && dir == 0) {
#pragma unroll
        for (int dvb = 0; dvb < 2; ++dvb)
#pragma unroll
            for (int g = 0; g < 4; ++g) { const int dv = 32 * dvb + 8 * g + 4 * hh;
                const u32x2 ov = *(const u32x2*)(P + (size_t)(row0 + it) * NP + PC_CO + hd * 64 + dv);
                const float o0 = sigmoidf_(bf2f(ov.x & 0xffffu)), o1 = sigmoidf_(bf2f(ov.x >> 16)), o2 = sigmoidf_(bf2f(ov.y & 0xffffu)), o3 = sigmoidf_(bf2f(ov.y >> 16));
                const float h0 = acc[dvb][4 * g] + ZH[it * 65 + dv], h1 = acc[dvb][4 * g + 1] + ZH[it * 65 + dv + 1], h2 = acc[dvb][4 * g + 2] + ZH[it * 65 + dv + 2], h3 = acc[dvb][4 * g + 3] + ZH[it * 65 + dv + 3];
                ym_store4(YMIX + (size_t)(row0 + it) * 1024 + 512 + hd * 64 + dv, o0 * h0, o1 * h1, o2 * h2, o3 * h3); }
    }
    __syncthreads();
}


#define MIX_COMMON \
    const int qo = probe ? 4 : 0; \
    const int tid = otid(wv), lane = tid & 63, w = tid >> 6, l31 = lane & 31; \
    unsigned char* ws = opq(p.ws); \
    unsigned* ctl = (unsigned*)(ws + WS_CTL); \
    LAS int* slot = (LAS int*)(lds + LDS_MISC + 64); \
    const int myx = *(const LAS int*)(lds + LDS_MISC + 72); \
    const bf16_t* P = (const bf16_t*)(ws + WS_P); \
    ym_t* YMIX = (ym_t*)(ws + WS_YMIX); \
    const bool need_ctx = (l == 0); (void)lane; (void)P;

__device__ __forceinline__ void mix_D(int wv, const Params& p, int l, LAS unsigned char* lds, bool probe) {
    MIX_COMMON
    const bf16_t* QD = (const bf16_t*)(ws + WS_QD); const bf16_t* KD = (const bf16_t*)(ws + WS_KD); const bf16_t* VD = (const bf16_t*)(ws + WS_VD);
    const int per = 32 + (need_ctx ? 2 : 0);
    XQ q{ctl + CTL_Q(l, qo + 0, 0), myx, per, 0};
    for (;;) { const int uu = q_next(tid, q, slot); if (uu < 0) break;
        const int xx = uu / per, j = uu % per;
        PolD pol; int b, h, row; const bool lat = j < 32;
        if (lat) { const int pair = xx + 8 * (j >> 4); b = pair >> 2; h = pair & 3; row = b * SEQ + (j & 15) * 512 + 64 * w + l31; pol.nloc = 128; }
        else { const int v = 2 * xx + (j - 32); b = v >> 2; h = v & 3; row = TL + b * CTXL + 32 * w + l31; pol.nloc = 0; }
        pol.ntiles = pol.nloc + 4;
        pol.kbase = KD + (size_t)b * SEQ * 384 + h * 96; pol.vbase = VD + (size_t)b * SEQ * 256 + h * 64;
        pol.kctx = KD + (size_t)(TL + b * CTXL) * 384 + h * 96; pol.vctx = VD + (size_t)(TL + b * CTXL) * 256 + h * 64;
        pol.qrow = QD + (size_t)row * 384 + h * 96; pol.orow = YMIX + (size_t)row * 1024 + 768 + h * 64;
        pol.qscale = 0.10206207261596575f * LOG2E; pol.m0 = -1e30f; pol.l0 = 0.f;
        if (lat) attn_pp<2>(wv, lds, pol, 32 * 384, 32 * 1024); else attn_core<1>(wv, lds, pol); }
}
__device__ __forceinline__ void mix_B(int wv, const Params& p, int l, LAS unsigned char* lds, bool probe) {
    MIX_COMMON
    const int per = 64 + (need_ctx ? 2 : 0);
    XQ q{ctl + CTL_Q(l, qo + 1, 0), myx, per, 0};
    for (;;) { const int uu = q_next(tid, q, slot); if (uu < 0) break;
        const int xx = uu / per, j = uu % per;
        PolB pol; int b, h, row;
        LAS float* rp = (LAS float*)(lds + 65536);
        if (j < 64) { const int pair = xx + 8 * (j >> 5); b = pair >> 2; h = pair & 3; const int R0 = (j & 31) * 4; pol.r = R0 + (w >> 1); pol.c = 32 * (w & 1) + l31; row = b * SEQ + pol.r * 64 + pol.c;
            pol.klo = min(max(R0 - 4, 0), 120); const int khi = min(max(R0 - 1, 0), 120) + 7; pol.nloc = khi - pol.klo + 1; pol.wr0 = min(max(pol.r - 4, 0), 120); }
        else { const int v = 2 * xx + (j - 64); b = v >> 2; h = v & 3; row = TL + b * CTXL + 32 * w + l31; pol.nloc = 0; pol.klo = 0; pol.wr0 = 0; pol.r = 0; pol.c = 0; }
        for (int i = tid; i < 465; i += NTHR) rp[i] = p.nat_rpb[((size_t)l * 4 + h) * 465 + i] * LOG2E;
        __syncthreads();
        pol.rpb = rp; pol.ntiles = pol.nloc + 4; pol.set_lane(lane >> 5);
        pol.kbase = P + (size_t)b * SEQ * NP + PC_BK + h * 64; pol.vbase = P + (size_t)b * SEQ * NP + PC_BV + h * 64;
        pol.kctx = P + (size_t)(TL + b * CTXL) * NP + PC_BK + h * 64; pol.vctx = P + (size_t)(TL + b * CTXL) * NP + PC_BV + h * 64;
        pol.qrow = P + (size_t)row * NP + PC_BQ + h * 64; pol.orow = YMIX + (size_t)row * 1024 + 256 + h * 64;
        pol.qscale = 0.125f * LOG2E; pol.m0 = -1e30f; pol.l0 = 0.f;
        attn_core<1>(wv, lds, pol); }
}
__device__ __forceinline__ void mix_A(int wv, const Params& p, int l, LAS unsigned char* lds, bool probe) {
    MIX_COMMON
    const bf16_t* QA = (const bf16_t*)(ws + WS_QA); const bf16_t* KA = (const bf16_t*)(ws + WS_KA);
    const int per = 64 + (need_ctx ? 2 : 0);
    XQ q{ctl + CTL_Q(l, qo + 2, 0), myx, per, 0};
    for (;;) { const int uu = q_next(tid, q, slot); if (uu < 0) break;
        const int xx = uu / per, j = uu % per;
        PolA pol; int b, hkv, head, row;
        if (j < 64) { b = xx >> 1; hkv = xx & 1; const int qb = j; head = 2 * hkv + (w >> 2); pol.q0 = qb * 128 + (w & 3) * 32; pol.qpos = pol.q0 + l31; row = b * SEQ + pol.qpos;
            const int tlo = (qb == 0) ? 2 : 0, thi = (qb == 63) ? 4 : 6; pol.nloc = thi - tlo; pol.kp0 = (qb - 1) * 128 + 64 * tlo; }
        else { const int v = 2 * xx + (j - 64); b = v >> 2; hkv = (v >> 1) & 1; head = 2 * hkv + (v & 1); row = TL + b * CTXL + 32 * w + l31; pol.nloc = 0; pol.kp0 = 0; pol.q0 = 0; pol.qpos = 0; }
        pol.ntiles = pol.nloc + 4;
        pol.kbase = KA + (size_t)b * SEQ * 128 + hkv * 64; pol.vbase = P + (size_t)b * SEQ * NP + PC_AV + hkv * 64;
        pol.kctx = KA + (size_t)(TL + b * CTXL) * 128 + hkv * 64; pol.vctx = P + (size_t)(TL + b * CTXL) * NP + PC_AV + hkv * 64;
        pol.qrow = QA + (size_t)row * 256 + head * 64; pol.orow = YMIX + (size_t)row * 1024 + head * 64;
        pol.qscale = 0.125f * LOG2E; pol.m0 = p.attn_sink[l * 4 + head] * LOG2E; pol.l0 = 1.0f;
        attn_core<1>(wv, lds, pol); }
}
__device__ __forceinline__ void mix_C(int wv, const Params& p, int l, LAS unsigned char* lds, bool probe) {
    MIX_COMMON
    (void)w; (void)l31; (void)YMIX;
    const int per = NBATCH * (need_ctx ? NCHUNK : 128) * 4 / 16;
    XQ q{ctl + CTL_Q(l, qo + 3, 0), myx, per, 0};
    for (;;) { const int pr = q_next(tid, q, slot); if (pr < 0) break;
        mlstm_out_pair(wv, p, lds, l, 2 * pr, 2 * pr + 1); }
}
#ifndef MIX_MASK
#define MIX_MASK 15
#endif
__device__ __forceinline__ void phase_mixers(int wv, const Params& p, int l, LAS unsigned char* lds) {
    if (MIX_MASK & 1) mix_D(wv, p, l, lds, false);
    if (MIX_MASK & 2) mix_B(wv, p, l, lds, false);
    if (MIX_MASK & 4) mix_A(wv, p, l, lds, false);
    if (MIX_MASK & 8) mix_C(wv, p, l, lds, false);
}
#ifndef PROBE_MIX
#define PROBE_MIX 15
#endif
__device__ __forceinline__ void phase_mixers_probe(int wv, const Params& p, int l, LAS unsigned char* lds) {
    if (PROBE_MIX & 1) mix_D(wv, p, l, lds, true);
    if (PROBE_MIX & 2) mix_B(wv, p, l, lds, true);
    if (PROBE_MIX & 4) mix_A(wv, p, l, lds, true);
    if (PROBE_MIX & 8) mix_C(wv, p, l, lds, true);
}

__device__ __forceinline__ void phase_router(int wv, const Params& p, int l, LAS unsigned char* lds) {
    const int tid = otid(wv), lane = tid & 63, w = tid >> 6, hh = lane >> 5, l31 = lane & 31;
    unsigned char* ws = opq(p.ws);
    const float* MOD = (const float*)(ws + WS_MOD); const float* XA = (const float*)(ws + WS_XA); unsigned char* H2F = ws + WS_H2B;
    const bf16_t* WRT = (const bf16_t*)(ws + WS_WRT) + (size_t)l * 2 * 32 * 1024;
    float* GATE = (float*)(ws + WS_GATE); int* LIST = (int*)(ws + WS_LIST); unsigned* ctl = (unsigned*)(ws + WS_CTL);
    constexpr int HROW = 1028;
    LAS float* HT = (LAS float*)lds;
    LAS float* RED = (LAS float*)lds;
    LAS int* LCNT = (LAS int*)(lds + 131584);
    LAS int* LBASE = LCNT + 32;
    LAS int* PA = LBASE + 32;
    LAS int* PE = PA + 640;
    const int T = (l == 0) ? TA : TL, ntile = T / 32, NASSIGN = TA * 4;
    if (tid < 32) LCNT[tid] = 0;
    if (blockIdx.x == 0 && tid < 64) *(u32x4*)(H2F + (size_t)TA * 1024 + tid * 16) = (u32x4){0u, 0u, 0u, 0u};
    __syncthreads();
    int iter = 0;
    for (int tl = blockIdx.x; tl < ntile; tl += gridDim.x, ++iter) {
        const int r0 = tl * 32;
#pragma unroll 1
        for (int i = 0; i < 4; ++i) { const int rl = 4 * w + i, r = r0 + rl;
            const int mrow = (r < TL) ? (r >> 13) : 4; const float* mod = MOD + ((size_t)l * 5 + mrow) * 6144;
            f32x4 v[4]; row_load(XA + (size_t)r * 1024, lane, v); const float rstd = row_rstd(v);
            row_modulate(v, rstd, p.g_norm2 + l * 1024, mod + 4 * 1024, mod + 3 * 1024, lane);
            row_store_fp8(H2F + (size_t)r * 1024, lane, v);
#pragma unroll
            for (int q = 0; q < 4; ++q) *(LAS f32x4*)(HT + rl * HROW + q * 256 + lane * 4) = v[q]; }
        __syncthreads();
        f32x16 acc = zero16();
#pragma unroll 2
        for (int ks = 0; ks < 8; ++ks) { const int k0 = 128 * w + 16 * ks + 8 * hh;
            const f32x4 x0 = *(const LAS f32x4*)(HT + l31 * HROW + k0), x1 = *(const LAS f32x4*)(HT + l31 * HROW + k0 + 4);
            u32x4 ah, alo; float hf[8] = {x0[0], x0[1], x0[2], x0[3], x1[0], x1[1], x1[2], x1[3]};
#pragma unroll
            for (int q = 0; q < 4; ++q) { const unsigned hp = pk2(hf[2 * q], hf[2 * q + 1]); ah[q] = hp; alo[q] = pk2(hf[2 * q] - bf2f(hp & 0xffffu), hf[2 * q + 1] - bf2f(hp >> 16)); }
            const bf16x8 bh = *(const bf16x8*)(WRT + (size_t)l31 * 1024 + k0), bl = *(const bf16x8*)(WRT + (size_t)(32 + l31) * 1024 + k0);
            acc = mfma32(as_bf16x8(ah), bh, acc); acc = mfma32(as_bf16x8(alo), bh, acc); acc = mfma32(as_bf16x8(ah), bl, acc); }
        __syncthreads();
#pragma unroll
        for (int r = 0; r < 16; ++r) RED[(w * 32 + (r & 3) + 8 * (r >> 2) + 4 * hh) * 33 + l31] = acc[r];
        __syncthreads();
#pragma unroll 1
        for (int i = 0; i < 4; ++i) { const int rl = 4 * w + i, r = r0 + rl;
            float v = NEG_INF;
            if (lane < 32) { v = p.b_router[l * 32 + lane];
#pragma unroll
                for (int ww = 0; ww < 8; ++ww) v += RED[(ww * 32 + rl) * 33 + lane]; }
            float tv[4]; int te[4];
#pragma unroll
            for (int k = 0; k < 4; ++k) { float bv = v; int bi = lane;
#pragma unroll
                for (int d = 32; d >= 1; d >>= 1) { const float ov = __shfl_xor(bv, d); const int oi = __shfl_xor(bi, d); if (ov > bv || (ov == bv && oi < bi)) { bv = ov; bi = oi; } }
                tv[k] = bv; te[k] = bi; if (lane == bi) v = NEG_INF; }
            if (lane < 4) { const float e0 = 1.0f, e1 = fexp(tv[1] - tv[0]), e2 = fexp(tv[2] - tv[0]), e3 = fexp(tv[3] - tv[0]); const float inv = 1.0f / (e0 + e1 + e2 + e3);
                const float g = (lane == 0 ? e0 : lane == 1 ? e1 : lane == 2 ? e2 : e3) * inv; const int e = (lane == 0 ? te[0] : lane == 1 ? te[1] : lane == 2 ? te[2] : te[3]);
                const int a = r * 4 + lane; GATE[a] = g;
                const int lr = __hip_atomic_fetch_add(&LCNT[e], 1, __ATOMIC_RELAXED, __HIP_MEMORY_SCOPE_WORKGROUP); const int pi = iter * 128 + rl * 4 + lane; PA[pi] = a; PE[pi] = (e << 16) | lr; }
        }
        __syncthreads();
    }
    if (tid < 32) LBASE[tid] = (int)__hip_atomic_fetch_add(ctl + CTL_CNT(l, tid), (unsigned)LCNT[tid], __ATOMIC_RELAXED, __HIP_MEMORY_SCOPE_AGENT);
    __syncthreads();
    for (int i = tid; i < iter * 128; i += NTHR) { const int pe = PE[i], e = pe >> 16, lr = pe & 0xffff; LIST[(size_t)e * NASSIGN + LBASE[e] + lr] = PA[i]; }
    __syncthreads();
}

__device__ __forceinline__ void phase_gather(int wv, const Params& p, int l, LAS unsigned char* lds) {
    const int tid = otid(wv), lane = tid & 63, gw = blockIdx.x * NWAVE + (tid >> 6), nw = gridDim.x * NWAVE;
    unsigned char* ws = opq(p.ws);
    const unsigned* ctl = (const unsigned*)(ws + WS_CTL); int* SLOTT = (int*)(ws + WS_SLOTT);
    const int* LIST = (const int*)(ws + WS_LIST); const float* GATE = (const float*)(ws + WS_GATE);
    int* SLOTA = (int*)(ws + WS_SLOTA); float* SLOTG = (float*)(ws + WS_SLOTG); int* TILEE = (int*)(ws + WS_TILEE);
    LAS int* CNT = (LAS int*)lds; LAS int* PST = CNT + 32;
    constexpr int NASSIGN = TA * 4;
    if (tid < 32) CNT[tid] = (int)__hip_atomic_load(ctl + CTL_CNT(l, tid), __ATOMIC_RELAXED, __HIP_MEMORY_SCOPE_AGENT);
    __syncthreads();
    if (tid == 0) { int s = 0; for (int e = 0; e < 32; ++e) { PST[e] = s; s += (CNT[e] + 255) & ~255; } PST[32] = s; }
    __syncthreads();
    const int nslot = PST[32], ntiles = nslot >> 8;
    if (blockIdx.x == 0) { for (int t = tid; t < ntiles; t += NTHR) { int e = 0; for (int j = 1; j < 32; ++j) if (PST[j] <= t * 256) e = j; TILEE[t] = e; } if (tid == 0) TILEE[MAXTILE] = ntiles; }
    for (int s = blockIdx.x * NTHR + tid; s < nslot; s += gridDim.x * NTHR) {
        int e = 0;
#pragma unroll
        for (int j = 1; j < 32; ++j) if (PST[j] <= s) e = j;
        const int r = s - PST[e];
        int a = -1;
        if (r < CNT[e]) a = LIST[(size_t)e * NASSIGN + r];
        SLOTA[s] = a; SLOTG[s] = (a >= 0) ? GATE[a] : 0.f; SLOTT[s] = (a >= 0) ? (a >> 2) : TA;
    }
}

#define XB_TMO      128
#define XB_XCNT(j)  (256  + 64 * (j))
#define XB_XSUB(j)  (1280 + 64 * (j))
#define XB_XGEN(j)  (2304 + 64 * (j))
#define XB_TOP      3328
#define XB_TOPGEN   3392
#define XCD_BAR_WORDS 3456
#define XB_SPIN_CAP (1u << 18)
__device__ __forceinline__ unsigned xb_ld(unsigned* p)              { return __hip_atomic_load(p, __ATOMIC_RELAXED, __HIP_MEMORY_SCOPE_AGENT); }
__device__ __forceinline__ unsigned xb_add(unsigned* p, unsigned v) { return __hip_atomic_fetch_add(p, v, __ATOMIC_RELAXED, __HIP_MEMORY_SCOPE_AGENT); }
__device__ __forceinline__ unsigned xb_xcc_id() { return (unsigned)__builtin_amdgcn_s_getreg((3 << 11) | 20) & 0xFu; }
#define XB_SPIN(cond, bar) do { unsigned _sp = 0; while (cond) { __builtin_amdgcn_s_sleep(1); \
    if ((++_sp & 255u) == 0u) { if (xb_ld(&(bar)[XB_TMO])) break; if (_sp > XB_SPIN_CAP) { atomicAdd(&(bar)[XB_TMO], 1u); break; } } } } while (0)
struct XcdBarrier { unsigned* bar; unsigned x; volatile LAS unsigned* st; };
__device__ __forceinline__ XcdBarrier xcd_barrier_post(int tid, unsigned* bar, volatile LAS unsigned* st) {
    XcdBarrier b; b.bar = bar; b.x = xb_xcc_id(); b.st = st;
    if (tid == 0) st[2] = xb_add(&bar[XB_XCNT(b.x)], 1u);
    return b;
}
__device__ __forceinline__ void xcd_barrier_complete(unsigned* bar, unsigned x, unsigned& nloc, unsigned& nx) {
    const unsigned G = gridDim.x * gridDim.y * gridDim.z;
    unsigned sum, cnt, mine, sp = 0u;
    for (;;) {
        sum = 0u; cnt = 0u; mine = 0u;
#pragma unroll
        for (unsigned j = 0; j < 16; ++j) { const unsigned c = xb_ld(&bar[XB_XCNT(j)]); sum += c; cnt += (c > 0u) ? 1u : 0u; mine = (j == x) ? c : mine; }
        if (sum == G) break;
        __builtin_amdgcn_s_sleep(1);
        if ((++sp & 255u) == 0u) { if (xb_ld(&bar[XB_TMO])) break; if (sp > XB_SPIN_CAP) { atomicAdd(&bar[XB_TMO], 1u); break; } }
    }
    nloc = mine > 0u ? mine : 1u; nx = cnt > 0u ? cnt : 1u;
}
__device__ __forceinline__ void xcd_barrier(int wv, const XcdBarrier& b) {
    asm volatile("s_waitcnt vmcnt(0)" ::: "memory");
    __syncthreads();
    if (otid(wv) == 0) {
        unsigned* bar = b.bar;
        __builtin_amdgcn_s_waitcnt(0);
        unsigned nloc = b.st[0], nx = b.st[1];
        if (nloc == 0u) { xcd_barrier_complete(bar, b.x, nloc, nx); b.st[0] = nloc; b.st[1] = nx; }
        const unsigned old = xb_add(&bar[XB_XSUB(b.x)], 1u);
        const unsigned gen = old / nloc;
        if (old + 1u == (gen + 1u) * nloc) {
            __builtin_amdgcn_fence(__ATOMIC_RELEASE, "agent");
            asm volatile("s_waitcnt vmcnt(0)" ::: "memory");
            const unsigned og = xb_add(&bar[XB_TOP], 1u);
            const unsigned tg = og / nx;
            if (og + 1u == (tg + 1u) * nx) xb_add(&bar[XB_TOPGEN], 1u);
            else XB_SPIN(xb_ld(&bar[XB_TOPGEN]) == tg, bar);
            __builtin_amdgcn_fence(__ATOMIC_ACQUIRE, "agent");
            xb_add(&bar[XB_XGEN(b.x)], 1u);
            asm volatile("s_waitcnt vmcnt(0)" ::: "memory");
        } else {
            XB_SPIN(xb_ld(&bar[XB_XGEN(b.x)]) == gen, bar);
            __builtin_amdgcn_fence(__ATOMIC_ACQUIRE, "agent");
            asm volatile("s_waitcnt vmcnt(0)" ::: "memory");
        }
    }
    __syncthreads();
}

constexpr int NPHASE = 23;
extern __shared__ __attribute__((aligned(16))) unsigned char smem_raw[];

#ifndef EN_MASK
#define EN_MASK 0xFFF
#endif
#define EN(k) ((EN_MASK >> (k)) & 1)
#ifndef PROBE_REP
#define PROBE_REP -1
#endif
#define RUN(id) ((id) >= p.phase_lo && (id) < p.phase_hi)
#define SYNC() do { if (p.use_bar) xcd_barrier(wv, bar); } while (0)
template <int l>
__device__ __forceinline__ void run_layer(int wv, const Params& p, LAS unsigned char* lds, const XcdBarrier& bar) {
    unsigned char* ws = opq(p.ws);
    const int cid = __builtin_amdgcn_readfirstlane(*(const LAS int*)(lds + LDS_MISC + 68));
        const int pb = 1 + 11 * l;
        const int T = (l == 0) ? TA : TL;
        if (l == 0) { if (EN(0) && RUN(pb + 0)) phase_norm1_l0(wv, p); SYNC(); if (PROBE_REP == 0) { phase_norm1_l0(wv, p); SYNC(); } }
        if (EN(1) && RUN(pb + 1)) {
            pg8::Gemm g{(const bf16_t*)(ws + WS_HB), (const bf16_t*)(ws + WS_WIN) + (size_t)l * NP * 1024, TA, NP, 1024};
            pg8::StaticOrder S; S.init(TA, NP, gridDim.x, cid);
            EpiStoreBf16 E{(bf16_t*)(ws + WS_P), NP};
            pg8::gemm_phase(wv, lds, g, S, E, nullptr);
        }
        if (PROBE_REP == 21 && l == 0) {
            SYNC();
            struct SameTile : pg8::StaticOrder { __device__ __forceinline__ bool next(int i, pg8::Unit& u) const { pg8::Unit t; const bool ok = pg8::StaticOrder::next(i, t); u.pm = 0; u.pn = 0; return ok; } };
            pg8::Gemm g{(const bf16_t*)(ws + WS_HB), (const bf16_t*)(ws + WS_WIN), TA, NP, 1024};
            SameTile S; S.init(TA, NP, gridDim.x, cid);
            EpiStoreBf16 E{(bf16_t*)(ws + WS_XS), NP};
            pg8::gemm_phase(wv, lds, g, S, E, nullptr);
        }
        if (PROBE_REP == 22 && l == 0) {
            SYNC();
            pg8::Gemm g{(const bf16_t*)(ws + WS_HB), (const bf16_t*)(ws + WS_WIN), TA, NP, 1024};
            pg8::StaticOrder S; S.init(TA, NP, gridDim.x, cid);
            EpiStoreBf16 E{(bf16_t*)(ws + WS_XS), NP};
            pg8::gemm_phase(wv, lds, g, S, E, nullptr);
        }
        SYNC();
        if (EN(2) && RUN(pb + 2)) phase_prep(wv, p, l, lds);
        if (PROBE_REP == 2 && l == 0) { SYNC(); if (PROBE_MIX & 1) prep_elem(wv, p, l, lds); __syncthreads(); if (PROBE_MIX & 2) prep_state(wv, p, l, lds); }
        SYNC();
        if (EN(3) && RUN(pb + 3)) phase_scan(wv, p, lds);
        if (PROBE_REP == 3 && l == 0) { SYNC(); phase_scan(wv, p, lds); }
        SYNC();
        if (EN(4) && RUN(pb + 4)) phase_mixers(wv, p, l, lds);
        if (PROBE_REP == 4 && l == 0) { SYNC(); phase_mixers_probe(wv, p, l, lds); }
        SYNC();
        if (EN(5) && RUN(pb + 5)) {
            pg8::Gemm g{(const bf16_t*)(ws + WS_YMIX), (const bf16_t*)(ws + WS_WOUT + (size_t)l * 1024 * 1024 * (YM_FP8 ? 1 : 2)), T, 1024, YM_FP8 ? 512 : 1024};
            pg8::StaticOrder S; S.init(T, 1024, gridDim.x, cid);
            const float* MOD = (const float*)(ws + WS_MOD);
            EpiResid E{l == 0 ? p.x : (const float*)(ws + WS_XB), l == 0 ? p.ctx : (const float*)(ws + WS_XB) + (size_t)TL * 1024, (float*)(ws + WS_XA), MOD + (size_t)l * 5 * 6144 + 2 * 1024, YM_FP8 ? 0.03125f : 1.0f};
            pg8::gemm_phase<EpiResid, pg8::StaticOrder, false, YM_FP8 != 0>(wv, lds, g, S, E, nullptr);
        }
        SYNC();
        if (PROBE_REP == 25 && l == 0) {
            pg8::Gemm g{(const bf16_t*)(ws + WS_YMIX), (const bf16_t*)(ws + WS_WOUT + (size_t)l * 1024 * 1024 * (YM_FP8 ? 1 : 2)), T, 1024, YM_FP8 ? 512 : 1024};
            pg8::StaticOrder S; S.init(T, 1024, gridDim.x, cid);
            const float* MOD = (const float*)(ws + WS_MOD);
            EpiResid E{p.x, p.ctx, (float*)(ws + WS_XA), MOD + (size_t)l * 5 * 6144 + 2 * 1024, YM_FP8 ? 0.03125f : 1.0f};
            pg8::gemm_phase<EpiResid, pg8::StaticOrder, false, YM_FP8 != 0>(wv, lds, g, S, E, nullptr);
            SYNC();
        }
        if (EN(6) && RUN(pb + 6)) phase_router(wv, p, l, lds);
        SYNC();
        if (EN(7) && RUN(pb + 7)) phase_gather(wv, p, l, lds);
        if (PROBE_REP == 7 && l == 0) { SYNC(); phase_gather(wv, p, l, lds); }
        SYNC();
        if (EN(8) && RUN(pb + 8)) {
            const int* TILEE = (const int*)(ws + WS_TILEE);
            pg8::Gemm g{(const bf16_t*)(ws + WS_H2B), (const bf16_t*)(ws + WS_WGU + (size_t)l * 32 * 2048 * 1024), MAXSLOT, 32 * 2048, 512, (const int*)(ws + WS_SLOTT)};
            MoeOrder S{TILEE, __builtin_amdgcn_readfirstlane(TILEE[MAXTILE]), 8, (int)gridDim.x, cid};
            EpiGU E{ws + WS_ACT, p.b_gu + (size_t)l * 32 * 2048};
            pg8::gemm_phase<EpiGU, MoeOrder, false, true, true>(wv, lds, g, S, E, nullptr);
        }
        SYNC();
        if (PROBE_REP == 23 && l == 0) {
            const int* TILEE = (const int*)(ws + WS_TILEE);
            pg8::Gemm g{(const bf16_t*)(ws + WS_H2B), (const bf16_t*)(ws + WS_WGU + (size_t)l * 32 * 2048 * 1024), MAXSLOT, 32 * 2048, 512, (const int*)(ws + WS_SLOTT)};
            MoeOrder S{TILEE, __builtin_amdgcn_readfirstlane(TILEE[MAXTILE]), 8, (int)gridDim.x, cid};
            EpiGU E{ws + WS_ACT, p.b_gu + (size_t)l * 32 * 2048};
            pg8::gemm_phase<EpiGU, MoeOrder, false, true, true>(wv, lds, g, S, E, nullptr);
            SYNC();
        }
        if (EN(9) && RUN(pb + 9)) {
            const int* TILEE = (const int*)(ws + WS_TILEE);
            pg8::Gemm g{(const bf16_t*)(ws + WS_ACT), (const bf16_t*)(ws + WS_WDN + (size_t)l * 32 * 1024 * 1024), MAXSLOT, 32 * 1024, 512};
            MoeOrder S{TILEE, __builtin_amdgcn_readfirstlane(TILEE[MAXTILE]), 4, (int)gridDim.x, cid};
            EpiDown E{(bf16_t*)(ws + WS_Y), p.b_down + (size_t)l * 32 * 1024, (const int*)(ws + WS_SLOTA), (const float*)(ws + WS_SLOTG)};
            pg8::gemm_phase<EpiDown, MoeOrder, false, true>(wv, lds, g, S, E, nullptr);
        }
        SYNC();
        if (PROBE_REP == 24 && l == 0) {
            const int* TILEE = (const int*)(ws + WS_TILEE);
            pg8::Gemm g{(const bf16_t*)(ws + WS_ACT), (const bf16_t*)(ws + WS_WDN + (size_t)l * 32 * 1024 * 1024), MAXSLOT, 32 * 1024, 512};
            MoeOrder S{TILEE, __builtin_amdgcn_readfirstlane(TILEE[MAXTILE]), 4, (int)gridDim.x, cid};
            EpiDown E{(bf16_t*)(ws + WS_Y), p.b_down + (size_t)l * 32 * 1024, (const int*)(ws + WS_SLOTA), (const float*)(ws + WS_SLOTG)};
            pg8::gemm_phase<EpiDown, MoeOrder, false, true>(wv, lds, g, S, E, nullptr);
            SYNC();
        }
        if (EN(10) && RUN(pb + 10)) phase_combine(wv, p, l);
        if (PROBE_REP == 10 && l == 0) { SYNC(); phase_combine(wv, p, l); }
        if (l == 0) SYNC();
    }

__global__ void __launch_bounds__(NTHR, 2) mk_forward(Params p) {
    LAS unsigned char* lds = (LAS unsigned char*)smem_raw;
    const int wv = __builtin_amdgcn_readfirstlane((int)threadIdx.x >> 6);
    { const int t0 = otid(wv); if (t0 < 32) ((LAS unsigned*)(lds + LDS_MISC))[t0] = 0u; }
    __syncthreads();
    unsigned* ctl = (unsigned*)(p.ws + WS_CTL);
    XcdBarrier bar; bar.bar = ctl; bar.x = 0; bar.st = (volatile LAS unsigned*)(lds + LDS_MISC);
    if (p.use_bar) bar = xcd_barrier_post(otid(wv), ctl, (volatile LAS unsigned*)(lds + LDS_MISC));
    if (EN(11) && RUN(0)) phase_prologue(wv, p, lds);
    SYNC();
    if (PROBE_REP == 11) { phase_prologue(wv, p, lds); SYNC(); }
    if (otid(wv) == 0) { LAS unsigned* ms = (LAS unsigned*)(lds + LDS_MISC); unsigned cid = blockIdx.x;
        if (p.use_bar) { bool ok = (gridDim.x & 7u) == 0u;
            for (unsigned j = 0; j < 16; ++j) { const unsigned c = xb_ld(&ctl[XB_XCNT(j)]); ok = ok && (c == (j < 8 ? gridDim.x >> 3 : 0u)); }
            if (ok) cid = ms[2] * 8u + bar.x; }
        ms[17] = cid; ms[18] = cid & 7u; }
    __syncthreads();
    run_layer<0>(wv, p, lds, bar);
    run_layer<1>(wv, p, lds, bar);
}
#undef RUN
#undef SYNC

extern "C" void kernel_launch(void* const* d_in, const int* in_sizes, int n_in, void* d_out, int out_size, void* d_ws, size_t ws_size, hipStream_t stream) {
    static int grid = 0;
    if (grid == 0) {
        if (n_in != 25 || ws_size < WS_END) { fprintf(stderr, "kernel_launch: expected 25 inputs and >= %zu bytes of workspace, got %d inputs, %zu bytes; nothing launched\n", (size_t)WS_END, n_in, ws_size); grid = -1; return; }
        int dev = 0, cus = 0, per_cu = 0;
        hipGetDevice(&dev); hipDeviceGetAttribute(&cus, hipDeviceAttributeMultiprocessorCount, dev);
        if (hipFuncSetAttribute((const void*)mk_forward, hipFuncAttributeMaxDynamicSharedMemorySize, LDS_BYTES) != hipSuccess) { fprintf(stderr, "kernel_launch: hipFuncSetAttribute failed\n"); grid = -1; return; }
        hipOccupancyMaxActiveBlocksPerMultiprocessor(&per_cu, (const void*)mk_forward, NTHR, LDS_BYTES);
        if (per_cu < 1) fprintf(stderr, "kernel_launch: occupancy query reports %d workgroups per CU\n", per_cu);
        grid = cus > 0 ? cus : 256;
    }
    if (grid < 0) return;
    Params p{};
    const float** pp = (const float**)&p;
    for (int i = 0; i < 25; ++i) pp[i] = (const float*)d_in[i];
    p.out = (float*)d_out; p.ws = (unsigned char*)d_ws; p.pad0 = 0;
    hipMemsetAsync((unsigned char*)d_ws + WS_CTL, 0, CTL_BYTES, stream);
#if MK_LAUNCHES == 1
    p.phase_lo = 0; p.phase_hi = NPHASE; p.use_bar = 1;
    hipLaunchKernelGGL(mk_forward, dim3(grid), dim3(NTHR), LDS_BYTES, stream, p);
#else
    for (int ph = 0; ph < NPHASE; ++ph) { if (ph == 12) continue;
        p.phase_lo = ph; p.phase_hi = ph + 1; p.use_bar = 0;
        hipLaunchKernelGGL(mk_forward, dim3(grid), dim3(NTHR), LDS_BYTES, stream, p); }
#endif
}
```

```cpp
#include <hip/hip_runtime.h>
#include <cstdio>
#include <cstdint>

#ifndef MK_LAUNCHES
#define MK_LAUNCHES 1
#endif
#ifndef MK_CHECK
#define MK_CHECK 0
#endif

typedef unsigned short bf16_t;
typedef short bf16x8 __attribute__((ext_vector_type(8)));
typedef short s16x4 __attribute__((ext_vector_type(4)));
typedef float f32x4 __attribute__((ext_vector_type(4)));
typedef float f32x16 __attribute__((ext_vector_type(16)));
typedef unsigned u32x4 __attribute__((ext_vector_type(4)));
typedef unsigned u32x2 __attribute__((ext_vector_type(2)));
#define LAS __attribute__((address_space(3)))

constexpr int NTHR = 512, NWAVE = 8;
constexpr int DM = 1024, NBATCH = 4, SEQ = 8192, CTXL = 256, TL = NBATCH * SEQ, TC = NBATCH * CTXL, TA = TL + TC;
constexpr int NP = 3584;
constexpr int PC_AQ = 0, PC_AK = 256, PC_AV = 384, PC_BQ = 512, PC_BK = 768, PC_BV = 1024, PC_CQK = 1280, PC_CV = 1792, PC_CO = 2048, PC_CG = 2304,
              PC_DCQ = 2320, PC_DCKV = 2512, PC_DKR = 2640, PC_DQF = 2672, PC_DKVF = 3056, PC_END = 3568;
constexpr int INC = 2672;
constexpr int NEXP = 32, MAXSLOT = 143360, MAXTILE = MAXSLOT / 256;
constexpr int NCHUNK = 132;
constexpr int NCU = NBATCH * NCHUNK * 4 * 2;
constexpr float LOG2E = 1.4426950408889634f;
constexpr float EPS = 1e-6f;

constexpr int LDS_BYTES = 147456;
constexpr int LDS_MISC = LDS_BYTES - 256;

constexpr size_t al256(size_t x) { return (x + 255) & ~(size_t)255; }
constexpr size_t WS_CTL = 0, CTL_BYTES = 65536;
constexpr size_t WS_MOD = WS_CTL + CTL_BYTES;
constexpr size_t WS_RA = al256(WS_MOD + (size_t)2 * 5 * 6144 * 4);
constexpr size_t WS_RD = al256(WS_RA + (size_t)SEQ * 32 * 8);
constexpr size_t WS_WIN = al256(WS_RD + (size_t)SEQ * 16 * 8);
constexpr size_t WS_WOUT = al256(WS_WIN + (size_t)2 * NP * 1024 * 2);
constexpr size_t WS_WGU = al256(WS_WOUT + (size_t)2 * 1024 * 1024 * 2);
constexpr size_t WS_WDN = al256(WS_WGU + (size_t)2 * 32 * 2048 * 1024 * 2);
constexpr size_t WS_WRT = al256(WS_WDN + (size_t)2 * 32 * 1024 * 1024 * 2);
constexpr size_t WS_HB = al256(WS_WRT + (size_t)2 * 2 * 32 * 1024 * 2);
constexpr size_t WS_H2B = al256(WS_HB + (size_t)TA * 1024 * 2);
constexpr size_t WS_P = al256(WS_H2B + (size_t)TA * 1024 * 2);
constexpr size_t WS_QA = al256(WS_P + (size_t)TA * NP * 2);
constexpr size_t WS_KA = al256(WS_QA + (size_t)TA * 256 * 2);
constexpr size_t WS_QD = al256(WS_KA + (size_t)TA * 128 * 2);
constexpr size_t WS_KD = al256(WS_QD + (size_t)TA * 384 * 2);
constexpr size_t WS_VD = al256(WS_KD + (size_t)TA * 384 * 2);
constexpr size_t WS_QC = al256(WS_VD + (size_t)TA * 256 * 2);
constexpr size_t WS_KC = al256(WS_QC + (size_t)TA * 256 * 2);
constexpr size_t WS_MIXEND = al256(WS_KC + (size_t)TA * 256 * 2);
constexpr size_t WS_ACT = WS_P;
static_assert(WS_MIXEND - WS_P >= (size_t)MAXSLOT * 1024 * 2, "ACT alias");
constexpr size_t WS_GATES = WS_MIXEND;
constexpr size_t WS_DC = al256(WS_GATES + (size_t)TA * 16 * 4);
constexpr size_t WS_DN = al256(WS_DC + (size_t)NCU * 4096 * 4);
constexpr size_t WS_DFA = al256(WS_DN + (size_t)NCU * 64 * 4);
constexpr size_t WS_CS = al256(WS_DFA + (size_t)NCU * 2 * 4);
constexpr size_t WS_NS = al256(WS_CS + (size_t)NCU * 4096 * 2);
constexpr size_t WS_MS = al256(WS_NS + (size_t)NCU * 64 * 4);
constexpr size_t WS_YMIX = al256(WS_MS + (size_t)NCU * 4);
constexpr size_t WS_XA = al256(WS_YMIX + (size_t)TA * 1024 * 2);
constexpr size_t WS_XB = al256(WS_XA + (size_t)TA * 1024 * 4);
constexpr size_t WS_GATE = al256(WS_XB + (size_t)TA * 1024 * 4);
constexpr size_t WS_LIST = al256(WS_GATE + (size_t)TA * 4 * 4);
constexpr size_t WS_SLOTA = al256(WS_LIST + (size_t)32 * TA * 4 * 4);
constexpr size_t WS_SLOTG = al256(WS_SLOTA + (size_t)MAXSLOT * 4);
constexpr size_t WS_SLOTT = al256(WS_SLOTG + (size_t)MAXSLOT * 4);
constexpr size_t WS_TILEE = al256(WS_SLOTT + (size_t)MAXSLOT * 4);
constexpr size_t WS_XS = al256(WS_TILEE + (size_t)(MAXTILE + 64) * 4);
constexpr size_t WS_Y = WS_XS;
constexpr size_t WS_DBG = al256(WS_XS + (size_t)MAXSLOT * 1024 * 2);
constexpr size_t WS_END = WS_DBG + 65536;

#define CTL_Q(l, q, x) (4096 + (((l) * 8 + (q)) * 8 + (x)) * 64)
#define CTL_CNT(l, e) (12288 + (l) * 2048 + (e) * 64)

struct Params {
    const float *x, *c, *ctx, *c_ctx, *w_ada, *b_ada, *g_norm1, *g_norm2, *w_in, *attn_sink, *nat_rpb, *mlstm_conv, *mlstm_gate_bias,
                *mla_g_q, *mla_w_uq, *mla_g_kv, *mla_w_ukv, *w_out, *w_router, *b_router, *w_gu, *b_gu, *w_down, *b_down, *g_final;
    float* out;
    unsigned char* ws;
    int phase_lo, phase_hi, use_bar, pad0;
};

__device__ __forceinline__ int otid(int wv) { int t = wv * 64 + (int)__builtin_amdgcn_mbcnt_hi(~0u, __builtin_amdgcn_mbcnt_lo(~0u, 0u)); asm volatile("" : "+v"(t)); return t; }
__device__ __forceinline__ unsigned char* opq(unsigned char* q) { asm volatile("" : "+s"(q)); return q; }
#ifndef YM_FP8
#define YM_FP8 0
#endif
#if YM_FP8
typedef unsigned char ym_t;
#else
typedef unsigned short ym_t;
#endif
__device__ __forceinline__ float bf2f(unsigned b) { return __uint_as_float(b << 16); }
typedef __bf16 bf16v2_t __attribute__((ext_vector_type(2)));
typedef float f32v2_t __attribute__((ext_vector_type(2)));
__device__ __forceinline__ unsigned pk2(float lo, float hi) { const f32v2_t f = {lo, hi}; const bf16v2_t v = __builtin_convertvector(f, bf16v2_t); return __builtin_bit_cast(unsigned, v); }
__device__ __forceinline__ unsigned pk_fp8x4(float a, float b, float c, float d) { int r = 0; r = __builtin_amdgcn_cvt_pk_fp8_f32(a, b, r, false); r = __builtin_amdgcn_cvt_pk_fp8_f32(c, d, r, true); return (unsigned)r; }
__device__ __forceinline__ unsigned pk_fp8x4(float a, float b, float c, float d);
__device__ __forceinline__ void ym_store4(ym_t* p, float a, float b, float c, float d) {
#if YM_FP8
    *(unsigned*)p = pk_fp8x4(a, b, c, d);
#else
    u32x2 w; w.x = pk2(a, b); w.y = pk2(c, d); *(u32x2*)p = w;
#endif
}
__device__ __forceinline__ unsigned short f2bf(float f) { return (unsigned short)(pk2(f, 0.f) & 0xffffu); }
__device__ __forceinline__ float fexp2(float x) { return __builtin_amdgcn_exp2f(x); }
__device__ __forceinline__ float fexp(float x) { return __builtin_amdgcn_exp2f(x * LOG2E); }
__device__ __forceinline__ float wave_sum(float v) {
#pragma unroll
    for (int d = 32; d >= 1; d >>= 1) v += __shfl_xor(v, d);
    return v;
}
__device__ __forceinline__ float wave_max(float v) {
#pragma unroll
    for (int d = 32; d >= 1; d >>= 1) v = fmaxf(v, __shfl_xor(v, d));
    return v;
}
__device__ __forceinline__ float wave_incl_sum(float v, int lane) {
#pragma unroll
    for (int d = 1; d < 64; d <<= 1) { const float t = __shfl_up(v, d); if (lane >= d) v += t; }
    return v;
}
__device__ __forceinline__ float wave_incl_max(float v, int lane) {
#pragma unroll
    for (int d = 1; d < 64; d <<= 1) { const float t = __shfl_up(v, d); if (lane >= d) v = fmaxf(v, t); }
    return v;
}
__device__ __forceinline__ f32x16 mfma32(bf16x8 a, bf16x8 b, f32x16 c) { return __builtin_amdgcn_mfma_f32_32x32x16_bf16(a, b, c, 0, 0, 0); }
__device__ __forceinline__ f32x16 zero16() { f32x16 z;
#pragma unroll
    for (int i = 0; i < 16; ++i) z[i] = 0.f;
    return z; }
__device__ __forceinline__ s16x4 tr_read(LAS unsigned char* p) { return __builtin_amdgcn_ds_read_tr16_b64_v4i16((LAS s16x4*)p); }
__device__ __forceinline__ bf16x8 cat8(s16x4 a, s16x4 b) { return __builtin_shufflevector(a, b, 0, 1, 2, 3, 4, 5, 6, 7); }
__device__ __forceinline__ bf16x8 as_bf16x8(u32x4 v) { return __builtin_bit_cast(bf16x8, v); }
__device__ __forceinline__ float sigmoidf_(float x) { return 1.0f / (1.0f + fexp(-x)); }
__device__ __forceinline__ float siluf_(float x) { return x * sigmoidf_(x); }

__device__ __forceinline__ void row_load(const float* row, int lane, f32x4 (&v)[4]) {
#pragma unroll
    for (int i = 0; i < 4; ++i) v[i] = *(const f32x4*)(row + i * 256 + lane * 4);
}
__device__ __forceinline__ float row_rstd(const f32x4 (&v)[4]) {
    float s = 0.f;
#pragma unroll
    for (int i = 0; i < 4; ++i) s += v[i][0] * v[i][0] + v[i][1] * v[i][1] + v[i][2] * v[i][2] + v[i][3] * v[i][3];
    s = wave_sum(s);
    return rsqrtf(s * (1.0f / 1024.0f) + EPS);
}
__device__ __forceinline__ void row_modulate(f32x4 (&v)[4], float rstd, const float* g, const float* sc, const float* sh, int lane) {
#pragma unroll
    for (int i = 0; i < 4; ++i) {
        const f32x4 gg = *(const f32x4*)(g + i * 256 + lane * 4), s1 = *(const f32x4*)(sc + i * 256 + lane * 4), s0 = *(const f32x4*)(sh + i * 256 + lane * 4);
#pragma unroll
        for (int j = 0; j < 4; ++j) v[i][j] = (v[i][j] * rstd * gg[j]) * (1.0f + s1[j]) + s0[j];
    }
}
__device__ __forceinline__ void row_store_fp8(unsigned char* row, int lane, const f32x4 (&v)[4]) {
#pragma unroll
    for (int i = 0; i < 4; ++i) *(unsigned*)(row + i * 256 + lane * 4) = pk_fp8x4(v[i][0], v[i][1], v[i][2], v[i][3]);
}
__device__ __forceinline__ void row_store_bf16(bf16_t* row, int lane, const f32x4 (&v)[4]) {
#pragma unroll
    for (int i = 0; i < 4; ++i) { u32x2 w; w.x = pk2(v[i][0], v[i][1]); w.y = pk2(v[i][2], v[i][3]); *(u32x2*)(row + i * 256 + lane * 4) = w; }
}
namespace pg8 {
#define PG8_LAS __attribute__((address_space(3)))
typedef unsigned short bf16_t;
typedef short bf16x8 __attribute__((ext_vector_type(8)));
typedef float f32x4 __attribute__((ext_vector_type(4)));
typedef unsigned u32x4 __attribute__((ext_vector_type(4)));
constexpr int FP8_ONE = 0x7f7f7f7f;
constexpr int BM = 256, BK = 64, HALF = 128, HTB = HALF * BK * 2  , STAGE_BYTES = 8 * HTB, NXCD = 8, WGM = 8;

__host__ __device__ __forceinline__ int lds_byte(int r, int c) { const int st = (r >> 4) * 2 + (c >> 5), rr = r & 15, cc = c & 31, ob = rr * 64 + cc * 2; return st * 1024 + (ob ^ (((ob >> 9) & 1) << 5)); }
__host__ __device__ __forceinline__ void stage_rc(int b, int& R, int& C) { const int st = b / 1024, sb = b % 1024, swz = sb ^ (((sb >> 9) & 1) << 5); R = (st >> 1) * 16 + swz / 64; C = (st & 1) * 32 + (swz % 64) / 2; }
__host__ __device__ __forceinline__ int perm32(int rho) { const int n = rho >> 4, i = rho & 15; return 8 * (i >> 2) + 4 * n + (i & 3); }

struct Unit { int pm, pn; };
struct Gemm { const bf16_t* A; const bf16_t* Bt; int M, N, K; const int* rowmap; };

struct StaticOrder {
    int nM, nN, nwg, G, c;
    __host__ __device__ void init(int M, int N, int G_, int c_) { nM = M / BM; nN = N / BM; nwg = nM * nN; G = G_; c = c_; }
    __host__ __device__ bool next(int i, Unit& u) const {
        const long L = (long)i * G + c; if (L >= nwg) return false;
        int wgid = (int)L; { const int q = nwg / NXCD, r = nwg % NXCD, xcd = wgid % NXCD, off = wgid / NXCD; wgid = (xcd < r ? xcd * (q + 1) : r * (q + 1) + (xcd - r) * q) + off; }
        const int nig = WGM * nN, gid = wgid / nig, fm = gid * WGM, gsz = (nM - fm) < WGM ? (nM - fm) : WGM;
        u.pm = fm + ((wgid % nig) % gsz); u.pn = (wgid % nig) / gsz; return true;
    }
    __device__ __forceinline__ void a_ready(const Unit&) const {}
    __device__ __forceinline__ void done(const Unit&) const {}
};
template <class Epi, class Sched, bool STAMP = false, bool FP8 = false, bool GATHER = false>
__device__ __forceinline__ void gemm_phase(int wv, PG8_LAS unsigned char* lds, const Gemm g, const Sched& S, const Epi& E, unsigned long long* stamps) {
    const int tid = otid(wv), wid = __builtin_amdgcn_readfirstlane(tid >> 6), lane = tid & 63, wr = wid >> 2, wc = wid & 3, fr = lane & 15, fq = lane >> 4;
    const int K = g.K, nt = K / BK;
    int ts_lo = 0, ts_hi = 0, nts = 0; const unsigned long long rt_entry = STAMP ? (unsigned long long)wall_clock64() : 0ull;
#define PG8_STAMP() do { if (STAMP && wid == 0 && nts < 64) { const unsigned long long _c = (unsigned long long)clock64(); \
        ts_lo = (lane == nts) ? (int)(unsigned)_c : ts_lo; ts_hi = (lane == nts) ? (int)(unsigned)(_c >> 32) : ts_hi; ++nts; } } while (0)
    PG8_STAMP();
    unsigned voffA[2], voffB[2];
#pragma unroll
    for (int i = 0; i < 2; ++i) { int R, C; stage_rc(tid * 16 + i * 8192, R, C); const int Rb = Epi::PERM ? ((R & ~31) + perm32(R & 31)) : R;
        voffA[i] = (unsigned)(R * K + C) * 2u; voffB[i] = (unsigned)(Rb * K + C) * 2u; }
    int gR0, gC0; stage_rc(tid * 16, gR0, gC0);
    unsigned vAc[2][2], vAn[2][2];
#define PG8_ROWS(arr, unit) do { _Pragma("unroll") for (int h_ = 0; h_ < 2; ++h_) _Pragma("unroll") for (int i_ = 0; i_ < 2; ++i_) \
        arr[h_][i_] = (unsigned)g.rowmap[(unit).pm * BM + h_ * HALF + i_ * 64 + gR0] * (unsigned)(K * 2) + (unsigned)(gC0 * 2); } while (0)
    const char* const baseA = (const char*)g.A; const char* const baseB = (const char*)g.Bt;
    const __amdgpu_buffer_rsrc_t rsA = __builtin_amdgcn_make_buffer_rsrc((void*)g.A, 0, 0x7ffff000, 0x00020000), rsB = __builtin_amdgcn_make_buffer_rsrc((void*)g.Bt, 0, 0x7ffff000, 0x00020000);
    const unsigned row64 = (unsigned)(64 * K * 2);
    const size_t kstep = (size_t)(BK * 2);
    const size_t hstep = (size_t)HALF * K * 2;
    const size_t tstep = 2 * hstep;
    const unsigned ldsw = (unsigned)wid * 1024u;
    const int aoff = lds_byte(wr * 64 + fr, fq * 8), boff = lds_byte(wc * 32 + fr, fq * 8);
#define PG8_SA(b, h) (((b) * 2 + (h)) * HTB)
#define PG8_SB(b, h) ((4 + (b) * 2 + (h)) * HTB)
#define PG8_STG(bufoff, gbase, W) do { const unsigned so_ = (unsigned)__builtin_amdgcn_readfirstlane((int)((const char*)(gbase) - base##W)); _Pragma("unroll") for (int _i = 0; _i < 2; ++_i) \
        __builtin_amdgcn_raw_ptr_buffer_load_lds(rs##W, (PG8_LAS unsigned*)(lds + (bufoff) + ldsw + _i * 8192), 16, voff##W[_i], so_, 0, 0); } while (0)
#define PG8_STGA(b, h, kptr, arr) do { if constexpr (GATHER) { const unsigned so_ = (unsigned)__builtin_amdgcn_readfirstlane((int)((const char*)(kptr) - baseA)); _Pragma("unroll") for (int _i = 0; _i < 2; ++_i) \
        __builtin_amdgcn_raw_ptr_buffer_load_lds(rsA, (PG8_LAS unsigned*)(lds + PG8_SA(b, h) + ldsw + _i * 8192), 16, arr[h][_i], so_, 0, 0); } \
    else { PG8_STG(PG8_SA(b, h), (kptr) + (h) * hstep, A); } } while (0)
#define PG8_LDA(dst, b, h) do { _Pragma("unroll") for (int m = 0; m < 4; ++m) _Pragma("unroll") for (int k = 0; k < 2; ++k) dst[m][k] = *(const PG8_LAS bf16x8*)(lds + PG8_SA(b, h) + aoff + m * 2048 + k * 1024); } while (0)
#define PG8_LDB(dst, b, h) do { _Pragma("unroll") for (int n = 0; n < 2; ++n) _Pragma("unroll") for (int k = 0; k < 2; ++k) dst[n][k] = *(const PG8_LAS bf16x8*)(lds + PG8_SB(b, h) + boff + n * 2048 + k * 1024); } while (0)
#define PG8_MMA(ai, bj, At, Bt) do { __builtin_amdgcn_s_setprio(1); _Pragma("unroll") for (int m = 0; m < 4; ++m) _Pragma("unroll") for (int n = 0; n < 2; ++n) { \
        if constexpr (FP8) { typedef int i32x8_ __attribute__((ext_vector_type(8))); typedef int i32x4_ __attribute__((ext_vector_type(4))); \
            const i32x8_ bw = __builtin_shufflevector(__builtin_bit_cast(i32x4_, Bt[n][0]), __builtin_bit_cast(i32x4_, Bt[n][1]), 0, 1, 2, 3, 4, 5, 6, 7); \
            const i32x8_ aw = __builtin_shufflevector(__builtin_bit_cast(i32x4_, At[m][0]), __builtin_bit_cast(i32x4_, At[m][1]), 0, 1, 2, 3, 4, 5, 6, 7); \
            asm volatile("v_mfma_scale_f32_16x16x128_f8f6f4 %0, %1, %2, %0, %3, %3 op_sel_hi:[0,0,0]" : "+v"(acc[ai][bj][m][n]) : "v"(bw), "v"(aw), "v"(fp8_one)); } \
        else { _Pragma("unroll") for (int k = 0; k < 2; ++k) acc[ai][bj][m][n] = __builtin_amdgcn_mfma_f32_16x16x32_bf16(Bt[n][k], At[m][k], acc[ai][bj][m][n], 0, 0, 0); } } \
        __builtin_amdgcn_s_setprio(0); } while (0)
#define PG8_WAIT_V(n) asm volatile("s_waitcnt vmcnt(" #n ")" ::: "memory")
#define PG8_WAIT_L(n) asm volatile("s_waitcnt lgkmcnt(" #n ")" ::: "memory")
#define PG8_BAR __builtin_amdgcn_s_barrier()
#define PG8_SCHED __builtin_amdgcn_sched_barrier(0)
    Unit cur, nxt; int ui = 0;
    if (!S.next(0, cur)) return;
    f32x4 acc[2][2][4][2];
#pragma unroll
    for (int a = 0; a < 2; ++a)
#pragma unroll
        for (int b = 0; b < 2; ++b)
#pragma unroll
            for (int m = 0; m < 4; ++m)
#pragma unroll
                for (int n = 0; n < 2; ++n) acc[a][b][m][n] = (f32x4){0.f, 0.f, 0.f, 0.f};
    int fp8_one = FP8_ONE; asm volatile("" : "+v"(fp8_one));
    typedef int i32x8_ __attribute__((ext_vector_type(8))); typedef int i32x4_ __attribute__((ext_vector_type(4)));
    bf16x8 At[4][2], B0[2][2], B1[2][2];
    const char* cA = (const char*)g.A + (GATHER ? (size_t)0 : (size_t)cur.pm * tstep); const char* cB = (const char*)g.Bt + (size_t)cur.pn * tstep;
    if constexpr (GATHER) PG8_ROWS(vAc, cur);
    S.a_ready(cur);
    PG8_STG(PG8_SB(0, 0), cB, B); PG8_STGA(0, 0, cA, vAc); PG8_STG(PG8_SB(0, 1), cB + hstep, B); PG8_STGA(0, 1, cA, vAc);
    if (wr == 1) PG8_BAR;
    PG8_WAIT_V(4); PG8_BAR;
    PG8_STG(PG8_SB(1, 0), cB + kstep, B); PG8_STGA(1, 0, cA + kstep, vAc); PG8_STG(PG8_SB(1, 1), cB + hstep + kstep, B);
    PG8_WAIT_V(6); PG8_BAR;
    PG8_STAMP();
    for (;;) {
        const bool has_next = S.next(ui + 1, nxt);
        const char* nA = (has_next && !GATHER) ? (const char*)g.A + (size_t)nxt.pm * tstep : cA; const char* nB = has_next ? (const char*)g.Bt + (size_t)nxt.pn * tstep : cB;
        if constexpr (GATHER) { if (has_next) PG8_ROWS(vAn, nxt); else { _Pragma("unroll") for (int h_ = 0; h_ < 2; ++h_) _Pragma("unroll") for (int i_ = 0; i_ < 2; ++i_) vAn[h_][i_] = vAc[h_][i_]; } }
        for (int t = 0; t < nt; t += 2) {
            const bool last = (t == nt - 2);
            const char* a1 = cA + (size_t)(t + 1) * kstep;
            const char* a2 = last ? nA : cA + (size_t)(t + 2) * kstep; const char* b2 = last ? nB : cB + (size_t)(t + 2) * kstep;
            const char* a3 = a2 + kstep; const char* b3 = b2 + kstep;
            if (last && has_next) S.a_ready(nxt);
            PG8_LDB(B0, 0, 0); PG8_SCHED; PG8_LDA(At, 0, 0); PG8_STGA(1, 1, a1, vAc);
            PG8_WAIT_L(8); PG8_BAR; PG8_WAIT_L(0); PG8_MMA(0, 0, At, B0); PG8_BAR; PG8_SCHED;
            PG8_LDB(B1, 0, 1); PG8_STG(PG8_SB(0, 0), b2, B);
            PG8_BAR; PG8_WAIT_L(0); PG8_MMA(0, 1, At, B1); PG8_BAR;
            PG8_LDA(At, 0, 1); if (GATHER && last) PG8_STGA(0, 0, a2, vAn); else PG8_STGA(0, 0, a2, vAc);
            PG8_BAR; PG8_WAIT_L(0); PG8_MMA(1, 0, At, B0); PG8_BAR; PG8_SCHED;
            PG8_STG(PG8_SB(0, 1), b2 + hstep, B);
            PG8_WAIT_V(6); PG8_BAR; PG8_MMA(1, 1, At, B1); PG8_BAR;
            PG8_LDB(B0, 1, 0); PG8_SCHED; PG8_LDA(At, 1, 0); if (GATHER && last) PG8_STGA(0, 1, a2, vAn); else PG8_STGA(0, 1, a2, vAc);
            PG8_WAIT_L(8); PG8_BAR; PG8_WAIT_L(0); PG8_MMA(0, 0, At, B0); PG8_BAR; PG8_SCHED;
            PG8_LDB(B1, 1, 1); PG8_STG(PG8_SB(1, 0), b3, B);
            PG8_BAR; PG8_WAIT_L(0); PG8_MMA(0, 1, At, B1); PG8_BAR;
            PG8_LDA(At, 1, 1); if (GATHER && last) PG8_STGA(1, 0, a3, vAn); else PG8_STGA(1, 0, a3, vAc);
            PG8_BAR; PG8_WAIT_L(0); PG8_MMA(1, 0, At, B0); PG8_BAR; PG8_SCHED;
            PG8_STG(PG8_SB(1, 1), b3 + hstep, B);
            PG8_WAIT_V(6); PG8_BAR; PG8_MMA(1, 1, At, B1); PG8_BAR;
        }
        PG8_STAMP();
        if constexpr (FP8) asm volatile("s_nop 15\n\ts_nop 15\n\ts_nop 15" ::: "memory");
        if constexpr (!Epi::AFTER_DRAIN) { __builtin_amdgcn_sched_barrier(0); E(acc, cur, wr, wc, fr, fq); S.done(cur); __builtin_amdgcn_sched_barrier(0); }
        PG8_STAMP();
        if (!has_next) break;
#pragma unroll
        for (int a = 0; a < 2; ++a)
#pragma unroll
            for (int b = 0; b < 2; ++b)
#pragma unroll
                for (int m = 0; m < 4; ++m)
#pragma unroll
                    for (int n = 0; n < 2; ++n) acc[a][b][m][n] = (f32x4){0.f, 0.f, 0.f, 0.f};
        cur = nxt; cA = nA; cB = nB; ++ui;
        if constexpr (GATHER) { _Pragma("unroll") for (int h_ = 0; h_ < 2; ++h_) _Pragma("unroll") for (int i_ = 0; i_ < 2; ++i_) vAc[h_][i_] = vAn[h_][i_]; }
    }
    PG8_WAIT_V(0);
    if (wr == 0) PG8_BAR;
    PG8_BAR;
    if constexpr (Epi::AFTER_DRAIN) { E.fused(acc, cur, wr, wc, fr, fq, lds, wid, lane); S.done(cur); }
    PG8_STAMP();
    if (STAMP && wid == 0) { stamps[lane] = lane < nts ? (((unsigned long long)(unsigned)ts_hi << 32) | (unsigned)ts_lo) : 0ull;
        if (lane == 62) stamps[62] = rt_entry; if (lane == 63) stamps[63] = (unsigned long long)wall_clock64(); }
#undef PG8_STAMP
#undef PG8_SA
#undef PG8_SB
#undef PG8_STG
#undef PG8_STGA
#undef PG8_ROWS
#undef PG8_LDA
#undef PG8_LDB
#undef PG8_MMA
#undef PG8_WAIT_V
#undef PG8_WAIT_L
#undef PG8_BAR
#undef PG8_SCHED
}
}

__device__ __forceinline__ void epi_lane(int& fr, int& fq) { int l = (int)__builtin_amdgcn_mbcnt_hi(~0u, __builtin_amdgcn_mbcnt_lo(~0u, 0u)); asm volatile("" : "+v"(l)); fr = l & 15; fq = l >> 4; }
struct EpiStoreBf16 {
    static constexpr bool PERM = true, AFTER_DRAIN = false;
    bf16_t* O; int ldc;
    __device__ __forceinline__ void operator()(const f32x4 (&acc)[2][2][4][2], const pg8::Unit& u, int wr, int wc, int fr_, int fq_) const {
        int fr, fq; epi_lane(fr, fq); (void)fr_; (void)fq_;
        const int row0 = u.pm * 256 + wr * 64 + fr, col0 = u.pn * 256 + wc * 32 + 8 * fq;
#pragma unroll
        for (int ai = 0; ai < 2; ++ai)
#pragma unroll
            for (int m = 0; m < 4; ++m) { bf16_t* rowp = O + (size_t)(row0 + ai * 128 + m * 16) * ldc + col0;
#pragma unroll
                for (int bj = 0; bj < 2; ++bj) { const f32x4 v0 = acc[ai][bj][m][0], v1 = acc[ai][bj][m][1];
                    u32x4 w; w.x = pk2(v0[0], v0[1]); w.y = pk2(v0[2], v0[3]); w.z = pk2(v1[0], v1[1]); w.w = pk2(v1[2], v1[3]);
                    *(u32x4*)(rowp + bj * 128) = w; } }
    }
};
struct EpiResid {
    static constexpr bool PERM = false, AFTER_DRAIN = false;
    const float* xin_lat; const float* xin_ctx; float* xo; const float* mod_gate; float wscale;
    __device__ __forceinline__ void operator()(const f32x4 (&acc)[2][2][4][2], const pg8::Unit& u, int wr, int wc, int fr_, int fq_) const {
        int fr, fq; epi_lane(fr, fq); (void)fr_; (void)fq_;
        const int row0 = u.pm * 256 + wr * 64 + fr, col0 = u.pn * 256 + wc * 32 + 4 * fq;
        const int mrow = (u.pm < TL / 256) ? (u.pm >> 5) : 4;
        const float* xin = (u.pm < TL / 256) ? xin_lat : (xin_ctx - (size_t)TL * 1024);
        f32x4 gv[2][2];
#pragma unroll
        for (int bj = 0; bj < 2; ++bj)
#pragma unroll
            for (int n = 0; n < 2; ++n) gv[bj][n] = *(const f32x4*)(mod_gate + (size_t)mrow * 6144 + col0 + bj * 128 + n * 16) * wscale;
#pragma unroll
        for (int ai = 0; ai < 2; ++ai)
#pragma unroll
            for (int m = 0; m < 4; ++m) { const size_t off = (size_t)(row0 + ai * 128 + m * 16) * 1024 + col0;
#pragma unroll
                for (int bj = 0; bj < 2; ++bj)
#pragma unroll
                    for (int n = 0; n < 2; ++n) { const f32x4 xi = *(const f32x4*)(xin + off + bj * 128 + n * 16);
                        *(f32x4*)(xo + off + bj * 128 + n * 16) = xi + gv[bj][n] * acc[ai][bj][m][n]; } }
    }
};
struct EpiDelta {
    static constexpr bool PERM = true, AFTER_DRAIN = false;
    bf16_t* D; const float* mod_gate; float wscale;
    __device__ __forceinline__ void operator()(const f32x4 (&acc)[2][2][4][2], const pg8::Unit& u, int wr, int wc, int fr_, int fq_) const {
        int fr, fq; epi_lane(fr, fq); (void)fr_; (void)fq_;
        const int row0 = u.pm * 256 + wr * 64 + fr, col0 = u.pn * 256 + wc * 32 + 8 * fq;
        const int mrow = (u.pm < TL / 256) ? (u.pm >> 5) : 4;
        f32x4 gv[2][2];
#pragma unroll
        for (int bj = 0; bj < 2; ++bj)
#pragma unroll
            for (int n = 0; n < 2; ++n) gv[bj][n] = *(const f32x4*)(mod_gate + (size_t)mrow * 6144 + col0 + bj * 128 + 4 * n) * wscale;
#pragma unroll
        for (int ai = 0; ai < 2; ++ai)
#pragma unroll
            for (int m = 0; m < 4; ++m) { bf16_t* rowp = D + (size_t)(row0 + ai * 128 + m * 16) * 1024 + col0;
#pragma unroll
                for (int bj = 0; bj < 2; ++bj) { const f32x4 v0 = acc[ai][bj][m][0] * gv[bj][0], v1 = acc[ai][bj][m][1] * gv[bj][1];
                    u32x4 w; w.x = pk2(v0[0], v0[1]); w.y = pk2(v0[2], v0[3]); w.z = pk2(v1[0], v1[1]); w.w = pk2(v1[2], v1[3]);
                    *(u32x4*)(rowp + bj * 128) = w; } }
    }
};
__device__ __forceinline__ float swiglu_(float g, float u) {
    g = fminf(g, 7.0f); u = fminf(fmaxf(u, -7.0f), 7.0f);
    return (u + 1.0f) * g * __builtin_amdgcn_rcpf(1.0f + fexp(-1.702f * g));
}
struct EpiGU {
    static constexpr bool PERM = true, AFTER_DRAIN = false;
    unsigned char* Act; const float* bias;
    __device__ __forceinline__ void operator()(const f32x4 (&acc)[2][2][4][2], const pg8::Unit& u, int wr, int wc, int fr_, int fq_) const {
        int fr, fq; epi_lane(fr, fq); (void)fr_; (void)fq_;
        const int e = u.pn >> 3, pnl = u.pn & 7;
        const int row0 = u.pm * 256 + wr * 64 + fr, col0 = pnl * 256 + wc * 32 + 8 * fq;
        f32x4 bv[2][2];
#pragma unroll
        for (int bj = 0; bj < 2; ++bj)
#pragma unroll
            for (int n = 0; n < 2; ++n) bv[bj][n] = *(const f32x4*)(bias + (size_t)e * 2048 + col0 + bj * 128 + 4 * n);
#pragma unroll
        for (int ai = 0; ai < 2; ++ai)
#pragma unroll
            for (int m = 0; m < 4; ++m) { unsigned char* rowp = Act + (size_t)(row0 + ai * 128 + m * 16) * 1024 + (col0 >> 1);
#pragma unroll
                for (int bj = 0; bj < 2; ++bj) { const f32x4 v0 = acc[ai][bj][m][0] * 0.03125f + bv[bj][0], v1 = acc[ai][bj][m][1] * 0.03125f + bv[bj][1];
                    *(unsigned*)(rowp + bj * 64) = pk_fp8x4(swiglu_(v0[0], v0[1]), swiglu_(v0[2], v0[3]), swiglu_(v1[0], v1[1]), swiglu_(v1[2], v1[3])); }
                __builtin_amdgcn_sched_barrier(0); }
    }
};
struct EpiDown {
    static constexpr bool PERM = true, AFTER_DRAIN = false;
    bf16_t* Y; const float* bias; const int* slot_a; const float* slot_g;
    __device__ __forceinline__ void operator()(const f32x4 (&acc)[2][2][4][2], const pg8::Unit& u, int wr, int wc, int fr_, int fq_) const {
        int fr, fq; epi_lane(fr, fq); (void)fr_; (void)fq_;
        const int e = u.pn >> 2, pnl = u.pn & 3;
        const int row0 = u.pm * 256 + wr * 64 + fr, col0 = pnl * 256 + wc * 32 + 8 * fq;
        f32x4 bv[2][2];
#pragma unroll
        for (int bj = 0; bj < 2; ++bj)
#pragma unroll
            for (int n = 0; n < 2; ++n) bv[bj][n] = *(const f32x4*)(bias + (size_t)e * 1024 + col0 + bj * 128 + 4 * n);
#pragma unroll
        for (int ai = 0; ai < 2; ++ai)
#pragma unroll
            for (int m = 0; m < 4; ++m) { const int slot = row0 + ai * 128 + m * 16; const int a = slot_a[slot]; const float gt = slot_g[slot];
                if (a >= 0) { bf16_t* rowp = Y + (size_t)a * 1024 + col0;
#pragma unroll
                    for (int bj = 0; bj < 2; ++bj) { const f32x4 v0 = (acc[ai][bj][m][0] * 0.03125f + bv[bj][0]) * gt, v1 = (acc[ai][bj][m][1] * 0.03125f + bv[bj][1]) * gt;
                        u32x4 w; w.x = pk2(v0[0], v0[1]); w.y = pk2(v0[2], v0[3]); w.z = pk2(v1[0], v1[1]); w.w = pk2(v1[2], v1[3]);
                        *(u32x4*)(rowp + bj * 128) = w; } } }
    }
};
struct MoeOrder {
    const int* tile_e; int ntiles, nN, G, c;
    __device__ __forceinline__ bool next(int i, pg8::Unit& u) const {
        const int x = c & 7, r = c >> 3, j = i * (G >> 3) + r;
        const int pm = x + 8 * (j / nN), pl = j % nN; if (pm >= ntiles) return false;
        u.pm = pm; u.pn = __builtin_amdgcn_readfirstlane(tile_e[pm]) * nN + pl; return true;
    }
    __device__ __forceinline__ void a_ready(const pg8::Unit&) const {}
    __device__ __forceinline__ void done(const pg8::Unit&) const {}
};

__device__ __forceinline__ void transpose_tile(int wv, const float* __restrict__ src, int ldsrc, int k0, int n0, int nmax, bf16_t* __restrict__ dst, int ldd, LAS unsigned char* lds) {
    LAS bf16_t* T = (LAS bf16_t*)lds;
    const int tid = otid(wv), r = tid >> 4, c4 = (tid & 15) * 4;
#pragma unroll
    for (int pass = 0; pass < 2; ++pass) { const int k = r + 32 * pass;
        f32x4 v = (f32x4){0.f, 0.f, 0.f, 0.f};
        if (n0 + c4 < nmax) v = *(const f32x4*)(src + (size_t)(k0 + k) * ldsrc + n0 + c4);
#pragma unroll
        for (int i = 0; i < 4; ++i) T[(c4 + i) * 66 + k] = f2bf(v[i]); }
    __syncthreads();
    { const int n = tid >> 3, kc = (tid & 7) * 8;
      if (n0 + n < nmax) { const LAS unsigned* tp = (const LAS unsigned*)(T + n * 66 + kc); u32x4 w; w.x = tp[0]; w.y = tp[1]; w.z = tp[2]; w.w = tp[3];
          *(u32x4*)(dst + (size_t)(n0 + n) * ldd + k0 + kc) = w; } }
    __syncthreads();
}

__device__ __forceinline__ void transpose_tile_fp8(int wv, const float* __restrict__ src, int ldsrc, int k0, int n0, unsigned char* __restrict__ dst, int ldd, LAS unsigned char* lds) {
    LAS float* T = (LAS float*)lds;
    const int tid = otid(wv), r = tid >> 4, c4 = (tid & 15) * 4;
#pragma unroll
    for (int pass = 0; pass < 2; ++pass) { const int k = r + 32 * pass;
        const f32x4 v = *(const f32x4*)(src + (size_t)(k0 + k) * ldsrc + n0 + c4);
#pragma unroll
        for (int i = 0; i < 4; ++i) T[(c4 + i) * 65 + k] = v[i] * 32.0f; }
    __syncthreads();
    { const int n = tid >> 3, kc = (tid & 7) * 8; const LAS float* tp = T + n * 65 + kc;
      u32x2 w; w.x = pk_fp8x4(tp[0], tp[1], tp[2], tp[3]); w.y = pk_fp8x4(tp[4], tp[5], tp[6], tp[7]);
      *(u32x2*)(dst + (size_t)(n0 + n) * ldd + k0 + kc) = w; }
    __syncthreads();
}

__device__ __forceinline__ void phase_prologue(int wv, const Params& p, LAS unsigned char* lds) {
    const int tid = otid(wv), bid = blockIdx.x, nblk = gridDim.x;
    unsigned char* ws = opq(p.ws);
    unsigned char* WGU = ws + WS_WGU; unsigned char* WDN = ws + WS_WDN; bf16_t* WOUT = (bf16_t*)(ws + WS_WOUT); bf16_t* WIN = (bf16_t*)(ws + WS_WIN); bf16_t* WRT = (bf16_t*)(ws + WS_WRT);
    float* MOD = (float*)(ws + WS_MOD); float2* RA = (float2*)(ws + WS_RA); float2* RD = (float2*)(ws + WS_RD);
    constexpr int T_WGU = 64 * 16 * 32, T_WDN = 64 * 16 * 16, T_WOUT = 2 * 256, T_WIN = 2 * 16 * 42, T_FOLD = 2 * 64, T_ADA = 2 * 96, T_ROPE = SEQ * 48 / 512, T_WRT = 2 * 32 * 1024 / 512, T_PAD = 2 * 16 * 1024 / 512;
    constexpr int O_WDN = T_WGU, O_WOUT = O_WDN + T_WDN, O_WIN = O_WOUT + T_WOUT, O_FOLD = O_WIN + T_WIN, O_ADA = O_FOLD + T_FOLD, O_ROPE = O_ADA + T_ADA, O_WRT = O_ROPE + T_ROPE, O_PAD = O_WRT + T_WRT, NTASK = O_PAD + T_PAD;
    {
        constexpr int NT_GU = 64 * 8 * 32, NT_DN = 64 * 8 * 16, NT_WO = YM_FP8 ? 2 * 8 * 16 : 0, NT_ALL = NT_GU + NT_DN + NT_WO;
        const int tid = otid(wv), r = tid >> 4, c4 = (tid & 15) * 4, on = tid >> 3, okc = (tid & 7) * 16;
        f32x4 v[4];
        auto tile_src = [&](int tt, const float*& src, int& ldsrc, unsigned char*& dst) {
            if (tt < NT_GU) { const int mat = tt >> 8, t = tt & 255, kt = t >> 5, nt = t & 31; src = p.w_gu + (size_t)mat * 1024 * 2048 + (size_t)kt * 128 * 2048 + nt * 64; ldsrc = 2048; dst = WGU + (size_t)mat * 2048 * 1024 + (size_t)nt * 64 * 1024 + kt * 128; }
            else if (tt >= NT_GU + NT_DN) { const int u = tt - NT_GU - NT_DN, mat = u >> 7, t = u & 127, kt = t >> 4, nt = t & 15; src = p.w_out + (size_t)mat * 1024 * 1024 + (size_t)kt * 128 * 1024 + nt * 64; ldsrc = 1024; dst = (unsigned char*)WOUT + (size_t)mat * 1024 * 1024 + (size_t)nt * 64 * 1024 + kt * 128; }
            else { const int u = tt - NT_GU, mat = u >> 7, t = u & 127, kt = t >> 4, nt = t & 15; src = p.w_down + (size_t)mat * 1024 * 1024 + (size_t)kt * 128 * 1024 + nt * 64; ldsrc = 1024; dst = WDN + (size_t)mat * 1024 * 1024 + (size_t)nt * 64 * 1024 + kt * 128; } };
        int tt = bid; int buf = 0;
        if (tt < NT_ALL) { const float* src; int ld; unsigned char* dst; tile_src(tt, src, ld, dst);
#pragma unroll
            for (int ps = 0; ps < 4; ++ps) v[ps] = *(const f32x4*)(src + (size_t)(r + 32 * ps) * ld + c4); }
        for (; tt < NT_ALL; tt += nblk) {
            LAS float* T = (LAS float*)(lds + buf * 33280);
#pragma unroll
            for (int ps = 0; ps < 4; ++ps)
#pragma unroll
                for (int i = 0; i < 4; ++i) T[(c4 + i) * 130 + r + 32 * ps] = v[ps][i] * 32.0f;
            __syncthreads();
            const float* src; int ld; unsigned char* dst; tile_src(tt, src, ld, dst);
            if (tt + nblk < NT_ALL) { const float* s2; int ld2; unsigned char* d2; tile_src(tt + nblk, s2, ld2, d2);
#pragma unroll
                for (int ps = 0; ps < 4; ++ps) v[ps] = *(const f32x4*)(s2 + (size_t)(r + 32 * ps) * ld2 + c4); }
            const LAS float* tp = T + on * 130 + okc;
            u32x4 w; w.x = pk_fp8x4(tp[0], tp[1], tp[2], tp[3]); w.y = pk_fp8x4(tp[4], tp[5], tp[6], tp[7]); w.z = pk_fp8x4(tp[8], tp[9], tp[10], tp[11]); w.w = pk_fp8x4(tp[12], tp[13], tp[14], tp[15]);
            *(u32x4*)(dst + (size_t)on * 1024 + okc) = w;
            buf ^= 1;
        }
        __syncthreads();
    }
    for (int task = bid + O_WOUT; task < NTASK; task += nblk) {
        if (task < O_WDN) {
            const int mat = task >> 9, t = task & 511, kt = t >> 5, nt = t & 31;
            transpose_tile_fp8(wv, p.w_gu + (size_t)mat * 1024 * 2048, 2048, kt * 64, nt * 64, WGU + (size_t)mat * 2048 * 1024, 1024, lds);
        } else if (task < O_WOUT) {
            const int tt = task - O_WDN, mat = tt >> 8, t = tt & 255, kt = t >> 4, nt = t & 15;
            transpose_tile_fp8(wv, p.w_down + (size_t)mat * 1024 * 1024, 1024, kt * 64, nt * 64, WDN + (size_t)mat * 1024 * 1024, 1024, lds);
        } else if (task < O_WIN) {
            if (YM_FP8) continue;
            const int tt = task - O_WOUT, mat = tt >> 8, t = tt & 255, kt = t >> 4, nt = t & 15;
            transpose_tile(wv, p.w_out + (size_t)mat * 1024 * 1024, 1024, kt * 64, nt * 64, 1024, WOUT + (size_t)mat * 1024 * 1024, 1024, lds);
        } else if (task < O_FOLD) {
            const int tt = task - O_WIN, mat = tt / (16 * 42), t = tt % (16 * 42), kt = t / 42, nt = t % 42;
            transpose_tile(wv, p.w_in + (size_t)mat * 1024 * INC, INC, kt * 64, nt * 64, INC, WIN + (size_t)mat * NP * 1024, 1024, lds);
        } else if (task < O_ADA) {
            const int tt = task - O_FOLD, l = tt >> 6, k0 = (tt & 63) * 16;
            LAS float* Aq = (LAS float*)lds;
            LAS float* Akv = Aq + 16 * 192;
            for (int i = tid; i < 16 * 192; i += NTHR) { const int r = i / 192, j = i % 192; Aq[i] = p.w_in[((size_t)l * 1024 + k0 + r) * INC + PC_DCQ + j] * p.mla_g_q[l * 192 + j]; }
            for (int i = tid; i < 16 * 128; i += NTHR) { const int r = i / 128, j = i % 128; Akv[i] = p.w_in[((size_t)l * 1024 + k0 + r) * INC + PC_DCKV + j] * p.mla_g_kv[l * 128 + j]; }
            __syncthreads();
            for (int n = tid; n < 896; n += NTHR) {
                float acc[16];
#pragma unroll
                for (int r = 0; r < 16; ++r) acc[r] = 0.f;
                if (n < 384) { const float* W = p.mla_w_uq + (size_t)l * 192 * 384 + n;
                    for (int j = 0; j < 192; ++j) { const float wv = W[(size_t)j * 384];
#pragma unroll
                        for (int r = 0; r < 16; ++r) acc[r] += Aq[r * 192 + j] * wv; }
                } else { const float* W = p.mla_w_ukv + (size_t)l * 128 * 512 + (n - 384);
                    for (int j = 0; j < 128; ++j) { const float wv = W[(size_t)j * 512];
#pragma unroll
                        for (int r = 0; r < 16; ++r) acc[r] += Akv[r * 128 + j] * wv; } }
                u32x4 w0, w1; w0.x = pk2(acc[0], acc[1]); w0.y = pk2(acc[2], acc[3]); w0.z = pk2(acc[4], acc[5]); w0.w = pk2(acc[6], acc[7]);
                w1.x = pk2(acc[8], acc[9]); w1.y = pk2(acc[10], acc[11]); w1.z = pk2(acc[12], acc[13]); w1.w = pk2(acc[14], acc[15]);
                bf16_t* d = WIN + ((size_t)l * NP + PC_DQF + n) * 1024 + k0; *(u32x4*)d = w0; *(u32x4*)(d + 8) = w1;
            }
            __syncthreads();
        } else if (task < O_ROPE) {
            const int tt = task - O_ADA, l = tt / 96, n0 = (tt % 96) * 64;
            LAS float* SC = (LAS float*)lds;
            LAS float* RED = SC + 5 * 1024;
            for (int i = tid; i < 5 * 1024; i += NTHR) { const int r = i >> 10, k = i & 1023; const float v = (r < 4) ? p.c[r * 1024 + k] : p.c_ctx[k]; SC[i] = siluf_(v); }
            __syncthreads();
            { const int kc = tid >> 6, col = tid & 63; float a[5] = {0.f, 0.f, 0.f, 0.f, 0.f};
              const float* W = p.w_ada + ((size_t)l * 1024 + kc * 128) * 6144 + n0 + col;
              for (int k = 0; k < 128; ++k) { const float wv = W[(size_t)k * 6144];
#pragma unroll
                  for (int r = 0; r < 5; ++r) a[r] += SC[r * 1024 + kc * 128 + k] * wv; }
#pragma unroll
              for (int r = 0; r < 5; ++r) RED[(kc * 5 + r) * 64 + col] = a[r]; }
            __syncthreads();
            if (tid < 320) { const int r = tid >> 6, col = tid & 63; float s = p.b_ada[l * 6144 + n0 + col];
#pragma unroll
                for (int kc = 0; kc < 8; ++kc) s += RED[(kc * 5 + r) * 64 + col];
                MOD[((size_t)l * 5 + r) * 6144 + n0 + col] = s; }
            __syncthreads();
        } else if (task < O_WRT) {
            const int idx = (task - O_ROPE) * 512 + tid, t = idx / 48, j = idx % 48;
            if (j < 32) { const int i = j & 15; const float inv = powf(10000.0f, -(float)(2 * i) / 32.0f); const float pos = (j < 16) ? (float)(t >> 6) : (float)(t & 63);
                float s, c; sincosf(pos * inv, &s, &c); RA[t * 32 + j] = make_float2(c, s); }
            else { const int jj = j - 32, i = jj & 7; const float inv = powf(10000.0f, -(float)(2 * i) / 16.0f); const float pos = (jj < 8) ? (float)(t >> 6) : (float)(t & 63);
                float s, c; sincosf(pos * inv, &s, &c); RD[t * 16 + jj] = make_float2(c, s); }
        } else if (task < O_PAD) {
            const int idx = (task - O_WRT) * 512 + tid, l = idx >> 15, e = (idx >> 10) & 31, k = idx & 1023;
            const float w = p.w_router[((size_t)l * 1024 + k) * 32 + e]; const unsigned short hi = f2bf(w); const unsigned short lo = f2bf(w - bf2f(hi));
            WRT[(((size_t)l * 2 + 0) * 32 + e) * 1024 + k] = hi; WRT[(((size_t)l * 2 + 1) * 32 + e) * 1024 + k] = lo;
        } else {
            const int idx = (task - O_PAD) * 512 + tid, l = idx >> 14, r = (idx >> 10) & 15, k = idx & 1023;
            WIN[((size_t)l * NP + PC_END + r) * 1024 + k] = 0;
        }
    }
}

__device__ __forceinline__ void phase_norm1_l0(int wv, const Params& p) {
    const int tid = otid(wv), lane = tid & 63, gw = blockIdx.x * NWAVE + (tid >> 6), nw = gridDim.x * NWAVE;
    const float* MOD = (const float*)(p.ws + WS_MOD); bf16_t* HB = (bf16_t*)(p.ws + WS_HB);
    for (int r = gw; r < TA; r += nw) {
        const float* src = (r < TL) ? p.x + (size_t)r * 1024 : p.ctx + (size_t)(r - TL) * 1024;
        const int mrow = (r < TL) ? (r >> 13) : 4; const float* mod = MOD + (size_t)mrow * 6144;
        f32x4 v[4]; row_load(src, lane, v); const float rstd = row_rstd(v);
        row_modulate(v, rstd, p.g_norm1, mod + 1024, mod, lane);
        row_store_bf16(HB + (size_t)r * 1024, lane, v);
    }
}
__device__ __forceinline__ void phase_combine(int wv, const Params& p, int l) {
    const int tid = otid(wv), lane = tid & 63, gw = blockIdx.x * NWAVE + (tid >> 6), nw = gridDim.x * NWAVE;
    const float* MOD = (const float*)(p.ws + WS_MOD); bf16_t* HB = (bf16_t*)(p.ws + WS_HB); const bf16_t* Y = (const bf16_t*)(p.ws + WS_Y);
    const float* XA = (const float*)(p.ws + WS_XA); float* XB = (float*)(p.ws + WS_XB);
    const int T = (l == 0) ? TA : TL;
    for (int r = gw; r < T; r += nw) {
        const int mrow = (r < TL) ? (r >> 13) : 4; const float* mod = MOD + ((size_t)l * 5 + mrow) * 6144;
        f32x4 v[4]; row_load(XA + (size_t)r * 1024, lane, v);
#pragma unroll
        for (int i = 0; i < 4; ++i) {
            f32x4 s = (f32x4){0.f, 0.f, 0.f, 0.f};
#pragma unroll
            for (int k = 0; k < 4; ++k) { const u32x2 w = *(const u32x2*)(Y + ((size_t)r * 4 + k) * 1024 + i * 256 + lane * 4);
                s[0] += bf2f(w.x & 0xffffu); s[1] += bf2f(w.x >> 16); s[2] += bf2f(w.y & 0xffffu); s[3] += bf2f(w.y >> 16); }
            const f32x4 g2 = *(const f32x4*)(mod + 5 * 1024 + i * 256 + lane * 4);
            v[i] = v[i] + g2 * s;
        }
        const float rstd = row_rstd(v);
        if (l == 0) {
#pragma unroll
            for (int i = 0; i < 4; ++i) *(f32x4*)(XB + (size_t)r * 1024 + i * 256 + lane * 4) = v[i];
            const float* mod1 = MOD + ((size_t)5 + mrow) * 6144;
            row_modulate(v, rstd, p.g_norm1 + 1024, mod1 + 1024, mod1, lane);
            row_store_bf16(HB + (size_t)r * 1024, lane, v);
        } else {
#pragma unroll
            for (int i = 0; i < 4; ++i) { const f32x4 gg = *(const f32x4*)(p.g_final + i * 256 + lane * 4);
                *(f32x4*)(p.out + (size_t)r * 1024 + i * 256 + lane * 4) = v[i] * rstd * gg; }
        }
    }
}

__device__ __forceinline__ int cu_index(int b, int tc, int h, int dir) { return ((b * NCHUNK + tc) * 4 + h) * 2 + dir; }
__device__ __forceinline__ float logsigmoidf_(float x) { return fminf(x, 0.f) - log1pf(__expf(-fabsf(x))); }

__device__ __forceinline__ void prep_elem(int wv, const Params& p, int l, LAS unsigned char* lds) {
    const int tid = otid(wv);
    unsigned char* ws = opq(p.ws);
    const bf16_t* P = (const bf16_t*)(ws + WS_P);
    bf16_t* QA = (bf16_t*)(ws + WS_QA); bf16_t* KA = (bf16_t*)(ws + WS_KA); bf16_t* QD = (bf16_t*)(ws + WS_QD); bf16_t* KD = (bf16_t*)(ws + WS_KD); bf16_t* VD = (bf16_t*)(ws + WS_VD);
    bf16_t* QC = (bf16_t*)(ws + WS_QC); bf16_t* KC = (bf16_t*)(ws + WS_KC); float* GATES = (float*)(ws + WS_GATES);
    const float2* RA = (const float2*)(ws + WS_RA); const float2* RD = (const float2*)(ws + WS_RD);
    LAS float* RQ = (LAS float*)lds;
    constexpr int CH = 44;
    const int per = (TA + gridDim.x - 1) / gridDim.x, rbeg = blockIdx.x * per, rend = min(rbeg + per, TA);
    for (int row0 = rbeg; row0 < rend; row0 += CH) {
        const int nr = min(CH, rend - row0);
        for (int itc = tid; itc < ((nr + 3) & ~3) * 16; itc += NTHR) { const int i = itc >> 4, sub = itc & 15; float sq = 0.f, sk = 0.f;
          if (i < nr) { const bf16_t* pr = P + (size_t)(row0 + i) * NP + PC_DCQ;
              const u32x4 c0 = *(const u32x4*)(pr + sub * 8), c1 = *(const u32x4*)(pr + (sub + 16) * 8); u32x4 c2 = (u32x4){0u, 0u, 0u, 0u}; if (sub < 8) c2 = *(const u32x4*)(pr + (sub + 32) * 8);
#pragma unroll
              for (int q = 0; q < 4; ++q) { const float a0 = bf2f(c0[q] & 0xffffu), a1 = bf2f(c0[q] >> 16), b0 = bf2f(c1[q] & 0xffffu), b1 = bf2f(c1[q] >> 16), d0 = bf2f(c2[q] & 0xffffu), d1 = bf2f(c2[q] >> 16);
                  sq += a0 * a0 + a1 * a1; const float t1 = b0 * b0 + b1 * b1; if (sub < 8) sq += t1; else sk += t1; sk += d0 * d0 + d1 * d1; } }
#pragma unroll
          for (int d = 8; d >= 1; d >>= 1) { sq += __shfl_xor(sq, d); sk += __shfl_xor(sk, d); }
          if (sub == 0 && i < nr) { RQ[i] = rsqrtf(sq * (1.0f / 192.0f) + EPS); RQ[64 + i] = rsqrtf(sk * (1.0f / 128.0f) + EPS); } }
        for (int it = tid; it < nr * 24; it += NTHR) {
            const int i = it / 24, r = it % 24, head = r >> 2, j0 = (r & 3) * 8, row = row0 + i;
            const bf16_t* src = P + (size_t)row * NP + (head < 4 ? PC_AQ + head * 64 : PC_AK + (head - 4) * 64) + j0;
            const u32x4 a = *(const u32x4*)src, bq = *(const u32x4*)(src + 32);
            u32x4 o1, o2;
            if (row >= TL) { o1 = a; o2 = bq; }
            else { const float2* tab = RA + (size_t)(row & (SEQ - 1)) * 32 + j0;
#pragma unroll
                for (int q = 0; q < 4; ++q) { const float x1a = bf2f(a[q] & 0xffffu), x1b = bf2f(a[q] >> 16), x2a = bf2f(bq[q] & 0xffffu), x2b = bf2f(bq[q] >> 16);
                    const float2 ca = tab[2 * q], cb = tab[2 * q + 1];
                    o1[q] = pk2(x1a * ca.x - x2a * ca.y, x1b * cb.x - x2b * cb.y); o2[q] = pk2(x2a * ca.x + x1a * ca.y, x2b * cb.x + x1b * cb.y); } }
            bf16_t* dst = (head < 4) ? QA + (size_t)row * 256 + head * 64 + j0 : KA + (size_t)row * 128 + (head - 4) * 64 + j0;
            *(u32x4*)dst = o1; *(u32x4*)(dst + 32) = o2;
        }
        for (int it = tid; it < nr * 64; it += NTHR) {
            const int i = it >> 6, c0 = (it & 63) * 8, row = row0 + i;
            const bool isc = row >= TL; const int t = isc ? ((row - TL) & (CTXL - 1)) : (row & (SEQ - 1)), nseq = isc ? CTXL : SEQ;
            const bf16_t* src = P + (size_t)row * NP + PC_CQK + c0;
            const u32x4 u1 = *(const u32x4*)src;
            u32x4 u0 = (u32x4){0u, 0u, 0u, 0u}, u2 = (u32x4){0u, 0u, 0u, 0u};
            if (t > 0) u0 = *(const u32x4*)(src - NP);
            if (t + 1 < nseq) u2 = *(const u32x4*)(src + NP);
            const float* cw = p.mlstm_conv + (size_t)l * 3 * 512 + c0;
            const float sc = (c0 >= 256) ? 0.125f : 1.0f;
            u32x4 o;
#pragma unroll
            for (int q = 0; q < 4; ++q) {
                const float ya = cw[2 * q] * bf2f(u0[q] & 0xffffu) + cw[512 + 2 * q] * bf2f(u1[q] & 0xffffu) + cw[1024 + 2 * q] * bf2f(u2[q] & 0xffffu);
                const float yb = cw[2 * q + 1] * bf2f(u0[q] >> 16) + cw[512 + 2 * q + 1] * bf2f(u1[q] >> 16) + cw[1024 + 2 * q + 1] * bf2f(u2[q] >> 16);
                o[q] = pk2(siluf_(ya) * sc, siluf_(yb) * sc); }
            if (c0 < 256) *(u32x4*)(QC + (size_t)row * 256 + c0) = o; else *(u32x4*)(KC + (size_t)row * 256 + (c0 - 256)) = o;
        }
        for (int itc = tid; itc < nr * 16; itc += NTHR) { const int i = itc >> 4, gi = itc & 15;
          { float v = bf2f(P[(size_t)(row0 + i) * NP + PC_CG + gi]) + p.mlstm_gate_bias[l * 16 + gi];
              if ((gi >> 2) & 1) v = logsigmoidf_(v);
              GATES[(size_t)(row0 + i) * 16 + gi] = v; } }
        __syncthreads();
        for (int it = tid; it < nr * 128; it += NTHR) {
            const int i = it >> 7, g = it & 127, row = row0 + i; const bool is_ctx = row >= TL; const int t = row & (SEQ - 1);
            const bf16_t* pr = P + (size_t)row * NP;
            const float rq = RQ[i], rkv = RQ[64 + i];
            u32x4 o;
            if (g < 96) {
                const bool isq = g < 48; const int g2 = isq ? g : g - 48, h = g2 / 12, gg = g2 % 12;
                const float sc = isq ? rq : ((gg < 8) ? rkv : 1.0f);
                const bf16_t* base = isq ? pr + PC_DQF + h * 96 : (gg < 8 ? pr + PC_DKVF + h * 128 : pr + PC_DKR - 64);
                if (gg < 8 || is_ctx) { const u32x4 a = *(const u32x4*)(base + gg * 8);
#pragma unroll
                    for (int q = 0; q < 4; ++q) o[q] = pk2(bf2f(a[q] & 0xffffu) * sc, bf2f(a[q] >> 16) * sc);
                } else { const int jj = (gg & 1) * 8;
                    const u32x4 x1 = *(const u32x4*)(base + 64 + jj), x2 = *(const u32x4*)(base + 80 + jj); const float2* tab = RD + (size_t)t * 16 + jj; const bool first = gg < 10;
#pragma unroll
                    for (int q = 0; q < 4; ++q) { const float x1a = bf2f(x1[q] & 0xffffu), x1b = bf2f(x1[q] >> 16), x2a = bf2f(x2[q] & 0xffffu), x2b = bf2f(x2[q] >> 16); const float2 ca = tab[2 * q], cb = tab[2 * q + 1];
                        const float ra = first ? x1a * ca.x - x2a * ca.y : x2a * ca.x + x1a * ca.y, rb = first ? x1b * cb.x - x2b * cb.y : x2b * cb.x + x1b * cb.y;
                        o[q] = pk2(ra * sc, rb * sc); } }
                bf16_t* dst = (isq ? QD : KD) + (size_t)row * 384 + h * 96 + gg * 8; *(u32x4*)dst = o;
            } else { const int g2 = g - 96, h = g2 >> 3, gg = g2 & 7;
                const u32x4 a = *(const u32x4*)(pr + PC_DKVF + h * 128 + 64 + gg * 8);
#pragma unroll
                for (int q = 0; q < 4; ++q) o[q] = pk2(bf2f(a[q] & 0xffffu) * rkv, bf2f(a[q] >> 16) * rkv);
                *(u32x4*)(VD + (size_t)row * 256 + h * 64 + gg * 8) = o; }
        }
        __syncthreads();
    }
}
__device__ __forceinline__ void prep_state(int wv, const Params& p, int l, LAS unsigned char* lds) {
    const int tid = otid(wv), lane = tid & 63, w = tid >> 6;
    unsigned char* ws = opq(p.ws);
    const bf16_t* P = (const bf16_t*)(ws + WS_P);
    float* DC = (float*)(ws + WS_DC); float* DN = (float*)(ws + WS_DN); float* DFA = (float*)(ws + WS_DFA);
    LAS unsigned char* KW = lds;
    LAS unsigned char* VT = lds + 24576;
    LAS float* KF = (LAS float*)(lds + 36864);
    LAS float* WL = (LAS float*)(lds + 53504);
    constexpr int NU = (TA / 64) * 4;
    for (int un = blockIdx.x; un < NU; un += gridDim.x) {
        const int ch = un >> 2, hd = un & 3;
        const bool is_ctx = ch >= TL / 64; const int cc = ch - TL / 64;
        const int b = is_ctx ? (cc >> 2) : (ch >> 7), tc = is_ctx ? 128 + (cc & 3) : (ch & 127);
        const int row0 = ch * 64, t0 = is_ctx ? (cc & 3) * 64 : (ch & 127) * 64, nseq = is_ctx ? CTXL : SEQ;
        {
            const int s = tid >> 3, part = tid & 7, c0 = 256 + hd * 64 + part * 8, t = t0 + s;
            const bf16_t* src = P + (size_t)(row0 + s) * NP + PC_CQK + c0;
            const u32x4 u1 = *(const u32x4*)src;
            u32x4 u0 = (u32x4){0u, 0u, 0u, 0u}, u2 = (u32x4){0u, 0u, 0u, 0u};
            if (t > 0) u0 = *(const u32x4*)(src - NP);
            if (t + 1 < nseq) u2 = *(const u32x4*)(src + NP);
            const float* cw = p.mlstm_conv + (size_t)l * 3 * 512 + c0;
#pragma unroll
            for (int q = 0; q < 4; ++q) {
                const float ya = cw[2 * q] * bf2f(u0[q] & 0xffffu) + cw[512 + 2 * q] * bf2f(u1[q] & 0xffffu) + cw[1024 + 2 * q] * bf2f(u2[q] & 0xffffu);
                const float yb = cw[2 * q + 1] * bf2f(u0[q] >> 16) + cw[512 + 2 * q + 1] * bf2f(u1[q] >> 16) + cw[1024 + 2 * q + 1] * bf2f(u2[q] >> 16);
                const unsigned pk = pk2(siluf_(ya) * 0.125f, siluf_(yb) * 0.125f);
                KF[s * 65 + part * 8 + 2 * q] = bf2f(pk & 0xffffu); KF[s * 65 + part * 8 + 2 * q + 1] = bf2f(pk >> 16); }
            *(LAS u32x4*)(VT + s * 192 + part * 16) = *(const u32x4*)(P + (size_t)(row0 + s) * NP + PC_CV + hd * 64 + part * 8);
        }
        if (w < 2) {
            const int dir = w, i = dir ? 63 - lane : lane;
            const bf16_t* pg = P + (size_t)(row0 + i) * NP + PC_CG;
            const float ig = bf2f(pg[(dir ? 8 : 0) + hd]) + p.mlstm_gate_bias[l * 16 + (dir ? 8 : 0) + hd];
            const float lf = logsigmoidf_(bf2f(pg[(dir ? 12 : 4) + hd]) + p.mlstm_gate_bias[l * 16 + (dir ? 12 : 4) + hd]);
            const float bc = wave_incl_sum(lf, lane), bend = __shfl(bc, 63);
            const float val = bend - bc + ig, a = wave_max(val);
            WL[dir * 64 + i] = fexp(val - a);
            if (lane == 0) { float* fa = DFA + (size_t)cu_index(b, tc, hd, dir) * 2; fa[0] = bend; fa[1] = a; }
        }
        __syncthreads();
        {
            const int s = tid >> 3, part = tid & 7;
#pragma unroll
            for (int dir = 0; dir < 2; ++dir) { const float wt = WL[dir * 64 + s]; u32x4 o;
#pragma unroll
                for (int q = 0; q < 4; ++q) o[q] = pk2(KF[s * 65 + part * 8 + 2 * q] * wt, KF[s * 65 + part * 8 + 2 * q + 1] * wt);
                *(LAS u32x4*)(KW + dir * 12288 + s * 192 + part * 16) = o; }
        }
        __syncthreads();
        {
            const int dir = w >> 2, dvb = (w >> 1) & 1, dkb = w & 1, hh = lane >> 5, l31 = lane & 31;
            const int q4 = (lane & 15) >> 2, colo = 16 * ((lane >> 4) & 1) + 4 * (lane & 3);
            f32x16 acc = zero16();
#pragma unroll
            for (int ks = 0; ks < 4; ++ks) {
                const int r0 = 16 * ks + 8 * hh + q4;
                const bf16x8 af = cat8(tr_read(VT + r0 * 192 + (32 * dvb + colo) * 2), tr_read(VT + (r0 + 4) * 192 + (32 * dvb + colo) * 2));
                const bf16x8 bfr = cat8(tr_read(KW + dir * 12288 + r0 * 192 + (32 * dkb + colo) * 2), tr_read(KW + dir * 12288 + (r0 + 4) * 192 + (32 * dkb + colo) * 2));
                acc = mfma32(af, bfr, acc);
            }
            float* dc = DC + (size_t)cu_index(b, tc, hd, dir) * 4096;
#pragma unroll
            for (int r = 0; r < 16; ++r) { const int dv = 32 * dvb + (r & 3) + 8 * (r >> 2) + 4 * hh; dc[dv * 64 + 32 * dkb + l31] = acc[r]; }
            { const int d2 = tid >> 8, dk = (tid >> 2) & 63, part = tid & 3; float sm = 0.f;
#pragma unroll 4
              for (int ss = 0; ss < 16; ++ss) sm += bf2f(*(const LAS bf16_t*)(KW + d2 * 12288 + (part * 16 + ss) * 192 + dk * 2));
              sm += __shfl_xor(sm, 1); sm += __shfl_xor(sm, 2);
              if (part == 0) DN[(size_t)cu_index(b, tc, hd, d2) * 64 + dk] = sm; }
        }
        __syncthreads();
    }
}
__device__ __forceinline__ void phase_prep(int wv, const Params& p, int l, LAS unsigned char* lds) {
    prep_elem(wv, p, l, lds);
    __syncthreads();
    prep_state(wv, p, l, lds);
}

__device__ __forceinline__ void phase_scan(int wv, const Params& p, LAS unsigned char* lds) {
    const int tid = otid(wv);
    unsigned char* ws = opq(p.ws);
    const float* DC = (const float*)(ws + WS_DC); const float* DN = (const float*)(ws + WS_DN); const float* DFA = (const float*)(ws + WS_DFA);
    bf16_t* CS = (bf16_t*)(ws + WS_CS); float* NS = (float*)(ws + WS_NS); float* MS = (float*)(ws + WS_MS);
    LAS float* FA = (LAS float*)lds;
    LAS float* AL = FA + 2 * NCHUNK;
    LAS float* BE = AL + NCHUNK;
    LAS int* UI = (LAS int*)(BE + NCHUNK);
    for (int u = blockIdx.x; u < 256; u += gridDim.x) {
        const int slice = u & 7, dir = (u >> 3) & 1, h = (u >> 4) & 3, b = u >> 6;
        if (tid < NCHUNK) { const int j = tid; const int tc = dir ? ((j < 4) ? 128 + (3 - j) : 131 - j) : ((j < 4) ? 128 + j : j - 4);
            const int ui = cu_index(b, tc, h, dir); UI[j] = ui; FA[2 * j] = DFA[(size_t)ui * 2]; FA[2 * j + 1] = DFA[(size_t)ui * 2 + 1]; }
        __syncthreads();
        if (tid == 0) { float m = 0.f;
            for (int j = 0; j < NCHUNK; ++j) { const float F = FA[2 * j], a = FA[2 * j + 1]; const float mn = fmaxf(F + m, a);
                AL[j] = fexp(F + m - mn); BE[j] = fexp(a - mn); if (slice == 0) MS[UI[j]] = m; m = mn; } }
        __syncthreads();
        { const int e = slice * 512 + tid; float c = 0.f;
#pragma unroll 1
          for (int j0 = 0; j0 < NCHUNK; j0 += 12) { float d[12];
#pragma unroll
              for (int jj = 0; jj < 12; ++jj) d[jj] = DC[(size_t)UI[j0 + jj] * 4096 + e];
#pragma unroll
              for (int jj = 0; jj < 12; ++jj) { const int j = j0 + jj; CS[(size_t)UI[j] * 4096 + e] = f2bf(c); c = AL[j] * c + BE[j] * d[jj]; } } }
        if (slice == 0 && tid < 64) { float n = 0.f;
#pragma unroll 1
            for (int j0 = 0; j0 < NCHUNK; j0 += 12) { float d[12];
#pragma unroll
                for (int jj = 0; jj < 12; ++jj) d[jj] = DN[(size_t)UI[j0 + jj] * 64 + tid];
#pragma unroll
                for (int jj = 0; jj < 12; ++jj) { const int j = j0 + jj; NS[(size_t)UI[j] * 64 + tid] = n; n = AL[j] * n + BE[j] * d[jj]; } } }
        __syncthreads();
    }
}

template <int QB, class Pol>
__device__ __forceinline__ void attn_core(int wv, LAS unsigned char* lds, const Pol& pol, int q2off = 0, int o2off = 0) {
    constexpr int DQ = Pol::DQ, KS = DQ / 16, NDMA = (DQ == 96) ? 3 : 2;
    constexpr int KN_OFF = 0, KR_OFF = 8192, V_OFF = (DQ == 96) ? 12288 : 8192, STAGE = V_OFF + 8192;
    const int tid = otid(wv), lane = tid & 63, hh = lane >> 5, l31 = lane & 31;
    bf16x8 qf[QB][KS];
#pragma unroll
    for (int qb = 0; qb < QB; ++qb)
#pragma unroll
        for (int ks = 0; ks < KS; ++ks) { const u32x4 raw = *(const u32x4*)(pol.qrow + (size_t)qb * q2off + 16 * ks + 8 * hh); u32x4 sc;
#pragma unroll
            for (int q = 0; q < 4; ++q) sc[q] = pk2(bf2f(raw[q] & 0xffffu) * pol.qscale, bf2f(raw[q] >> 16) * pol.qscale);
            qf[qb][ks] = as_bf16x8(sc); }
    f32x16 O[QB][2]; float m[QB], lsum[QB];
#pragma unroll
    for (int qb = 0; qb < QB; ++qb) { O[qb][0] = zero16(); O[qb][1] = zero16(); m[qb] = pol.m0; lsum[qb] = (hh == 0) ? pol.l0 : 0.f; }
    const int drow = 8 * wv + (lane >> 3), dpos = lane & 7;
    const int kn_src = ((dpos ^ ((drow >> 1) & 7)) * 8), v_src = ((dpos ^ (((drow >> 1) & 1) << 2)) * 8);
    const int rrow = 16 * (wv & 3) + (lane >> 2), rpos = lane & 3, kr_src = 64 + ((rpos ^ ((rrow >> 2) & 3)) * 8);
    int kn_rd[2], kr_rd[2];
#pragma unroll
    for (int kbk = 0; kbk < 2; ++kbk) { const int key = 32 * kbk + l31; kn_rd[kbk] = KN_OFF + key * 128 + ((hh ^ ((key >> 1) & 7)) * 16); kr_rd[kbk] = KR_OFF + key * 64 + ((hh ^ ((key >> 2) & 3)) * 16); }
    const int q4 = (lane & 15) >> 2;
    const int vchunk = 2 * ((lane >> 4) & 1) + ((lane & 3) >> 1), vsw = ((q4 >> 1) & 1) << 2;
    const int v_rd0 = V_OFF + (4 * hh + q4) * 128 + (((vchunk) ^ vsw) * 16) + 8 * (lane & 1);
    const int v_rd1 = V_OFF + (4 * hh + q4) * 128 + (((vchunk + 4) ^ vsw) * 16) + 8 * (lane & 1);
    const int nt = pol.ntiles;
#define ATT_DMA(t, st) do { const bf16_t* kp_; const bf16_t* vp_; int ks_, vs_; pol.tile_ptrs((t), kp_, ks_, vp_, vs_); LAS unsigned char* sb_ = lds + (st) * STAGE; \
        __builtin_amdgcn_global_load_lds((const unsigned*)(kp_ + (size_t)drow * ks_ + kn_src), (LAS unsigned*)(sb_ + KN_OFF + wv * 1024), 16, 0, 0); \
        __builtin_amdgcn_global_load_lds((const unsigned*)(vp_ + (size_t)drow * vs_ + v_src), (LAS unsigned*)(sb_ + V_OFF + wv * 1024), 16, 0, 0); \
        if (DQ == 96 && wv < 4) __builtin_amdgcn_global_load_lds((const unsigned*)(kp_ + (size_t)rrow * ks_ + kr_src), (LAS unsigned*)(sb_ + KR_OFF + wv * 1024), 16, 0, 0); } while (0)
    asm volatile("s_waitcnt vmcnt(0)" ::: "memory");
    ATT_DMA(0, 0); ATT_DMA(nt > 1 ? 1 : 0, 1);
    int st = 0;
    for (int t = 0; t < nt; ++t) {
        if (NDMA == 3 && wv < 4) asm volatile("s_waitcnt vmcnt(3)" ::: "memory"); else asm volatile("s_waitcnt vmcnt(2)" ::: "memory");
        __builtin_amdgcn_s_barrier(); asm volatile("" ::: "memory");
        { const int tn = (t + 2 < nt) ? t + 2 : nt - 1; const int sn = (st == 0) ? 2 : st - 1; ATT_DMA(tn, sn); }
        if (pol.wave_active(t)) {
            LAS unsigned char* sb = lds + st * STAGE;
            f32x16 s[QB][2];
#pragma unroll
            for (int qb = 0; qb < QB; ++qb) { s[qb][0] = zero16(); s[qb][1] = zero16(); }
#pragma unroll
            for (int ks = 0; ks < KS; ++ks) {
                bf16x8 a0, a1;
                if (ks < 4) { a0 = *(const LAS bf16x8*)(sb + (kn_rd[0] ^ (ks * 32))); a1 = *(const LAS bf16x8*)(sb + (kn_rd[1] ^ (ks * 32))); }
                else { a0 = *(const LAS bf16x8*)(sb + (kr_rd[0] ^ ((ks - 4) * 32))); a1 = *(const LAS bf16x8*)(sb + (kr_rd[1] ^ ((ks - 4) * 32))); }
#pragma unroll
                for (int qb = 0; qb < QB; ++qb) { s[qb][0] = mfma32(a0, qf[qb][ks], s[qb][0]); s[qb][1] = mfma32(a1, qf[qb][ks], s[qb][1]); }
            }
            if (QB == 1 && pol.tile_masked(t)) {
#pragma unroll
                for (int r = 0; r < 16; ++r) { const int e0 = (r & 3) + 8 * (r >> 2); s[0][0][r] = pol.score(s[0][0][r], t, e0, hh); s[0][1][r] = pol.score(s[0][1][r], t, 32 + e0, hh); }
            }
            bf16x8 pf[QB][2][2];
#pragma unroll
            for (int qb = 0; qb < QB; ++qb) {
                float mx = s[qb][0][0];
#pragma unroll
                for (int r = 1; r < 16; ++r) mx = fmaxf(mx, s[qb][0][r]);
#pragma unroll
                for (int r = 0; r < 16; ++r) mx = fmaxf(mx, s[qb][1][r]);
                mx = fmaxf(mx, __shfl_xor(mx, 32));
                if (__any(mx > m[qb])) {
                    const float mn = fmaxf(m[qb], mx), alpha = fexp2(m[qb] - mn); m[qb] = mn; lsum[qb] *= alpha;
#pragma unroll
                    for (int r = 0; r < 16; ++r) { O[qb][0][r] *= alpha; O[qb][1][r] *= alpha; }
                }
                const float mc = m[qb]; float ps = 0.f;
#pragma unroll
                for (int r = 0; r < 16; ++r) { s[qb][0][r] = fexp2(s[qb][0][r] - mc); s[qb][1][r] = fexp2(s[qb][1][r] - mc); ps += s[qb][0][r] + s[qb][1][r]; }
                lsum[qb] += ps;
#pragma unroll
                for (int sx = 0; sx < 2; ++sx) { u32x4 w0, w1;
#pragma unroll
                    for (int q = 0; q < 4; ++q) { w0[q] = pk2(s[qb][0][8 * sx + 2 * q], s[qb][0][8 * sx + 2 * q + 1]); w1[q] = pk2(s[qb][1][8 * sx + 2 * q], s[qb][1][8 * sx + 2 * q + 1]); }
                    pf[qb][0][sx] = as_bf16x8(w0); pf[qb][1][sx] = as_bf16x8(w1); }
            }
            {
                LAS unsigned char* va = sb + v_rd0; LAS unsigned char* vbp = sb + v_rd1;
                u32x2 x0, x1, x2, x3, x4, x5, x6, x7;
#define TRR8(o0, o1, o2, o3, o4, o5, o6, o7) asm volatile( \
                    "ds_read_b64_tr_b16 %0, %8 offset:" #o0 "\n\tds_read_b64_tr_b16 %1, %8 offset:" #o1 "\n\tds_read_b64_tr_b16 %2, %9 offset:" #o2 "\n\tds_read_b64_tr_b16 %3, %9 offset:" #o3 "\n\t" \
                    "ds_read_b64_tr_b16 %4, %8 offset:" #o4 "\n\tds_read_b64_tr_b16 %5, %8 offset:" #o5 "\n\tds_read_b64_tr_b16 %6, %9 offset:" #o6 "\n\tds_read_b64_tr_b16 %7, %9 offset:" #o7 "\n\t" \
                    "s_waitcnt lgkmcnt(0)" \
                    : "=&v"(x0), "=&v"(x1), "=&v"(x2), "=&v"(x3), "=&v"(x4), "=&v"(x5), "=&v"(x6), "=&v"(x7) : "v"(va), "v"(vbp) : "memory")
#define V8(a, b) as_bf16x8((u32x4){(a).x, (a).y, (b).x, (b).y})
                TRR8(0, 1024, 0, 1024, 2048, 3072, 2048, 3072);
#pragma unroll
                for (int qb = 0; qb < QB; ++qb) { O[qb][0] = mfma32(V8(x0, x1), pf[qb][0][0], O[qb][0]); O[qb][1] = mfma32(V8(x2, x3), pf[qb][0][0], O[qb][1]);
                                                  O[qb][0] = mfma32(V8(x4, x5), pf[qb][0][1], O[qb][0]); O[qb][1] = mfma32(V8(x6, x7), pf[qb][0][1], O[qb][1]); }
                TRR8(4096, 5120, 4096, 5120, 6144, 7168, 6144, 7168);
#pragma unroll
                for (int qb = 0; qb < QB; ++qb) { O[qb][0] = mfma32(V8(x0, x1), pf[qb][1][0], O[qb][0]); O[qb][1] = mfma32(V8(x2, x3), pf[qb][1][0], O[qb][1]);
                                                  O[qb][0] = mfma32(V8(x4, x5), pf[qb][1][1], O[qb][0]); O[qb][1] = mfma32(V8(x6, x7), pf[qb][1][1], O[qb][1]); }
#undef V8
#undef TRR8
            }
        }
        st = (st == 2) ? 0 : st + 1;
    }
#undef ATT_DMA
    asm volatile("s_waitcnt vmcnt(0)" ::: "memory");
    __builtin_amdgcn_s_barrier(); asm volatile("" ::: "memory");
#pragma unroll
    for (int qb = 0; qb < QB; ++qb) {
        float ls = lsum[qb]; ls += __shfl_xor(ls, 32);
        const float inv = 1.0f / ls; ym_t* orow = pol.orow + (size_t)qb * o2off;
#pragma unroll
        for (int g = 0; g < 4; ++g) {
            ym_store4(orow + 8 * g + 4 * hh, O[qb][0][4 * g] * inv, O[qb][0][4 * g + 1] * inv, O[qb][0][4 * g + 2] * inv, O[qb][0][4 * g + 3] * inv);
            ym_store4(orow + 32 + 8 * g + 4 * hh, O[qb][1][4 * g] * inv, O[qb][1][4 * g + 1] * inv, O[qb][1][4 * g + 2] * inv, O[qb][1][4 * g + 3] * inv);
        }
    }
}

template <int QB, class Pol>
__device__ __forceinline__ void attn_pp(int wv, LAS unsigned char* lds, const Pol& pol, int q2off = 0, int o2off = 0) {
    constexpr int DQ = Pol::DQ, KS = DQ / 16, NDMA = (DQ == 96) ? 3 : 2;
    constexpr int KN_OFF = 0, KR_OFF = 8192, V_OFF = (DQ == 96) ? 12288 : 8192, STAGE = V_OFF + 8192;
    const int tid = otid(wv), lane = tid & 63, hh = lane >> 5, l31 = lane & 31;
    const int grp = wv >> 2;
    bf16x8 qf[QB][KS];
#pragma unroll
    for (int qb = 0; qb < QB; ++qb)
#pragma unroll
        for (int ks = 0; ks < KS; ++ks) { const u32x4 raw = *(const u32x4*)(pol.qrow + (size_t)qb * q2off + 16 * ks + 8 * hh); u32x4 sc;
#pragma unroll
            for (int q = 0; q < 4; ++q) sc[q] = pk2(bf2f(raw[q] & 0xffffu) * pol.qscale, bf2f(raw[q] >> 16) * pol.qscale);
            qf[qb][ks] = as_bf16x8(sc); }
    f32x16 O[QB][2]; float m[QB], lsum[QB];
#pragma unroll
    for (int qb = 0; qb < QB; ++qb) { O[qb][0] = zero16(); O[qb][1] = zero16(); m[qb] = pol.m0; lsum[qb] = (hh == 0) ? pol.l0 : 0.f; }
    const int drow = 8 * wv + (lane >> 3), dpos = lane & 7;
    const int kn_src = ((dpos ^ ((drow >> 1) & 7)) * 8), v_src = ((dpos ^ (((drow >> 1) & 1) << 2)) * 8);
    const int rrow = 16 * (wv & 3) + (lane >> 2), rpos = lane & 3, kr_src = 64 + ((rpos ^ ((rrow >> 2) & 3)) * 8);
    int kn_rd[2], kr_rd[2];
#pragma unroll
    for (int kbk = 0; kbk < 2; ++kbk) { const int key = 32 * kbk + l31; kn_rd[kbk] = KN_OFF + key * 128 + ((hh ^ ((key >> 1) & 7)) * 16); kr_rd[kbk] = KR_OFF + key * 64 + ((hh ^ ((key >> 2) & 3)) * 16); }
    const int q4 = (lane & 15) >> 2;
    const int vchunk = 2 * ((lane >> 4) & 1) + ((lane & 3) >> 1), vsw = ((q4 >> 1) & 1) << 2;
    const int v_rd0 = V_OFF + (4 * hh + q4) * 128 + (((vchunk) ^ vsw) * 16) + 8 * (lane & 1);
    const int v_rd1 = V_OFF + (4 * hh + q4) * 128 + (((vchunk + 4) ^ vsw) * 16) + 8 * (lane & 1);
    const int nt = pol.ntiles;
#define ATT_DMA(t, st) do { const bf16_t* kp_; const bf16_t* vp_; int ks_, vs_; pol.tile_ptrs((t), kp_, ks_, vp_, vs_); LAS unsigned char* sb_ = lds + (st) * STAGE; \
        __builtin_amdgcn_global_load_lds((const unsigned*)(kp_ + (size_t)drow * ks_ + kn_src), (LAS unsigned*)(sb_ + KN_OFF + wv * 1024), 16, 0, 0); \
        __builtin_amdgcn_global_load_lds((const unsigned*)(vp_ + (size_t)drow * vs_ + v_src), (LAS unsigned*)(sb_ + V_OFF + wv * 1024), 16, 0, 0); \
        if (DQ == 96 && wv < 4) __builtin_amdgcn_global_load_lds((const unsigned*)(kp_ + (size_t)rrow * ks_ + kr_src), (LAS unsigned*)(sb_ + KR_OFF + wv * 1024), 16, 0, 0); } while (0)
#define ATT_WAIT1() do { if (NDMA == 3 && wv < 4) asm volatile("s_waitcnt vmcnt(3)" ::: "memory"); else asm volatile("s_waitcnt vmcnt(2)" ::: "memory"); } while (0)
#define ATT_BAR() do { asm volatile("" ::: "memory"); __builtin_amdgcn_s_barrier(); asm volatile("" ::: "memory"); } while (0)
    asm volatile("s_waitcnt vmcnt(0)" ::: "memory");
    ATT_DMA(0, 0); ATT_DMA(nt > 1 ? 1 : 0, 1);
    ATT_WAIT1();
    if (grp == 1) ATT_BAR();
    f32x16 s[QB][2]; bf16x8 pf[QB][2][2];
    bool act_prev = false;
#pragma unroll
    for (int qb = 0; qb < QB; ++qb) { s[qb][0] = zero16(); s[qb][1] = zero16();
#pragma unroll
        for (int a = 0; a < 2; ++a)
#pragma unroll
            for (int b = 0; b < 2; ++b) pf[qb][a][b] = as_bf16x8((u32x4){0u, 0u, 0u, 0u}); }
    for (int t = 0; t <= nt; ++t) {
        ATT_BAR();
        { const int tn = (t + 2 < nt) ? t + 2 : nt - 1; ATT_DMA(tn, (t + 2) & 3); }
        if (t > 0 && act_prev) {
            LAS unsigned char* sb = lds + ((t - 1) & 3) * STAGE;
            LAS unsigned char* va = sb + v_rd0; LAS unsigned char* vbp = sb + v_rd1;
            u32x2 x0, x1, x2, x3, x4, x5, x6, x7;
#define TRR8(o0, o1, o2, o3, o4, o5, o6, o7) asm volatile( \
                "ds_read_b64_tr_b16 %0, %8 offset:" #o0 "\n\tds_read_b64_tr_b16 %1, %8 offset:" #o1 "\n\tds_read_b64_tr_b16 %2, %9 offset:" #o2 "\n\tds_read_b64_tr_b16 %3, %9 offset:" #o3 "\n\t" \
                "ds_read_b64_tr_b16 %4, %8 offset:" #o4 "\n\tds_read_b64_tr_b16 %5, %8 offset:" #o5 "\n\tds_read_b64_tr_b16 %6, %9 offset:" #o6 "\n\tds_read_b64_tr_b16 %7, %9 offset:" #o7 "\n\t" \
                "s_waitcnt lgkmcnt(0)" \
                : "=&v"(x0), "=&v"(x1), "=&v"(x2), "=&v"(x3), "=&v"(x4), "=&v"(x5), "=&v"(x6), "=&v"(x7) : "v"(va), "v"(vbp) : "memory")
#define V8(a, b) as_bf16x8((u32x4){(a).x, (a).y, (b).x, (b).y})
            TRR8(0, 1024, 0, 1024, 2048, 3072, 2048, 3072);
#pragma unroll
            for (int qb = 0; qb < QB; ++qb) { O[qb][0] = mfma32(V8(x0, x1), pf[qb][0][0], O[qb][0]); O[qb][1] = mfma32(V8(x2, x3), pf[qb][0][0], O[qb][1]);
                                              O[qb][0] = mfma32(V8(x4, x5), pf[qb][0][1], O[qb][0]); O[qb][1] = mfma32(V8(x6, x7), pf[qb][0][1], O[qb][1]); }
            TRR8(4096, 5120, 4096, 5120, 6144, 7168, 6144, 7168);
#pragma unroll
            for (int qb = 0; qb < QB; ++qb) { O[qb][0] = mfma32(V8(x0, x1), pf[qb][1][0], O[qb][0]); O[qb][1] = mfma32(V8(x2, x3), pf[qb][1][0], O[qb][1]);
                                              O[qb][0] = mfma32(V8(x4, x5), pf[qb][1][1], O[qb][0]); O[qb][1] = mfma32(V8(x6, x7), pf[qb][1][1], O[qb][1]); }
#undef V8
#undef TRR8
        }
        const bool act = (t < nt) && pol.wave_active(t);
        if (act) {
            LAS unsigned char* sb = lds + (t & 3) * STAGE;
#pragma unroll
            for (int qb = 0; qb < QB; ++qb) { s[qb][0] = zero16(); s[qb][1] = zero16(); }
#pragma unroll
            for (int ks = 0; ks < KS; ++ks) {
                bf16x8 a0, a1;
                if (ks < 4) { a0 = *(const LAS bf16x8*)(sb + (kn_rd[0] ^ (ks * 32))); a1 = *(const LAS bf16x8*)(sb + (kn_rd[1] ^ (ks * 32))); }
                else { a0 = *(const LAS bf16x8*)(sb + (kr_rd[0] ^ ((ks - 4) * 32))); a1 = *(const LAS bf16x8*)(sb + (kr_rd[1] ^ ((ks - 4) * 32))); }
#pragma unroll
                for (int qb = 0; qb < QB; ++qb) { s[qb][0] = mfma32(a0, qf[qb][ks], s[qb][0]); s[qb][1] = mfma32(a1, qf[qb][ks], s[qb][1]); }
            }
        }
        ATT_WAIT1();
        ATT_BAR();
        if (act) {
            if (QB == 1 && pol.tile_masked(t)) {
#pragma unroll
                for (int r = 0; r < 16; ++r) { const int e0 = (r & 3) + 8 * (r >> 2); s[0][0][r] = pol.score(s[0][0][r], t, e0, hh); s[0][1][r] = pol.score(s[0][1][r], t, 32 + e0, hh); }
            }
#pragma unroll
            for (int qb = 0; qb < QB; ++qb) {
                float mx = s[qb][0][0];
#pragma unroll
                for (int r = 1; r < 16; ++r) mx = fmaxf(mx, s[qb][0][r]);
#pragma unroll
                for (int r = 0; r < 16; ++r) mx = fmaxf(mx, s[qb][1][r]);
                mx = fmaxf(mx, __shfl_xor(mx, 32));
                if (__any(mx > m[qb])) {
                    const float mn = fmaxf(m[qb], mx), alpha = fexp2(m[qb] - mn); m[qb] = mn; lsum[qb] *= alpha;
#pragma unroll
                    for (int r = 0; r < 16; ++r) { O[qb][0][r] *= alpha; O[qb][1][r] *= alpha; }
                }
                const float mc = m[qb]; float ps = 0.f;
#pragma unroll
                for (int r = 0; r < 16; ++r) { s[qb][0][r] = fexp2(s[qb][0][r] - mc); s[qb][1][r] = fexp2(s[qb][1][r] - mc); ps += s[qb][0][r] + s[qb][1][r]; }
                lsum[qb] += ps;
#pragma unroll
                for (int sx = 0; sx < 2; ++sx) { u32x4 w0, w1;
#pragma unroll
                    for (int q = 0; q < 4; ++q) { w0[q] = pk2(s[qb][0][8 * sx + 2 * q], s[qb][0][8 * sx + 2 * q + 1]); w1[q] = pk2(s[qb][1][8 * sx + 2 * q], s[qb][1][8 * sx + 2 * q + 1]); }
                    pf[qb][0][sx] = as_bf16x8(w0); pf[qb][1][sx] = as_bf16x8(w1); }
            }
        }
        act_prev = act;
    }
    if (grp == 0) ATT_BAR();
#undef ATT_DMA
#undef ATT_WAIT1
    asm volatile("s_waitcnt vmcnt(0)" ::: "memory");
    ATT_BAR();
#undef ATT_BAR
#pragma unroll
    for (int qb = 0; qb < QB; ++qb) {
        float ls = lsum[qb]; ls += __shfl_xor(ls, 32);
        const float inv = 1.0f / ls; ym_t* orow = pol.orow + (size_t)qb * o2off;
#pragma unroll
        for (int g = 0; g < 4; ++g) {
            ym_store4(orow + 8 * g + 4 * hh, O[qb][0][4 * g] * inv, O[qb][0][4 * g + 1] * inv, O[qb][0][4 * g + 2] * inv, O[qb][0][4 * g + 3] * inv);
            ym_store4(orow + 32 + 8 * g + 4 * hh, O[qb][1][4 * g] * inv, O[qb][1][4 * g + 1] * inv, O[qb][1][4 * g + 2] * inv, O[qb][1][4 * g + 3] * inv);
        }
    }
}

template <int QB, class Pol>
__device__ __forceinline__ void attn_core_old(int wv, LAS unsigned char* lds, const Pol& pol, int q2off = 0, int o2off = 0) {
    constexpr int DQ = Pol::DQ, KS = DQ / 16, KROW = DQ * 2 + 16, VROW = 192, KBUF = 64 * KROW, VBUF = 64 * VROW, KCH = DQ / 8;
    const int tid = otid(wv), lane = tid & 63, hh = lane >> 5, l31 = lane & 31;
    LAS unsigned char* kb = lds; LAS unsigned char* vb = lds + 2 * KBUF;
    bf16x8 qf[QB][KS];
#pragma unroll
    for (int qb = 0; qb < QB; ++qb)
#pragma unroll
        for (int ks = 0; ks < KS; ++ks) { const u32x4 raw = *(const u32x4*)(pol.qrow + (size_t)qb * q2off + 16 * ks + 8 * hh); u32x4 sc;
#pragma unroll
            for (int q = 0; q < 4; ++q) sc[q] = pk2(bf2f(raw[q] & 0xffffu) * pol.qscale, bf2f(raw[q] >> 16) * pol.qscale);
            qf[qb][ks] = as_bf16x8(sc); }
    f32x16 O[QB][2]; float m[QB], lsum[QB];
#pragma unroll
    for (int qb = 0; qb < QB; ++qb) { O[qb][0] = zero16(); O[qb][1] = zero16(); m[qb] = pol.m0; lsum[qb] = (hh == 0) ? pol.l0 : 0.f; }
    const int kkey0 = tid / KCH, kpart0 = tid % KCH, c1 = tid + NTHR, kkey1 = c1 / KCH, kpart1 = c1 % KCH; const bool has1 = c1 < 64 * KCH;
    const int vkey = tid >> 3, vpart = tid & 7;
    u32x4 kr0, kr1 = (u32x4){0u, 0u, 0u, 0u}, vr;
    const int q4 = (lane & 15) >> 2, colo = 16 * ((lane >> 4) & 1) + 4 * (lane & 3);
    const int nt = pol.ntiles;
#define ATT_GLOAD(t) do { const bf16_t* kp_; const bf16_t* vp_; int ks_, vs_; pol.tile_ptrs((t), kp_, ks_, vp_, vs_); \
        kr0 = *(const u32x4*)(kp_ + (size_t)kkey0 * ks_ + kpart0 * 8); if (has1) kr1 = *(const u32x4*)(kp_ + (size_t)kkey1 * ks_ + kpart1 * 8); \
        vr = *(const u32x4*)(vp_ + (size_t)vkey * vs_ + vpart * 8); } while (0)
#define ATT_LSTORE(buf) do { *(LAS u32x4*)(kb + (buf) * KBUF + kkey0 * KROW + kpart0 * 16) = kr0; if (has1) *(LAS u32x4*)(kb + (buf) * KBUF + kkey1 * KROW + kpart1 * 16) = kr1; \
        *(LAS u32x4*)(vb + (buf) * VBUF + vkey * VROW + vpart * 16) = vr; } while (0)
    ATT_GLOAD(0); ATT_LSTORE(0); __syncthreads();
    for (int t = 0; t < nt; ++t) {
        const int buf = t & 1;
        if (t + 1 < nt) ATT_GLOAD(t + 1);
        if (pol.wave_active(t)) {
            LAS unsigned char* kt = kb + buf * KBUF; LAS unsigned char* vt = vb + buf * VBUF;
            f32x16 s[QB][2];
#pragma unroll
            for (int qb = 0; qb < QB; ++qb) { s[qb][0] = zero16(); s[qb][1] = zero16(); }
#pragma unroll
            for (int ks = 0; ks < KS; ++ks) {
                const bf16x8 a0 = *(const LAS bf16x8*)(kt + l31 * KROW + (16 * ks + 8 * hh) * 2);
                const bf16x8 a1 = *(const LAS bf16x8*)(kt + (32 + l31) * KROW + (16 * ks + 8 * hh) * 2);
#pragma unroll
                for (int qb = 0; qb < QB; ++qb) { s[qb][0] = mfma32(a0, qf[qb][ks], s[qb][0]); s[qb][1] = mfma32(a1, qf[qb][ks], s[qb][1]); }
            }
            if (QB == 1 && pol.tile_masked(t)) {
#pragma unroll
                for (int r = 0; r < 16; ++r) { const int e0 = (r & 3) + 8 * (r >> 2); s[0][0][r] = pol.score(s[0][0][r], t, e0, hh); s[0][1][r] = pol.score(s[0][1][r], t, 32 + e0, hh); }
            }
            bf16x8 pf[QB][2][2];
#pragma unroll
            for (int qb = 0; qb < QB; ++qb) {
                float mx = s[qb][0][0];
#pragma unroll
                for (int r = 1; r < 16; ++r) mx = fmaxf(mx, s[qb][0][r]);
#pragma unroll
                for (int r = 0; r < 16; ++r) mx = fmaxf(mx, s[qb][1][r]);
                mx = fmaxf(mx, __shfl_xor(mx, 32));
                if (__any(mx > m[qb])) {
                    const float mn = fmaxf(m[qb], mx), alpha = fexp2(m[qb] - mn); m[qb] = mn; lsum[qb] *= alpha;
#pragma unroll
                    for (int r = 0; r < 16; ++r) { O[qb][0][r] *= alpha; O[qb][1][r] *= alpha; }
                }
                const float mc = m[qb]; float ps = 0.f;
#pragma unroll
                for (int r = 0; r < 16; ++r) { s[qb][0][r] = fexp2(s[qb][0][r] - mc); s[qb][1][r] = fexp2(s[qb][1][r] - mc); ps += s[qb][0][r] + s[qb][1][r]; }
                lsum[qb] += ps;
#pragma unroll
                for (int sx = 0; sx < 2; ++sx) { u32x4 w0, w1;
#pragma unroll
                    for (int q = 0; q < 4; ++q) { w0[q] = pk2(s[qb][0][8 * sx + 2 * q], s[qb][0][8 * sx + 2 * q + 1]); w1[q] = pk2(s[qb][1][8 * sx + 2 * q], s[qb][1][8 * sx + 2 * q + 1]); }
                    pf[qb][0][sx] = as_bf16x8(w0); pf[qb][1][sx] = as_bf16x8(w1); }
            }
#pragma unroll
            for (int kbk = 0; kbk < 2; ++kbk)
#pragma unroll
                for (int sx = 0; sx < 2; ++sx) {
                    const int r0 = 32 * kbk + 16 * sx + 4 * hh + q4;
                    const bf16x8 v0 = cat8(tr_read(vt + r0 * VROW + colo * 2), tr_read(vt + (r0 + 8) * VROW + colo * 2));
                    const bf16x8 v1 = cat8(tr_read(vt + r0 * VROW + (32 + colo) * 2), tr_read(vt + (r0 + 8) * VROW + (32 + colo) * 2));
#pragma unroll
                    for (int qb = 0; qb < QB; ++qb) { O[qb][0] = mfma32(v0, pf[qb][kbk][sx], O[qb][0]); O[qb][1] = mfma32(v1, pf[qb][kbk][sx], O[qb][1]); }
                }
        }
        if (t + 1 < nt) ATT_LSTORE(buf ^ 1);
        __syncthreads();
    }
#undef ATT_GLOAD
#undef ATT_LSTORE
#pragma unroll
    for (int qb = 0; qb < QB; ++qb) {
        float ls = lsum[qb]; ls += __shfl_xor(ls, 32);
        const float inv = 1.0f / ls; ym_t* orow = pol.orow + (size_t)qb * o2off;
#pragma unroll
        for (int g = 0; g < 4; ++g) {
            ym_store4(orow + 8 * g + 4 * hh, O[qb][0][4 * g] * inv, O[qb][0][4 * g + 1] * inv, O[qb][0][4 * g + 2] * inv, O[qb][0][4 * g + 3] * inv);
            ym_store4(orow + 32 + 8 * g + 4 * hh, O[qb][1][4 * g] * inv, O[qb][1][4 * g + 1] * inv, O[qb][1][4 * g + 2] * inv, O[qb][1][4 * g + 3] * inv);
        }
    }
}

constexpr float NEG_INF = -__builtin_inff();
struct PolD {
    static constexpr int DQ = 96;
    const bf16_t *kbase, *vbase, *kctx, *vctx, *qrow; ym_t* orow; int nloc, ntiles; float qscale, m0, l0;
    __device__ __forceinline__ void tile_ptrs(int t, const bf16_t*& kp, int& ks, const bf16_t*& vp, int& vs) const {
        ks = 384; vs = 256;
        if (t < nloc) { kp = kbase + (size_t)t * 64 * 384; vp = vbase + (size_t)t * 64 * 256; } else { kp = kctx + (size_t)(t - nloc) * 64 * 384; vp = vctx + (size_t)(t - nloc) * 64 * 256; } }
    __device__ __forceinline__ bool wave_active(int) const { return true; }
    __device__ __forceinline__ bool tile_masked(int) const { return false; }
    __device__ __forceinline__ float score(float s, int, int, int) const { return s; }
};
struct PolA {
    static constexpr int DQ = 64;
    const bf16_t *kbase, *vbase, *kctx, *vctx, *qrow; ym_t* orow; int nloc, ntiles; float qscale, m0, l0;
    int kp0, q0, qpos;
    __device__ __forceinline__ void tile_ptrs(int t, const bf16_t*& kp, int& ks, const bf16_t*& vp, int& vs) const {
        ks = 128; vs = NP;
        if (t < nloc) { const int k0 = kp0 + 64 * t; kp = kbase + (size_t)k0 * 128; vp = vbase + (size_t)k0 * NP; } else { kp = kctx + (size_t)(t - nloc) * 64 * 128; vp = vctx + (size_t)(t - nloc) * 64 * NP; } }
    __device__ __forceinline__ bool wave_active(int t) const { const int k0 = kp0 + 64 * t; return t >= nloc || (k0 + 63 >= q0 - 128 && k0 <= q0 + 31 + 128); }
    __device__ __forceinline__ bool tile_masked(int t) const { const int k0 = kp0 + 64 * t; return t < nloc && !(k0 >= q0 + 31 - 128 && k0 + 63 <= q0 + 128); }
    __device__ __forceinline__ float score(float s, int t, int e0, int hh) const { const int d = qpos - (kp0 + 64 * t + e0 + 4 * hh); return (d <= 128 && d >= -128) ? s : NEG_INF; }
};
struct PolB {
    static constexpr int DQ = 64;
    const bf16_t *kbase, *vbase, *kctx, *vctx, *qrow; ym_t* orow; int nloc, ntiles; float qscale, m0, l0;
    int klo, wr0, r, c; const LAS float* rpb;
    unsigned mlo, mhi; int bbase;
    __device__ __forceinline__ void set_lane(int hh) { const int cs = min(max(c - 8, 0), 48); const unsigned long long m = (0xffffull << cs) >> (4 * hh); mlo = (unsigned)m; mhi = (unsigned)(m >> 32); bbase = 15 - c + 4 * hh; }
    __device__ __forceinline__ void tile_ptrs(int t, const bf16_t*& kp, int& ks, const bf16_t*& vp, int& vs) const {
        ks = NP; vs = NP;
        if (t < nloc) { kp = kbase + (size_t)(klo + t) * 64 * NP; vp = vbase + (size_t)(klo + t) * 64 * NP; } else { kp = kctx + (size_t)(t - nloc) * 64 * NP; vp = vctx + (size_t)(t - nloc) * 64 * NP; } }
    __device__ __forceinline__ bool wave_active(int t) const { return t >= nloc || (klo + t >= wr0 && klo + t < wr0 + 8); }
    __device__ __forceinline__ bool tile_masked(int t) const { return t < nloc; }
    __device__ __forceinline__ float score(float s, int t, int e0, int) const {
        const bool ok = ((e0 < 32 ? (mlo >> e0) : (mhi >> (e0 - 32))) & 1u) != 0u;
        const float bias = rpb[(klo + t - r + 7) * 31 + bbase + e0];
        return ok ? s + bias : NEG_INF; }
};

struct XQ { unsigned* heads; int x, per; int dx; };
__device__ __forceinline__ int q_next(int tid, XQ& q, LAS int* slot) {
    for (;;) {
        if (q.dx >= 8) return -1;
        const int xx = (q.x + q.dx) & 7;
        __syncthreads();
        if (tid == 0) *slot = (int)__hip_atomic_fetch_add(q.heads + xx * 64, 1u, __ATOMIC_RELAXED, __HIP_MEMORY_SCOPE_AGENT);
        __syncthreads();
        const int j = *slot;
        if (j < q.per) return xx * q.per + j;
        ++q.dx;
    }
}

__device__ __forceinline__ void mlstm_out_pair(int wv, const Params& p, LAS unsigned char* lds, int l, int u0, int u1) {
    const int tid = otid(wv), lane = tid & 63, w = tid >> 6, hh = lane >> 5, l31 = lane & 31;
    const int half = w >> 2, wl = w & 3;
    unsigned char* ws = opq(p.ws);
    const bf16_t* P = (const bf16_t*)(ws + WS_P); const bf16_t* QC = (const bf16_t*)(ws + WS_QC); const bf16_t* KC = (const bf16_t*)(ws + WS_KC);
    const float* GATES = (const float*)(ws + WS_GATES); const bf16_t* CS = (const bf16_t*)(ws + WS_CS); const float* NS = (const float*)(ws + WS_NS); const float* MS = (const float*)(ws + WS_MS);
    ym_t* YMIX = (ym_t*)(ws + WS_YMIX);
    const bool need_ctx = (l == 0);
    const int u = half ? u1 : u0; const bool valid = u >= 0;
    const int hd = u & 3, v = u >> 2; int b, tc;
    if (need_ctx) { b = v / NCHUNK; tc = v % NCHUNK; } else { b = v >> 7; tc = v & 127; }
    LAS unsigned char* hb = lds + half * 36864;
    LAS unsigned char* VT = hb;
    LAS float* ZU = (LAS float*)(hb + 12288);
    LAS float* ZC = ZU + 128;
    LAS float* ZI = ZC + 128;
    LAS float* ZE = ZI + 128;
    LAS float* ZN = ZE + 128;
    LAS float* ZH = (LAS float*)(hb + 16384);
    const int row0 = (tc < 128) ? b * SEQ + tc * 64 : TL + b * CTXL + (tc - 128) * 64;
    if (valid) {
        if (wl < 2) { const int dir = wl, i = dir ? 63 - lane : lane;
            const float lf = GATES[(size_t)(row0 + i) * 16 + (dir ? 12 : 4) + hd], ig = GATES[(size_t)(row0 + i) * 16 + (dir ? 8 : 0) + hd];
            const float bc = wave_incl_sum(lf, lane), uu = ig - bc, pm = wave_incl_max(uu, lane);
            const float min_ = MS[cu_index(b, tc, hd, dir)], mx = fmaxf(min_, pm);
            ZU[dir * 64 + lane] = uu; ZC[dir * 64 + lane] = -mx; ZI[dir * 64 + lane] = fexp(min_ - mx); ZE[dir * 64 + lane] = fexp(-(bc + mx));
        } else { const int dir = wl - 2; ZN[dir * 64 + lane] = NS[(size_t)cu_index(b, tc, hd, dir) * 64 + lane]; }
        { const int t4 = wl * 64 + lane;
#pragma unroll
          for (int ps = 0; ps < 2; ++ps) { const int c = t4 + 256 * ps, s = c >> 3, part = c & 7; *(LAS u32x4*)(VT + s * 192 + part * 16) = *(const u32x4*)(P + (size_t)(row0 + s) * NP + PC_CV + hd * 64 + part * 8); } }
    }
    __syncthreads();
    const int dir = wl >> 1, tb = wl & 1;
    const int t = 32 * tb + l31, it = dir ? 63 - t : t;
    f32x16 acc[2], acc2[2]; float inter = 0.f, rden = 0.f;
    if (valid) {
        bf16x8 qf[4];
#pragma unroll
        for (int ks = 0; ks < 4; ++ks) qf[ks] = *(const bf16x8*)(QC + (size_t)(row0 + it) * 256 + hd * 64 + 16 * ks + 8 * hh);
        f32x16 st[2];
#pragma unroll
        for (int sb = 0; sb < 2; ++sb) { const int s = 32 * sb + l31, is = dir ? 63 - s : s; st[sb] = zero16();
#pragma unroll
            for (int ks = 0; ks < 4; ++ks) { const bf16x8 a = *(const bf16x8*)(KC + (size_t)(row0 + is) * 256 + hd * 64 + 16 * ks + 8 * hh); st[sb] = mfma32(a, qf[ks], st[sb]); } }
        const float ct = ZC[dir * 64 + t];
        float dsum = 0.f;
#pragma unroll
        for (int sb = 0; sb < 2; ++sb)
#pragma unroll
            for (int r = 0; r < 16; ++r) { const int s = 32 * sb + (r & 3) + 8 * (r >> 2) + 4 * hh;
                const float vv = (s <= t) ? st[sb][r] * fexp(ZU[dir * 64 + s] + ct) : 0.f; st[sb][r] = vv; dsum += vv; }
        dsum += __shfl_xor(dsum, 32);
        acc[0] = zero16(); acc[1] = zero16(); acc2[0] = zero16(); acc2[1] = zero16();
        const int q4 = (lane & 15) >> 2, colo = 16 * ((lane >> 4) & 1) + 4 * (lane & 3);
#pragma unroll
        for (int sb = 0; sb < 2; ++sb)
#pragma unroll
            for (int s2 = 0; s2 < 2; ++s2) { u32x4 wvv;
#pragma unroll
                for (int q = 0; q < 4; ++q) wvv[q] = pk2(st[sb][8 * s2 + 2 * q], st[sb][8 * s2 + 2 * q + 1]);
                const int sa = 32 * sb + 16 * s2 + 4 * hh + q4, sb8 = sa + 8;
                const int ia = dir ? 63 - sa : sa, ib = dir ? 63 - sb8 : sb8;
#pragma unroll
                for (int dvb = 0; dvb < 2; ++dvb) { const bf16x8 vf = cat8(tr_read(VT + ia * 192 + (32 * dvb + colo) * 2), tr_read(VT + ib * 192 + (32 * dvb + colo) * 2));
                    acc[dvb] = mfma32(vf, as_bf16x8(wvv), acc[dvb]); } }
        float qn = 0.f;
#pragma unroll
        for (int ks = 0; ks < 4; ++ks) {
#pragma unroll
            for (int dvb = 0; dvb < 2; ++dvb) { const bf16x8 cf = *(const bf16x8*)(CS + (size_t)cu_index(b, tc, hd, dir) * 4096 + (size_t)(32 * dvb + l31) * 64 + 16 * ks + 8 * hh); acc2[dvb] = mfma32(cf, qf[ks], acc2[dvb]); }
#pragma unroll
            for (int j = 0; j < 8; ++j) qn += bf2f((unsigned)(unsigned short)qf[ks][j]) * ZN[dir * 64 + 16 * ks + 8 * hh + j]; }
        qn += __shfl_xor(qn, 32);
        inter = ZI[dir * 64 + t]; const float den = dsum + inter * qn; rden = 1.0f / fmaxf(fabsf(den), ZE[dir * 64 + t]);
#pragma unroll
        for (int dvb = 0; dvb < 2; ++dvb)
#pragma unroll
            for (int r = 0; r < 16; ++r) acc[dvb][r] = (acc[dvb][r] + inter * acc2[dvb][r]) * rden;
        if (dir == 1) {
#pragma unroll
            for (int dvb = 0; dvb < 2; ++dvb)
#pragma unroll
                for (int r = 0; r < 16; ++r) ZH[it * 65 + 32 * dvb + (r & 3) + 8 * (r >> 2) + 4 * hh] = acc[dvb][r];
        }
    }
    __syncthreads();
    if (valid && dir == 0) {
#pragma unroll
        for (int dvb = 0; dvb < 2; ++dvb)
#pragma unroll
            for (int g = 0; g < 4; ++g) { const int dv = 32 * dvb + 8 * g + 4 * hh;
                const u32x2 ov = *(const u32x2*)(P + (size_t)(row0 + it) * NP + PC_CO + hd * 64 + dv);
                const float o0 = sigmoidf_(bf2f(ov.x & 0xffffu)), o1 = sigmoidf_(bf2f(ov.x >> 16)), o2 = sigmoidf_(bf2f(ov.y & 0xffffu)), o3 = sigmoidf_(bf2f(ov.y >> 16));
                const float h0 = acc[dvb][4 * g] + ZH[it * 65 + dv], h1 = acc[dvb][4 * g + 1] + ZH[it * 65 + dv + 1], h2 = acc[dvb][4 * g + 2] + ZH[it * 65 + dv + 2], h3 = acc[dvb][4 * g + 3] + ZH[it * 65 + dv + 3];
                ym_store4(YMIX + (size_t)(row0 + it) * 1024 + 512 + hd * 64 + dv, o0 * h0, o1 * h1, o2 * h2, o3 * h3); }
    }
    __syncthreads();
}


#define MIX_COMMON \
    const int qo = probe ? 4 : 0; \
    const int tid = otid(wv), lane = tid & 63, w = tid >> 6, l31 = lane & 31; \
    unsigned char* ws = opq(p.ws); \
    unsigned* ctl = (unsigned*)(ws + WS_CTL); \
    LAS int* slot = (LAS int*)(lds + LDS_MISC + 64); \
    const int myx = *(const LAS int*)(lds + LDS_MISC + 72); \
    const bf16_t* P = (const bf16_t*)(ws + WS_P); \
    ym_t* YMIX = (ym_t*)(ws + WS_YMIX); \
    const bool need_ctx = (l == 0); (void)lane; (void)P;

__device__ __forceinline__ void mix_D(int wv, const Params& p, int l, LAS unsigned char* lds, bool probe) {
    MIX_COMMON
    const bf16_t* QD = (const bf16_t*)(ws + WS_QD); const bf16_t* KD = (const bf16_t*)(ws + WS_KD); const bf16_t* VD = (const bf16_t*)(ws + WS_VD);
    const int per = 32 + (need_ctx ? 2 : 0);
    XQ q{ctl + CTL_Q(l, qo + 0, 0), myx, per, 0};
    for (;;) { const int uu = q_next(tid, q, slot); if (uu < 0) break;
        const int xx = uu / per, j = uu % per;
        PolD pol; int b, h, row; const bool lat = j < 32;
        if (lat) { const int pair = xx + 8 * (j >> 4); b = pair >> 2; h = pair & 3; row = b * SEQ + (j & 15) * 512 + 64 * w + l31; pol.nloc = 128; }
        else { const int v = 2 * xx + (j - 32); b = v >> 2; h = v & 3; row = TL + b * CTXL + 32 * w + l31; pol.nloc = 0; }
        pol.ntiles = pol.nloc + 4;
        pol.kbase = KD + (size_t)b * SEQ * 384 + h * 96; pol.vbase = VD + (size_t)b * SEQ * 256 + h * 64;
        pol.kctx = KD + (size_t)(TL + b * CTXL) * 384 + h * 96; pol.vctx = VD + (size_t)(TL + b * CTXL) * 256 + h * 64;
        pol.qrow = QD + (size_t)row * 384 + h * 96; pol.orow = YMIX + (size_t)row * 1024 + 768 + h * 64;
        pol.qscale = 0.10206207261596575f * LOG2E; pol.m0 = -1e30f; pol.l0 = 0.f;
        if (lat) attn_pp<2>(wv, lds, pol, 32 * 384, 32 * 1024); else attn_core<1>(wv, lds, pol); }
}
__device__ __forceinline__ void mix_B(int wv, const Params& p, int l, LAS unsigned char* lds, bool probe) {
    MIX_COMMON
    const int per = 64 + (need_ctx ? 2 : 0);
    XQ q{ctl + CTL_Q(l, qo + 1, 0), myx, per, 0};
    for (;;) { const int uu = q_next(tid, q, slot); if (uu < 0) break;
        const int xx = uu / per, j = uu % per;
        PolB pol; int b, h, row;
        LAS float* rp = (LAS float*)(lds + 65536);
        if (j < 64) { const int pair = xx + 8 * (j >> 5); b = pair >> 2; h = pair & 3; const int R0 = (j & 31) * 4; pol.r = R0 + (w >> 1); pol.c = 32 * (w & 1) + l31; row = b * SEQ + pol.r * 64 + pol.c;
            pol.klo = min(max(R0 - 4, 0), 120); const int khi = min(max(R0 - 1, 0), 120) + 7; pol.nloc = khi - pol.klo + 1; pol.wr0 = min(max(pol.r - 4, 0), 120); }
        else { const int v = 2 * xx + (j - 64); b = v >> 2; h = v & 3; row = TL + b * CTXL + 32 * w + l31; pol.nloc = 0; pol.klo = 0; pol.wr0 = 0; pol.r = 0; pol.c = 0; }
        for (int i = tid; i < 465; i += NTHR) rp[i] = p.nat_rpb[((size_t)l * 4 + h) * 465 + i] * LOG2E;
        __syncthreads();
        pol.rpb = rp; pol.ntiles = pol.nloc + 4; pol.set_lane(lane >> 5);
        pol.kbase = P + (size_t)b * SEQ * NP + PC_BK + h * 64; pol.vbase = P + (size_t)b * SEQ * NP + PC_BV + h * 64;
        pol.kctx = P + (size_t)(TL + b * CTXL) * NP + PC_BK + h * 64; pol.vctx = P + (size_t)(TL + b * CTXL) * NP + PC_BV + h * 64;
        pol.qrow = P + (size_t)row * NP + PC_BQ + h * 64; pol.orow = YMIX + (size_t)row * 1024 + 256 + h * 64;
        pol.qscale = 0.125f * LOG2E; pol.m0 = -1e30f; pol.l0 = 0.f;
        attn_core<1>(wv, lds, pol); }
}
__device__ __forceinline__ void mix_A(int wv, const Params& p, int l, LAS unsigned char* lds, bool probe) {
    MIX_COMMON
    const bf16_t* QA = (const bf16_t*)(ws + WS_QA); const bf16_t* KA = (const bf16_t*)(ws + WS_KA);
    const int per = 64 + (need_ctx ? 2 : 0);
    XQ q{ctl + CTL_Q(l, qo + 2, 0), myx, per, 0};
    for (;;) { const int uu = q_next(tid, q, slot); if (uu < 0) break;
        const int xx = uu / per, j = uu % per;
        PolA pol; int b, hkv, head, row;
        if (j < 64) { b = xx >> 1; hkv = xx & 1; const int qb = j; head = 2 * hkv + (w >> 2); pol.q0 = qb * 128 + (w & 3) * 32; pol.qpos = pol.q0 + l31; row = b * SEQ + pol.qpos;
            const int tlo = (qb == 0) ? 2 : 0, thi = (qb == 63) ? 4 : 6; pol.nloc = thi - tlo; pol.kp0 = (qb - 1) * 128 + 64 * tlo; }
        else { const int v = 2 * xx + (j - 64); b = v >> 2; hkv = (v >> 1) & 1; head = 2 * hkv + (v & 1); row = TL + b * CTXL + 32 * w + l31; pol.nloc = 0; pol.kp0 = 0; pol.q0 = 0; pol.qpos = 0; }
        pol.ntiles = pol.nloc + 4;
        pol.kbase = KA + (size_t)b * SEQ * 128 + hkv * 64; pol.vbase = P + (size_t)b * SEQ * NP + PC_AV + hkv * 64;
        pol.kctx = KA + (size_t)(TL + b * CTXL) * 128 + hkv * 64; pol.vctx = P + (size_t)(TL + b * CTXL) * NP + PC_AV + hkv * 64;
        pol.qrow = QA + (size_t)row * 256 + head * 64; pol.orow = YMIX + (size_t)row * 1024 + head * 64;
        pol.qscale = 0.125f * LOG2E; pol.m0 = p.attn_sink[l * 4 + head] * LOG2E; pol.l0 = 1.0f;
        attn_core<1>(wv, lds, pol); }
}
__device__ __forceinline__ void mix_C(int wv, const Params& p, int l, LAS unsigned char* lds, bool probe) {
    MIX_COMMON
    (void)w; (void)l31; (void)YMIX;
    const int per = NBATCH * (need_ctx ? NCHUNK : 128) * 4 / 16;
    XQ q{ctl + CTL_Q(l, qo + 3, 0), myx, per, 0};
    for (;;) { const int pr = q_next(tid, q, slot); if (pr < 0) break;
        mlstm_out_pair(wv, p, lds, l, 2 * pr, 2 * pr + 1); }
}
#ifndef MIX_MASK
#define MIX_MASK 15
#endif
__device__ __forceinline__ void phase_mixers(int wv, const Params& p, int l, LAS unsigned char* lds) {
    if (MIX_MASK & 1) mix_D(wv, p, l, lds, false);
    if (MIX_MASK & 2) mix_B(wv, p, l, lds, false);
    if (MIX_MASK & 4) mix_A(wv, p, l, lds, false);
    if (MIX_MASK & 8) mix_C(wv, p, l, lds, false);
}
#ifndef PROBE_MIX
#define PROBE_MIX 15
#endif
__device__ __forceinline__ void phase_mixers_probe(int wv, const Params& p, int l, LAS unsigned char* lds) {
    if (PROBE_MIX & 1) mix_D(wv, p, l, lds, true);
    if (PROBE_MIX & 2) mix_B(wv, p, l, lds, true);
    if (PROBE_MIX & 4) mix_A(wv, p, l, lds, true);
    if (PROBE_MIX & 8) mix_C(wv, p, l, lds, true);
}

__device__ __forceinline__ void phase_router(int wv, const Params& p, int l, LAS unsigned char* lds) {
    const int tid = otid(wv), lane = tid & 63, w = tid >> 6, hh = lane >> 5, l31 = lane & 31;
    unsigned char* ws = opq(p.ws);
    const float* MOD = (const float*)(ws + WS_MOD); float* XA = (float*)(ws + WS_XA); unsigned char* H2F = ws + WS_H2B;
    const bf16_t* DELTA = (const bf16_t*)(ws + WS_HB); const float* XB = (const float*)(ws + WS_XB);
    const bf16_t* WRT = (const bf16_t*)(ws + WS_WRT) + (size_t)l * 2 * 32 * 1024;
    float* GATE = (float*)(ws + WS_GATE); int* LIST = (int*)(ws + WS_LIST); unsigned* ctl = (unsigned*)(ws + WS_CTL);
    constexpr int HROW = 1028;
    LAS float* HT = (LAS float*)lds;
    LAS float* RED = (LAS float*)lds;
    LAS int* LCNT = (LAS int*)(lds + 131584);
    LAS int* LBASE = LCNT + 32;
    LAS int* PA = LBASE + 32;
    LAS int* PE = PA + 640;
    const int T = (l == 0) ? TA : TL, ntile = T / 32, NASSIGN = TA * 4;
    if (tid < 32) LCNT[tid] = 0;
    if (blockIdx.x == 0 && tid < 64) *(u32x4*)(H2F + (size_t)TA * 1024 + tid * 16) = (u32x4){0u, 0u, 0u, 0u};
    __syncthreads();
    int iter = 0;
    for (int tl = blockIdx.x; tl < ntile; tl += gridDim.x, ++iter) {
        const int r0 = tl * 32;
#pragma unroll 1
        for (int i = 0; i < 4; ++i) { const int rl = 4 * w + i, r = r0 + rl;
            const int mrow = (r < TL) ? (r >> 13) : 4; const float* mod = MOD + ((size_t)l * 5 + mrow) * 6144;
            const float* xin = (l == 0) ? ((r < TL) ? p.x + (size_t)r * 1024 : p.ctx + (size_t)(r - TL) * 1024) : XB + (size_t)r * 1024;
            f32x4 v[4]; row_load(xin, lane, v);
#pragma unroll
            for (int q = 0; q < 4; ++q) { const u32x2 dw = *(const u32x2*)(DELTA + (size_t)r * 1024 + q * 256 + lane * 4);
                v[q][0] += bf2f(dw.x & 0xffffu); v[q][1] += bf2f(dw.x >> 16); v[q][2] += bf2f(dw.y & 0xffffu); v[q][3] += bf2f(dw.y >> 16);
                *(f32x4*)(XA + (size_t)r * 1024 + q * 256 + lane * 4) = v[q]; }
            const float rstd = row_rstd(v);
            row_modulate(v, rstd, p.g_norm2 + l * 1024, mod + 4 * 1024, mod + 3 * 1024, lane);
            row_store_fp8(H2F + (size_t)r * 1024, lane, v);
#pragma unroll
            for (int q = 0; q < 4; ++q) *(LAS f32x4*)(HT + rl * HROW + q * 256 + lane * 4) = v[q]; }
        __syncthreads();
        f32x16 acc = zero16();
#pragma unroll 2
        for (int ks = 0; ks < 8; ++ks) { const int k0 = 128 * w + 16 * ks + 8 * hh;
            const f32x4 x0 = *(const LAS f32x4*)(HT + l31 * HROW + k0), x1 = *(const LAS f32x4*)(HT + l31 * HROW + k0 + 4);
            u32x4 ah, alo; float hf[8] = {x0[0], x0[1], x0[2], x0[3], x1[0], x1[1], x1[2], x1[3]};
#pragma unroll
            for (int q = 0; q < 4; ++q) { const unsigned hp = pk2(hf[2 * q], hf[2 * q + 1]); ah[q] = hp; alo[q] = pk2(hf[2 * q] - bf2f(hp & 0xffffu), hf[2 * q + 1] - bf2f(hp >> 16)); }
            const bf16x8 bh = *(const bf16x8*)(WRT + (size_t)l31 * 1024 + k0), bl = *(const bf16x8*)(WRT + (size_t)(32 + l31) * 1024 + k0);
            acc = mfma32(as_bf16x8(ah), bh, acc); acc = mfma32(as_bf16x8(alo), bh, acc); acc = mfma32(as_bf16x8(ah), bl, acc); }
        __syncthreads();
#pragma unroll
        for (int r = 0; r < 16; ++r) RED[(w * 32 + (r & 3) + 8 * (r >> 2) + 4 * hh) * 33 + l31] = acc[r];
        __syncthreads();
#pragma unroll 1
        for (int i = 0; i < 4; ++i) { const int rl = 4 * w + i, r = r0 + rl;
            float v = NEG_INF;
            if (lane < 32) { v = p.b_router[l * 32 + lane];
#pragma unroll
                for (int ww = 0; ww < 8; ++ww) v += RED[(ww * 32 + rl) * 33 + lane]; }
            float tv[4]; int te[4];
#pragma unroll
            for (int k = 0; k < 4; ++k) { float bv = v; int bi = lane;
#pragma unroll
                for (int d = 32; d >= 1; d >>= 1) { const float ov = __shfl_xor(bv, d); const int oi = __shfl_xor(bi, d); if (ov > bv || (ov == bv && oi < bi)) { bv = ov; bi = oi; } }
                tv[k] = bv; te[k] = bi; if (lane == bi) v = NEG_INF; }
            if (lane < 4) { const float e0 = 1.0f, e1 = fexp(tv[1] - tv[0]), e2 = fexp(tv[2] - tv[0]), e3 = fexp(tv[3] - tv[0]); const float inv = 1.0f / (e0 + e1 + e2 + e3);
                const float g = (lane == 0 ? e0 : lane == 1 ? e1 : lane == 2 ? e2 : e3) * inv; const int e = (lane == 0 ? te[0] : lane == 1 ? te[1] : lane == 2 ? te[2] : te[3]);
                const int a = r * 4 + lane; GATE[a] = g;
                const int lr = __hip_atomic_fetch_add(&LCNT[e], 1, __ATOMIC_RELAXED, __HIP_MEMORY_SCOPE_WORKGROUP); const int pi = iter * 128 + rl * 4 + lane; PA[pi] = a; PE[pi] = (e << 16) | lr; }
        }
        __syncthreads();
    }
    if (tid < 32) LBASE[tid] = (int)__hip_atomic_fetch_add(ctl + CTL_CNT(l, tid), (unsigned)LCNT[tid], __ATOMIC_RELAXED, __HIP_MEMORY_SCOPE_AGENT);
    __syncthreads();
    for (int i = tid; i < iter * 128; i += NTHR) { const int pe = PE[i], e = pe >> 16, lr = pe & 0xffff; LIST[(size_t)e * NASSIGN + LBASE[e] + lr] = PA[i]; }
    __syncthreads();
}

__device__ __forceinline__ void phase_gather(int wv, const Params& p, int l, LAS unsigned char* lds) {
    const int tid = otid(wv), lane = tid & 63, gw = blockIdx.x * NWAVE + (tid >> 6), nw = gridDim.x * NWAVE;
    unsigned char* ws = opq(p.ws);
    const unsigned* ctl = (const unsigned*)(ws + WS_CTL); int* SLOTT = (int*)(ws + WS_SLOTT);
    const int* LIST = (const int*)(ws + WS_LIST); const float* GATE = (const float*)(ws + WS_GATE);
    int* SLOTA = (int*)(ws + WS_SLOTA); float* SLOTG = (float*)(ws + WS_SLOTG); int* TILEE = (int*)(ws + WS_TILEE);
    LAS int* CNT = (LAS int*)lds; LAS int* PST = CNT + 32;
    constexpr int NASSIGN = TA * 4;
    if (tid < 32) CNT[tid] = (int)__hip_atomic_load(ctl + CTL_CNT(l, tid), __ATOMIC_RELAXED, __HIP_MEMORY_SCOPE_AGENT);
    __syncthreads();
    if (tid == 0) { int s = 0; for (int e = 0; e < 32; ++e) { PST[e] = s; s += (CNT[e] + 255) & ~255; } PST[32] = s; }
    __syncthreads();
    const int nslot = PST[32], ntiles = nslot >> 8;
    if (blockIdx.x == 0) { for (int t = tid; t < ntiles; t += NTHR) { int e = 0; for (int j = 1; j < 32; ++j) if (PST[j] <= t * 256) e = j; TILEE[t] = e; } if (tid == 0) TILEE[MAXTILE] = ntiles; }
    for (int s = blockIdx.x * NTHR + tid; s < nslot; s += gridDim.x * NTHR) {
        int e = 0;
#pragma unroll
        for (int j = 1; j < 32; ++j) if (PST[j] <= s) e = j;
        const int r = s - PST[e];
        int a = -1;
        if (r < CNT[e]) a = LIST[(size_t)e * NASSIGN + r];
        SLOTA[s] = a; SLOTG[s] = (a >= 0) ? GATE[a] : 0.f; SLOTT[s] = (a >= 0) ? (a >> 2) : TA;
    }
}

#define XB_TMO      128
#define XB_XCNT(j)  (256  + 64 * (j))
#define XB_XSUB(j)  (1280 + 64 * (j))
#define XB_XGEN(j)  (2304 + 64 * (j))
#define XB_TOP      3328
#define XB_TOPGEN   3392
#define XCD_BAR_WORDS 3456
#define XB_SPIN_CAP (1u << 18)
__device__ __forceinline__ unsigned xb_ld(unsigned* p)              { return __hip_atomic_load(p, __ATOMIC_RELAXED, __HIP_MEMORY_SCOPE_AGENT); }
__device__ __forceinline__ unsigned xb_add(unsigned* p, unsigned v) { return __hip_atomic_fetch_add(p, v, __ATOMIC_RELAXED, __HIP_MEMORY_SCOPE_AGENT); }
__device__ __forceinline__ unsigned xb_xcc_id() { return (unsigned)__builtin_amdgcn_s_getreg((3 << 11) | 20) & 0xFu; }
#define XB_SPIN(cond, bar) do { unsigned _sp = 0; while (cond) { __builtin_amdgcn_s_sleep(1); \
    if ((++_sp & 255u) == 0u) { if (xb_ld(&(bar)[XB_TMO])) break; if (_sp > XB_SPIN_CAP) { atomicAdd(&(bar)[XB_TMO], 1u); break; } } } } while (0)
struct XcdBarrier { unsigned* bar; unsigned x; volatile LAS unsigned* st; };
__device__ __forceinline__ XcdBarrier xcd_barrier_post(int tid, unsigned* bar, volatile LAS unsigned* st) {
    XcdBarrier b; b.bar = bar; b.x = xb_xcc_id(); b.st = st;
    if (tid == 0) st[2] = xb_add(&bar[XB_XCNT(b.x)], 1u);
    return b;
}
__device__ __forceinline__ void xcd_barrier_complete(unsigned* bar, unsigned x, unsigned& nloc, unsigned& nx) {
    const unsigned G = gridDim.x * gridDim.y * gridDim.z;
    unsigned sum, cnt, mine, sp = 0u;
    for (;;) {
        sum = 0u; cnt = 0u; mine = 0u;
#pragma unroll
        for (unsigned j = 0; j < 16; ++j) { const unsigned c = xb_ld(&bar[XB_XCNT(j)]); sum += c; cnt += (c > 0u) ? 1u : 0u; mine = (j == x) ? c : mine; }
        if (sum == G) break;
        __builtin_amdgcn_s_sleep(1);
        if ((++sp & 255u) == 0u) { if (xb_ld(&bar[XB_TMO])) break; if (sp > XB_SPIN_CAP) { atomicAdd(&bar[XB_TMO], 1u); break; } }
    }
    nloc = mine > 0u ? mine : 1u; nx = cnt > 0u ? cnt : 1u;
}
__device__ __forceinline__ void xcd_barrier(int wv, const XcdBarrier& b) {
    asm volatile("s_waitcnt vmcnt(0)" ::: "memory");
    __syncthreads();
    if (otid(wv) == 0) {
        unsigned* bar = b.bar;
        __builtin_amdgcn_s_waitcnt(0);
        unsigned nloc = b.st[0], nx = b.st[1];
        if (nloc == 0u) { xcd_barrier_complete(bar, b.x, nloc, nx); b.st[0] = nloc; b.st[1] = nx; }
        const unsigned old = xb_add(&bar[XB_XSUB(b.x)], 1u);
        const unsigned gen = old / nloc;
        if (old + 1u == (gen + 1u) * nloc) {
            __builtin_amdgcn_fence(__ATOMIC_RELEASE, "agent");
            asm volatile("s_waitcnt vmcnt(0)" ::: "memory");
            const unsigned og = xb_add(&bar[XB_TOP], 1u);
            const unsigned tg = og / nx;
            if (og + 1u == (tg + 1u) * nx) xb_add(&bar[XB_TOPGEN], 1u);
            else XB_SPIN(xb_ld(&bar[XB_TOPGEN]) == tg, bar);
            __builtin_amdgcn_fence(__ATOMIC_ACQUIRE, "agent");
            xb_add(&bar[XB_XGEN(b.x)], 1u);
            asm volatile("s_waitcnt vmcnt(0)" ::: "memory");
        } else {
            XB_SPIN(xb_ld(&bar[XB_XGEN(b.x)]) == gen, bar);
            __builtin_amdgcn_fence(__ATOMIC_ACQUIRE, "agent");
            asm volatile("s_waitcnt vmcnt(0)" ::: "memory");
        }
    }
    __syncthreads();
}

constexpr int NPHASE = 23;
extern __shared__ __attribute__((aligned(16))) unsigned char smem_raw[];

#ifndef EN_MASK
#define EN_MASK 0xFFF
#endif
#define EN(k) ((EN_MASK >> (k)) & 1)
#ifndef PROBE_REP
#define PROBE_REP -1
#endif
#define RUN(id) ((id) >= p.phase_lo && (id) < p.phase_hi)
#define SYNC() do { if (p.use_bar) xcd_barrier(wv, bar); } while (0)
template <int l>
__device__ __forceinline__ void run_layer(int wv, const Params& p, LAS unsigned char* lds, const XcdBarrier& bar) {
    unsigned char* ws = opq(p.ws);
    const int cid = __builtin_amdgcn_readfirstlane(*(const LAS int*)(lds + LDS_MISC + 68));
        const int pb = 1 + 11 * l;
        const int T = (l == 0) ? TA : TL;
        if (l == 0) { if (EN(0) && RUN(pb + 0)) phase_norm1_l0(wv, p); SYNC(); if (PROBE_REP == 0) { phase_norm1_l0(wv, p); SYNC(); } }
        if (EN(1) && RUN(pb + 1)) {
            pg8::Gemm g{(const bf16_t*)(ws + WS_HB), (const bf16_t*)(ws + WS_WIN) + (size_t)l * NP * 1024, TA, NP, 1024};
            pg8::StaticOrder S; S.init(TA, NP, gridDim.x, cid);
            EpiStoreBf16 E{(bf16_t*)(ws + WS_P), NP};
            pg8::gemm_phase(wv, lds, g, S, E, nullptr);
        }
        if (PROBE_REP == 21 && l == 0) {
            SYNC();
            struct SameTile : pg8::StaticOrder { __device__ __forceinline__ bool next(int i, pg8::Unit& u) const { pg8::Unit t; const bool ok = pg8::StaticOrder::next(i, t); u.pm = 0; u.pn = 0; return ok; } };
            pg8::Gemm g{(const bf16_t*)(ws + WS_HB), (const bf16_t*)(ws + WS_WIN), TA, NP, 1024};
            SameTile S; S.init(TA, NP, gridDim.x, cid);
            EpiStoreBf16 E{(bf16_t*)(ws + WS_XS), NP};
            pg8::gemm_phase(wv, lds, g, S, E, nullptr);
        }
        if (PROBE_REP == 22 && l == 0) {
            SYNC();
            pg8::Gemm g{(const bf16_t*)(ws + WS_HB), (const bf16_t*)(ws + WS_WIN), TA, NP, 1024};
            pg8::StaticOrder S; S.init(TA, NP, gridDim.x, cid);
            EpiStoreBf16 E{(bf16_t*)(ws + WS_XS), NP};
            pg8::gemm_phase(wv, lds, g, S, E, nullptr);
        }
        SYNC();
        if (EN(2) && RUN(pb + 2)) phase_prep(wv, p, l, lds);
        if (PROBE_REP == 2 && l == 0) { SYNC(); if (PROBE_MIX & 1) prep_elem(wv, p, l, lds); __syncthreads(); if (PROBE_MIX & 2) prep_state(wv, p, l, lds); }
        SYNC();
        if (EN(3) && RUN(pb + 3)) phase_scan(wv, p, lds);
        if (PROBE_REP == 3 && l == 0) { SYNC(); phase_scan(wv, p, lds); }
        SYNC();
        if (EN(4) && RUN(pb + 4)) phase_mixers(wv, p, l, lds);
        if (PROBE_REP == 4 && l == 0) { SYNC(); phase_mixers_probe(wv, p, l, lds); }
        SYNC();
        if (EN(5) && RUN(pb + 5)) {
            pg8::Gemm g{(const bf16_t*)(ws + WS_YMIX), (const bf16_t*)(ws + WS_WOUT + (size_t)l * 1024 * 1024 * (YM_FP8 ? 1 : 2)), T, 1024, YM_FP8 ? 512 : 1024};
            pg8::StaticOrder S; S.init(T, 1024, gridDim.x, cid);
            const float* MOD = (const float*)(ws + WS_MOD);
            EpiDelta E{(bf16_t*)(ws + WS_HB), MOD + (size_t)l * 5 * 6144 + 2 * 1024, YM_FP8 ? 0.03125f : 1.0f};
            pg8::gemm_phase<EpiDelta, pg8::StaticOrder, false, YM_FP8 != 0>(wv, lds, g, S, E, nullptr);
        }
        SYNC();
        if (PROBE_REP == 25 && l == 0) {
            pg8::Gemm g{(const bf16_t*)(ws + WS_YMIX), (const bf16_t*)(ws + WS_WOUT + (size_t)l * 1024 * 1024 * (YM_FP8 ? 1 : 2)), T, 1024, YM_FP8 ? 512 : 1024};
            pg8::StaticOrder S; S.init(T, 1024, gridDim.x, cid);
            const float* MOD = (const float*)(ws + WS_MOD);
            EpiDelta E{(bf16_t*)(ws + WS_HB), MOD + (size_t)l * 5 * 6144 + 2 * 1024, YM_FP8 ? 0.03125f : 1.0f};
            pg8::gemm_phase<EpiDelta, pg8::StaticOrder, false, YM_FP8 != 0>(wv, lds, g, S, E, nullptr);
            SYNC();
        }
        if (EN(6) && RUN(pb + 6)) phase_router(wv, p, l, lds);
        SYNC();
        if (EN(7) && RUN(pb + 7)) phase_gather(wv, p, l, lds);
        if (PROBE_REP == 7 && l == 0) { SYNC(); phase_gather(wv, p, l, lds); }
        SYNC();
        if (EN(8) && RUN(pb + 8)) {
            const int* TILEE = (const int*)(ws + WS_TILEE);
            pg8::Gemm g{(const bf16_t*)(ws + WS_H2B), (const bf16_t*)(ws + WS_WGU + (size_t)l * 32 * 2048 * 1024), MAXSLOT, 32 * 2048, 512, (const int*)(ws + WS_SLOTT)};
            MoeOrder S{TILEE, __builtin_amdgcn_readfirstlane(TILEE[MAXTILE]), 8, (int)gridDim.x, cid};
            EpiGU E{ws + WS_ACT, p.b_gu + (size_t)l * 32 * 2048};
            pg8::gemm_phase<EpiGU, MoeOrder, false, true, true>(wv, lds, g, S, E, nullptr);
        }
        SYNC();
        if (PROBE_REP == 23 && l == 0) {
            const int* TILEE = (const int*)(ws + WS_TILEE);
            pg8::Gemm g{(const bf16_t*)(ws + WS_H2B), (const bf16_t*)(ws + WS_WGU + (size_t)l * 32 * 2048 * 1024), MAXSLOT, 32 * 2048, 512, (const int*)(ws + WS_SLOTT)};
            MoeOrder S{TILEE, __builtin_amdgcn_readfirstlane(TILEE[MAXTILE]), 8, (int)gridDim.x, cid};
            EpiGU E{ws + WS_ACT, p.b_gu + (size_t)l * 32 * 2048};
            pg8::gemm_phase<EpiGU, MoeOrder, false, true, true>(wv, lds, g, S, E, nullptr);
            SYNC();
        }
        if (EN(9) && RUN(pb + 9)) {
            const int* TILEE = (const int*)(ws + WS_TILEE);
            pg8::Gemm g{(const bf16_t*)(ws + WS_ACT), (const bf16_t*)(ws + WS_WDN + (size_t)l * 32 * 1024 * 1024), MAXSLOT, 32 * 1024, 512};
            MoeOrder S{TILEE, __builtin_amdgcn_readfirstlane(TILEE[MAXTILE]), 4, (int)gridDim.x, cid};
            EpiDown E{(bf16_t*)(ws + WS_Y), p.b_down + (size_t)l * 32 * 1024, (const int*)(ws + WS_SLOTA), (const float*)(ws + WS_SLOTG)};
            pg8::gemm_phase<EpiDown, MoeOrder, false, true>(wv, lds, g, S, E, nullptr);
        }
        SYNC();
        if (PROBE_REP == 24 && l == 0) {
            const int* TILEE = (const int*)(ws + WS_TILEE);
            pg8::Gemm g{(const bf16_t*)(ws + WS_ACT), (const bf16_t*)(ws + WS_WDN + (size_t)l * 32 * 1024 * 1024), MAXSLOT, 32 * 1024, 512};
            MoeOrder S{TILEE, __builtin_amdgcn_readfirstlane(TILEE[MAXTILE]), 4, (int)gridDim.x, cid};
            EpiDown E{(bf16_t*)(ws + WS_Y), p.b_down + (size_t)l * 32 * 1024, (const int*)(ws + WS_SLOTA), (const float*)(ws + WS_SLOTG)};
            pg8::gemm_phase<EpiDown, MoeOrder, false, true>(wv, lds, g, S, E, nullptr);
            SYNC();
        }
        if (EN(10) && RUN(pb + 10)) phase_combine(wv, p, l);
        if (PROBE_REP == 10 && l == 0) { SYNC(); phase_combine(wv, p, l); }
        if (l == 0) SYNC();
    }

__global__ void __launch_bounds__(NTHR, 2) mk_forward(Params p) {
    LAS unsigned char* lds = (LAS unsigned char*)smem_raw;
    const int wv = __builtin_amdgcn_readfirstlane((int)threadIdx.x >> 6);
    { const int t0 = otid(wv); if (t0 < 32) ((LAS unsigned*)(lds + LDS_MISC))[t0] = 0u; }
    __syncthreads();
    unsigned* ctl = (unsigned*)(p.ws + WS_CTL);
    XcdBarrier bar; bar.bar = ctl; bar.x = 0; bar.st = (volatile LAS unsigned*)(lds + LDS_MISC);
    if (p.use_bar) bar = xcd_barrier_post(otid(wv), ctl, (volatile LAS unsigned*)(lds + LDS_MISC));
    if (EN(11) && RUN(0)) phase_prologue(wv, p, lds);
    SYNC();
    if (PROBE_REP == 11) { phase_prologue(wv, p, lds); SYNC(); }
    if (otid(wv) == 0) { LAS unsigned* ms = (LAS unsigned*)(lds + LDS_MISC); unsigned cid = blockIdx.x;
        if (p.use_bar) { bool ok = (gridDim.x & 7u) == 0u;
            for (unsigned j = 0; j < 16; ++j) { const unsigned c = xb_ld(&ctl[XB_XCNT(j)]); ok = ok && (c == (j < 8 ? gridDim.x >> 3 : 0u)); }
            if (ok) cid = ms[2] * 8u + bar.x; }
        ms[17] = cid; ms[18] = cid & 7u; }
    __syncthreads();
    run_layer<0>(wv, p, lds, bar);
    run_layer<1>(wv, p, lds, bar);
}
#undef RUN
#undef SYNC

extern "C" void kernel_launch(void* const* d_in, const int* in_sizes, int n_in, void* d_out, int out_size, void* d_ws, size_t ws_size, hipStream_t stream) {
    static int grid = 0;
    if (grid == 0) {
        if (n_in != 25 || ws_size < WS_END) { fprintf(stderr, "kernel_launch: expected 25 inputs and >= %zu bytes of workspace, got %d inputs, %zu bytes; nothing launched\n", (size_t)WS_END, n_in, ws_size); grid = -1; return; }
        int dev = 0, cus = 0, per_cu = 0;
        hipGetDevice(&dev); hipDeviceGetAttribute(&cus, hipDeviceAttributeMultiprocessorCount, dev);
        if (hipFuncSetAttribute((const void*)mk_forward, hipFuncAttributeMaxDynamicSharedMemorySize, LDS_BYTES) != hipSuccess) { fprintf(stderr, "kernel_launch: hipFuncSetAttribute failed\n"); grid = -1; return; }
        hipOccupancyMaxActiveBlocksPerMultiprocessor(&per_cu, (const void*)mk_forward, NTHR, LDS_BYTES);
        if (per_cu < 1) fprintf(stderr, "kernel_launch: occupancy query reports %d workgroups per CU\n", per_cu);
        grid = cus > 0 ? cus : 256;
    }
    if (grid < 0) return;
    Params p{};
    const float** pp = (const float**)&p;
    for (int i = 0; i < 25; ++i) pp[i] = (const float*)d_in[i];
    p.out = (float*)d_out; p.ws = (unsigned char*)d_ws; p.pad0 = 0;
    hipMemsetAsync((unsigned char*)d_ws + WS_CTL, 0, CTL_BYTES, stream);
#if MK_LAUNCHES == 1
    p.phase_lo = 0; p.phase_hi = NPHASE; p.use_bar = 1;
    hipLaunchKernelGGL(mk_forward, dim3(grid), dim3(NTHR), LDS_BYTES, stream, p);
#else
    for (int ph = 0; ph < NPHASE; ++ph) { if (ph == 12) continue;
        p.phase_lo = ph; p.phase_hi = ph + 1; p.use_bar = 0;
        hipLaunchKernelGGL(mk_forward, dim3(grid), dim3(NTHR), LDS_BYTES, stream, p); }
#endif
}
```

```cpp
#include <hip/hip_runtime.h>
#include <cstdio>
#include <cstdint>

#ifndef MK_LAUNCHES
#define MK_LAUNCHES 1
#endif
#ifndef MK_CHECK
#define MK_CHECK 0
#endif

typedef unsigned short bf16_t;
typedef short bf16x8 __attribute__((ext_vector_type(8)));
typedef short s16x4 __attribute__((ext_vector_type(4)));
typedef float f32x4 __attribute__((ext_vector_type(4)));
typedef float f32x16 __attribute__((ext_vector_type(16)));
typedef unsigned u32x4 __attribute__((ext_vector_type(4)));
typedef unsigned u32x2 __attribute__((ext_vector_type(2)));
#define LAS __attribute__((address_space(3)))

constexpr int NTHR = 512, NWAVE = 8;
constexpr int DM = 1024, NBATCH = 4, SEQ = 8192, CTXL = 256, TL = NBATCH * SEQ, TC = NBATCH * CTXL, TA = TL + TC;
constexpr int NP = 3584;
constexpr int PC_AQ = 0, PC_AK = 256, PC_AV = 384, PC_BQ = 512, PC_BK = 768, PC_BV = 1024, PC_CQK = 1280, PC_CV = 1792, PC_CO = 2048, PC_CG = 2304,
              PC_DCQ = 2320, PC_DCKV = 2512, PC_DKR = 2640, PC_DQF = 2672, PC_DKVF = 3056, PC_END = 3568;
constexpr int INC = 2672;
constexpr int NEXP = 32, MAXSLOT = 143360, MAXTILE = MAXSLOT / 256;
constexpr int NCHUNK = 132;
constexpr int NCU = NBATCH * NCHUNK * 4 * 2;
constexpr float LOG2E = 1.4426950408889634f;
constexpr float EPS = 1e-6f;

constexpr int LDS_BYTES = 147456;
constexpr int LDS_MISC = LDS_BYTES - 256;

constexpr size_t al256(size_t x) { return (x + 255) & ~(size_t)255; }
constexpr size_t WS_CTL = 0, CTL_BYTES = 65536;
constexpr size_t WS_MOD = WS_CTL + CTL_BYTES;
constexpr size_t WS_RA = al256(WS_MOD + (size_t)2 * 5 * 6144 * 4);
constexpr size_t WS_RD = al256(WS_RA + (size_t)SEQ * 32 * 8);
constexpr size_t WS_WIN = al256(WS_RD + (size_t)SEQ * 16 * 8);
constexpr size_t WS_WOUT = al256(WS_WIN + (size_t)2 * NP * 1024 * 2);
constexpr size_t WS_WGU = al256(WS_WOUT + (size_t)2 * 1024 * 1024 * 2);
constexpr size_t WS_WDN = al256(WS_WGU + (size_t)2 * 32 * 2048 * 1024 * 2);
constexpr size_t WS_WRT = al256(WS_WDN + (size_t)2 * 32 * 1024 * 1024 * 2);
constexpr size_t WS_HB = al256(WS_WRT + (size_t)2 * 2 * 32 * 1024 * 2);
constexpr size_t WS_H2B = al256(WS_HB + (size_t)TA * 1024 * 2);
constexpr size_t WS_P = al256(WS_H2B + (size_t)TA * 1024 * 2);
constexpr size_t WS_QA = al256(WS_P + (size_t)TA * NP * 2);
constexpr size_t WS_KA = al256(WS_QA + (size_t)TA * 256 * 2);
constexpr size_t WS_QD = al256(WS_KA + (size_t)TA * 128 * 2);
constexpr size_t WS_KD = al256(WS_QD + (size_t)TA * 384 * 2);
constexpr size_t WS_VD = al256(WS_KD + (size_t)TA * 384 * 2);
constexpr size_t WS_QC = al256(WS_VD + (size_t)TA * 256 * 2);
constexpr size_t WS_KC = al256(WS_QC + (size_t)TA * 256 * 2);
constexpr size_t WS_MIXEND = al256(WS_KC + (size_t)TA * 256 * 2);
constexpr size_t WS_ACT = WS_P;
static_assert(WS_MIXEND - WS_P >= (size_t)MAXSLOT * 1024 * 2, "ACT alias");
constexpr size_t WS_GATES = WS_MIXEND;
constexpr size_t WS_DC = al256(WS_GATES + (size_t)TA * 16 * 4);
constexpr size_t WS_DN = al256(WS_DC + (size_t)NCU * 4096 * 4);
constexpr size_t WS_DFA = al256(WS_DN + (size_t)NCU * 64 * 4);
constexpr size_t WS_CS = al256(WS_DFA + (size_t)NCU * 2 * 4);
constexpr size_t WS_NS = al256(WS_CS + (size_t)NCU * 4096 * 2);
constexpr size_t WS_MS = al256(WS_NS + (size_t)NCU * 64 * 4);
constexpr size_t WS_YMIX = al256(WS_MS + (size_t)NCU * 4);
constexpr size_t WS_XA = al256(WS_YMIX + (size_t)TA * 1024 * 2);
constexpr size_t WS_XB = al256(WS_XA + (size_t)TA * 1024 * 4);
constexpr size_t WS_GATE = al256(WS_XB + (size_t)TA * 1024 * 4);
constexpr size_t WS_LIST = al256(WS_GATE + (size_t)TA * 4 * 4);
constexpr size_t WS_SLOTA = al256(WS_LIST + (size_t)32 * TA * 4 * 4);
constexpr size_t WS_SLOTG = al256(WS_SLOTA + (size_t)MAXSLOT * 4);
constexpr size_t WS_SLOTT = al256(WS_SLOTG + (size_t)MAXSLOT * 4);
constexpr size_t WS_TILEE = al256(WS_SLOTT + (size_t)MAXSLOT * 4);
constexpr size_t WS_XS = al256(WS_TILEE + (size_t)(MAXTILE + 64) * 4);
constexpr size_t WS_Y = WS_XS;
constexpr size_t WS_DBG = al256(WS_XS + (size_t)MAXSLOT * 1024 * 2);
constexpr size_t WS_END = WS_DBG + 65536;

#define CTL_Q(l, q, x) (4096 + (((l) * 8 + (q)) * 8 + (x)) * 64)
#define CTL_CNT(l, e) (12288 + (l) * 2048 + (e) * 64)

struct Params {
    const float *x, *c, *ctx, *c_ctx, *w_ada, *b_ada, *g_norm1, *g_norm2, *w_in, *attn_sink, *nat_rpb, *mlstm_conv, *mlstm_gate_bias,
                *mla_g_q, *mla_w_uq, *mla_g_kv, *mla_w_ukv, *w_out, *w_router, *b_router, *w_gu, *b_gu, *w_down, *b_down, *g_final;
    float* out;
    unsigned char* ws;
    int phase_lo, phase_hi, use_bar, pad0;
};

__device__ __forceinline__ int otid(int wv) { int t = wv * 64 + (int)__builtin_amdgcn_mbcnt_hi(~0u, __builtin_amdgcn_mbcnt_lo(~0u, 0u)); asm volatile("" : "+v"(t)); return t; }
__device__ __forceinline__ unsigned char* opq(unsigned char* q) { asm volatile("" : "+s"(q)); return q; }
#ifndef YM_FP8
#define YM_FP8 0
#endif
#if YM_FP8
typedef unsigned char ym_t;
#else
typedef unsigned short ym_t;
#endif
__device__ __forceinline__ float bf2f(unsigned b) { return __uint_as_float(b << 16); }
typedef __bf16 bf16v2_t __attribute__((ext_vector_type(2)));
typedef float f32v2_t __attribute__((ext_vector_type(2)));
__device__ __forceinline__ unsigned pk2(float lo, float hi) { const f32v2_t f = {lo, hi}; const bf16v2_t v = __builtin_convertvector(f, bf16v2_t); return __builtin_bit_cast(unsigned, v); }
__device__ __forceinline__ unsigned pk_fp8x4(float a, float b, float c, float d) { int r = 0; r = __builtin_amdgcn_cvt_pk_fp8_f32(a, b, r, false); r = __builtin_amdgcn_cvt_pk_fp8_f32(c, d, r, true); return (unsigned)r; }
__device__ __forceinline__ unsigned pk_fp8x4(float a, float b, float c, float d);
__device__ __forceinline__ void ym_store4(ym_t* p, float a, float b, float c, float d) {
#if YM_FP8
    *(unsigned*)p = pk_fp8x4(a, b, c, d);
#else
    u32x2 w; w.x = pk2(a, b); w.y = pk2(c, d); *(u32x2*)p = w;
#endif
}
__device__ __forceinline__ unsigned short f2bf(float f) { return (unsigned short)(pk2(f, 0.f) & 0xffffu); }
__device__ __forceinline__ float fexp2(float x) { return __builtin_amdgcn_exp2f(x); }
__device__ __forceinline__ float fexp(float x) { return __builtin_amdgcn_exp2f(x * LOG2E); }
__device__ __forceinline__ float wave_sum(float v) {
#pragma unroll
    for (int d = 32; d >= 1; d >>= 1) v += __shfl_xor(v, d);
    return v;
}
__device__ __forceinline__ float wave_max(float v) {
#pragma unroll
    for (int d = 32; d >= 1; d >>= 1) v = fmaxf(v, __shfl_xor(v, d));
    return v;
}
__device__ __forceinline__ float wave_incl_sum(float v, int lane) {
#pragma unroll
    for (int d = 1; d < 64; d <<= 1) { const float t = __shfl_up(v, d); if (lane >= d) v += t; }
    return v;
}
__device__ __forceinline__ float wave_incl_max(float v, int lane) {
#pragma unroll
    for (int d = 1; d < 64; d <<= 1) { const float t = __shfl_up(v, d); if (lane >= d) v = fmaxf(v, t); }
    return v;
}
__device__ __forceinline__ f32x16 mfma32(bf16x8 a, bf16x8 b, f32x16 c) { return __builtin_amdgcn_mfma_f32_32x32x16_bf16(a, b, c, 0, 0, 0); }
__device__ __forceinline__ f32x16 zero16() { f32x16 z;
#pragma unroll
    for (int i = 0; i < 16; ++i) z[i] = 0.f;
    return z; }
__device__ __forceinline__ s16x4 tr_read(LAS unsigned char* p) { return __builtin_amdgcn_ds_read_tr16_b64_v4i16((LAS s16x4*)p); }
__device__ __forceinline__ bf16x8 cat8(s16x4 a, s16x4 b) { return __builtin_shufflevector(a, b, 0, 1, 2, 3, 4, 5, 6, 7); }
__device__ __forceinline__ bf16x8 as_bf16x8(u32x4 v) { return __builtin_bit_cast(bf16x8, v); }
__device__ __forceinline__ float sigmoidf_(float x) { return 1.0f / (1.0f + fexp(-x)); }
__device__ __forceinline__ float siluf_(float x) { return x * sigmoidf_(x); }

__device__ __forceinline__ void row_load(const float* row, int lane, f32x4 (&v)[4]) {
#pragma unroll
    for (int i = 0; i < 4; ++i) v[i] = *(const f32x4*)(row + i * 256 + lane * 4);
}
__device__ __forceinline__ float row_rstd(const f32x4 (&v)[4]) {
    float s = 0.f;
#pragma unroll
    for (int i = 0; i < 4; ++i) s += v[i][0] * v[i][0] + v[i][1] * v[i][1] + v[i][2] * v[i][2] + v[i][3] * v[i][3];
    s = wave_sum(s);
    return rsqrtf(s * (1.0f / 1024.0f) + EPS);
}
__device__ __forceinline__ void row_modulate(f32x4 (&v)[4], float rstd, const float* g, const float* sc, const float* sh, int lane) {
#pragma unroll
    for (int i = 0; i < 4; ++i) {
        const f32x4 gg = *(const f32x4*)(g + i * 256 + lane * 4), s1 = *(const f32x4*)(sc + i * 256 + lane * 4), s0 = *(const f32x4*)(sh + i * 256 + lane * 4);
#pragma unroll
        for (int j = 0; j < 4; ++j) v[i][j] = (v[i][j] * rstd * gg[j]) * (1.0f + s1[j]) + s0[j];
    }
}
__device__ __forceinline__ void row_store_fp8(unsigned char* row, int lane, const f32x4 (&v)[4]) {
#pragma unroll
    for (int i = 0; i < 4; ++i) *(unsigned*)(row + i * 256 + lane * 4) = pk_fp8x4(v[i][0], v[i][1], v[i][2], v[i][3]);
}
__device__ __forceinline__ void row_store_bf16(bf16_t* row, int lane, const f32x4 (&v)[4]) {
#pragma unroll
    for (int i = 0; i < 4; ++i) { u32x2 w; w.x = pk2(v[i][0], v[i][1]); w.y = pk2(v[i][2], v[i][3]); *(u32x2*)(row + i * 256 + lane * 4) = w; }
}
namespace pg8 {
#define PG8_LAS __attribute__((address_space(3)))
typedef unsigned short bf16_t;
typedef short bf16x8 __attribute__((ext_vector_type(8)));
typedef float f32x4 __attribute__((ext_vector_type(4)));
typedef unsigned u32x4 __attribute__((ext_vector_type(4)));
constexpr int FP8_ONE = 0x7f7f7f7f;
constexpr int BM = 256, BK = 64, HALF = 128, HTB = HALF * BK * 2  , STAGE_BYTES = 8 * HTB, NXCD = 8, WGM = 8;

__host__ __device__ __forceinline__ int lds_byte(int r, int c) { const int st = (r >> 4) * 2 + (c >> 5), rr = r & 15, cc = c & 31, ob = rr * 64 + cc * 2; return st * 1024 + (ob ^ (((ob >> 9) & 1) << 5)); }
__host__ __device__ __forceinline__ void stage_rc(int b, int& R, int& C) { const int st = b / 1024, sb = b % 1024, swz = sb ^ (((sb >> 9) & 1) << 5); R = (st >> 1) * 16 + swz / 64; C = (st & 1) * 32 + (swz % 64) / 2; }
__host__ __device__ __forceinline__ int perm32(int rho) { const int n = rho >> 4, i = rho & 15; return 8 * (i >> 2) + 4 * n + (i & 3); }

struct Unit { int pm, pn; };
struct Gemm { const bf16_t* A; const bf16_t* Bt; int M, N, K; const int* rowmap; };

struct StaticOrder {
    int nM, nN, nwg, G, c;
    __host__ __device__ void init(int M, int N, int G_, int c_) { nM = M / BM; nN = N / BM; nwg = nM * nN; G = G_; c = c_; }
    __host__ __device__ bool next(int i, Unit& u) const {
        const long L = (long)i * G + c; if (L >= nwg) return false;
        int wgid = (int)L; { const int q = nwg / NXCD, r = nwg % NXCD, xcd = wgid % NXCD, off = wgid / NXCD; wgid = (xcd < r ? xcd * (q + 1) : r * (q + 1) + (xcd - r) * q) + off; }
        const int nig = WGM * nN, gid = wgid / nig, fm = gid * WGM, gsz = (nM - fm) < WGM ? (nM - fm) : WGM;
        u.pm = fm + ((wgid % nig) % gsz); u.pn = (wgid % nig) / gsz; return true;
    }
    __device__ __forceinline__ void a_ready(const Unit&) const {}
    __device__ __forceinline__ void done(const Unit&) const {}
};
template <class Epi, class Sched, bool STAMP = false, bool FP8 = false, bool GATHER = false>
__device__ __forceinline__ void gemm_phase(int wv, PG8_LAS unsigned char* lds, const Gemm g, const Sched& S, const Epi& E, unsigned long long* stamps) {
    const int tid = otid(wv), wid = __builtin_amdgcn_readfirstlane(tid >> 6), lane = tid & 63, wr = wid >> 2, wc = wid & 3, fr = lane & 15, fq = lane >> 4;
    const int K = g.K, nt = K / BK;
    int ts_lo = 0, ts_hi = 0, nts = 0; const unsigned long long rt_entry = STAMP ? (unsigned long long)wall_clock64() : 0ull;
#define PG8_STAMP() do { if (STAMP && wid == 0 && nts < 64) { const unsigned long long _c = (unsigned long long)clock64(); \
        ts_lo = (lane == nts) ? (int)(unsigned)_c : ts_lo; ts_hi = (lane == nts) ? (int)(unsigned)(_c >> 32) : ts_hi; ++nts; } } while (0)
    PG8_STAMP();
    unsigned voffA[2], voffB[2];
#pragma unroll
    for (int i = 0; i < 2; ++i) { int R, C; stage_rc(tid * 16 + i * 8192, R, C); const int Rb = Epi::PERM ? ((R & ~31) + perm32(R & 31)) : R;
        voffA[i] = (unsigned)(R * K + C) * 2u; voffB[i] = (unsigned)(Rb * K + C) * 2u; }
    int gR0, gC0; stage_rc(tid * 16, gR0, gC0);
    unsigned vAc[2][2], vAn[2][2];
#define PG8_ROWS(arr, unit) do { _Pragma("unroll") for (int h_ = 0; h_ < 2; ++h_) _Pragma("unroll") for (int i_ = 0; i_ < 2; ++i_) \
        arr[h_][i_] = (unsigned)g.rowmap[(unit).pm * BM + h_ * HALF + i_ * 64 + gR0] * (unsigned)(K * 2) + (unsigned)(gC0 * 2); } while (0)
    const char* const baseA = (const char*)g.A; const char* const baseB = (const char*)g.Bt;
    const __amdgpu_buffer_rsrc_t rsA = __builtin_amdgcn_make_buffer_rsrc((void*)g.A, 0, 0x7ffff000, 0x00020000), rsB = __builtin_amdgcn_make_buffer_rsrc((void*)g.Bt, 0, 0x7ffff000, 0x00020000);
    const unsigned row64 = (unsigned)(64 * K * 2);
    const size_t kstep = (size_t)(BK * 2);
    const size_t hstep = (size_t)HALF * K * 2;
    const size_t tstep = 2 * hstep;
    const unsigned ldsw = (unsigned)wid * 1024u;
    const int aoff = lds_byte(wr * 64 + fr, fq * 8), boff = lds_byte(wc * 32 + fr, fq * 8);
#define PG8_SA(b, h) (((b) * 2 + (h)) * HTB)
#define PG8_SB(b, h) ((4 + (b) * 2 + (h)) * HTB)
#define PG8_STG(bufoff, gbase, W) do { const unsigned so_ = (unsigned)__builtin_amdgcn_readfirstlane((int)((const char*)(gbase) - base##W)); _Pragma("unroll") for (int _i = 0; _i < 2; ++_i) \
        __builtin_amdgcn_raw_ptr_buffer_load_lds(rs##W, (PG8_LAS unsigned*)(lds + (bufoff) + ldsw + _i * 8192), 16, voff##W[_i], so_, 0, 0); } while (0)
#define PG8_STGA(b, h, kptr, arr) do { if constexpr (GATHER) { const unsigned so_ = (unsigned)__builtin_amdgcn_readfirstlane((int)((const char*)(kptr) - baseA)); _Pragma("unroll") for (int _i = 0; _i < 2; ++_i) \
        __builtin_amdgcn_raw_ptr_buffer_load_lds(rsA, (PG8_LAS unsigned*)(lds + PG8_SA(b, h) + ldsw + _i * 8192), 16, arr[h][_i], so_, 0, 0); } \
    else { PG8_STG(PG8_SA(b, h), (kptr) + (h) * hstep, A); } } while (0)
#define PG8_LDA(dst, b, h) do { _Pragma("unroll") for (int m = 0; m < 4; ++m) _Pragma("unroll") for (int k = 0; k < 2; ++k) dst[m][k] = *(const PG8_LAS bf16x8*)(lds + PG8_SA(b, h) + aoff + m * 2048 + k * 1024); } while (0)
#define PG8_LDB(dst, b, h) do { _Pragma("unroll") for (int n = 0; n < 2; ++n) _Pragma("unroll") for (int k = 0; k < 2; ++k) dst[n][k] = *(const PG8_LAS bf16x8*)(lds + PG8_SB(b, h) + boff + n * 2048 + k * 1024); } while (0)
#define PG8_MMA(ai, bj, At, Bt) do { __builtin_amdgcn_s_setprio(1); _Pragma("unroll") for (int m = 0; m < 4; ++m) _Pragma("unroll") for (int n = 0; n < 2; ++n) { \
        if constexpr (FP8) { typedef int i32x8_ __attribute__((ext_vector_type(8))); typedef int i32x4_ __attribute__((ext_vector_type(4))); \
            const i32x8_ bw = __builtin_shufflevector(__builtin_bit_cast(i32x4_, Bt[n][0]), __builtin_bit_cast(i32x4_, Bt[n][1]), 0, 1, 2, 3, 4, 5, 6, 7); \
            const i32x8_ aw = __builtin_shufflevector(__builtin_bit_cast(i32x4_, At[m][0]), __builtin_bit_cast(i32x4_, At[m][1]), 0, 1, 2, 3, 4, 5, 6, 7); \
            asm volatile("v_mfma_scale_f32_16x16x128_f8f6f4 %0, %1, %2, %0, %3, %3 op_sel_hi:[0,0,0]" : "+v"(acc[ai][bj][m][n]) : "v"(bw), "v"(aw), "v"(fp8_one)); } \
        else { _Pragma("unroll") for (int k = 0; k < 2; ++k) acc[ai][bj][m][n] = __builtin_amdgcn_mfma_f32_16x16x32_bf16(Bt[n][k], At[m][k], acc[ai][bj][m][n], 0, 0, 0); } } \
        __builtin_amdgcn_s_setprio(0); } while (0)
#define PG8_WAIT_V(n) asm volatile("s_waitcnt vmcnt(" #n ")" ::: "memory")
#define PG8_WAIT_L(n) asm volatile("s_waitcnt lgkmcnt(" #n ")" ::: "memory")
#define PG8_BAR __builtin_amdgcn_s_barrier()
#define PG8_SCHED __builtin_amdgcn_sched_barrier(0)
    Unit cur, nxt; int ui = 0;
    if (!S.next(0, cur)) return;
    f32x4 acc[2][2][4][2];
#pragma unroll
    for (int a = 0; a < 2; ++a)
#pragma unroll
        for (int b = 0; b < 2; ++b)
#pragma unroll
            for (int m = 0; m < 4; ++m)
#pragma unroll
                for (int n = 0; n < 2; ++n) acc[a][b][m][n] = (f32x4){0.f, 0.f, 0.f, 0.f};
    int fp8_one = FP8_ONE; asm volatile("" : "+v"(fp8_one));
    typedef int i32x8_ __attribute__((ext_vector_type(8))); typedef int i32x4_ __attribute__((ext_vector_type(4)));
    bf16x8 At[4][2], B0[2][2], B1[2][2];
    const char* cA = (const char*)g.A + (GATHER ? (size_t)0 : (size_t)cur.pm * tstep); const char* cB = (const char*)g.Bt + (size_t)cur.pn * tstep;
    if constexpr (GATHER) PG8_ROWS(vAc, cur);
    S.a_ready(cur);
    PG8_STG(PG8_SB(0, 0), cB, B); PG8_STGA(0, 0, cA, vAc); PG8_STG(PG8_SB(0, 1), cB + hstep, B); PG8_STGA(0, 1, cA, vAc);
    if (wr == 1) PG8_BAR;
    PG8_WAIT_V(4); PG8_BAR;
    PG8_STG(PG8_SB(1, 0), cB + kstep, B); PG8_STGA(1, 0, cA + kstep, vAc); PG8_STG(PG8_SB(1, 1), cB + hstep + kstep, B);
    PG8_WAIT_V(6); PG8_BAR;
    PG8_STAMP();
    for (;;) {
        const bool has_next = S.next(ui + 1, nxt);
        const char* nA = (has_next && !GATHER) ? (const char*)g.A + (size_t)nxt.pm * tstep : cA; const char* nB = has_next ? (const char*)g.Bt + (size_t)nxt.pn * tstep : cB;
        if constexpr (GATHER) { if (has_next) PG8_ROWS(vAn, nxt); else { _Pragma("unroll") for (int h_ = 0; h_ < 2; ++h_) _Pragma("unroll") for (int i_ = 0; i_ < 2; ++i_) vAn[h_][i_] = vAc[h_][i_]; } }
        for (int t = 0; t < nt; t += 2) {
            const bool last = (t == nt - 2);
            const char* a1 = cA + (size_t)(t + 1) * kstep;
            const char* a2 = last ? nA : cA + (size_t)(t + 2) * kstep; const char* b2 = last ? nB : cB + (size_t)(t + 2) * kstep;
            const char* a3 = a2 + kstep; const char* b3 = b2 + kstep;
            if (last && has_next) S.a_ready(nxt);
            PG8_LDB(B0, 0, 0); PG8_SCHED; PG8_LDA(At, 0, 0); PG8_STGA(1, 1, a1, vAc);
            PG8_WAIT_L(8); PG8_BAR; PG8_WAIT_L(0); PG8_MMA(0, 0, At, B0); PG8_BAR; PG8_SCHED;
            PG8_LDB(B1, 0, 1); PG8_STG(PG8_SB(0, 0), b2, B);
            PG8_BAR; PG8_WAIT_L(0); PG8_MMA(0, 1, At, B1); PG8_BAR;
            PG8_LDA(At, 0, 1); if (GATHER && last) PG8_STGA(0, 0, a2, vAn); else PG8_STGA(0, 0, a2, vAc);
            PG8_BAR; PG8_WAIT_L(0); PG8_MMA(1, 0, At, B0); PG8_BAR; PG8_SCHED;
            PG8_STG(PG8_SB(0, 1), b2 + hstep, B);
            PG8_WAIT_V(6); PG8_BAR; PG8_MMA(1, 1, At, B1); PG8_BAR;
            PG8_LDB(B0, 1, 0); PG8_SCHED; PG8_LDA(At, 1, 0); if (GATHER && last) PG8_STGA(0, 1, a2, vAn); else PG8_STGA(0, 1, a2, vAc);
            PG8_WAIT_L(8); PG8_BAR; PG8_WAIT_L(0); PG8_MMA(0, 0, At, B0); PG8_BAR; PG8_SCHED;
            PG8_LDB(B1, 1, 1); PG8_STG(PG8_SB(1, 0), b3, B);
            PG8_BAR; PG8_WAIT_L(0); PG8_MMA(0, 1, At, B1); PG8_BAR;
            PG8_LDA(At, 1, 1); if (GATHER && last) PG8_STGA(1, 0, a3, vAn); else PG8_STGA(1, 0, a3, vAc);
            PG8_BAR; PG8_WAIT_L(0); PG8_MMA(1, 0, At, B0); PG8_BAR; PG8_SCHED;
            PG8_STG(PG8_SB(1, 1), b3 + hstep, B);
            PG8_WAIT_V(6); PG8_BAR; PG8_MMA(1, 1, At, B1); PG8_BAR;
        }
        PG8_STAMP();
        if constexpr (FP8) asm volatile("s_nop 15\n\ts_nop 15\n\ts_nop 15" ::: "memory");
        if constexpr (!Epi::AFTER_DRAIN) { __builtin_amdgcn_sched_barrier(0); E(acc, cur, wr, wc, fr, fq); S.done(cur); __builtin_amdgcn_sched_barrier(0); }
        PG8_STAMP();
        if (!has_next) break;
#pragma unroll
        for (int a = 0; a < 2; ++a)
#pragma unroll
            for (int b = 0; b < 2; ++b)
#pragma unroll
                for (int m = 0; m < 4; ++m)
#pragma unroll
                    for (int n = 0; n < 2; ++n) acc[a][b][m][n] = (f32x4){0.f, 0.f, 0.f, 0.f};
        cur = nxt; cA = nA; cB = nB; ++ui;
        if constexpr (GATHER) { _Pragma("unroll") for (int h_ = 0; h_ < 2; ++h_) _Pragma("unroll") for (int i_ = 0; i_ < 2; ++i_) vAc[h_][i_] = vAn[h_][i_]; }
    }
    PG8_WAIT_V(0);
    if (wr == 0) PG8_BAR;
    PG8_BAR;
    if constexpr (Epi::AFTER_DRAIN) { E.fused(acc, cur, wr, wc, fr, fq, lds, wid, lane); S.done(cur); }
    PG8_STAMP();
    if (STAMP && wid == 0) { stamps[lane] = lane < nts ? (((unsigned long long)(unsigned)ts_hi << 32) | (unsigned)ts_lo) : 0ull;
        if (lane == 62) stamps[62] = rt_entry; if (lane == 63) stamps[63] = (unsigned long long)wall_clock64(); }
#undef PG8_STAMP
#undef PG8_SA
#undef PG8_SB
#undef PG8_STG
#undef PG8_STGA
#undef PG8_ROWS
#undef PG8_LDA
#undef PG8_LDB
#undef PG8_MMA
#undef PG8_WAIT_V
#undef PG8_WAIT_L
#undef PG8_BAR
#undef PG8_SCHED
}
}

__device__ __forceinline__ void epi_lane(int& fr, int& fq) { int l = (int)__builtin_amdgcn_mbcnt_hi(~0u, __builtin_amdgcn_mbcnt_lo(~0u, 0u)); asm volatile("" : "+v"(l)); fr = l & 15; fq = l >> 4; }
struct EpiStoreBf16 {
    static constexpr bool PERM = true, AFTER_DRAIN = false;
    bf16_t* O; int ldc;
    __device__ __forceinline__ void operator()(const f32x4 (&acc)[2][2][4][2], const pg8::Unit& u, int wr, int wc, int fr_, int fq_) const {
        int fr, fq; epi_lane(fr, fq); (void)fr_; (void)fq_;
        const int row0 = u.pm * 256 + wr * 64 + fr, col0 = u.pn * 256 + wc * 32 + 8 * fq;
#pragma unroll
        for (int ai = 0; ai < 2; ++ai)
#pragma unroll
            for (int m = 0; m < 4; ++m) { bf16_t* rowp = O + (size_t)(row0 + ai * 128 + m * 16) * ldc + col0;
#pragma unroll
                for (int bj = 0; bj < 2; ++bj) { const f32x4 v0 = acc[ai][bj][m][0], v1 = acc[ai][bj][m][1];
                    u32x4 w; w.x = pk2(v0[0], v0[1]); w.y = pk2(v0[2], v0[3]); w.z = pk2(v1[0], v1[1]); w.w = pk2(v1[2], v1[3]);
                    *(u32x4*)(rowp + bj * 128) = w; } }
    }
};
struct EpiResid {
    static constexpr bool PERM = false, AFTER_DRAIN = false;
    const float* xin_lat; const float* xin_ctx; float* xo; const float* mod_gate; float wscale;
    __device__ __forceinline__ void operator()(const f32x4 (&acc)[2][2][4][2], const pg8::Unit& u, int wr, int wc, int fr_, int fq_) const {
        int fr, fq; epi_lane(fr, fq); (void)fr_; (void)fq_;
        const int row0 = u.pm * 256 + wr * 64 + fr, col0 = u.pn * 256 + wc * 32 + 4 * fq;
        const int mrow = (u.pm < TL / 256) ? (u.pm >> 5) : 4;
        const float* xin = (u.pm < TL / 256) ? xin_lat : (xin_ctx - (size_t)TL * 1024);
        f32x4 gv[2][2];
#pragma unroll
        for (int bj = 0; bj < 2; ++bj)
#pragma unroll
            for (int n = 0; n < 2; ++n) gv[bj][n] = *(const f32x4*)(mod_gate + (size_t)mrow * 6144 + col0 + bj * 128 + n * 16) * wscale;
#pragma unroll
        for (int ai = 0; ai < 2; ++ai)
#pragma unroll
            for (int m = 0; m < 4; ++m) { const size_t off = (size_t)(row0 + ai * 128 + m * 16) * 1024 + col0;
#pragma unroll
                for (int bj = 0; bj < 2; ++bj)
#pragma unroll
                    for (int n = 0; n < 2; ++n) { const f32x4 xi = *(const f32x4*)(xin + off + bj * 128 + n * 16);
                        *(f32x4*)(xo + off + bj * 128 + n * 16) = xi + gv[bj][n] * acc[ai][bj][m][n]; } }
    }
};
struct EpiDelta {
    static constexpr bool PERM = true, AFTER_DRAIN = false;
    bf16_t* D; const float* mod_gate; float wscale;
    __device__ __forceinline__ void operator()(const f32x4 (&acc)[2][2][4][2], const pg8::Unit& u, int wr, int wc, int fr_, int fq_) const {
        int fr, fq; epi_lane(fr, fq); (void)fr_; (void)fq_;
        const int row0 = u.pm * 256 + wr * 64 + fr, col0 = u.pn * 256 + wc * 32 + 8 * fq;
        const int mrow = (u.pm < TL / 256) ? (u.pm >> 5) : 4;
        f32x4 gv[2][2];
#pragma unroll
        for (int bj = 0; bj < 2; ++bj)
#pragma unroll
            for (int n = 0; n < 2; ++n) gv[bj][n] = *(const f32x4*)(mod_gate + (size_t)mrow * 6144 + col0 + bj * 128 + 4 * n) * wscale;
#pragma unroll
        for (int ai = 0; ai < 2; ++ai)
#pragma unroll
            for (int m = 0; m < 4; ++m) { bf16_t* rowp = D + (size_t)(row0 + ai * 128 + m * 16) * 1024 + col0;
#pragma unroll
                for (int bj = 0; bj < 2; ++bj) { const f32x4 v0 = acc[ai][bj][m][0] * gv[bj][0], v1 = acc[ai][bj][m][1] * gv[bj][1];
                    u32x4 w; w.x = pk2(v0[0], v0[1]); w.y = pk2(v0[2], v0[3]); w.z = pk2(v1[0], v1[1]); w.w = pk2(v1[2], v1[3]);
                    *(u32x4*)(rowp + bj * 128) = w; } }
    }
};
__device__ __forceinline__ float swiglu_(float g, float u) {
    g = fminf(g, 7.0f); u = fminf(fmaxf(u, -7.0f), 7.0f);
    return (u + 1.0f) * g * __builtin_amdgcn_rcpf(1.0f + fexp(-1.702f * g));
}
struct EpiGU {
    static constexpr bool PERM = true, AFTER_DRAIN = false;
    unsigned char* Act; const float* bias;
    __device__ __forceinline__ void operator()(const f32x4 (&acc)[2][2][4][2], const pg8::Unit& u, int wr, int wc, int fr_, int fq_) const {
        int fr, fq; epi_lane(fr, fq); (void)fr_; (void)fq_;
        const int e = u.pn >> 3, pnl = u.pn & 7;
        const int row0 = u.pm * 256 + wr * 64 + fr, col0 = pnl * 256 + wc * 32 + 8 * fq;
        f32x4 bv[2][2];
#pragma unroll
        for (int bj = 0; bj < 2; ++bj)
#pragma unroll
            for (int n = 0; n < 2; ++n) bv[bj][n] = *(const f32x4*)(bias + (size_t)e * 2048 + col0 + bj * 128 + 4 * n);
#pragma unroll
        for (int ai = 0; ai < 2; ++ai)
#pragma unroll
            for (int m = 0; m < 4; ++m) { unsigned char* rowp = Act + (size_t)(row0 + ai * 128 + m * 16) * 1024 + (col0 >> 1);
#pragma unroll
                for (int bj = 0; bj < 2; ++bj) { const f32x4 v0 = acc[ai][bj][m][0] * 0.03125f + bv[bj][0], v1 = acc[ai][bj][m][1] * 0.03125f + bv[bj][1];
                    *(unsigned*)(rowp + bj * 64) = pk_fp8x4(swiglu_(v0[0], v0[1]), swiglu_(v0[2], v0[3]), swiglu_(v1[0], v1[1]), swiglu_(v1[2], v1[3])); }
                __builtin_amdgcn_sched_barrier(0); }
    }
};
struct EpiDown {
    static constexpr bool PERM = true, AFTER_DRAIN = false;
    bf16_t* Y; const float* bias; const int* slot_a; const float* slot_g;
    __device__ __forceinline__ void operator()(const f32x4 (&acc)[2][2][4][2], const pg8::Unit& u, int wr, int wc, int fr_, int fq_) const {
        int fr, fq; epi_lane(fr, fq); (void)fr_; (void)fq_;
        const int e = u.pn >> 2, pnl = u.pn & 3;
        const int row0 = u.pm * 256 + wr * 64 + fr, col0 = pnl * 256 + wc * 32 + 8 * fq;
        f32x4 bv[2][2];
#pragma unroll
        for (int bj = 0; bj < 2; ++bj)
#pragma unroll
            for (int n = 0; n < 2; ++n) bv[bj][n] = *(const f32x4*)(bias + (size_t)e * 1024 + col0 + bj * 128 + 4 * n);
#pragma unroll
        for (int ai = 0; ai < 2; ++ai)
#pragma unroll
            for (int m = 0; m < 4; ++m) { const int slot = row0 + ai * 128 + m * 16; const int a = slot_a[slot]; const float gt = slot_g[slot];
                if (a >= 0) { bf16_t* rowp = Y + (size_t)a * 1024 + col0;
#pragma unroll
                    for (int bj = 0; bj < 2; ++bj) { const f32x4 v0 = (acc[ai][bj][m][0] * 0.03125f + bv[bj][0]) * gt, v1 = (acc[ai][bj][m][1] * 0.03125f + bv[bj][1]) * gt;
                        u32x4 w; w.x = pk2(v0[0], v0[1]); w.y = pk2(v0[2], v0[3]); w.z = pk2(v1[0], v1[1]); w.w = pk2(v1[2], v1[3]);
                        *(u32x4*)(rowp + bj * 128) = w; } } }
    }
};
struct MoeOrder {
    const int* tile_e; int ntiles, nN, G, c;
    __device__ __forceinline__ bool next(int i, pg8::Unit& u) const {
        const int x = c & 7, r = c >> 3, j = i * (G >> 3) + r;
        const int pm = x + 8 * (j / nN), pl = j % nN; if (pm >= ntiles) return false;
        u.pm = pm; u.pn = __builtin_amdgcn_readfirstlane(tile_e[pm]) * nN + pl; return true;
    }
    __device__ __forceinline__ void a_ready(const pg8::Unit&) const {}
    __device__ __forceinline__ void done(const pg8::Unit&) const {}
};

__device__ __forceinline__ void transpose_tile(int wv, const float* __restrict__ src, int ldsrc, int k0, int n0, int nmax, bf16_t* __restrict__ dst, int ldd, LAS unsigned char* lds) {
    LAS bf16_t* T = (LAS bf16_t*)lds;
    const int tid = otid(wv), r = tid >> 4, c4 = (tid & 15) * 4;
#pragma unroll
    for (int pass = 0; pass < 2; ++pass) { const int k = r + 32 * pass;
        f32x4 v = (f32x4){0.f, 0.f, 0.f, 0.f};
        if (n0 + c4 < nmax) v = *(const f32x4*)(src + (size_t)(k0 + k) * ldsrc + n0 + c4);
#pragma unroll
        for (int i = 0; i < 4; ++i) T[(c4 + i) * 66 + k] = f2bf(v[i]); }
    __syncthreads();
    { const int n = tid >> 3, kc = (tid & 7) * 8;
      if (n0 + n < nmax) { const LAS unsigned* tp = (const LAS unsigned*)(T + n * 66 + kc); u32x4 w; w.x = tp[0]; w.y = tp[1]; w.z = tp[2]; w.w = tp[3];
          *(u32x4*)(dst + (size_t)(n0 + n) * ldd + k0 + kc) = w; } }
    __syncthreads();
}

__device__ __forceinline__ void transpose_tile_fp8(int wv, const float* __restrict__ src, int ldsrc, int k0, int n0, unsigned char* __restrict__ dst, int ldd, LAS unsigned char* lds) {
    LAS float* T = (LAS float*)lds;
    const int tid = otid(wv), r = tid >> 4, c4 = (tid & 15) * 4;
#pragma unroll
    for (int pass = 0; pass < 2; ++pass) { const int k = r + 32 * pass;
        const f32x4 v = *(const f32x4*)(src + (size_t)(k0 + k) * ldsrc + n0 + c4);
#pragma unroll
        for (int i = 0; i < 4; ++i) T[(c4 + i) * 65 + k] = v[i] * 32.0f; }
    __syncthreads();
    { const int n = tid >> 3, kc = (tid & 7) * 8; const LAS float* tp = T + n * 65 + kc;
      u32x2 w; w.x = pk_fp8x4(tp[0], tp[1], tp[2], tp[3]); w.y = pk_fp8x4(tp[4], tp[5], tp[6], tp[7]);
      *(u32x2*)(dst + (size_t)(n0 + n) * ldd + k0 + kc) = w; }
    __syncthreads();
}

__device__ __forceinline__ void phase_prologue(int wv, const Params& p, LAS unsigned char* lds) {
    const int tid = otid(wv), bid = blockIdx.x, nblk = gridDim.x;
    unsigned char* ws = opq(p.ws);
    unsigned char* WGU = ws + WS_WGU; unsigned char* WDN = ws + WS_WDN; bf16_t* WOUT = (bf16_t*)(ws + WS_WOUT); bf16_t* WIN = (bf16_t*)(ws + WS_WIN); bf16_t* WRT = (bf16_t*)(ws + WS_WRT);
    float* MOD = (float*)(ws + WS_MOD); float2* RA = (float2*)(ws + WS_RA); float2* RD = (float2*)(ws + WS_RD);
    constexpr int T_WGU = 64 * 16 * 32, T_WDN = 64 * 16 * 16, T_WOUT = 2 * 256, T_WIN = 2 * 16 * 42, T_FOLD = 2 * 64, T_ADA = 2 * 96, T_ROPE = SEQ * 48 / 512, T_WRT = 2 * 32 * 1024 / 512, T_PAD = 2 * 16 * 1024 / 512;
    constexpr int O_WDN = T_WGU, O_WOUT = O_WDN + T_WDN, O_WIN = O_WOUT + T_WOUT, O_FOLD = O_WIN + T_WIN, O_ADA = O_FOLD + T_FOLD, O_ROPE = O_ADA + T_ADA, O_WRT = O_ROPE + T_ROPE, O_PAD = O_WRT + T_WRT, NTASK = O_PAD + T_PAD;
    {
        constexpr int NT_GU = 64 * 8 * 32, NT_DN = 64 * 8 * 16, NT_WO = YM_FP8 ? 2 * 8 * 16 : 0, NT_ALL = NT_GU + NT_DN + NT_WO;
        const int tid = otid(wv), r = tid >> 4, c4 = (tid & 15) * 4, on = tid >> 3, okc = (tid & 7) * 16;
        f32x4 v[4];
        auto tile_src = [&](int tt, const float*& src, int& ldsrc, unsigned char*& dst) {
            if (tt < NT_GU) { const int mat = tt >> 8, t = tt & 255, kt = t >> 5, nt = t & 31; src = p.w_gu + (size_t)mat * 1024 * 2048 + (size_t)kt * 128 * 2048 + nt * 64; ldsrc = 2048; dst = WGU + (size_t)mat * 2048 * 1024 + (size_t)nt * 64 * 1024 + kt * 128; }
            else if (tt >= NT_GU + NT_DN) { const int u = tt - NT_GU - NT_DN, mat = u >> 7, t = u & 127, kt = t >> 4, nt = t & 15; src = p.w_out + (size_t)mat * 1024 * 1024 + (size_t)kt * 128 * 1024 + nt * 64; ldsrc = 1024; dst = (unsigned char*)WOUT + (size_t)mat * 1024 * 1024 + (size_t)nt * 64 * 1024 + kt * 128; }
            else { const int u = tt - NT_GU, mat = u >> 7, t = u & 127, kt = t >> 4, nt = t & 15; src = p.w_down + (size_t)mat * 1024 * 1024 + (size_t)kt * 128 * 1024 + nt * 64; ldsrc = 1024; dst = WDN + (size_t)mat * 1024 * 1024 + (size_t)nt * 64 * 1024 + kt * 128; } };
        int tt = bid; int buf = 0;
        if (tt < NT_ALL) { const float* src; int ld; unsigned char* dst; tile_src(tt, src, ld, dst);
#pragma unroll
            for (int ps = 0; ps < 4; ++ps) v[ps] = *(const f32x4*)(src + (size_t)(r + 32 * ps) * ld + c4); }
        for (; tt < NT_ALL; tt += nblk) {
            LAS float* T = (LAS float*)(lds + buf * 33280);
#pragma unroll
            for (int ps = 0; ps < 4; ++ps)
#pragma unroll
                for (int i = 0; i < 4; ++i) T[(c4 + i) * 130 + r + 32 * ps] = v[ps][i] * 32.0f;
            __syncthreads();
            const float* src; int ld; unsigned char* dst; tile_src(tt, src, ld, dst);
            if (tt + nblk < NT_ALL) { const float* s2; int ld2; unsigned char* d2; tile_src(tt + nblk, s2, ld2, d2);
#pragma unroll
                for (int ps = 0; ps < 4; ++ps) v[ps] = *(const f32x4*)(s2 + (size_t)(r + 32 * ps) * ld2 + c4); }
            const LAS float* tp = T + on * 130 + okc;
            u32x4 w; w.x = pk_fp8x4(tp[0], tp[1], tp[2], tp[3]); w.y = pk_fp8x4(tp[4], tp[5], tp[6], tp[7]); w.z = pk_fp8x4(tp[8], tp[9], tp[10], tp[11]); w.w = pk_fp8x4(tp[12], tp[13], tp[14], tp[15]);
            *(u32x4*)(dst + (size_t)on * 1024 + okc) = w;
            buf ^= 1;
        }
        __syncthreads();
    }
    for (int task = bid + O_WOUT; task < NTASK; task += nblk) {
        if (task < O_WDN) {
            const int mat = task >> 9, t = task & 511, kt = t >> 5, nt = t & 31;
            transpose_tile_fp8(wv, p.w_gu + (size_t)mat * 1024 * 2048, 2048, kt * 64, nt * 64, WGU + (size_t)mat * 2048 * 1024, 1024, lds);
        } else if (task < O_WOUT) {
            const int tt = task - O_WDN, mat = tt >> 8, t = tt & 255, kt = t >> 4, nt = t & 15;
            transpose_tile_fp8(wv, p.w_down + (size_t)mat * 1024 * 1024, 1024, kt * 64, nt * 64, WDN + (size_t)mat * 1024 * 1024, 1024, lds);
        } else if (task < O_WIN) {
            if (YM_FP8) continue;
            const int tt = task - O_WOUT, mat = tt >> 8, t = tt & 255, kt = t >> 4, nt = t & 15;
            transpose_tile(wv, p.w_out + (size_t)mat * 1024 * 1024, 1024, kt * 64, nt * 64, 1024, WOUT + (size_t)mat * 1024 * 1024, 1024, lds);
        } else if (task < O_FOLD) {
            const int tt = task - O_WIN, mat = tt / (16 * 42), t = tt % (16 * 42), kt = t / 42, nt = t % 42;
            transpose_tile(wv, p.w_in + (size_t)mat * 1024 * INC, INC, kt * 64, nt * 64, INC, WIN + (size_t)mat * NP * 1024, 1024, lds);
        } else if (task < O_ADA) {
            const int tt = task - O_FOLD, l = tt >> 6, k0 = (tt & 63) * 16;
            LAS float* Aq = (LAS float*)lds;
            LAS float* Akv = Aq + 16 * 192;
            for (int i = tid; i < 16 * 192; i += NTHR) { const int r = i / 192, j = i % 192; Aq[i] = p.w_in[((size_t)l * 1024 + k0 + r) * INC + PC_DCQ + j] * p.mla_g_q[l * 192 + j]; }
            for (int i = tid; i < 16 * 128; i += NTHR) { const int r = i / 128, j = i % 128; Akv[i] = p.w_in[((size_t)l * 1024 + k0 + r) * INC + PC_DCKV + j] * p.mla_g_kv[l * 128 + j]; }
            __syncthreads();
            for (int n = tid; n < 896; n += NTHR) {
                float acc[16];
#pragma unroll
                for (int r = 0; r < 16; ++r) acc[r] = 0.f;
                if (n < 384) { const float* W = p.mla_w_uq + (size_t)l * 192 * 384 + n;
                    for (int j = 0; j < 192; ++j) { const float wv = W[(size_t)j * 384];
#pragma unroll
                        for (int r = 0; r < 16; ++r) acc[r] += Aq[r * 192 + j] * wv; }
                } else { const float* W = p.mla_w_ukv + (size_t)l * 128 * 512 + (n - 384);
                    for (int j = 0; j < 128; ++j) { const float wv = W[(size_t)j * 512];
#pragma unroll
                        for (int r = 0; r < 16; ++r) acc[r] += Akv[r * 128 + j] * wv; } }
                u32x4 w0, w1; w0.x = pk2(acc[0], acc[1]); w0.y = pk2(acc[2], acc[3]); w0.z = pk2(acc[4], acc[5]); w0.w = pk2(acc[6], acc[7]);
                w1.x = pk2(acc[8], acc[9]); w1.y = pk2(acc[10], acc[11]); w1.z = pk2(acc[12], acc[13]); w1.w = pk2(acc[14], acc[15]);
                bf16_t* d = WIN + ((size_t)l * NP + PC_DQF + n) * 1024 + k0; *(u32x4*)d = w0; *(u32x4*)(d + 8) = w1;
            }
            __syncthreads();
        } else if (task < O_ROPE) {
            const int tt = task - O_ADA, l = tt / 96, n0 = (tt % 96) * 64;
            LAS float* SC = (LAS float*)lds;
            LAS float* RED = SC + 5 * 1024;
            for (int i = tid; i < 5 * 1024; i += NTHR) { const int r = i >> 10, k = i & 1023; const float v = (r < 4) ? p.c[r * 1024 + k] : p.c_ctx[k]; SC[i] = siluf_(v); }
            __syncthreads();
            { const int kc = tid >> 6, col = tid & 63; float a[5] = {0.f, 0.f, 0.f, 0.f, 0.f};
              const float* W = p.w_ada + ((size_t)l * 1024 + kc * 128) * 6144 + n0 + col;
              for (int k = 0; k < 128; ++k) { const float wv = W[(size_t)k * 6144];
#pragma unroll
                  for (int r = 0; r < 5; ++r) a[r] += SC[r * 1024 + kc * 128 + k] * wv; }
#pragma unroll
              for (int r = 0; r < 5; ++r) RED[(kc * 5 + r) * 64 + col] = a[r]; }
            __syncthreads();
            if (tid < 320) { const int r = tid >> 6, col = tid & 63; float s = p.b_ada[l * 6144 + n0 + col];
#pragma unroll
                for (int kc = 0; kc < 8; ++kc) s += RED[(kc * 5 + r) * 64 + col];
                MOD[((size_t)l * 5 + r) * 6144 + n0 + col] = s; }
            __syncthreads();
        } else if (task < O_WRT) {
            const int idx = (task - O_ROPE) * 512 + tid, t = idx / 48, j = idx % 48;
            if (j < 32) { const int i = j & 15; const float inv = powf(10000.0f, -(float)(2 * i) / 32.0f); const float pos = (j < 16) ? (float)(t >> 6) : (float)(t & 63);
                float s, c; sincosf(pos * inv, &s, &c); RA[t * 32 + j] = make_float2(c, s); }
            else { const int jj = j - 32, i = jj & 7; const float inv = powf(10000.0f, -(float)(2 * i) / 16.0f); const float pos = (jj < 8) ? (float)(t >> 6) : (float)(t & 63);
                float s, c; sincosf(pos * inv, &s, &c); RD[t * 16 + jj] = make_float2(c, s); }
        } else if (task < O_PAD) {
            const int idx = (task - O_WRT) * 512 + tid, l = idx >> 15, e = (idx >> 10) & 31, k = idx & 1023;
            const float w = p.w_router[((size_t)l * 1024 + k) * 32 + e]; const unsigned short hi = f2bf(w); const unsigned short lo = f2bf(w - bf2f(hi));
            WRT[(((size_t)l * 2 + 0) * 32 + e) * 1024 + k] = hi; WRT[(((size_t)l * 2 + 1) * 32 + e) * 1024 + k] = lo;
        } else {
            const int idx = (task - O_PAD) * 512 + tid, l = idx >> 14, r = (idx >> 10) & 15, k = idx & 1023;
            WIN[((size_t)l * NP + PC_END + r) * 1024 + k] = 0;
        }
    }
}

__device__ __forceinline__ void phase_norm1_l0(int wv, const Params& p) {
    const int tid = otid(wv), lane = tid & 63, gw = blockIdx.x * NWAVE + (tid >> 6), nw = gridDim.x * NWAVE;
    const float* MOD = (const float*)(p.ws + WS_MOD); bf16_t* HB = (bf16_t*)(p.ws + WS_HB);
    for (int r = gw; r < TA; r += nw) {
        const float* src = (r < TL) ? p.x + (size_t)r * 1024 : p.ctx + (size_t)(r - TL) * 1024;
        const int mrow = (r < TL) ? (r >> 13) : 4; const float* mod = MOD + (size_t)mrow * 6144;
        f32x4 v[4]; row_load(src, lane, v); const float rstd = row_rstd(v);
        row_modulate(v, rstd, p.g_norm1, mod + 1024, mod, lane);
        row_store_bf16(HB + (size_t)r * 1024, lane, v);
    }
}
__device__ __forceinline__ void phase_combine(int wv, const Params& p, int l) {
    const int tid = otid(wv), lane = tid & 63, gw = blockIdx.x * NWAVE + (tid >> 6), nw = gridDim.x * NWAVE;
    const float* MOD = (const float*)(p.ws + WS_MOD); bf16_t* HB = (bf16_t*)(p.ws + WS_HB); const bf16_t* Y = (const bf16_t*)(p.ws + WS_Y);
    const float* XA = (const float*)(p.ws + WS_XA); float* XB = (float*)(p.ws + WS_XB);
    const int T = (l == 0) ? TA : TL;
    for (int r = gw; r < T; r += nw) {
        const int mrow = (r < TL) ? (r >> 13) : 4; const float* mod = MOD + ((size_t)l * 5 + mrow) * 6144;
        f32x4 v[4]; row_load(XA + (size_t)r * 1024, lane, v);
#pragma unroll
        for (int i = 0; i < 4; ++i) {
            f32x4 s = (f32x4){0.f, 0.f, 0.f, 0.f};
#pragma unroll
            for (int k = 0; k < 4; ++k) { const u32x2 w = *(const u32x2*)(Y + ((size_t)r * 4 + k) * 1024 + i * 256 + lane * 4);
                s[0] += bf2f(w.x & 0xffffu); s[1] += bf2f(w.x >> 16); s[2] += bf2f(w.y & 0xffffu); s[3] += bf2f(w.y >> 16); }
            const f32x4 g2 = *(const f32x4*)(mod + 5 * 1024 + i * 256 + lane * 4);
            v[i] = v[i] + g2 * s;
        }
        const float rstd = row_rstd(v);
        if (l == 0) {
#pragma unroll
            for (int i = 0; i < 4; ++i) *(f32x4*)(XB + (size_t)r * 1024 + i * 256 + lane * 4) = v[i];
            const float* mod1 = MOD + ((size_t)5 + mrow) * 6144;
            row_modulate(v, rstd, p.g_norm1 + 1024, mod1 + 1024, mod1, lane);
            row_store_bf16(HB + (size_t)r * 1024, lane, v);
        } else {
#pragma unroll
            for (int i = 0; i < 4; ++i) { const f32x4 gg = *(const f32x4*)(p.g_final + i * 256 + lane * 4);
                *(f32x4*)(p.out + (size_t)r * 1024 + i * 256 + lane * 4) = v[i] * rstd * gg; }
        }
    }
}

__device__ __forceinline__ int cu_index(int b, int tc, int h, int dir) { return ((b * NCHUNK + tc) * 4 + h) * 2 + dir; }
__device__ __forceinline__ float logsigmoidf_(float x) { return fminf(x, 0.f) - log1pf(__expf(-fabsf(x))); }

__device__ __forceinline__ void prep_elem(int wv, const Params& p, int l, LAS unsigned char* lds) {
    const int tid = otid(wv);
    unsigned char* ws = opq(p.ws);
    const bf16_t* P = (const bf16_t*)(ws + WS_P);
    bf16_t* QA = (bf16_t*)(ws + WS_QA); bf16_t* KA = (bf16_t*)(ws + WS_KA); bf16_t* QD = (bf16_t*)(ws + WS_QD); bf16_t* KD = (bf16_t*)(ws + WS_KD); bf16_t* VD = (bf16_t*)(ws + WS_VD);
    bf16_t* QC = (bf16_t*)(ws + WS_QC); bf16_t* KC = (bf16_t*)(ws + WS_KC); float* GATES = (float*)(ws + WS_GATES);
    const float2* RA = (const float2*)(ws + WS_RA); const float2* RD = (const float2*)(ws + WS_RD);
    LAS float* RQ = (LAS float*)lds;
    constexpr int CH = 44;
    const int per = (TA + gridDim.x - 1) / gridDim.x, rbeg = blockIdx.x * per, rend = min(rbeg + per, TA);
    for (int row0 = rbeg; row0 < rend; row0 += CH) {
        const int nr = min(CH, rend - row0);
        for (int itc = tid; itc < ((nr + 3) & ~3) * 16; itc += NTHR) { const int i = itc >> 4, sub = itc & 15; float sq = 0.f, sk = 0.f;
          if (i < nr) { const bf16_t* pr = P + (size_t)(row0 + i) * NP + PC_DCQ;
              const u32x4 c0 = *(const u32x4*)(pr + sub * 8), c1 = *(const u32x4*)(pr + (sub + 16) * 8); u32x4 c2 = (u32x4){0u, 0u, 0u, 0u}; if (sub < 8) c2 = *(const u32x4*)(pr + (sub + 32) * 8);
#pragma unroll
              for (int q = 0; q < 4; ++q) { const float a0 = bf2f(c0[q] & 0xffffu), a1 = bf2f(c0[q] >> 16), b0 = bf2f(c1[q] & 0xffffu), b1 = bf2f(c1[q] >> 16), d0 = bf2f(c2[q] & 0xffffu), d1 = bf2f(c2[q] >> 16);
                  sq += a0 * a0 + a1 * a1; const float t1 = b0 * b0 + b1 * b1; if (sub < 8) sq += t1; else sk += t1; sk += d0 * d0 + d1 * d1; } }
#pragma unroll
          for (int d = 8; d >= 1; d >>= 1) { sq += __shfl_xor(sq, d); sk += __shfl_xor(sk, d); }
          if (sub == 0 && i < nr) { RQ[i] = rsqrtf(sq * (1.0f / 192.0f) + EPS); RQ[64 + i] = rsqrtf(sk * (1.0f / 128.0f) + EPS); } }
        for (int it = tid; it < nr * 24; it += NTHR) {
            const int i = it / 24, r = it % 24, head = r >> 2, j0 = (r & 3) * 8, row = row0 + i;
            const bf16_t* src = P + (size_t)row * NP + (head < 4 ? PC_AQ + head * 64 : PC_AK + (head - 4) * 64) + j0;
            const u32x4 a = *(const u32x4*)src, bq = *(const u32x4*)(src + 32);
            u32x4 o1, o2;
            if (row >= TL) { o1 = a; o2 = bq; }
            else { const float2* tab = RA + (size_t)(row & (SEQ - 1)) * 32 + j0;
#pragma unroll
                for (int q = 0; q < 4; ++q) { const float x1a = bf2f(a[q] & 0xffffu), x1b = bf2f(a[q] >> 16), x2a = bf2f(bq[q] & 0xffffu), x2b = bf2f(bq[q] >> 16);
                    const float2 ca = tab[2 * q], cb = tab[2 * q + 1];
                    o1[q] = pk2(x1a * ca.x - x2a * ca.y, x1b * cb.x - x2b * cb.y); o2[q] = pk2(x2a * ca.x + x1a * ca.y, x2b * cb.x + x1b * cb.y); } }
            bf16_t* dst = (head < 4) ? QA + (size_t)row * 256 + head * 64 + j0 : KA + (size_t)row * 128 + (head - 4) * 64 + j0;
            *(u32x4*)dst = o1; *(u32x4*)(dst + 32) = o2;
        }
        for (int it = tid; it < nr * 64; it += NTHR) {
            const int i = it >> 6, c0 = (it & 63) * 8, row = row0 + i;
            const bool isc = row >= TL; const int t = isc ? ((row - TL) & (CTXL - 1)) : (row & (SEQ - 1)), nseq = isc ? CTXL : SEQ;
            const bf16_t* src = P + (size_t)row * NP + PC_CQK + c0;
            const u32x4 u1 = *(const u32x4*)src;
            u32x4 u0 = (u32x4){0u, 0u, 0u, 0u}, u2 = (u32x4){0u, 0u, 0u, 0u};
            if (t > 0) u0 = *(const u32x4*)(src - NP);
            if (t + 1 < nseq) u2 = *(const u32x4*)(src + NP);
            const float* cw = p.mlstm_conv + (size_t)l * 3 * 512 + c0;
            const float sc = (c0 >= 256) ? 0.125f : 1.0f;
            u32x4 o;
#pragma unroll
            for (int q = 0; q < 4; ++q) {
                const float ya = cw[2 * q] * bf2f(u0[q] & 0xffffu) + cw[512 + 2 * q] * bf2f(u1[q] & 0xffffu) + cw[1024 + 2 * q] * bf2f(u2[q] & 0xffffu);
                const float yb = cw[2 * q + 1] * bf2f(u0[q] >> 16) + cw[512 + 2 * q + 1] * bf2f(u1[q] >> 16) + cw[1024 + 2 * q + 1] * bf2f(u2[q] >> 16);
                o[q] = pk2(siluf_(ya) * sc, siluf_(yb) * sc); }
            if (c0 < 256) *(u32x4*)(QC + (size_t)row * 256 + c0) = o; else *(u32x4*)(KC + (size_t)row * 256 + (c0 - 256)) = o;
        }
        for (int itc = tid; itc < nr * 16; itc += NTHR) { const int i = itc >> 4, gi = itc & 15;
          { float v = bf2f(P[(size_t)(row0 + i) * NP + PC_CG + gi]) + p.mlstm_gate_bias[l * 16 + gi];
              if ((gi >> 2) & 1) v = logsigmoidf_(v);
              GATES[(size_t)(row0 + i) * 16 + gi] = v; } }
        __syncthreads();
        for (int it = tid; it < nr * 128; it += NTHR) {
            const int i = it >> 7, g = it & 127, row = row0 + i; const bool is_ctx = row >= TL; const int t = row & (SEQ - 1);
            const bf16_t* pr = P + (size_t)row * NP;
            const float rq = RQ[i], rkv = RQ[64 + i];
            u32x4 o;
            if (g < 96) {
                const bool isq = g < 48; const int g2 = isq ? g : g - 48, h = g2 / 12, gg = g2 % 12;
                const float sc = isq ? rq : ((gg < 8) ? rkv : 1.0f);
                const bf16_t* base = isq ? pr + PC_DQF + h * 96 : (gg < 8 ? pr + PC_DKVF + h * 128 : pr + PC_DKR - 64);
                if (gg < 8 || is_ctx) { const u32x4 a = *(const u32x4*)(base + gg * 8);
#pragma unroll
                    for (int q = 0; q < 4; ++q) o[q] = pk2(bf2f(a[q] & 0xffffu) * sc, bf2f(a[q] >> 16) * sc);
                } else { const int jj = (gg & 1) * 8;
                    const u32x4 x1 = *(const u32x4*)(base + 64 + jj), x2 = *(const u32x4*)(base + 80 + jj); const float2* tab = RD + (size_t)t * 16 + jj; const bool first = gg < 10;
#pragma unroll
                    for (int q = 0; q < 4; ++q) { const float x1a = bf2f(x1[q] & 0xffffu), x1b = bf2f(x1[q] >> 16), x2a = bf2f(x2[q] & 0xffffu), x2b = bf2f(x2[q] >> 16); const float2 ca = tab[2 * q], cb = tab[2 * q + 1];
                        const float ra = first ? x1a * ca.x - x2a * ca.y : x2a * ca.x + x1a * ca.y, rb = first ? x1b * cb.x - x2b * cb.y : x2b * cb.x + x1b * cb.y;
                        o[q] = pk2(ra * sc, rb * sc); } }
                bf16_t* dst = (isq ? QD : KD) + (size_t)row * 384 + h * 96 + gg * 8; *(u32x4*)dst = o;
            } else { const int g2 = g - 96, h = g2 >> 3, gg = g2 & 7;
                const u32x4 a = *(const u32x4*)(pr + PC_DKVF + h * 128 + 64 + gg * 8);
#pragma unroll
                for (int q = 0; q < 4; ++q) o[q] = pk2(bf2f(a[q] & 0xffffu) * rkv, bf2f(a[q] >> 16) * rkv);
                *(u32x4*)(VD + (size_t)row * 256 + h * 64 + gg * 8) = o; }
        }
        __syncthreads();
    }
}
__device__ __forceinline__ void prep_state(int wv, const Params& p, int l, LAS unsigned char* lds) {
    const int tid = otid(wv), lane = tid & 63, w = tid >> 6;
    unsigned char* ws = opq(p.ws);
    const bf16_t* P = (const bf16_t*)(ws + WS_P);
    float* DC = (float*)(ws + WS_DC); float* DN = (float*)(ws + WS_DN); float* DFA = (float*)(ws + WS_DFA);
    LAS unsigned char* KW = lds;
    LAS unsigned char* VT = lds + 24576;
    LAS float* KF = (LAS float*)(lds + 36864);
    LAS float* WL = (LAS float*)(lds + 53504);
    constexpr int NU = (TA / 64) * 4;
    for (int un = blockIdx.x; un < NU; un += gridDim.x) {
        const int ch = un >> 2, hd = un & 3;
        const bool is_ctx = ch >= TL / 64; const int cc = ch - TL / 64;
        const int b = is_ctx ? (cc >> 2) : (ch >> 7), tc = is_ctx ? 128 + (cc & 3) : (ch & 127);
        const int row0 = ch * 64, t0 = is_ctx ? (cc & 3) * 64 : (ch & 127) * 64, nseq = is_ctx ? CTXL : SEQ;
        {
            const int s = tid >> 3, part = tid & 7, c0 = 256 + hd * 64 + part * 8, t = t0 + s;
            const bf16_t* src = P + (size_t)(row0 + s) * NP + PC_CQK + c0;
            const u32x4 u1 = *(const u32x4*)src;
            u32x4 u0 = (u32x4){0u, 0u, 0u, 0u}, u2 = (u32x4){0u, 0u, 0u, 0u};
            if (t > 0) u0 = *(const u32x4*)(src - NP);
            if (t + 1 < nseq) u2 = *(const u32x4*)(src + NP);
            const float* cw = p.mlstm_conv + (size_t)l * 3 * 512 + c0;
#pragma unroll
            for (int q = 0; q < 4; ++q) {
                const float ya = cw[2 * q] * bf2f(u0[q] & 0xffffu) + cw[512 + 2 * q] * bf2f(u1[q] & 0xffffu) + cw[1024 + 2 * q] * bf2f(u2[q] & 0xffffu);
                const float yb = cw[2 * q + 1] * bf2f(u0[q] >> 16) + cw[512 + 2 * q + 1] * bf2f(u1[q] >> 16) + cw[1024 + 2 * q + 1] * bf2f(u2[q] >> 16);
                const unsigned pk = pk2(siluf_(ya) * 0.125f, siluf_(yb) * 0.125f);
                KF[s * 65 + part * 8 + 2 * q] = bf2f(pk & 0xffffu); KF[s * 65 + part * 8 + 2 * q + 1] = bf2f(pk >> 16); }
            *(LAS u32x4*)(VT + s * 192 + part * 16) = *(const u32x4*)(P + (size_t)(row0 + s) * NP + PC_CV + hd * 64 + part * 8);
        }
        if (w < 2) {
            const int dir = w, i = dir ? 63 - lane : lane;
            const bf16_t* pg = P + (size_t)(row0 + i) * NP + PC_CG;
            const float ig = bf2f(pg[(dir ? 8 : 0) + hd]) + p.mlstm_gate_bias[l * 16 + (dir ? 8 : 0) + hd];
            const float lf = logsigmoidf_(bf2f(pg[(dir ? 12 : 4) + hd]) + p.mlstm_gate_bias[l * 16 + (dir ? 12 : 4) + hd]);
            const float bc = wave_incl_sum(lf, lane), bend = __shfl(bc, 63);
            const float val = bend - bc + ig, a = wave_max(val);
            WL[dir * 64 + i] = fexp(val - a);
            if (lane == 0) { float* fa = DFA + (size_t)cu_index(b, tc, hd, dir) * 2; fa[0] = bend; fa[1] = a; }
        }
        __syncthreads();
        {
            const int s = tid >> 3, part = tid & 7;
#pragma unroll
            for (int dir = 0; dir < 2; ++dir) { const float wt = WL[dir * 64 + s]; u32x4 o;
#pragma unroll
                for (int q = 0; q < 4; ++q) o[q] = pk2(KF[s * 65 + part * 8 + 2 * q] * wt, KF[s * 65 + part * 8 + 2 * q + 1] * wt);
                *(LAS u32x4*)(KW + dir * 12288 + s * 192 + part * 16) = o; }
        }
        __syncthreads();
        {
            const int dir = w >> 2, dvb = (w >> 1) & 1, dkb = w & 1, hh = lane >> 5, l31 = lane & 31;
            const int q4 = (lane & 15) >> 2, colo = 16 * ((lane >> 4) & 1) + 4 * (lane & 3);
            f32x16 acc = zero16();
#pragma unroll
            for (int ks = 0; ks < 4; ++ks) {
                const int r0 = 16 * ks + 8 * hh + q4;
                const bf16x8 af = cat8(tr_read(VT + r0 * 192 + (32 * dvb + colo) * 2), tr_read(VT + (r0 + 4) * 192 + (32 * dvb + colo) * 2));
                const bf16x8 bfr = cat8(tr_read(KW + dir * 12288 + r0 * 192 + (32 * dkb + colo) * 2), tr_read(KW + dir * 12288 + (r0 + 4) * 192 + (32 * dkb + colo) * 2));
                acc = mfma32(af, bfr, acc);
            }
            float* dc = DC + (size_t)cu_index(b, tc, hd, dir) * 4096;
#pragma unroll
            for (int r = 0; r < 16; ++r) { const int dv = 32 * dvb + (r & 3) + 8 * (r >> 2) + 4 * hh; dc[dv * 64 + 32 * dkb + l31] = acc[r]; }
            { const int d2 = tid >> 8, dk = (tid >> 2) & 63, part = tid & 3; float sm = 0.f;
#pragma unroll 4
              for (int ss = 0; ss < 16; ++ss) sm += bf2f(*(const LAS bf16_t*)(KW + d2 * 12288 + (part * 16 + ss) * 192 + dk * 2));
              sm += __shfl_xor(sm, 1); sm += __shfl_xor(sm, 2);
              if (part == 0) DN[(size_t)cu_index(b, tc, hd, d2) * 64 + dk] = sm; }
        }
        __syncthreads();
    }
}
__device__ __forceinline__ void phase_prep(int wv, const Params& p, int l, LAS unsigned char* lds) {
    prep_elem(wv, p, l, lds);
    __syncthreads();
    prep_state(wv, p, l, lds);
}

__device__ __forceinline__ void phase_scan(int wv, const Params& p, LAS unsigned char* lds) {
    const int tid = otid(wv);
    unsigned char* ws = opq(p.ws);
    const float* DC = (const float*)(ws + WS_DC); const float* DN = (const float*)(ws + WS_DN); const float* DFA = (const float*)(ws + WS_DFA);
    bf16_t* CS = (bf16_t*)(ws + WS_CS); float* NS = (float*)(ws + WS_NS); float* MS = (float*)(ws + WS_MS);
    LAS float* FA = (LAS float*)lds;
    LAS float* AL = FA + 2 * NCHUNK;
    LAS float* BE = AL + NCHUNK;
    LAS int* UI = (LAS int*)(BE + NCHUNK);
    for (int u = blockIdx.x; u < 256; u += gridDim.x) {
        const int slice = u & 7, dir = (u >> 3) & 1, h = (u >> 4) & 3, b = u >> 6;
        if (tid < NCHUNK) { const int j = tid; const int tc = dir ? ((j < 4) ? 128 + (3 - j) : 131 - j) : ((j < 4) ? 128 + j : j - 4);
            const int ui = cu_index(b, tc, h, dir); UI[j] = ui; FA[2 * j] = DFA[(size_t)ui * 2]; FA[2 * j + 1] = DFA[(size_t)ui * 2 + 1]; }
        __syncthreads();
        if (tid == 0) { float m = 0.f;
            for (int j = 0; j < NCHUNK; ++j) { const float F = FA[2 * j], a = FA[2 * j + 1]; const float mn = fmaxf(F + m, a);
                AL[j] = fexp(F + m - mn); BE[j] = fexp(a - mn); if (slice == 0) MS[UI[j]] = m; m = mn; } }
        __syncthreads();
        { const int e = slice * 512 + tid; float c = 0.f;
#pragma unroll 1
          for (int j0 = 0; j0 < NCHUNK; j0 += 12) { float d[12];
#pragma unroll
              for (int jj = 0; jj < 12; ++jj) d[jj] = DC[(size_t)UI[j0 + jj] * 4096 + e];
#pragma unroll
              for (int jj = 0; jj < 12; ++jj) { const int j = j0 + jj; CS[(size_t)UI[j] * 4096 + e] = f2bf(c); c = AL[j] * c + BE[j] * d[jj]; } } }
        if (slice == 0 && tid < 64) { float n = 0.f;
#pragma unroll 1
            for (int j0 = 0; j0 < NCHUNK; j0 += 12) { float d[12];
#pragma unroll
                for (int jj = 0; jj < 12; ++jj) d[jj] = DN[(size_t)UI[j0 + jj] * 64 + tid];
#pragma unroll
                for (int jj = 0; jj < 12; ++jj) { const int j = j0 + jj; NS[(size_t)UI[j] * 64 + tid] = n; n = AL[j] * n + BE[j] * d[jj]; } } }
        __syncthreads();
    }
}

template <int QB, class Pol>
__device__ __forceinline__ void attn_core(int wv, LAS unsigned char* lds, const Pol& pol, int q2off = 0, int o2off = 0) {
    constexpr int DQ = Pol::DQ, KS = DQ / 16, NDMA = (DQ == 96) ? 3 : 2;
    constexpr int KN_OFF = 0, KR_OFF = 8192, V_OFF = (DQ == 96) ? 12288 : 8192, STAGE = V_OFF + 8192;
    const int tid = otid(wv), lane = tid & 63, hh = lane >> 5, l31 = lane & 31;
    bf16x8 qf[QB][KS];
#pragma unroll
    for (int qb = 0; qb < QB; ++qb)
#pragma unroll
        for (int ks = 0; ks < KS; ++ks) { const u32x4 raw = *(const u32x4*)(pol.qrow + (size_t)qb * q2off + 16 * ks + 8 * hh); u32x4 sc;
#pragma unroll
            for (int q = 0; q < 4; ++q) sc[q] = pk2(bf2f(raw[q] & 0xffffu) * pol.qscale, bf2f(raw[q] >> 16) * pol.qscale);
            qf[qb][ks] = as_bf16x8(sc); }
    f32x16 O[QB][2]; float m[QB], lsum[QB];
#pragma unroll
    for (int qb = 0; qb < QB; ++qb) { O[qb][0] = zero16(); O[qb][1] = zero16(); m[qb] = pol.m0; lsum[qb] = (hh == 0) ? pol.l0 : 0.f; }
    const int drow = 8 * wv + (lane >> 3), dpos = lane & 7;
    const int kn_src = ((dpos ^ ((drow >> 1) & 7)) * 8), v_src = ((dpos ^ (((drow >> 1) & 1) << 2)) * 8);
    const int rrow = 16 * (wv & 3) + (lane >> 2), rpos = lane & 3, kr_src = 64 + ((rpos ^ ((rrow >> 2) & 3)) * 8);
    int kn_rd[2], kr_rd[2];
#pragma unroll
    for (int kbk = 0; kbk < 2; ++kbk) { const int key = 32 * kbk + l31; kn_rd[kbk] = KN_OFF + key * 128 + ((hh ^ ((key >> 1) & 7)) * 16); kr_rd[kbk] = KR_OFF + key * 64 + ((hh ^ ((key >> 2) & 3)) * 16); }
    const int q4 = (lane & 15) >> 2;
    const int vchunk = 2 * ((lane >> 4) & 1) + ((lane & 3) >> 1), vsw = ((q4 >> 1) & 1) << 2;
    const int v_rd0 = V_OFF + (4 * hh + q4) * 128 + (((vchunk) ^ vsw) * 16) + 8 * (lane & 1);
    const int v_rd1 = V_OFF + (4 * hh + q4) * 128 + (((vchunk + 4) ^ vsw) * 16) + 8 * (lane & 1);
    const int nt = pol.ntiles;
#define ATT_DMA(t, st) do { const bf16_t* kp_; const bf16_t* vp_; int ks_, vs_; pol.tile_ptrs((t), kp_, ks_, vp_, vs_); LAS unsigned char* sb_ = lds + (st) * STAGE; \
        __builtin_amdgcn_global_load_lds((const unsigned*)(kp_ + (size_t)drow * ks_ + kn_src), (LAS unsigned*)(sb_ + KN_OFF + wv * 1024), 16, 0, 0); \
        __builtin_amdgcn_global_load_lds((const unsigned*)(vp_ + (size_t)drow * vs_ + v_src), (LAS unsigned*)(sb_ + V_OFF + wv * 1024), 16, 0, 0); \
        if (DQ == 96 && wv < 4) __builtin_amdgcn_global_load_lds((const unsigned*)(kp_ + (size_t)rrow * ks_ + kr_src), (LAS unsigned*)(sb_ + KR_OFF + wv * 1024), 16, 0, 0); } while (0)
    asm volatile("s_waitcnt vmcnt(0)" ::: "memory");
    ATT_DMA(0, 0); ATT_DMA(nt > 1 ? 1 : 0, 1);
    int st = 0;
    for (int t = 0; t < nt; ++t) {
        if (NDMA == 3 && wv < 4) asm volatile("s_waitcnt vmcnt(3)" ::: "memory"); else asm volatile("s_waitcnt vmcnt(2)" ::: "memory");
        __builtin_amdgcn_s_barrier(); asm volatile("" ::: "memory");
        { const int tn = (t + 2 < nt) ? t + 2 : nt - 1; const int sn = (st == 0) ? 2 : st - 1; ATT_DMA(tn, sn); }
        if (pol.wave_active(t)) {
            LAS unsigned char* sb = lds + st * STAGE;
            f32x16 s[QB][2];
#pragma unroll
            for (int qb = 0; qb < QB; ++qb) { s[qb][0] = zero16(); s[qb][1] = zero16(); }
#pragma unroll
            for (int ks = 0; ks < KS; ++ks) {
                bf16x8 a0, a1;
                if (ks < 4) { a0 = *(const LAS bf16x8*)(sb + (kn_rd[0] ^ (ks * 32))); a1 = *(const LAS bf16x8*)(sb + (kn_rd[1] ^ (ks * 32))); }
                else { a0 = *(const LAS bf16x8*)(sb + (kr_rd[0] ^ ((ks - 4) * 32))); a1 = *(const LAS bf16x8*)(sb + (kr_rd[1] ^ ((ks - 4) * 32))); }
#pragma unroll
                for (int qb = 0; qb < QB; ++qb) { s[qb][0] = mfma32(a0, qf[qb][ks], s[qb][0]); s[qb][1] = mfma32(a1, qf[qb][ks], s[qb][1]); }
            }
            if (QB == 1 && pol.tile_masked(t)) {
#pragma unroll
                for (int r = 0; r < 16; ++r) { const int e0 = (r & 3) + 8 * (r >> 2); s[0][0][r] = pol.score(s[0][0][r], t, e0, hh); s[0][1][r] = pol.score(s[0][1][r], t, 32 + e0, hh); }
            }
            bf16x8 pf[QB][2][2];
#pragma unroll
            for (int qb = 0; qb < QB; ++qb) {
                float mx = s[qb][0][0];
#pragma unroll
                for (int r = 1; r < 16; ++r) mx = fmaxf(mx, s[qb][0][r]);
#pragma unroll
                for (int r = 0; r < 16; ++r) mx = fmaxf(mx, s[qb][1][r]);
                mx = fmaxf(mx, __shfl_xor(mx, 32));
                if (__any(mx > m[qb])) {
                    const float mn = fmaxf(m[qb], mx), alpha = fexp2(m[qb] - mn); m[qb] = mn; lsum[qb] *= alpha;
#pragma unroll
                    for (int r = 0; r < 16; ++r) { O[qb][0][r] *= alpha; O[qb][1][r] *= alpha; }
                }
                const float mc = m[qb]; float ps = 0.f;
#pragma unroll
                for (int r = 0; r < 16; ++r) { s[qb][0][r] = fexp2(s[qb][0][r] - mc); s[qb][1][r] = fexp2(s[qb][1][r] - mc); ps += s[qb][0][r] + s[qb][1][r]; }
                lsum[qb] += ps;
#pragma unroll
                for (int sx = 0; sx < 2; ++sx) { u32x4 w0, w1;
#pragma unroll
                    for (int q = 0; q < 4; ++q) { w0[q] = pk2(s[qb][0][8 * sx + 2 * q], s[qb][0][8 * sx + 2 * q + 1]); w1[q] = pk2(s[qb][1][8 * sx + 2 * q], s[qb][1][8 * sx + 2 * q + 1]); }
                    pf[qb][0][sx] = as_bf16x8(w0); pf[qb][1][sx] = as_bf16x8(w1); }
            }
            {
                LAS unsigned char* va = sb + v_rd0; LAS unsigned char* vbp = sb + v_rd1;
                u32x2 x0, x1, x2, x3, x4, x5, x6, x7;
#define TRR8(o0, o1, o2, o3, o4, o5, o6, o7) asm volatile( \
                    "ds_read_b64_tr_b16 %0, %8 offset:" #o0 "\n\tds_read_b64_tr_b16 %1, %8 offset:" #o1 "\n\tds_read_b64_tr_b16 %2, %9 offset:" #o2 "\n\tds_read_b64_tr_b16 %3, %9 offset:" #o3 "\n\t" \
                    "ds_read_b64_tr_b16 %4, %8 offset:" #o4 "\n\tds_read_b64_tr_b16 %5, %8 offset:" #o5 "\n\tds_read_b64_tr_b16 %6, %9 offset:" #o6 "\n\tds_read_b64_tr_b16 %7, %9 offset:" #o7 "\n\t" \
                    "s_waitcnt lgkmcnt(0)" \
                    : "=&v"(x0), "=&v"(x1), "=&v"(x2), "=&v"(x3), "=&v"(x4), "=&v"(x5), "=&v"(x6), "=&v"(x7) : "v"(va), "v"(vbp) : "memory")
#define V8(a, b) as_bf16x8((u32x4){(a).x, (a).y, (b).x, (b).y})
                TRR8(0, 1024, 0, 1024, 2048, 3072, 2048, 3072);
#pragma unroll
                for (int qb = 0; qb < QB; ++qb) { O[qb][0] = mfma32(V8(x0, x1), pf[qb][0][0], O[qb][0]); O[qb][1] = mfma32(V8(x2, x3), pf[qb][0][0], O[qb][1]);
                                                  O[qb][0] = mfma32(V8(x4, x5), pf[qb][0][1], O[qb][0]); O[qb][1] = mfma32(V8(x6, x7), pf[qb][0][1], O[qb][1]); }
                TRR8(4096, 5120, 4096, 5120, 6144, 7168, 6144, 7168);
#pragma unroll
                for (int qb = 0; qb < QB; ++qb) { O[qb][0] = mfma32(V8(x0, x1), pf[qb][1][0], O[qb][0]); O[qb][1] = mfma32(V8(x2, x3), pf[qb][1][0], O[qb][1]);
                                                  O[qb][0] = mfma32(V8(x4, x5), pf[qb][1][1], O[qb][0]); O[qb][1] = mfma32(V8(x6, x7), pf[qb][1][1], O[qb][1]); }
#undef V8
#undef TRR8
            }
        }
        st = (st == 2) ? 0 : st + 1;
    }
#undef ATT_DMA
    asm volatile("s_waitcnt vmcnt(0)" ::: "memory");
    __builtin_amdgcn_s_barrier(); asm volatile("" ::: "memory");
#pragma unroll
    for (int qb = 0; qb < QB; ++qb) {
        float ls = lsum[qb]; ls += __shfl_xor(ls, 32);
        const float inv = 1.0f / ls; ym_t* orow = pol.orow + (size_t)qb * o2off;
#pragma unroll
        for (int g = 0; g < 4; ++g) {
            ym_store4(orow + 8 * g + 4 * hh, O[qb][0][4 * g] * inv, O[qb][0][4 * g + 1] * inv, O[qb][0][4 * g + 2] * inv, O[qb][0][4 * g + 3] * inv);
            ym_store4(orow + 32 + 8 * g + 4 * hh, O[qb][1][4 * g] * inv, O[qb][1][4 * g + 1] * inv, O[qb][1][4 * g + 2] * inv, O[qb][1][4 * g + 3] * inv);
        }
    }
}

template <int QB, class Pol>
__device__ __forceinline__ void attn_pp(int wv, LAS unsigned char* lds, const Pol& pol, int q2off = 0, int o2off = 0) {
    constexpr int DQ = Pol::DQ, KS = DQ / 16, NDMA = (DQ == 96) ? 3 : 2;
    constexpr int KN_OFF = 0, KR_OFF = 8192, V_OFF = (DQ == 96) ? 12288 : 8192, STAGE = V_OFF + 8192;
    const int tid = otid(wv), lane = tid & 63, hh = lane >> 5, l31 = lane & 31;
    const int grp = wv >> 2;
    bf16x8 qf[QB][KS];
#pragma unroll
    for (int qb = 0; qb < QB; ++qb)
#pragma unroll
        for (int ks = 0; ks < KS; ++ks) { const u32x4 raw = *(const u32x4*)(pol.qrow + (size_t)qb * q2off + 16 * ks + 8 * hh); u32x4 sc;
#pragma unroll
            for (int q = 0; q < 4; ++q) sc[q] = pk2(bf2f(raw[q] & 0xffffu) * pol.qscale, bf2f(raw[q] >> 16) * pol.qscale);
            qf[qb][ks] = as_bf16x8(sc); }
    f32x16 O[QB][2]; float m[QB], lsum[QB];
#pragma unroll
    for (int qb = 0; qb < QB; ++qb) { O[qb][0] = zero16(); O[qb][1] = zero16(); m[qb] = pol.m0; lsum[qb] = (hh == 0) ? pol.l0 : 0.f; }
    const int drow = 8 * wv + (lane >> 3), dpos = lane & 7;
    const int kn_src = ((dpos ^ ((drow >> 1) & 7)) * 8), v_src = ((dpos ^ (((drow >> 1) & 1) << 2)) * 8);
    const int rrow = 16 * (wv & 3) + (lane >> 2), rpos = lane & 3, kr_src = 64 + ((rpos ^ ((rrow >> 2) & 3)) * 8);
    int kn_rd[2], kr_rd[2];
#pragma unroll
    for (int kbk = 0; kbk < 2; ++kbk) { const int key = 32 * kbk + l31; kn_rd[kbk] = KN_OFF + key * 128 + ((hh ^ ((key >> 1) & 7)) * 16); kr_rd[kbk] = KR_OFF + key * 64 + ((hh ^ ((key >> 2) & 3)) * 16); }
    const int q4 = (lane & 15) >> 2;
    const int vchunk = 2 * ((lane >> 4) & 1) + ((lane & 3) >> 1), vsw = ((q4 >> 1) & 1) << 2;
    const int v_rd0 = V_OFF + (4 * hh + q4) * 128 + (((vchunk) ^ vsw) * 16) + 8 * (lane & 1);
    const int v_rd1 = V_OFF + (4 * hh + q4) * 128 + (((vchunk + 4) ^ vsw) * 16) + 8 * (lane & 1);
    const int nt = pol.ntiles;
#define ATT_DMA(t, st) do { const bf16_t* kp_; const bf16_t* vp_; int ks_, vs_; pol.tile_ptrs((t), kp_, ks_, vp_, vs_); LAS unsigned char* sb_ = lds + (st) * STAGE; \
        __builtin_amdgcn_global_load_lds((const unsigned*)(kp_ + (size_t)drow * ks_ + kn_src), (LAS unsigned*)(sb_ + KN_OFF + wv * 1024), 16, 0, 0); \
        __builtin_amdgcn_global_load_lds((const unsigned*)(vp_ + (size_t)drow * vs_ + v_src), (LAS unsigned*)(sb_ + V_OFF + wv * 1024), 16, 0, 0); \
        if (DQ == 96 && wv < 4) __builtin_amdgcn_global_load_lds((const unsigned*)(kp_ + (size_t)rrow * ks_ + kr_src), (LAS unsigned*)(sb_ + KR_OFF + wv * 1024), 16, 0, 0); } while (0)
#define ATT_WAIT1() do { if (NDMA == 3 && wv < 4) asm volatile("s_waitcnt vmcnt(3)" ::: "memory"); else asm volatile("s_waitcnt vmcnt(2)" ::: "memory"); } while (0)
#define ATT_BAR() do { asm volatile("" ::: "memory"); __builtin_amdgcn_s_barrier(); asm volatile("" ::: "memory"); } while (0)
    asm volatile("s_waitcnt vmcnt(0)" ::: "memory");
    ATT_DMA(0, 0); ATT_DMA(nt > 1 ? 1 : 0, 1);
    ATT_WAIT1();
    if (grp == 1) ATT_BAR();
    f32x16 s[QB][2]; bf16x8 pf[QB][2][2];
    bool act_prev = false;
#pragma unroll
    for (int qb = 0; qb < QB; ++qb) { s[qb][0] = zero16(); s[qb][1] = zero16();
#pragma unroll
        for (int a = 0; a < 2; ++a)
#pragma unroll
            for (int b = 0; b < 2; ++b) pf[qb][a][b] = as_bf16x8((u32x4){0u, 0u, 0u, 0u}); }
    for (int t = 0; t <= nt; ++t) {
        ATT_BAR();
        { const int tn = (t + 2 < nt) ? t + 2 : nt - 1; ATT_DMA(tn, (t + 2) & 3); }
        if (t > 0 && act_prev) {
            LAS unsigned char* sb = lds + ((t - 1) & 3) * STAGE;
            LAS unsigned char* va = sb + v_rd0; LAS unsigned char* vbp = sb + v_rd1;
            u32x2 x0, x1, x2, x3, x4, x5, x6, x7;
#define TRR8(o0, o1, o2, o3, o4, o5, o6, o7) asm volatile( \
                "ds_read_b64_tr_b16 %0, %8 offset:" #o0 "\n\tds_read_b64_tr_b16 %1, %8 offset:" #o1 "\n\tds_read_b64_tr_b16 %2, %9 offset:" #o2 "\n\tds_read_b64_tr_b16 %3, %9 offset:" #o3 "\n\t" \
                "ds_read_b64_tr_b16 %4, %8 offset:" #o4 "\n\tds_read_b64_tr_b16 %5, %8 offset:" #o5 "\n\tds_read_b64_tr_b16 %6, %9 offset:" #o6 "\n\tds_read_b64_tr_b16 %7, %9 offset:" #o7 "\n\t" \
                "s_waitcnt lgkmcnt(0)" \
                : "=&v"(x0), "=&v"(x1), "=&v"(x2), "=&v"(x3), "=&v"(x4), "=&v"(x5), "=&v"(x6), "=&v"(x7) : "v"(va), "v"(vbp) : "memory")
#define V8(a, b) as_bf16x8((u32x4){(a).x, (a).y, (b).x, (b).y})
            TRR8(0, 1024, 0, 1024, 2048, 3072, 2048, 3072);
#pragma unroll
            for (int qb = 0; qb < QB; ++qb) { O[qb][0] = mfma32(V8(x0, x1), pf[qb][0][0], O[qb][0]); O[qb][1] = mfma32(V8(x2, x3), pf[qb][0][0], O[qb][1]);
                                              O[qb][0] = mfma32(V8(x4, x5), pf[qb][0][1], O[qb][0]); O[qb][1] = mfma32(V8(x6, x7), pf[qb][0][1], O[qb][1]); }
            TRR8(4096, 5120, 4096, 5120, 6144, 7168, 6144, 7168);
#pragma unroll
            for (int qb = 0; qb < QB; ++qb) { O[qb][0] = mfma32(V8(x0, x1), pf[qb][1][0], O[qb][0]); O[qb][1] = mfma32(V8(x2, x3), pf[qb][1][0], O[qb][1]);
                                              O[qb][0] = mfma32(V8(x4, x5), pf[qb][1][1], O[qb][0]); O[qb][1] = mfma32(V8(x6, x7), pf[qb][1][1], O[qb][1]); }
#undef V8
#undef TRR8
        }
        const bool act = (t < nt) && pol.wave_active(t);
        if (act) {
            LAS unsigned char* sb = lds + (t & 3) * STAGE;
#pragma unroll
            for (int qb = 0; qb < QB; ++qb) { s[qb][0] = zero16(); s[qb][1] = zero16(); }
#pragma unroll
            for (int ks = 0; ks < KS; ++ks) {
                bf16x8 a0, a1;
                if (ks < 4) { a0 = *(const LAS bf16x8*)(sb + (kn_rd[0] ^ (ks * 32))); a1 = *(const LAS bf16x8*)(sb + (kn_rd[1] ^ (ks * 32))); }
                else { a0 = *(const LAS bf16x8*)(sb + (kr_rd[0] ^ ((ks - 4) * 32))); a1 = *(const LAS bf16x8*)(sb + (kr_rd[1] ^ ((ks - 4) * 32))); }
#pragma unroll
                for (int qb = 0; qb < QB; ++qb) { s[qb][0] = mfma32(a0, qf[qb][ks], s[qb][0]); s[qb][1] = mfma32(a1, qf[qb][ks], s[qb][1]); }
            }
        }
        ATT_WAIT1();
        ATT_BAR();
        if (act) {
            if (QB == 1 && pol.tile_masked(t)) {
#pragma unroll
                for (int r = 0; r < 16; ++r) { const int e0 = (r & 3) + 8 * (r >> 2); s[0][0][r] = pol.score(s[0][0][r], t, e0, hh); s[0][1][r] = pol.score(s[0][1][r], t, 32 + e0, hh); }
            }
#pragma unroll
            for (int qb = 0; qb < QB; ++qb) {
                float mx = s[qb][0][0];
#pragma unroll
                for (int r = 1; r < 16; ++r) mx = fmaxf(mx, s[qb][0][r]);
#pragma unroll
                for (int r = 0; r < 16; ++r) mx = fmaxf(mx, s[qb][1][r]);
                mx = fmaxf(mx, __shfl_xor(mx, 32));
                if (__any(mx > m[qb])) {
                    const float mn = fmaxf(m[qb], mx), alpha = fexp2(m[qb] - mn); m[qb] = mn; lsum[qb] *= alpha;
#pragma unroll
                    for (int r = 0; r < 16; ++r) { O[qb][0][r] *= alpha; O[qb][1][r] *= alpha; }
                }
                const float mc = m[qb]; float ps = 0.f;
#pragma unroll
                for (int r = 0; r < 16; ++r) { s[qb][0][r] = fexp2(s[qb][0][r] - mc); s[qb][1][r] = fexp2(s[qb][1][r] - mc); ps += s[qb][0][r] + s[qb][1][r]; }
                lsum[qb] += ps;
#pragma unroll
                for (int sx = 0; sx < 2; ++sx) { u32x4 w0, w1;
#pragma unroll
                    for (int q = 0; q < 4; ++q) { w0[q] = pk2(s[qb][0][8 * sx + 2 * q], s[qb][0][8 * sx + 2 * q + 1]); w1[q] = pk2(s[qb][1][8 * sx + 2 * q], s[qb][1][8 * sx + 2 * q + 1]); }
                    pf[qb][0][sx] = as_bf16x8(w0); pf[qb][1][sx] = as_bf16x8(w1); }
            }
        }
        act_prev = act;
    }
    if (grp == 0) ATT_BAR();
#undef ATT_DMA
#undef ATT_WAIT1
    asm volatile("s_waitcnt vmcnt(0)" ::: "memory");
    ATT_BAR();
#undef ATT_BAR
#pragma unroll
    for (int qb = 0; qb < QB; ++qb) {
        float ls = lsum[qb]; ls += __shfl_xor(ls, 32);
        const float inv = 1.0f / ls; ym_t* orow = pol.orow + (size_t)qb * o2off;
#pragma unroll
        for (int g = 0; g < 4; ++g) {
            ym_store4(orow + 8 * g + 4 * hh, O[qb][0][4 * g] * inv, O[qb][0][4 * g + 1] * inv, O[qb][0][4 * g + 2] * inv, O[qb][0][4 * g + 3] * inv);
            ym_store4(orow + 32 + 8 * g + 4 * hh, O[qb][1][4 * g] * inv, O[qb][1][4 * g + 1] * inv, O[qb][1][4 * g + 2] * inv, O[qb][1][4 * g + 3] * inv);
        }
    }
}

template <int QB, class Pol>
__device__ __forceinline__ void attn_core_old(int wv, LAS unsigned char* lds, const Pol& pol, int q2off = 0, int o2off = 0) {
    constexpr int DQ = Pol::DQ, KS = DQ / 16, KROW = DQ * 2 + 16, VROW = 192, KBUF = 64 * KROW, VBUF = 64 * VROW, KCH = DQ / 8;
    const int tid = otid(wv), lane = tid & 63, hh = lane >> 5, l31 = lane & 31;
    LAS unsigned char* kb = lds; LAS unsigned char* vb = lds + 2 * KBUF;
    bf16x8 qf[QB][KS];
#pragma unroll
    for (int qb = 0; qb < QB; ++qb)
#pragma unroll
        for (int ks = 0; ks < KS; ++ks) { const u32x4 raw = *(const u32x4*)(pol.qrow + (size_t)qb * q2off + 16 * ks + 8 * hh); u32x4 sc;
#pragma unroll
            for (int q = 0; q < 4; ++q) sc[q] = pk2(bf2f(raw[q] & 0xffffu) * pol.qscale, bf2f(raw[q] >> 16) * pol.qscale);
            qf[qb][ks] = as_bf16x8(sc); }
    f32x16 O[QB][2]; float m[QB], lsum[QB];
#pragma unroll
    for (int qb = 0; qb < QB; ++qb) { O[qb][0] = zero16(); O[qb][1] = zero16(); m[qb] = pol.m0; lsum[qb] = (hh == 0) ? pol.l0 : 0.f; }
    const int kkey0 = tid / KCH, kpart0 = tid % KCH, c1 = tid + NTHR, kkey1 = c1 / KCH, kpart1 = c1 % KCH; const bool has1 = c1 < 64 * KCH;
    const int vkey = tid >> 3, vpart = tid & 7;
    u32x4 kr0, kr1 = (u32x4){0u, 0u, 0u, 0u}, vr;
    const int q4 = (lane & 15) >> 2, colo = 16 * ((lane >> 4) & 1) + 4 * (lane & 3);
    const int nt = pol.ntiles;
#define ATT_GLOAD(t) do { const bf16_t* kp_; const bf16_t* vp_; int ks_, vs_; pol.tile_ptrs((t), kp_, ks_, vp_, vs_); \
        kr0 = *(const u32x4*)(kp_ + (size_t)kkey0 * ks_ + kpart0 * 8); if (has1) kr1 = *(const u32x4*)(kp_ + (size_t)kkey1 * ks_ + kpart1 * 8); \
        vr = *(const u32x4*)(vp_ + (size_t)vkey * vs_ + vpart * 8); } while (0)
#define ATT_LSTORE(buf) do { *(LAS u32x4*)(kb + (buf) * KBUF + kkey0 * KROW + kpart0 * 16) = kr0; if (has1) *(LAS u32x4*)(kb + (buf) * KBUF + kkey1 * KROW + kpart1 * 16) = kr1; \
        *(LAS u32x4*)(vb + (buf) * VBUF + vkey * VROW + vpart * 16) = vr; } while (0)
    ATT_GLOAD(0); ATT_LSTORE(0); __syncthreads();
    for (int t = 0; t < nt; ++t) {
        const int buf = t & 1;
        if (t + 1 < nt) ATT_GLOAD(t + 1);
        if (pol.wave_active(t)) {
            LAS unsigned char* kt = kb + buf * KBUF; LAS unsigned char* vt = vb + buf * VBUF;
            f32x16 s[QB][2];
#pragma unroll
            for (int qb = 0; qb < QB; ++qb) { s[qb][0] = zero16(); s[qb][1] = zero16(); }
#pragma unroll
            for (int ks = 0; ks < KS; ++ks) {
                const bf16x8 a0 = *(const LAS bf16x8*)(kt + l31 * KROW + (16 * ks + 8 * hh) * 2);
                const bf16x8 a1 = *(const LAS bf16x8*)(kt + (32 + l31) * KROW + (16 * ks + 8 * hh) * 2);
#pragma unroll
                for (int qb = 0; qb < QB; ++qb) { s[qb][0] = mfma32(a0, qf[qb][ks], s[qb][0]); s[qb][1] = mfma32(a1, qf[qb][ks], s[qb][1]); }
            }
            if (QB == 1 && pol.tile_masked(t)) {
#pragma unroll
                for (int r = 0; r < 16; ++r) { const int e0 = (r & 3) + 8 * (r >> 2); s[0][0][r] = pol.score(s[0][0][r], t, e0, hh); s[0][1][r] = pol.score(s[0][1][r], t, 32 + e0, hh); }
            }
            bf16x8 pf[QB][2][2];
#pragma unroll
            for (int qb = 0; qb < QB; ++qb) {
                float mx = s[qb][0][0];
#pragma unroll
                for (int r = 1; r < 16; ++r) mx = fmaxf(mx, s[qb][0][r]);
#pragma unroll
                for (int r = 0; r < 16; ++r) mx = fmaxf(mx, s[qb][1][r]);
                mx = fmaxf(mx, __shfl_xor(mx, 32));
                if (__any(mx > m[qb])) {
                    const float mn = fmaxf(m[qb], mx), alpha = fexp2(m[qb] - mn); m[qb] = mn; lsum[qb] *= alpha;
#pragma unroll
                    for (int r = 0; r < 16; ++r) { O[qb][0][r] *= alpha; O[qb][1][r] *= alpha; }
                }
                const float mc = m[qb]; float ps = 0.f;
#pragma unroll
                for (int r = 0; r < 16; ++r) { s[qb][0][r] = fexp2(s[qb][0][r] - mc); s[qb][1][r] = fexp2(s[qb][1][r] - mc); ps += s[qb][0][r] + s[qb][1][r]; }
                lsum[qb] += ps;
#pragma unroll
                for (int sx = 0; sx < 2; ++sx) { u32x4 w0, w1;
#pragma unroll
                    for (int q = 0; q < 4; ++q) { w0[q] = pk2(s[qb][0][8 * sx + 2 * q], s[qb][0][8 * sx + 2 * q + 1]); w1[q] = pk2(s[qb][1][8 * sx + 2 * q], s[qb][1][8 * sx + 2 * q + 1]); }
                    pf[qb][0][sx] = as_bf16x8(w0); pf[qb][1][sx] = as_bf16x8(w1); }
            }
#pragma unroll
            for (int kbk = 0; kbk < 2; ++kbk)
#pragma unroll
                for (int sx = 0; sx < 2; ++sx) {
                    const int r0 = 32 * kbk + 16 * sx + 4 * hh + q4;
                    const bf16x8 v0 = cat8(tr_read(vt + r0 * VROW + colo * 2), tr_read(vt + (r0 + 8) * VROW + colo * 2));
                    const bf16x8 v1 = cat8(tr_read(vt + r0 * VROW + (32 + colo) * 2), tr_read(vt + (r0 + 8) * VROW + (32 + colo) * 2));
#pragma unroll
                    for (int qb = 0; qb < QB; ++qb) { O[qb][0] = mfma32(v0, pf[qb][kbk][sx], O[qb][0]); O[qb][1] = mfma32(v1, pf[qb][kbk][sx], O[qb][1]); }
                }
        }
        if (t + 1 < nt) ATT_LSTORE(buf ^ 1);
        __syncthreads();
    }
#undef ATT_GLOAD
#undef ATT_LSTORE
#pragma unroll
    for (int qb = 0; qb < QB; ++qb) {
        float ls = lsum[qb]; ls += __shfl_xor(ls, 32);
        const float inv = 1.0f / ls; ym_t* orow = pol.orow + (size_t)qb * o2off;
#pragma unroll
        for (int g = 0; g < 4; ++g) {
            ym_store4(orow + 8 * g + 4 * hh, O[qb][0][4 * g] * inv, O[qb][0][4 * g + 1] * inv, O[qb][0][4 * g + 2] * inv, O[qb][0][4 * g + 3] * inv);
            ym_store4(orow + 32 + 8 * g + 4 * hh, O[qb][1][4 * g] * inv, O[qb][1][4 * g + 1] * inv, O[qb][1][4 * g + 2] * inv, O[qb][1][4 * g + 3] * inv);
        }
    }
}

constexpr float NEG_INF = -__builtin_inff();
struct PolD {
    static constexpr int DQ = 96;
    const bf16_t *kbase, *vbase, *kctx, *vctx, *qrow; ym_t* orow; int nloc, ntiles; float qscale, m0, l0;
    __device__ __forceinline__ void tile_ptrs(int t, const bf16_t*& kp, int& ks, const bf16_t*& vp, int& vs) const {
        ks = 384; vs = 256;
        if (t < nloc) { kp = kbase + (size_t)t * 64 * 384; vp = vbase + (size_t)t * 64 * 256; } else { kp = kctx + (size_t)(t - nloc) * 64 * 384; vp = vctx + (size_t)(t - nloc) * 64 * 256; } }
    __device__ __forceinline__ bool wave_active(int) const { return true; }
    __device__ __forceinline__ bool tile_masked(int) const { return false; }
    __device__ __forceinline__ float score(float s, int, int, int) const { return s; }
};
struct PolA {
    static constexpr int DQ = 64;
    const bf16_t *kbase, *vbase, *kctx, *vctx, *qrow; ym_t* orow; int nloc, ntiles; float qscale, m0, l0;
    int kp0, q0, qpos;
    __device__ __forceinline__ void tile_ptrs(int t, const bf16_t*& kp, int& ks, const bf16_t*& vp, int& vs) const {
        ks = 128; vs = NP;
        if (t < nloc) { const int k0 = kp0 + 64 * t; kp = kbase + (size_t)k0 * 128; vp = vbase + (size_t)k0 * NP; } else { kp = kctx + (size_t)(t - nloc) * 64 * 128; vp = vctx + (size_t)(t - nloc) * 64 * NP; } }
    __device__ __forceinline__ bool wave_active(int t) const { const int k0 = kp0 + 64 * t; return t >= nloc || (k0 + 63 >= q0 - 128 && k0 <= q0 + 31 + 128); }
    __device__ __forceinline__ bool tile_masked(int t) const { const int k0 = kp0 + 64 * t; return t < nloc && !(k0 >= q0 + 31 - 128 && k0 + 63 <= q0 + 128); }
    __device__ __forceinline__ float score(float s, int t, int e0, int hh) const { const int d = qpos - (kp0 + 64 * t + e0 + 4 * hh); return (d <= 128 && d >= -128) ? s : NEG_INF; }
};
struct PolB {
    static constexpr int DQ = 64;
    const bf16_t *kbase, *vbase, *kctx, *vctx, *qrow; ym_t* orow; int nloc, ntiles; float qscale, m0, l0;
    int klo, wr0, r, c; const LAS float* rpb;
    unsigned mlo, mhi; int bbase;
    __device__ __forceinline__ void set_lane(int hh) { const int cs = min(max(c - 8, 0), 48); const unsigned long long m = (0xffffull << cs) >> (4 * hh); mlo = (unsigned)m; mhi = (unsigned)(m >> 32); bbase = 15 - c + 4 * hh; }
    __device__ __forceinline__ void tile_ptrs(int t, const bf16_t*& kp, int& ks, const bf16_t*& vp, int& vs) const {
        ks = NP; vs = NP;
        if (t < nloc) { kp = kbase + (size_t)(klo + t) * 64 * NP; vp = vbase + (size_t)(klo + t) * 64 * NP; } else { kp = kctx + (size_t)(t - nloc) * 64 * NP; vp = vctx + (size_t)(t - nloc) * 64 * NP; } }
    __device__ __forceinline__ bool wave_active(int t) const { return t >= nloc || (klo + t >= wr0 && klo + t < wr0 + 8); }
    __device__ __forceinline__ bool tile_masked(int t) const { return t < nloc; }
    __device__ __forceinline__ float score(float s, int t, int e0, int) const {
        const bool ok = ((e0 < 32 ? (mlo >> e0) : (mhi >> (e0 - 32))) & 1u) != 0u;
        const float bias = rpb[(klo + t - r + 7) * 31 + bbase + e0];
        return ok ? s + bias : NEG_INF; }
};

struct XQ { unsigned* heads; int x, per; int dx; };
__device__ __forceinline__ int q_next(int tid, XQ& q, LAS int* slot) {
    for (;;) {
        if (q.dx >= 8) return -1;
        const int xx = (q.x + q.dx) & 7;
        __syncthreads();
        if (tid == 0) *slot = (int)__hip_atomic_fetch_add(q.heads + xx * 64, 1u, __ATOMIC_RELAXED, __HIP_MEMORY_SCOPE_AGENT);
        __syncthreads();
        const int j = *slot;
        if (j < q.per) return xx * q.per + j;
        ++q.dx;
    }
}

__device__ __forceinline__ void mlstm_out_pair(int wv, const Params& p, LAS unsigned char* lds, int l, int u0, int u1) {
    const int tid = otid(wv), lane = tid & 63, w = tid >> 6, hh = lane >> 5, l31 = lane & 31;
    const int half = w >> 2, wl = w & 3;
    unsigned char* ws = opq(p.ws);
    const bf16_t* P = (const bf16_t*)(ws + WS_P); const bf16_t* QC = (const bf16_t*)(ws + WS_QC); const bf16_t* KC = (const bf16_t*)(ws + WS_KC);
    const float* GATES = (const float*)(ws + WS_GATES); const bf16_t* CS = (const bf16_t*)(ws + WS_CS); const float* NS = (const float*)(ws + WS_NS); const float* MS = (const float*)(ws + WS_MS);
    ym_t* YMIX = (ym_t*)(ws + WS_YMIX);
    const bool need_ctx = (l == 0);
    const int u = half ? u1 : u0; const bool valid = u >= 0;
    const int hd = u & 3, v = u >> 2; int b, tc;
    if (need_ctx) { b = v / NCHUNK; tc = v % NCHUNK; } else { b = v >> 7; tc = v & 127; }
    LAS unsigned char* hb = lds + half * 36864;
    LAS unsigned char* VT = hb;
    LAS float* ZU = (LAS float*)(hb + 12288);
    LAS float* ZC = ZU + 128;
    LAS float* ZI = ZC + 128;
    LAS float* ZE = ZI + 128;
    LAS float* ZN = ZE + 128;
    LAS float* ZH = (LAS float*)(hb + 16384);
    const int row0 = (tc < 128) ? b * SEQ + tc * 64 : TL + b * CTXL + (tc - 128) * 64;
    if (valid) {
        if (wl < 2) { const int dir = wl, i = dir ? 63 - lane : lane;
            const float lf = GATES[(size_t)(row0 + i) * 16 + (dir ? 12 : 4) + hd], ig = GATES[(size_t)(row0 + i) * 16 + (dir ? 8 : 0) + hd];
            const float bc = wave_incl_sum(lf, lane), uu = ig - bc, pm = wave_incl_max(uu, lane);
            const float min_ = MS[cu_index(b, tc, hd, dir)], mx = fmaxf(min_, pm);
            ZU[dir * 64 + lane] = uu; ZC[dir * 64 + lane] = -mx; ZI[dir * 64 + lane] = fexp(min_ - mx); ZE[dir * 64 + lane] = fexp(-(bc + mx));
        } else { const int dir = wl - 2; ZN[dir * 64 + lane] = NS[(size_t)cu_index(b, tc, hd, dir) * 64 + lane]; }
        { const int t4 = wl * 64 + lane;
#pragma unroll
          for (int ps = 0; ps < 2; ++ps) { const int c = t4 + 256 * ps, s = c >> 3, part = c & 7; *(LAS u32x4*)(VT + s * 192 + part * 16) = *(const u32x4*)(P + (size_t)(row0 + s) * NP + PC_CV + hd * 64 + part * 8); } }
    }
    __syncthreads();
    const int dir = wl >> 1, tb = wl & 1;
    const int t = 32 * tb + l31, it = dir ? 63 - t : t;
    f32x16 acc[2], acc2[2]; float inter = 0.f, rden = 0.f;
    if (valid) {
        bf16x8 qf[4];
#pragma unroll
        for (int ks = 0; ks < 4; ++ks) qf[ks] = *(const bf16x8*)(QC + (size_t)(row0 + it) * 256 + hd * 64 + 16 * ks + 8 * hh);
        f32x16 st[2];
#pragma unroll
        for (int sb = 0; sb < 2; ++sb) { const int s = 32 * sb + l31, is = dir ? 63 - s : s; st[sb] = zero16();
#pragma unroll
            for (int ks = 0; ks < 4; ++ks) { const bf16x8 a = *(const bf16x8*)(KC + (size_t)(row0 + is) * 256 + hd * 64 + 16 * ks + 8 * hh); st[sb] = mfma32(a, qf[ks], st[sb]); } }
        const float ct = ZC[dir * 64 + t];
        float dsum = 0.f;
#pragma unroll
        for (int sb = 0; sb < 2; ++sb)
#pragma unroll
            for (int r = 0; r < 16; ++r) { const int s = 32 * sb + (r & 3) + 8 * (r >> 2) + 4 * hh;
                const float vv = (s <= t) ? st[sb][r] * fexp(ZU[dir * 64 + s] + ct) : 0.f; st[sb][r] = vv; dsum += vv; }
        dsum += __shfl_xor(dsum, 32);
        acc[0] = zero16(); acc[1] = zero16(); acc2[0] = zero16(); acc2[1] = zero16();
        const int q4 = (lane & 15) >> 2, colo = 16 * ((lane >> 4) & 1) + 4 * (lane & 3);
#pragma unroll
        for (int sb = 0; sb < 2; ++sb)
#pragma unroll
            for (int s2 = 0; s2 < 2; ++s2) { u32x4 wvv;
#pragma unroll
                for (int q = 0; q < 4; ++q) wvv[q] = pk2(st[sb][8 * s2 + 2 * q], st[sb][8 * s2 + 2 * q + 1]);
                const int sa = 32 * sb + 16 * s2 + 4 * hh + q4, sb8 = sa + 8;
                const int ia = dir ? 63 - sa : sa, ib = dir ? 63 - sb8 : sb8;
#pragma unroll
                for (int dvb = 0; dvb < 2; ++dvb) { const bf16x8 vf = cat8(tr_read(VT + ia * 192 + (32 * dvb + colo) * 2), tr_read(VT + ib * 192 + (32 * dvb + colo) * 2));
                    acc[dvb] = mfma32(vf, as_bf16x8(wvv), acc[dvb]); } }
        float qn = 0.f;
#pragma unroll
        for (int ks = 0; ks < 4; ++ks) {
#pragma unroll
            for (int dvb = 0; dvb < 2; ++dvb) { const bf16x8 cf = *(const bf16x8*)(CS + (size_t)cu_index(b, tc, hd, dir) * 4096 + (size_t)(32 * dvb + l31) * 64 + 16 * ks + 8 * hh); acc2[dvb] = mfma32(cf, qf[ks], acc2[dvb]); }
#pragma unroll
            for (int j = 0; j < 8; ++j) qn += bf2f((unsigned)(unsigned short)qf[ks][j]) * ZN[dir * 64 + 16 * ks + 8 * hh + j]; }
        qn += __shfl_xor(qn, 32);
        inter = ZI[dir * 64 + t]; const float den = dsum + inter * qn; rden = 1.0f / fmaxf(fabsf(den), ZE[dir * 64 + t]);
#pragma unroll
        for (int dvb = 0; dvb < 2; ++dvb)
#pragma unroll
            for (int r = 0; r < 16; ++r) acc[dvb][r] = (acc[dvb][r] + inter * acc2[dvb][r]) * rden;
        if (dir == 1) {
#pragma unroll
            for (int dvb = 0; dvb < 2; ++dvb)
#pragma unroll
                for (int r = 0; r < 16; ++r) ZH[it * 65 + 32 * dvb + (r & 3) + 8 * (r >> 2) + 4 * hh] = acc[dvb][r];
        }
    }
    __syncthreads();
    if (valid && dir == 0) {
#pragma unroll
        for (int dvb = 0; dvb < 2; ++dvb)
#pragma unroll
            for (int g = 0; g < 4; ++g) { const int dv = 32 * dvb + 8 * g + 4 * hh;
                const u32x2 ov = *(const u32x2*)(P + (size_t)(row0 + it) * NP + PC_CO + hd * 64 + dv);
                const float o0 = sigmoidf_(bf2f(ov.x & 0xffffu)), o1 = sigmoidf_(bf2f(ov.x >> 16)), o2 = sigmoidf_(bf2f(ov.y & 0xffffu)), o3 = sigmoidf_(bf2f(ov.y >> 16));
                const float h0 = acc[dvb][4 * g] + ZH[it * 65 + dv], h1 = acc[dvb][4 * g + 1] + ZH[it * 65 + dv + 1], h2 = acc[dvb][4 * g + 2] + ZH[it * 65 + dv + 2], h3 = acc[dvb][4 * g + 3] + ZH[it * 65 + dv + 3];
                ym_store4(YMIX + (size_t)(row0 + it) * 1024 + 512 + hd * 64 + dv, o0 * h0, o1 * h1, o2 * h2, o3 * h3); }
    }
    __syncthreads();
}


#define MIX_COMMON \
    const int qo = probe ? 4 : 0; \
    const int tid = otid(wv), lane = tid & 63, w = tid >> 6, l31 = lane & 31; \
    unsigned char* ws = opq(p.ws); \
    unsigned* ctl = (unsigned*)(ws + WS_CTL); \
    LAS int* slot = (LAS int*)(lds + LDS_MISC + 64); \
    const int myx = *(const LAS int*)(lds + LDS_MISC + 72); \
    const bf16_t* P = (const bf16_t*)(ws + WS_P); \
    ym_t* YMIX = (ym_t*)(ws + WS_YMIX); \
    const bool need_ctx = (l == 0); (void)lane; (void)P;

__device__ __forceinline__ void mix_D(int wv, const Params& p, int l, LAS unsigned char* lds, bool probe) {
    MIX_COMMON
    const bf16_t* QD = (const bf16_t*)(ws + WS_QD); const bf16_t* KD = (const bf16_t*)(ws + WS_KD); const bf16_t* VD = (const bf16_t*)(ws + WS_VD);
    const int per = 32 + (need_ctx ? 2 : 0);
    XQ q{ctl + CTL_Q(l, qo + 0, 0), myx, per, 0};
    for (;;) { const int uu = q_next(tid, q, slot); if (uu < 0) break;
        const int xx = uu / per, j = uu % per;
        PolD pol; int b, h, row; const bool lat = j < 32;
        if (lat) { const int pair = xx + 8 * (j >> 4); b = pair >> 2; h = pair & 3; row = b * SEQ + (j & 15) * 512 + 64 * w + l31; pol.nloc = 128; }
        else { const int v = 2 * xx + (j - 32); b = v >> 2; h = v & 3; row = TL + b * CTXL + 32 * w + l31; pol.nloc = 0; }
        pol.ntiles = pol.nloc + 4;
        pol.kbase = KD + (size_t)b * SEQ * 384 + h * 96; pol.vbase = VD + (size_t)b * SEQ * 256 + h * 64;
        pol.kctx = KD + (size_t)(TL + b * CTXL) * 384 + h * 96; pol.vctx = VD + (size_t)(TL + b * CTXL) * 256 + h * 64;
        pol.qrow = QD + (size_t)row * 384 + h * 96; pol.orow = YMIX + (size_t)row * 1024 + 768 + h * 64;
        pol.qscale = 0.10206207261596575f * LOG2E; pol.m0 = -1e30f; pol.l0 = 0.f;
        if (lat) attn_pp<2>(wv, lds, pol, 32 * 384, 32 * 1024); else attn_core<1>(wv, lds, pol); }
}
__device__ __forceinline__ void mix_B(int wv, const Params& p, int l, LAS unsigned char* lds, bool probe) {
    MIX_COMMON
    const int per = 64 + (need_ctx ? 2 : 0);
    XQ q{ctl + CTL_Q(l, qo + 1, 0), myx, per, 0};
    for (;;) { const int uu = q_next(tid, q, slot); if (uu < 0) break;
        const int xx = uu / per, j = uu % per;
        PolB pol; int b, h, row;
        LAS float* rp = (LAS float*)(lds + 65536);
        if (j < 64) { const int pair = xx + 8 * (j >> 5); b = pair >> 2; h = pair & 3; const int R0 = (j & 31) * 4; pol.r = R0 + (w >> 1); pol.c = 32 * (w & 1) + l31; row = b * SEQ + pol.r * 64 + pol.c;
            pol.klo = min(max(R0 - 4, 0), 120); const int khi = min(max(R0 - 1, 0), 120) + 7; pol.nloc = khi - pol.klo + 1; pol.wr0 = min(max(pol.r - 4, 0), 120); }
        else { const int v = 2 * xx + (j - 64); b = v >> 2; h = v & 3; row = TL + b * CTXL + 32 * w + l31; pol.nloc = 0; pol.klo = 0; pol.wr0 = 0; pol.r = 0; pol.c = 0; }
        for (int i = tid; i < 465; i += NTHR) rp[i] = p.nat_rpb[((size_t)l * 4 + h) * 465 + i] * LOG2E;
        __syncthreads();
        pol.rpb = rp; pol.ntiles = pol.nloc + 4; pol.set_lane(lane >> 5);
        pol.kbase = P + (size_t)b * SEQ * NP + PC_BK + h * 64; pol.vbase = P + (size_t)b * SEQ * NP + PC_BV + h * 64;
        pol.kctx = P + (size_t)(TL + b * CTXL) * NP + PC_BK + h * 64; pol.vctx = P + (size_t)(TL + b * CTXL) * NP + PC_BV + h * 64;
        pol.qrow = P + (size_t)row * NP + PC_BQ + h * 64; pol.orow = YMIX + (size_t)row * 1024 + 256 + h * 64;
        pol.qscale = 0.125f * LOG2E; pol.m0 = -1e30f; pol.l0 = 0.f;
        attn_core<1>(wv, lds, pol); }
}
__device__ __forceinline__ void mix_A(int wv, const Params& p, int l, LAS unsigned char* lds, bool probe) {
    MIX_COMMON
    const bf16_t* QA = (const bf16_t*)(ws + WS_QA); const bf16_t* KA = (const bf16_t*)(ws + WS_KA);
    const int per = 64 + (need_ctx ? 2 : 0);
    XQ q{ctl + CTL_Q(l, qo + 2, 0), myx, per, 0};
    for (;;) { const int uu = q_next(tid, q, slot); if (uu < 0) break;
        const int xx = uu / per, j = uu % per;
        PolA pol; int b, hkv, head, row;
        if (j < 64) { b = xx >> 1; hkv = xx & 1; const int qb = j; head = 2 * hkv + (w >> 2); pol.q0 = qb * 128 + (w & 3) * 32; pol.qpos = pol.q0 + l31; row = b * SEQ + pol.qpos;
            const int tlo = (qb == 0) ? 2 : 0, thi = (qb == 63) ? 4 : 6; pol.nloc = thi - tlo; pol.kp0 = (qb - 1) * 128 + 64 * tlo; }
        else { const int v = 2 * xx + (j - 64); b = v >> 2; hkv = (v >> 1) & 1; head = 2 * hkv + (v & 1); row = TL + b * CTXL + 32 * w + l31; pol.nloc = 0; pol.kp0 = 0; pol.q0 = 0; pol.qpos = 0; }
        pol.ntiles = pol.nloc + 4;
        pol.kbase = KA + (size_t)b * SEQ * 128 + hkv * 64; pol.vbase = P + (size_t)b * SEQ * NP + PC_AV + hkv * 64;
        pol.kctx = KA + (size_t)(TL + b * CTXL) * 128 + hkv * 64; pol.vctx = P + (size_t)(TL + b * CTXL) * NP + PC_AV + hkv * 64;
        pol.qrow = QA + (size_t)row * 256 + head * 64; pol.orow = YMIX + (size_t)row * 1024 + head * 64;
        pol.qscale = 0.125f * LOG2E; pol.m0 = p.attn_sink[l * 4 + head] * LOG2E; pol.l0 = 1.0f;
        attn_core<1>(wv, lds, pol); }
}
__device__ __forceinline__ void mix_C(int wv, const Params& p, int l, LAS unsigned char* lds, bool probe) {
    MIX_COMMON
    (void)w; (void)l31; (void)YMIX;
    const int per = NBATCH * (need_ctx ? NCHUNK : 128) * 4 / 16;
    XQ q{ctl + CTL_Q(l, qo + 3, 0), myx, per, 0};
    for (;;) { const int pr = q_next(tid, q, slot); if (pr < 0) break;
        mlstm_out_pair(wv, p, lds, l, 2 * pr, 2 * pr + 1); }
}
#ifndef MIX_MASK
#define MIX_MASK 15
#endif
__device__ __forceinline__ void phase_mixers(int wv, const Params& p, int l, LAS unsigned char* lds) {
    if (MIX_MASK & 1) mix_D(wv, p, l, lds, false);
    if (MIX_MASK & 2) mix_B(wv, p, l, lds, false);
    if (MIX_MASK & 4) mix_A(wv, p, l, lds, false);
    if (MIX_MASK & 8) mix_C(wv, p, l, lds, false);
}
#ifndef PROBE_MIX
#define PROBE_MIX 15
#endif
__device__ __forceinline__ void phase_mixers_probe(int wv, const Params& p, int l, LAS unsigned char* lds) {
    if (PROBE_MIX & 1) mix_D(wv, p, l, lds, true);
    if (PROBE_MIX & 2) mix_B(wv, p, l, lds, true);
    if (PROBE_MIX & 4) mix_A(wv, p, l, lds, true);
    if (PROBE_MIX & 8) mix_C(wv, p, l, lds, true);
}

__device__ __forceinline__ void phase_router(int wv, const Params& p, int l, LAS unsigned char* lds, bool probe = false) {
    const int tid = otid(wv), lane = tid & 63, w = tid >> 6, hh = lane >> 5, l31 = lane & 31;
    unsigned char* ws = opq(p.ws);
    const float* MOD = (const float*)(ws + WS_MOD); float* XA = (float*)(ws + WS_XA); unsigned char* H2F = ws + WS_H2B;
    const bf16_t* DELTA = (const bf16_t*)(ws + WS_HB); const float* XB = (const float*)(ws + WS_XB);
    const bf16_t* WRT = (const bf16_t*)(ws + WS_WRT) + (size_t)l * 2 * 32 * 1024;
    float* GATE = (float*)(ws + WS_GATE); int* LIST = (int*)(ws + WS_LIST); unsigned* ctl = (unsigned*)(ws + WS_CTL);
    constexpr int HROW = 1028;
    LAS float* HT = (LAS float*)lds;
    LAS float* RED = (LAS float*)lds;
    LAS int* LCNT = (LAS int*)(lds + 131584);
    LAS int* LBASE = LCNT + 32;
    LAS int* PA = LBASE + 32;
    LAS int* PE = PA + 640;
    const int T = (l == 0) ? TA : TL, ntile = T / 32, NASSIGN = TA * 4;
    bf16x8 wbh[8], wbl[8];
#pragma unroll
    for (int ks = 0; ks < 8; ++ks) { const int k0 = 128 * w + 16 * ks + 8 * hh; wbh[ks] = *(const bf16x8*)(WRT + (size_t)l31 * 1024 + k0); wbl[ks] = *(const bf16x8*)(WRT + (size_t)(32 + l31) * 1024 + k0); }
    if (tid < 32) LCNT[tid] = 0;
    if (blockIdx.x == 0 && tid < 64) *(u32x4*)(H2F + (size_t)TA * 1024 + tid * 16) = (u32x4){0u, 0u, 0u, 0u};
    __syncthreads();
    int iter = 0;
    for (int tl = blockIdx.x; tl < ntile; tl += gridDim.x, ++iter) {
        const int r0 = tl * 32;
#pragma unroll 1
        for (int i = 0; i < 4; ++i) { const int rl = 4 * w + i, r = r0 + rl;
            const int mrow = (r < TL) ? (r >> 13) : 4; const float* mod = MOD + ((size_t)l * 5 + mrow) * 6144;
            const float* xin = (l == 0) ? ((r < TL) ? p.x + (size_t)r * 1024 : p.ctx + (size_t)(r - TL) * 1024) : XB + (size_t)r * 1024;
            f32x4 v[4]; row_load(xin, lane, v);
#pragma unroll
            for (int q = 0; q < 4; ++q) { const u32x2 dw = *(const u32x2*)(DELTA + (size_t)r * 1024 + q * 256 + lane * 4);
                v[q][0] += bf2f(dw.x & 0xffffu); v[q][1] += bf2f(dw.x >> 16); v[q][2] += bf2f(dw.y & 0xffffu); v[q][3] += bf2f(dw.y >> 16);
                *(f32x4*)(XA + (size_t)r * 1024 + q * 256 + lane * 4) = v[q]; }
            const float rstd = row_rstd(v);
            row_modulate(v, rstd, p.g_norm2 + l * 1024, mod + 4 * 1024, mod + 3 * 1024, lane);
            row_store_fp8(H2F + (size_t)r * 1024, lane, v);
#pragma unroll
            for (int q = 0; q < 4; ++q) *(LAS f32x4*)(HT + rl * HROW + q * 256 + lane * 4) = v[q]; }
        __syncthreads();
        f32x16 acc = zero16();
#pragma unroll
        for (int ks = 0; ks < 8; ++ks) { const int k0 = 128 * w + 16 * ks + 8 * hh;
            const f32x4 x0 = *(const LAS f32x4*)(HT + l31 * HROW + k0), x1 = *(const LAS f32x4*)(HT + l31 * HROW + k0 + 4);
            u32x4 ah, alo; float hf[8] = {x0[0], x0[1], x0[2], x0[3], x1[0], x1[1], x1[2], x1[3]};
#pragma unroll
            for (int q = 0; q < 4; ++q) { const unsigned hp = pk2(hf[2 * q], hf[2 * q + 1]); ah[q] = hp; alo[q] = pk2(hf[2 * q] - bf2f(hp & 0xffffu), hf[2 * q + 1] - bf2f(hp >> 16)); }
            const bf16x8 bh = wbh[ks], bl = wbl[ks];
            acc = mfma32(as_bf16x8(ah), bh, acc); acc = mfma32(as_bf16x8(alo), bh, acc); acc = mfma32(as_bf16x8(ah), bl, acc); }
        __syncthreads();
#pragma unroll
        for (int r = 0; r < 16; ++r) RED[(w * 32 + (r & 3) + 8 * (r >> 2) + 4 * hh) * 33 + l31] = acc[r];
        __syncthreads();
        LAS float* TV = (LAS float*)(lds + 131584 + 8192);
        LAS int* TE = (LAS int*)(TV + 128);
#pragma unroll 1
        for (int ps = 0; ps < 2; ++ps) { const int rl = 4 * w + 2 * ps + hh, e = l31;
            float v = p.b_router[l * 32 + e];
#pragma unroll
            for (int ww = 0; ww < 8; ++ww) v += RED[(ww * 32 + rl) * 33 + e];
            int rank = 0;
#pragma unroll
            for (int d = 1; d < 32; ++d) { const int src = (lane & 32) | ((lane + d) & 31); const float ov = __shfl(v, src); const int oe = (e + d) & 31; rank += (ov > v || (ov == v && oe < e)) ? 1 : 0; }
            if (rank < 4) { TV[(w * 4 + 2 * ps + hh) * 4 + rank] = v; TE[(w * 4 + 2 * ps + hh) * 4 + rank] = e; }
        }
        asm volatile("s_waitcnt lgkmcnt(0)" ::: "memory");
        if (lane < 16) { const int tk = lane >> 2, k = lane & 3, rl = 4 * w + tk, r = r0 + rl;
            const float t0 = TV[(w * 4 + tk) * 4 + 0], t1 = TV[(w * 4 + tk) * 4 + 1], t2 = TV[(w * 4 + tk) * 4 + 2], t3 = TV[(w * 4 + tk) * 4 + 3];
            const float e1 = fexp(t1 - t0), e2 = fexp(t2 - t0), e3 = fexp(t3 - t0), inv = 1.0f / (1.0f + e1 + e2 + e3);
            const float g = (k == 0 ? 1.0f : k == 1 ? e1 : k == 2 ? e2 : e3) * inv; const int e = TE[(w * 4 + tk) * 4 + k];
            const int a = r * 4 + k; GATE[a] = g;
            const int lr = __hip_atomic_fetch_add(&LCNT[e], 1, __ATOMIC_RELAXED, __HIP_MEMORY_SCOPE_WORKGROUP); const int pi = iter * 128 + rl * 4 + k; PA[pi] = a; PE[pi] = (e << 16) | lr; }
        __syncthreads();
    }
    if (tid < 32) LBASE[tid] = (int)__hip_atomic_fetch_add(probe ? ctl + 3456 + tid * 16 : ctl + CTL_CNT(l, tid), (unsigned)LCNT[tid], __ATOMIC_RELAXED, __HIP_MEMORY_SCOPE_AGENT);
    __syncthreads();
    for (int i = tid; i < iter * 128; i += NTHR) { const int pe = PE[i], e = pe >> 16, lr = pe & 0xffff; LIST[(size_t)e * NASSIGN + LBASE[e] + lr] = PA[i]; }
    __syncthreads();
}

__device__ __forceinline__ void phase_gather(int wv, const Params& p, int l, LAS unsigned char* lds) {
    const int tid = otid(wv), lane = tid & 63, gw = blockIdx.x * NWAVE + (tid >> 6), nw = gridDim.x * NWAVE;
    unsigned char* ws = opq(p.ws);
    const unsigned* ctl = (const unsigned*)(ws + WS_CTL); int* SLOTT = (int*)(ws + WS_SLOTT);
    const int* LIST = (const int*)(ws + WS_LIST); const float* GATE = (const float*)(ws + WS_GATE);
    int* SLOTA = (int*)(ws + WS_SLOTA); float* SLOTG = (float*)(ws + WS_SLOTG); int* TILEE = (int*)(ws + WS_TILEE);
    LAS int* CNT = (LAS int*)lds; LAS int* PST = CNT + 32;
    constexpr int NASSIGN = TA * 4;
    if (tid < 32) CNT[tid] = (int)__hip_atomic_load(ctl + CTL_CNT(l, tid), __ATOMIC_RELAXED, __HIP_MEMORY_SCOPE_AGENT);
    __syncthreads();
    if (tid == 0) { int s = 0; for (int e = 0; e < 32; ++e) { PST[e] = s; s += (CNT[e] + 255) & ~255; } PST[32] = s; }
    __syncthreads();
    const int nslot = PST[32], ntiles = nslot >> 8;
    if (blockIdx.x == 0) { for (int t = tid; t < ntiles; t += NTHR) { int e = 0; for (int j = 1; j < 32; ++j) if (PST[j] <= t * 256) e = j; TILEE[t] = e; } if (tid == 0) TILEE[MAXTILE] = ntiles; }
    for (int s = blockIdx.x * NTHR + tid; s < nslot; s += gridDim.x * NTHR) {
        int e = 0;
#pragma unroll
        for (int j = 1; j < 32; ++j) if (PST[j] <= s) e = j;
        const int r = s - PST[e];
        int a = -1;
        if (r < CNT[e]) a = LIST[(size_t)e * NASSIGN + r];
        SLOTA[s] = a; SLOTG[s] = (a >= 0) ? GATE[a] : 0.f; SLOTT[s] = (a >= 0) ? (a >> 2) : TA;
    }
}

#define XB_TMO      128
#define XB_XCNT(j)  (256  + 64 * (j))
#define XB_XSUB(j)  (1280 + 64 * (j))
#define XB_XGEN(j)  (2304 + 64 * (j))
#define XB_TOP      3328
#define XB_TOPGEN   3392
#define XCD_BAR_WORDS 3456
#define XB_SPIN_CAP (1u << 18)
__device__ __forceinline__ unsigned xb_ld(unsigned* p)              { return __hip_atomic_load(p, __ATOMIC_RELAXED, __HIP_MEMORY_SCOPE_AGENT); }
__device__ __forceinline__ unsigned xb_add(unsigned* p, unsigned v) { return __hip_atomic_fetch_add(p, v, __ATOMIC_RELAXED, __HIP_MEMORY_SCOPE_AGENT); }
__device__ __forceinline__ unsigned xb_xcc_id() { return (unsigned)__builtin_amdgcn_s_getreg((3 << 11) | 20) & 0xFu; }
#define XB_SPIN(cond, bar) do { unsigned _sp = 0; while (cond) { __builtin_amdgcn_s_sleep(1); \
    if ((++_sp & 255u) == 0u) { if (xb_ld(&(bar)[XB_TMO])) break; if (_sp > XB_SPIN_CAP) { atomicAdd(&(bar)[XB_TMO], 1u); break; } } } } while (0)
struct XcdBarrier { unsigned* bar; unsigned x; volatile LAS unsigned* st; };
__device__ __forceinline__ XcdBarrier xcd_barrier_post(int tid, unsigned* bar, volatile LAS unsigned* st) {
    XcdBarrier b; b.bar = bar; b.x = xb_xcc_id(); b.st = st;
    if (tid == 0) st[2] = xb_add(&bar[XB_XCNT(b.x)], 1u);
    return b;
}
__device__ __forceinline__ void xcd_barrier_complete(unsigned* bar, unsigned x, unsigned& nloc, unsigned& nx) {
    const unsigned G = gridDim.x * gridDim.y * gridDim.z;
    unsigned sum, cnt, mine, sp = 0u;
    for (;;) {
        sum = 0u; cnt = 0u; mine = 0u;
#pragma unroll
        for (unsigned j = 0; j < 16; ++j) { const unsigned c = xb_ld(&bar[XB_XCNT(j)]); sum += c; cnt += (c > 0u) ? 1u : 0u; mine = (j == x) ? c : mine; }
        if (sum == G) break;
        __builtin_amdgcn_s_sleep(1);
        if ((++sp & 255u) == 0u) { if (xb_ld(&bar[XB_TMO])) break; if (sp > XB_SPIN_CAP) { atomicAdd(&bar[XB_TMO], 1u); break; } }
    }
    nloc = mine > 0u ? mine : 1u; nx = cnt > 0u ? cnt : 1u;
}
__device__ __forceinline__ void xcd_barrier(int wv, const XcdBarrier& b) {
    asm volatile("s_waitcnt vmcnt(0)" ::: "memory");
    __syncthreads();
    if (otid(wv) == 0) {
        unsigned* bar = b.bar;
        __builtin_amdgcn_s_waitcnt(0);
        unsigned nloc = b.st[0], nx = b.st[1];
        if (nloc == 0u) { xcd_barrier_complete(bar, b.x, nloc, nx); b.st[0] = nloc; b.st[1] = nx; }
        const unsigned old = xb_add(&bar[XB_XSUB(b.x)], 1u);
        const unsigned gen = old / nloc;
        if (old + 1u == (gen + 1u) * nloc) {
            __builtin_amdgcn_fence(__ATOMIC_RELEASE, "agent");
            asm volatile("s_waitcnt vmcnt(0)" ::: "memory");
            const unsigned og = xb_add(&bar[XB_TOP], 1u);
            const unsigned tg = og / nx;
            if (og + 1u == (tg + 1u) * nx) xb_add(&bar[XB_TOPGEN], 1u);
            else XB_SPIN(xb_ld(&bar[XB_TOPGEN]) == tg, bar);
            __builtin_amdgcn_fence(__ATOMIC_ACQUIRE, "agent");
            xb_add(&bar[XB_XGEN(b.x)], 1u);
            asm volatile("s_waitcnt vmcnt(0)" ::: "memory");
        } else {
            XB_SPIN(xb_ld(&bar[XB_XGEN(b.x)]) == gen, bar);
            __builtin_amdgcn_fence(__ATOMIC_ACQUIRE, "agent");
            asm volatile("s_waitcnt vmcnt(0)" ::: "memory");
        }
    }
    __syncthreads();
}

constexpr int NPHASE = 23;
extern __shared__ __attribute__((aligned(16))) unsigned char smem_raw[];

#ifndef EN_MASK
#define EN_MASK 0xFFF
#endif
#define EN(k) ((EN_MASK >> (k)) & 1)
#ifndef PROBE_REP
#define PROBE_REP -1
#endif
#define RUN(id) ((id) >= p.phase_lo && (id) < p.phase_hi)
#define SYNC() do { if (p.use_bar) xcd_barrier(wv, bar); } while (0)
template <int l>
__device__ __forceinline__ void run_layer(int wv, const Params& p, LAS unsigned char* lds, const XcdBarrier& bar) {
    unsigned char* ws = opq(p.ws);
    const int cid = __builtin_amdgcn_readfirstlane(*(const LAS int*)(lds + LDS_MISC + 68));
        const int pb = 1 + 11 * l;
        const int T = (l == 0) ? TA : TL;
        if (l == 0) { if (EN(0) && RUN(pb + 0)) phase_norm1_l0(wv, p); SYNC(); if (PROBE_REP == 0) { phase_norm1_l0(wv, p); SYNC(); } }
        if (EN(1) && RUN(pb + 1)) {
            pg8::Gemm g{(const bf16_t*)(ws + WS_HB), (const bf16_t*)(ws + WS_WIN) + (size_t)l * NP * 1024, TA, NP, 1024};
            pg8::StaticOrder S; S.init(TA, NP, gridDim.x, cid);
            EpiStoreBf16 E{(bf16_t*)(ws + WS_P), NP};
            pg8::gemm_phase(wv, lds, g, S, E, nullptr);
        }
        if (PROBE_REP == 21 && l == 0) {
            SYNC();
            struct SameTile : pg8::StaticOrder { __device__ __forceinline__ bool next(int i, pg8::Unit& u) const { pg8::Unit t; const bool ok = pg8::StaticOrder::next(i, t); u.pm = 0; u.pn = 0; return ok; } };
            pg8::Gemm g{(const bf16_t*)(ws + WS_HB), (const bf16_t*)(ws + WS_WIN), TA, NP, 1024};
            SameTile S; S.init(TA, NP, gridDim.x, cid);
            EpiStoreBf16 E{(bf16_t*)(ws + WS_XS), NP};
            pg8::gemm_phase(wv, lds, g, S, E, nullptr);
        }
        if (PROBE_REP == 22 && l == 0) {
            SYNC();
            pg8::Gemm g{(const bf16_t*)(ws + WS_HB), (const bf16_t*)(ws + WS_WIN), TA, NP, 1024};
            pg8::StaticOrder S; S.init(TA, NP, gridDim.x, cid);
            EpiStoreBf16 E{(bf16_t*)(ws + WS_XS), NP};
            pg8::gemm_phase(wv, lds, g, S, E, nullptr);
        }
        SYNC();
        if (EN(2) && RUN(pb + 2)) phase_prep(wv, p, l, lds);
        if (PROBE_REP == 2 && l == 0) { SYNC(); if (PROBE_MIX & 1) prep_elem(wv, p, l, lds); __syncthreads(); if (PROBE_MIX & 2) prep_state(wv, p, l, lds); }
        SYNC();
        if (EN(3) && RUN(pb + 3)) phase_scan(wv, p, lds);
        if (PROBE_REP == 3 && l == 0) { SYNC(); phase_scan(wv, p, lds); }
        SYNC();
        if (EN(4) && RUN(pb + 4)) phase_mixers(wv, p, l, lds);
        if (PROBE_REP == 4 && l == 0) { SYNC(); phase_mixers_probe(wv, p, l, lds); }
        SYNC();
        if (EN(5) && RUN(pb + 5)) {
            pg8::Gemm g{(const bf16_t*)(ws + WS_YMIX), (const bf16_t*)(ws + WS_WOUT + (size_t)l * 1024 * 1024 * (YM_FP8 ? 1 : 2)), T, 1024, YM_FP8 ? 512 : 1024};
            pg8::StaticOrder S; S.init(T, 1024, gridDim.x, cid);
            const float* MOD = (const float*)(ws + WS_MOD);
            EpiDelta E{(bf16_t*)(ws + WS_HB), MOD + (size_t)l * 5 * 6144 + 2 * 1024, YM_FP8 ? 0.03125f : 1.0f};
            pg8::gemm_phase<EpiDelta, pg8::StaticOrder, false, YM_FP8 != 0>(wv, lds, g, S, E, nullptr);
        }
        SYNC();
        if (PROBE_REP == 25 && l == 0) {
            pg8::Gemm g{(const bf16_t*)(ws + WS_YMIX), (const bf16_t*)(ws + WS_WOUT + (size_t)l * 1024 * 1024 * (YM_FP8 ? 1 : 2)), T, 1024, YM_FP8 ? 512 : 1024};
            pg8::StaticOrder S; S.init(T, 1024, gridDim.x, cid);
            const float* MOD = (const float*)(ws + WS_MOD);
            EpiDelta E{(bf16_t*)(ws + WS_HB), MOD + (size_t)l * 5 * 6144 + 2 * 1024, YM_FP8 ? 0.03125f : 1.0f};
            pg8::gemm_phase<EpiDelta, pg8::StaticOrder, false, YM_FP8 != 0>(wv, lds, g, S, E, nullptr);
            SYNC();
        }
        if (EN(6) && RUN(pb + 6)) phase_router(wv, p, l, lds);
        if (PROBE_REP == 6 && l == 0) { SYNC(); phase_router(wv, p, l, lds, true); }
        SYNC();
        if (EN(7) && RUN(pb + 7)) phase_gather(wv, p, l, lds);
        if (PROBE_REP == 7 && l == 0) { SYNC(); phase_gather(wv, p, l, lds); }
        SYNC();
        if (EN(8) && RUN(pb + 8)) {
            const int* TILEE = (const int*)(ws + WS_TILEE);
            pg8::Gemm g{(const bf16_t*)(ws + WS_H2B), (const bf16_t*)(ws + WS_WGU + (size_t)l * 32 * 2048 * 1024), MAXSLOT, 32 * 2048, 512, (const int*)(ws + WS_SLOTT)};
            MoeOrder S{TILEE, __builtin_amdgcn_readfirstlane(TILEE[MAXTILE]), 8, (int)gridDim.x, cid};
            EpiGU E{ws + WS_ACT, p.b_gu + (size_t)l * 32 * 2048};
            pg8::gemm_phase<EpiGU, MoeOrder, false, true, true>(wv, lds, g, S, E, nullptr);
        }
        SYNC();
        if (PROBE_REP == 23 && l == 0) {
            const int* TILEE = (const int*)(ws + WS_TILEE);
            pg8::Gemm g{(const bf16_t*)(ws + WS_H2B), (const bf16_t*)(ws + WS_WGU + (size_t)l * 32 * 2048 * 1024), MAXSLOT, 32 * 2048, 512, (const int*)(ws + WS_SLOTT)};
            MoeOrder S{TILEE, __builtin_amdgcn_readfirstlane(TILEE[MAXTILE]), 8, (int)gridDim.x, cid};
            EpiGU E{ws + WS_ACT, p.b_gu + (size_t)l * 32 * 2048};
            pg8::gemm_phase<EpiGU, MoeOrder, false, true, true>(wv, lds, g, S, E, nullptr);
            SYNC();
        }
        if (EN(9) && RUN(pb + 9)) {
            const int* TILEE = (const int*)(ws + WS_TILEE);
            pg8::Gemm g{(const bf16_t*)(ws + WS_ACT), (const bf16_t*)(ws + WS_WDN + (size_t)l * 32 * 1024 * 1024), MAXSLOT, 32 * 1024, 512};
            MoeOrder S{TILEE, __builtin_amdgcn_readfirstlane(TILEE[MAXTILE]), 4, (int)gridDim.x, cid};
            EpiDown E{(bf16_t*)(ws + WS_Y), p.b_down + (size_t)l * 32 * 1024, (const int*)(ws + WS_SLOTA), (const float*)(ws + WS_SLOTG)};
            pg8::gemm_phase<EpiDown, MoeOrder, false, true>(wv, lds, g, S, E, nullptr);
        }
        SYNC();
        if (PROBE_REP == 24 && l == 0) {
            const int* TILEE = (const int*)(ws + WS_TILEE);
            pg8::Gemm g{(const bf16_t*)(ws + WS_ACT), (const bf16_t*)(ws + WS_WDN + (size_t)l * 32 * 1024 * 1024), MAXSLOT, 32 * 1024, 512};
            MoeOrder S{TILEE, __builtin_amdgcn_readfirstlane(TILEE[MAXTILE]), 4, (int)gridDim.x, cid};
            EpiDown E{(bf16_t*)(ws + WS_Y), p.b_down + (size_t)l * 32 * 1024, (const int*)(ws + WS_SLOTA), (const float*)(ws + WS_SLOTG)};
            pg8::gemm_phase<EpiDown, MoeOrder, false, true>(wv, lds, g, S, E, nullptr);
            SYNC();
        }
        if (EN(10) && RUN(pb + 10)) phase_combine(wv, p, l);
        if (PROBE_REP == 10 && l == 0) { SYNC(); phase_combine(wv, p, l); }
        if (l == 0) SYNC();
    }

__global__ void __launch_bounds__(NTHR, 2) mk_forward(Params p) {
    LAS unsigned char* lds = (LAS unsigned char*)smem_raw;
    const int wv = __builtin_amdgcn_readfirstlane((int)threadIdx.x >> 6);
    { const int t0 = otid(wv); if (t0 < 32) ((LAS unsigned*)(lds + LDS_MISC))[t0] = 0u; }
    __syncthreads();
    unsigned* ctl = (unsigned*)(p.ws + WS_CTL);
    XcdBarrier bar; bar.bar = ctl; bar.x = 0; bar.st = (volatile LAS unsigned*)(lds + LDS_MISC);
    if (p.use_bar) bar = xcd_barrier_post(otid(wv), ctl, (volatile LAS unsigned*)(lds + LDS_MISC));
    if (EN(11) && RUN(0)) phase_prologue(wv, p, lds);
    SYNC();
    if (PROBE_REP == 11) { phase_prologue(wv, p, lds); SYNC(); }
    if (otid(wv) == 0) { LAS unsigned* ms = (LAS unsigned*)(lds + LDS_MISC); unsigned cid = blockIdx.x;
        if (p.use_bar) { bool ok = (gridDim.x & 7u) == 0u;
            for (unsigned j = 0; j < 16; ++j) { const unsigned c = xb_ld(&ctl[XB_XCNT(j)]); ok = ok && (c == (j < 8 ? gridDim.x >> 3 : 0u)); }
            if (ok) cid = ms[2] * 8u + bar.x; }
        ms[17] = cid; ms[18] = cid & 7u; }
    __syncthreads();
    run_layer<0>(wv, p, lds, bar);
    run_layer<1>(wv, p, lds, bar);
}
#undef RUN
#undef SYNC

extern "C" void kernel_launch(void* const* d_in, const int* in_sizes, int n_in, void* d_out, int out_size, void* d_ws, size_t ws_size, hipStream_t stream) {
    static int grid = 0;
    if (grid == 0) {
        if (n_in != 25 || ws_size < WS_END) { fprintf(stderr, "kernel_launch: expected 25 inputs and >= %zu bytes of workspace, got %d inputs, %zu bytes; nothing launched\n", (size_t)WS_END, n_in, ws_size); grid = -1; return; }
        int dev = 0, cus = 0, per_cu = 0;
        hipGetDevice(&dev); hipDeviceGetAttribute(&cus, hipDeviceAttributeMultiprocessorCount, dev);
        if (hipFuncSetAttribute((const void*)mk_forward, hipFuncAttributeMaxDynamicSharedMemorySize, LDS_BYTES) != hipSuccess) { fprintf(stderr, "kernel_launch: hipFuncSetAttribute failed\n"); grid = -1; return; }
        hipOccupancyMaxActiveBlocksPerMultiprocessor(&per_cu, (const void*)mk_forward, NTHR, LDS_BYTES);
        if (per_cu < 1) fprintf(stderr, "kernel_launch: occupancy query reports %d workgroups per CU\n", per_cu);
        grid = cus > 0 ? cus : 256;
    }
    if (grid < 0) return;
    Params p{};
    const float** pp = (const float**)&p;
    for (int i = 0; i < 25; ++i) pp[i] = (const float*)d_in[i];
    p.out = (float*)d_out; p.ws = (unsigned char*)d_ws; p.pad0 = 0;
    hipMemsetAsync((unsigned char*)d_ws + WS_CTL, 0, CTL_BYTES, stream);
#if MK_LAUNCHES == 1
    p.phase_lo = 0; p.phase_hi = NPHASE; p.use_bar = 1;
    hipLaunchKernelGGL(mk_forward, dim3(grid), dim3(NTHR), LDS_BYTES, stream, p);
#else
    for (int ph = 0; ph < NPHASE; ++ph) { if (ph == 12) continue;
        p.phase_lo = ph; p.phase_hi = ph + 1; p.use_bar = 0;
        hipLaunchKernelGGL(mk_forward, dim3(grid), dim3(NTHR), LDS_BYTES, stream, p); }
#endif
}
```

```cpp
#include <hip/hip_runtime.h>
#include <cstdio>
#include <cstdint>

#ifndef MK_LAUNCHES
#define MK_LAUNCHES 1
#endif
#ifndef MK_CHECK
#define MK_CHECK 0
#endif

typedef unsigned short bf16_t;
typedef short bf16x8 __attribute__((ext_vector_type(8)));
typedef short s16x4 __attribute__((ext_vector_type(4)));
typedef float f32x4 __attribute__((ext_vector_type(4)));
typedef float f32x16 __attribute__((ext_vector_type(16)));
typedef unsigned u32x4 __attribute__((ext_vector_type(4)));
typedef unsigned u32x2 __attribute__((ext_vector_type(2)));
#define LAS __attribute__((address_space(3)))

constexpr int NTHR = 512, NWAVE = 8;
constexpr int DM = 1024, NBATCH = 4, SEQ = 8192, CTXL = 256, TL = NBATCH * SEQ, TC = NBATCH * CTXL, TA = TL + TC;
constexpr int NP = 3584;
constexpr int PC_AQ = 0, PC_AK = 256, PC_AV = 384, PC_BQ = 512, PC_BK = 768, PC_BV = 1024, PC_CQK = 1280, PC_CV = 1792, PC_CO = 2048, PC_CG = 2304,
              PC_DCQ = 2320, PC_DCKV = 2512, PC_DKR = 2640, PC_DQF = 2672, PC_DKVF = 3056, PC_END = 3568;
constexpr int INC = 2672;
constexpr int NEXP = 32, MAXSLOT = 143360, MAXTILE = MAXSLOT / 256;
constexpr int NCHUNK = 132;
constexpr int NCU = NBATCH * NCHUNK * 4 * 2;
constexpr float LOG2E = 1.4426950408889634f;
constexpr float EPS = 1e-6f;

constexpr int LDS_BYTES = 147456;
constexpr int LDS_MISC = LDS_BYTES - 256;

constexpr size_t al256(size_t x) { return (x + 255) & ~(size_t)255; }
constexpr size_t WS_CTL = 0, CTL_BYTES = 65536;
constexpr size_t WS_MOD = WS_CTL + CTL_BYTES;
constexpr size_t WS_RA = al256(WS_MOD + (size_t)2 * 5 * 6144 * 4);
constexpr size_t WS_RD = al256(WS_RA + (size_t)SEQ * 32 * 8);
constexpr size_t WS_WIN = al256(WS_RD + (size_t)SEQ * 16 * 8);
constexpr size_t WS_WOUT = al256(WS_WIN + (size_t)2 * NP * 1024 * 2);
constexpr size_t WS_WGU = al256(WS_WOUT + (size_t)2 * 1024 * 1024 * 2);
constexpr size_t WS_WDN = al256(WS_WGU + (size_t)2 * 32 * 2048 * 1024 * 2);
constexpr size_t WS_WRT = al256(WS_WDN + (size_t)2 * 32 * 1024 * 1024 * 2);
constexpr size_t WS_HB = al256(WS_WRT + (size_t)2 * 2 * 32 * 1024 * 2);
constexpr size_t WS_H2B = al256(WS_HB + (size_t)TA * 1024 * 2);
constexpr size_t WS_P = al256(WS_H2B + (size_t)TA * 1024 * 2);
constexpr size_t WS_QA = al256(WS_P + (size_t)TA * NP * 2);
constexpr size_t WS_KA = al256(WS_QA + (size_t)TA * 256 * 2);
constexpr size_t WS_QD = al256(WS_KA + (size_t)TA * 128 * 2);
constexpr size_t WS_KD = al256(WS_QD + (size_t)TA * 384 * 2);
constexpr size_t WS_VD = al256(WS_KD + (size_t)TA * 384 * 2);
constexpr size_t WS_QC = al256(WS_VD + (size_t)TA * 256 * 2);
constexpr size_t WS_KC = al256(WS_QC + (size_t)TA * 256 * 2);
constexpr size_t WS_MIXEND = al256(WS_KC + (size_t)TA * 256 * 2);
constexpr size_t WS_ACT = WS_P;
static_assert(WS_MIXEND - WS_P >= (size_t)MAXSLOT * 1024 * 2, "ACT alias");
constexpr size_t WS_GATES = WS_MIXEND;
constexpr size_t WS_DC = al256(WS_GATES + (size_t)TA * 16 * 4);
constexpr size_t WS_DN = al256(WS_DC + (size_t)NCU * 4096 * 4);
constexpr size_t WS_DFA = al256(WS_DN + (size_t)NCU * 64 * 4);
constexpr size_t WS_CS = al256(WS_DFA + (size_t)NCU * 2 * 4);
constexpr size_t WS_NS = al256(WS_CS + (size_t)NCU * 4096 * 2);
constexpr size_t WS_MS = al256(WS_NS + (size_t)NCU * 64 * 4);
constexpr size_t WS_YMIX = al256(WS_MS + (size_t)NCU * 4);
constexpr size_t WS_XA = al256(WS_YMIX + (size_t)TA * 1024 * 2);
constexpr size_t WS_XB = al256(WS_XA + (size_t)TA * 1024 * 4);
constexpr size_t WS_GATE = al256(WS_XB + (size_t)TA * 1024 * 4);
constexpr size_t WS_LIST = al256(WS_GATE + (size_t)TA * 4 * 4);
constexpr size_t WS_SLOTA = al256(WS_LIST + (size_t)32 * TA * 4 * 4);
constexpr size_t WS_SLOTG = al256(WS_SLOTA + (size_t)MAXSLOT * 4);
constexpr size_t WS_SLOTT = al256(WS_SLOTG + (size_t)MAXSLOT * 4);
constexpr size_t WS_TILEE = al256(WS_SLOTT + (size_t)MAXSLOT * 4);
constexpr size_t WS_XS = al256(WS_TILEE + (size_t)(MAXTILE + 64) * 4);
constexpr size_t WS_Y = WS_XS;
constexpr size_t WS_DBG = al256(WS_XS + (size_t)MAXSLOT * 1024 * 2);
constexpr size_t WS_END = WS_DBG + 65536;

#define CTL_Q(l, q, x) (4096 + (((l) * 8 + (q)) * 8 + (x)) * 64)
#define CTL_CNT(l, e) (12288 + (l) * 2048 + (e) * 64)

struct Params {
    const float *x, *c, *ctx, *c_ctx, *w_ada, *b_ada, *g_norm1, *g_norm2, *w_in, *attn_sink, *nat_rpb, *mlstm_conv, *mlstm_gate_bias,
                *mla_g_q, *mla_w_uq, *mla_g_kv, *mla_w_ukv, *w_out, *w_router, *b_router, *w_gu, *b_gu, *w_down, *b_down, *g_final;
    float* out;
    unsigned char* ws;
    int phase_lo, phase_hi, use_bar, pad0;
};

__device__ __forceinline__ int otid(int wv) { int t = wv * 64 + (int)__builtin_amdgcn_mbcnt_hi(~0u, __builtin_amdgcn_mbcnt_lo(~0u, 0u)); asm volatile("" : "+v"(t)); return t; }
__device__ __forceinline__ unsigned char* opq(unsigned char* q) { asm volatile("" : "+s"(q)); return q; }
#ifndef YM_FP8
#define YM_FP8 0
#endif
#if YM_FP8
typedef unsigned char ym_t;
#else
typedef unsigned short ym_t;
#endif
__device__ __forceinline__ float bf2f(unsigned b) { return __uint_as_float(b << 16); }
typedef __bf16 bf16v2_t __attribute__((ext_vector_type(2)));
typedef float f32v2_t __attribute__((ext_vector_type(2)));
__device__ __forceinline__ unsigned pk2(float lo, float hi) { const f32v2_t f = {lo, hi}; const bf16v2_t v = __builtin_convertvector(f, bf16v2_t); return __builtin_bit_cast(unsigned, v); }
__device__ __forceinline__ unsigned pk_fp8x4(float a, float b, float c, float d) { int r = 0; r = __builtin_amdgcn_cvt_pk_fp8_f32(a, b, r, false); r = __builtin_amdgcn_cvt_pk_fp8_f32(c, d, r, true); return (unsigned)r; }
__device__ __forceinline__ unsigned pk_fp8x4(float a, float b, float c, float d);
__device__ __forceinline__ void ym_store4(ym_t* p, float a, float b, float c, float d) {
#if YM_FP8
    *(unsigned*)p = pk_fp8x4(a, b, c, d);
#else
    u32x2 w; w.x = pk2(a, b); w.y = pk2(c, d); *(u32x2*)p = w;
#endif
}
__device__ __forceinline__ unsigned short f2bf(float f) { return (unsigned short)(pk2(f, 0.f) & 0xffffu); }
__device__ __forceinline__ float fexp2(float x) { return __builtin_amdgcn_exp2f(x); }
__device__ __forceinline__ float fexp(float x) { return __builtin_amdgcn_exp2f(x * LOG2E); }
__device__ __forceinline__ float wave_sum(float v) {
#pragma unroll
    for (int d = 32; d >= 1; d >>= 1) v += __shfl_xor(v, d);
    return v;
}
__device__ __forceinline__ float wave_max(float v) {
#pragma unroll
    for (int d = 32; d >= 1; d >>= 1) v = fmaxf(v, __shfl_xor(v, d));
    return v;
}
__device__ __forceinline__ float wave_incl_sum(float v, int lane) {
#pragma unroll
    for (int d = 1; d < 64; d <<= 1) { const float t = __shfl_up(v, d); if (lane >= d) v += t; }
    return v;
}
__device__ __forceinline__ float wave_incl_max(float v, int lane) {
#pragma unroll
    for (int d = 1; d < 64; d <<= 1) { const float t = __shfl_up(v, d); if (lane >= d) v = fmaxf(v, t); }
    return v;
}
__device__ __forceinline__ f32x16 mfma32(bf16x8 a, bf16x8 b, f32x16 c) { return __builtin_amdgcn_mfma_f32_32x32x16_bf16(a, b, c, 0, 0, 0); }
__device__ __forceinline__ f32x16 zero16() { f32x16 z;
#pragma unroll
    for (int i = 0; i < 16; ++i) z[i] = 0.f;
    return z; }
__device__ __forceinline__ s16x4 tr_read(LAS unsigned char* p) { return __builtin_amdgcn_ds_read_tr16_b64_v4i16((LAS s16x4*)p); }
__device__ __forceinline__ bf16x8 cat8(s16x4 a, s16x4 b) { return __builtin_shufflevector(a, b, 0, 1, 2, 3, 4, 5, 6, 7); }
__device__ __forceinline__ bf16x8 as_bf16x8(u32x4 v) { return __builtin_bit_cast(bf16x8, v); }
__device__ __forceinline__ float sigmoidf_(float x) { return 1.0f / (1.0f + fexp(-x)); }
__device__ __forceinline__ float siluf_(float x) { return x * sigmoidf_(x); }

__device__ __forceinline__ void row_load(const float* row, int lane, f32x4 (&v)[4]) {
#pragma unroll
    for (int i = 0; i < 4; ++i) v[i] = *(const f32x4*)(row + i * 256 + lane * 4);
}
__device__ __forceinline__ float row_rstd(const f32x4 (&v)[4]) {
    float s = 0.f;
#pragma unroll
    for (int i = 0; i < 4; ++i) s += v[i][0] * v[i][0] + v[i][1] * v[i][1] + v[i][2] * v[i][2] + v[i][3] * v[i][3];
    s = wave_sum(s);
    return rsqrtf(s * (1.0f / 1024.0f) + EPS);
}
__device__ __forceinline__ void row_modulate(f32x4 (&v)[4], float rstd, const float* g, const float* sc, const float* sh, int lane) {
#pragma unroll
    for (int i = 0; i < 4; ++i) {
        const f32x4 gg = *(const f32x4*)(g + i * 256 + lane * 4), s1 = *(const f32x4*)(sc + i * 256 + lane * 4), s0 = *(const f32x4*)(sh + i * 256 + lane * 4);
#pragma unroll
        for (int j = 0; j < 4; ++j) v[i][j] = (v[i][j] * rstd * gg[j]) * (1.0f + s1[j]) + s0[j];
    }
}
__device__ __forceinline__ void row_store_fp8(unsigned char* row, int lane, const f32x4 (&v)[4]) {
#pragma unroll
    for (int i = 0; i < 4; ++i) *(unsigned*)(row + i * 256 + lane * 4) = pk_fp8x4(v[i][0], v[i][1], v[i][2], v[i][3]);
}
__device__ __forceinline__ void row_store_bf16(bf16_t* row, int lane, const f32x4 (&v)[4]) {
#pragma unroll
    for (int i = 0; i < 4; ++i) { u32x2 w; w.x = pk2(v[i][0], v[i][1]); w.y = pk2(v[i][2], v[i][3]); *(u32x2*)(row + i * 256 + lane * 4) = w; }
}
namespace pg8 {
#define PG8_LAS __attribute__((address_space(3)))
typedef unsigned short bf16_t;
typedef short bf16x8 __attribute__((ext_vector_type(8)));
typedef float f32x4 __attribute__((ext_vector_type(4)));
typedef unsigned u32x4 __attribute__((ext_vector_type(4)));
constexpr int FP8_ONE = 0x7f7f7f7f;
constexpr int BM = 256, BK = 64, HALF = 128, HTB = HALF * BK * 2  , STAGE_BYTES = 8 * HTB, NXCD = 8, WGM = 8;

__host__ __device__ __forceinline__ int lds_byte(int r, int c) { const int st = (r >> 4) * 2 + (c >> 5), rr = r & 15, cc = c & 31, ob = rr * 64 + cc * 2; return st * 1024 + (ob ^ (((ob >> 9) & 1) << 5)); }
__host__ __device__ __forceinline__ void stage_rc(int b, int& R, int& C) { const int st = b / 1024, sb = b % 1024, swz = sb ^ (((sb >> 9) & 1) << 5); R = (st >> 1) * 16 + swz / 64; C = (st & 1) * 32 + (swz % 64) / 2; }
__host__ __device__ __forceinline__ int perm32(int rho) { const int n = rho >> 4, i = rho & 15; return 8 * (i >> 2) + 4 * n + (i & 3); }

struct Unit { int pm, pn, aux; };
struct Gemm { const bf16_t* A; const bf16_t* Bt; int M, N, K; const int* rowmap; };

struct StaticOrder {
    int nM, nN, nwg, G, c;
    __host__ __device__ void init(int M, int N, int G_, int c_) { nM = M / BM; nN = N / BM; nwg = nM * nN; G = G_; c = c_; }
    __host__ __device__ bool next(int i, Unit& u) const {
        const long L = (long)i * G + c; if (L >= nwg) return false;
        int wgid = (int)L; { const int q = nwg / NXCD, r = nwg % NXCD, xcd = wgid % NXCD, off = wgid / NXCD; wgid = (xcd < r ? xcd * (q + 1) : r * (q + 1) + (xcd - r) * q) + off; }
        const int nig = WGM * nN, gid = wgid / nig, fm = gid * WGM, gsz = (nM - fm) < WGM ? (nM - fm) : WGM;
        u.pm = fm + ((wgid % nig) % gsz); u.pn = (wgid % nig) / gsz; u.aux = i; return true;
    }
    __device__ __forceinline__ void a_ready(const Unit&) const {}
    __device__ __forceinline__ void done(const Unit&) const {}
};
template <class Epi, class Sched, bool STAMP = false, bool FP8 = false, bool GATHER = false>
__device__ __forceinline__ void gemm_phase(int wv, PG8_LAS unsigned char* lds, const Gemm g, const Sched& S, const Epi& E, unsigned long long* stamps) {
    const int tid = otid(wv), wid = __builtin_amdgcn_readfirstlane(tid >> 6), lane = tid & 63, wr = wid >> 2, wc = wid & 3, fr = lane & 15, fq = lane >> 4;
    const int K = g.K, nt = K / BK;
    int ts_lo = 0, ts_hi = 0, nts = 0; const unsigned long long rt_entry = STAMP ? (unsigned long long)wall_clock64() : 0ull;
#define PG8_STAMP() do { if (STAMP && wid == 0 && nts < 64) { const unsigned long long _c = (unsigned long long)clock64(); \
        ts_lo = (lane == nts) ? (int)(unsigned)_c : ts_lo; ts_hi = (lane == nts) ? (int)(unsigned)(_c >> 32) : ts_hi; ++nts; } } while (0)
    PG8_STAMP();
    unsigned voffA[2], voffB[2];
#pragma unroll
    for (int i = 0; i < 2; ++i) { int R, C; stage_rc(tid * 16 + i * 8192, R, C); const int Rb = Epi::PERM ? ((R & ~31) + perm32(R & 31)) : R;
        voffA[i] = (unsigned)(R * K + C) * 2u; voffB[i] = (unsigned)(Rb * K + C) * 2u; }
    int gR0, gC0; stage_rc(tid * 16, gR0, gC0);
    unsigned vAc[2][2], vAn[2][2];
#define PG8_ROWS(arr, unit) do { _Pragma("unroll") for (int h_ = 0; h_ < 2; ++h_) _Pragma("unroll") for (int i_ = 0; i_ < 2; ++i_) \
        arr[h_][i_] = (unsigned)g.rowmap[(unit).pm * BM + h_ * HALF + i_ * 64 + gR0] * (unsigned)(K * 2) + (unsigned)(gC0 * 2); } while (0)
    const char* const baseA = (const char*)g.A; const char* const baseB = (const char*)g.Bt;
    const __amdgpu_buffer_rsrc_t rsA = __builtin_amdgcn_make_buffer_rsrc((void*)g.A, 0, 0x7ffff000, 0x00020000), rsB = __builtin_amdgcn_make_buffer_rsrc((void*)g.Bt, 0, 0x7ffff000, 0x00020000);
    const unsigned row64 = (unsigned)(64 * K * 2);
    const size_t kstep = (size_t)(BK * 2);
    const size_t hstep = (size_t)HALF * K * 2;
    const size_t tstep = 2 * hstep;
    const unsigned ldsw = (unsigned)wid * 1024u;
    const int aoff = lds_byte(wr * 64 + fr, fq * 8), boff = lds_byte(wc * 32 + fr, fq * 8);
#define PG8_SA(b, h) (((b) * 2 + (h)) * HTB)
#define PG8_SB(b, h) ((4 + (b) * 2 + (h)) * HTB)
#define PG8_STG(bufoff, gbase, W) do { const unsigned so_ = (unsigned)__builtin_amdgcn_readfirstlane((int)((const char*)(gbase) - base##W)); _Pragma("unroll") for (int _i = 0; _i < 2; ++_i) \
        __builtin_amdgcn_raw_ptr_buffer_load_lds(rs##W, (PG8_LAS unsigned*)(lds + (bufoff) + ldsw + _i * 8192), 16, voff##W[_i], so_, 0, 0); } while (0)
#define PG8_STGA(b, h, kptr, arr) do { if constexpr (GATHER) { const unsigned so_ = (unsigned)__builtin_amdgcn_readfirstlane((int)((const char*)(kptr) - baseA)); _Pragma("unroll") for (int _i = 0; _i < 2; ++_i) \
        __builtin_amdgcn_raw_ptr_buffer_load_lds(rsA, (PG8_LAS unsigned*)(lds + PG8_SA(b, h) + ldsw + _i * 8192), 16, arr[h][_i], so_, 0, 0); } \
    else { PG8_STG(PG8_SA(b, h), (kptr) + (h) * hstep, A); } } while (0)
#define PG8_LDA(dst, b, h) do { _Pragma("unroll") for (int m = 0; m < 4; ++m) _Pragma("unroll") for (int k = 0; k < 2; ++k) dst[m][k] = *(const PG8_LAS bf16x8*)(lds + PG8_SA(b, h) + aoff + m * 2048 + k * 1024); } while (0)
#define PG8_LDB(dst, b, h) do { _Pragma("unroll") for (int n = 0; n < 2; ++n) _Pragma("unroll") for (int k = 0; k < 2; ++k) dst[n][k] = *(const PG8_LAS bf16x8*)(lds + PG8_SB(b, h) + boff + n * 2048 + k * 1024); } while (0)
#define PG8_MMA(ai, bj, At, Bt) do { __builtin_amdgcn_s_setprio(1); _Pragma("unroll") for (int m = 0; m < 4; ++m) _Pragma("unroll") for (int n = 0; n < 2; ++n) { \
        if constexpr (FP8) { typedef int i32x8_ __attribute__((ext_vector_type(8))); typedef int i32x4_ __attribute__((ext_vector_type(4))); \
            const i32x8_ bw = __builtin_shufflevector(__builtin_bit_cast(i32x4_, Bt[n][0]), __builtin_bit_cast(i32x4_, Bt[n][1]), 0, 1, 2, 3, 4, 5, 6, 7); \
            const i32x8_ aw = __builtin_shufflevector(__builtin_bit_cast(i32x4_, At[m][0]), __builtin_bit_cast(i32x4_, At[m][1]), 0, 1, 2, 3, 4, 5, 6, 7); \
            asm volatile("v_mfma_scale_f32_16x16x128_f8f6f4 %0, %1, %2, %0, %3, %3 op_sel_hi:[0,0,0]" : "+v"(acc[ai][bj][m][n]) : "v"(bw), "v"(aw), "v"(fp8_one)); } \
        else { _Pragma("unroll") for (int k = 0; k < 2; ++k) acc[ai][bj][m][n] = __builtin_amdgcn_mfma_f32_16x16x32_bf16(Bt[n][k], At[m][k], acc[ai][bj][m][n], 0, 0, 0); } } \
        __builtin_amdgcn_s_setprio(0); } while (0)
#define PG8_WAIT_V(n) asm volatile("s_waitcnt vmcnt(" #n ")" ::: "memory")
#define PG8_WAIT_L(n) asm volatile("s_waitcnt lgkmcnt(" #n ")" ::: "memory")
#define PG8_BAR __builtin_amdgcn_s_barrier()
#define PG8_SCHED __builtin_amdgcn_sched_barrier(0)
    Unit cur, nxt; int ui = 0;
    typename Epi::State est;
    if (!S.next(0, cur)) return;
    f32x4 acc[2][2][4][2];
#pragma unroll
    for (int a = 0; a < 2; ++a)
#pragma unroll
        for (int b = 0; b < 2; ++b)
#pragma unroll
            for (int m = 0; m < 4; ++m)
#pragma unroll
                for (int n = 0; n < 2; ++n) acc[a][b][m][n] = (f32x4){0.f, 0.f, 0.f, 0.f};
    int fp8_one = FP8_ONE; asm volatile("" : "+v"(fp8_one));
    typedef int i32x8_ __attribute__((ext_vector_type(8))); typedef int i32x4_ __attribute__((ext_vector_type(4)));
    bf16x8 At[4][2], B0[2][2], B1[2][2];
    const char* cA = (const char*)g.A + (GATHER ? (size_t)0 : (size_t)cur.pm * tstep); const char* cB = (const char*)g.Bt + (size_t)cur.pn * tstep;
    if constexpr (GATHER) PG8_ROWS(vAc, cur);
    S.a_ready(cur);
    PG8_STG(PG8_SB(0, 0), cB, B); PG8_STGA(0, 0, cA, vAc); PG8_STG(PG8_SB(0, 1), cB + hstep, B); PG8_STGA(0, 1, cA, vAc);
    if (wr == 1) PG8_BAR;
    PG8_WAIT_V(4); PG8_BAR;
    PG8_STG(PG8_SB(1, 0), cB + kstep, B); PG8_STGA(1, 0, cA + kstep, vAc); PG8_STG(PG8_SB(1, 1), cB + hstep + kstep, B);
    PG8_WAIT_V(6); PG8_BAR;
    PG8_STAMP();
    for (;;) {
        const bool has_next = S.next(ui + 1, nxt);
        const char* nA = (has_next && !GATHER) ? (const char*)g.A + (size_t)nxt.pm * tstep : cA; const char* nB = has_next ? (const char*)g.Bt + (size_t)nxt.pn * tstep : cB;
        if constexpr (GATHER) { if (has_next) PG8_ROWS(vAn, nxt); else { _Pragma("unroll") for (int h_ = 0; h_ < 2; ++h_) _Pragma("unroll") for (int i_ = 0; i_ < 2; ++i_) vAn[h_][i_] = vAc[h_][i_]; } }
        for (int t = 0; t < nt; t += 2) {
            const bool last = (t == nt - 2);
            const char* a1 = cA + (size_t)(t + 1) * kstep;
            const char* a2 = last ? nA : cA + (size_t)(t + 2) * kstep; const char* b2 = last ? nB : cB + (size_t)(t + 2) * kstep;
            const char* a3 = a2 + kstep; const char* b3 = b2 + kstep;
            if (last && has_next) S.a_ready(nxt);
            if (last) E.prefetch(est, cur, wr, wc);
            PG8_LDB(B0, 0, 0); PG8_SCHED; PG8_LDA(At, 0, 0); PG8_STGA(1, 1, a1, vAc);
            PG8_WAIT_L(8); PG8_BAR; PG8_WAIT_L(0); PG8_MMA(0, 0, At, B0); PG8_BAR; PG8_SCHED;
            PG8_LDB(B1, 0, 1); PG8_STG(PG8_SB(0, 0), b2, B);
            PG8_BAR; PG8_WAIT_L(0); PG8_MMA(0, 1, At, B1); PG8_BAR;
            PG8_LDA(At, 0, 1); if (GATHER && last) PG8_STGA(0, 0, a2, vAn); else PG8_STGA(0, 0, a2, vAc);
            PG8_BAR; PG8_WAIT_L(0); PG8_MMA(1, 0, At, B0); PG8_BAR; PG8_SCHED;
            PG8_STG(PG8_SB(0, 1), b2 + hstep, B);
            PG8_WAIT_V(6); PG8_BAR; PG8_MMA(1, 1, At, B1); PG8_BAR;
            PG8_LDB(B0, 1, 0); PG8_SCHED; PG8_LDA(At, 1, 0); if (GATHER && last) PG8_STGA(0, 1, a2, vAn); else PG8_STGA(0, 1, a2, vAc);
            PG8_WAIT_L(8); PG8_BAR; PG8_WAIT_L(0); PG8_MMA(0, 0, At, B0); PG8_BAR; PG8_SCHED;
            PG8_LDB(B1, 1, 1); PG8_STG(PG8_SB(1, 0), b3, B);
            PG8_BAR; PG8_WAIT_L(0); PG8_MMA(0, 1, At, B1); PG8_BAR;
            PG8_LDA(At, 1, 1); if (GATHER && last) PG8_STGA(1, 0, a3, vAn); else PG8_STGA(1, 0, a3, vAc);
            PG8_BAR; PG8_WAIT_L(0); PG8_MMA(1, 0, At, B0); PG8_BAR; PG8_SCHED;
            PG8_STG(PG8_SB(1, 1), b3 + hstep, B);
            PG8_WAIT_V(6); PG8_BAR; PG8_MMA(1, 1, At, B1); PG8_BAR;
        }
        PG8_STAMP();
        if constexpr (FP8) asm volatile("s_nop 15\n\ts_nop 15\n\ts_nop 15" ::: "memory");
        if constexpr (!Epi::AFTER_DRAIN) { __builtin_amdgcn_sched_barrier(0); E(acc, cur, wr, wc, fr, fq, est); S.done(cur); __builtin_amdgcn_sched_barrier(0); }
        PG8_STAMP();
        if (!has_next) break;
#pragma unroll
        for (int a = 0; a < 2; ++a)
#pragma unroll
            for (int b = 0; b < 2; ++b)
#pragma unroll
                for (int m = 0; m < 4; ++m)
#pragma unroll
                    for (int n = 0; n < 2; ++n) acc[a][b][m][n] = (f32x4){0.f, 0.f, 0.f, 0.f};
        cur = nxt; cA = nA; cB = nB; ++ui;
        if constexpr (GATHER) { _Pragma("unroll") for (int h_ = 0; h_ < 2; ++h_) _Pragma("unroll") for (int i_ = 0; i_ < 2; ++i_) vAc[h_][i_] = vAn[h_][i_]; }
    }
    PG8_WAIT_V(0);
    if (wr == 0) PG8_BAR;
    PG8_BAR;
    if constexpr (Epi::AFTER_DRAIN) { E.fused(acc, cur, wr, wc, fr, fq, lds, wid, lane); S.done(cur); }
    PG8_STAMP();
    if (STAMP && wid == 0) { stamps[lane] = lane < nts ? (((unsigned long long)(unsigned)ts_hi << 32) | (unsigned)ts_lo) : 0ull;
        if (lane == 62) stamps[62] = rt_entry; if (lane == 63) stamps[63] = (unsigned long long)wall_clock64(); }
#undef PG8_STAMP
#undef PG8_SA
#undef PG8_SB
#undef PG8_STG
#undef PG8_STGA
#undef PG8_ROWS
#undef PG8_LDA
#undef PG8_LDB
#undef PG8_MMA
#undef PG8_WAIT_V
#undef PG8_WAIT_L
#undef PG8_BAR
#undef PG8_SCHED
}
}

__device__ __forceinline__ void epi_lane(int& fr, int& fq) { int l = (int)__builtin_amdgcn_mbcnt_hi(~0u, __builtin_amdgcn_mbcnt_lo(~0u, 0u)); asm volatile("" : "+v"(l)); fr = l & 15; fq = l >> 4; }
struct EpiStoreBf16 {
    static constexpr bool PERM = true, AFTER_DRAIN = false;
    struct State {}; __device__ __forceinline__ void prefetch(State&, const pg8::Unit&, int, int) const {}
    bf16_t* O; int ldc;
    __device__ __forceinline__ void operator()(const f32x4 (&acc)[2][2][4][2], const pg8::Unit& u, int wr, int wc, int fr_, int fq_, const State& st) const {
        int fr, fq; epi_lane(fr, fq); (void)fr_; (void)fq_;
        const int row0 = u.pm * 256 + wr * 64 + fr, col0 = u.pn * 256 + wc * 32 + 8 * fq;
#pragma unroll
        for (int ai = 0; ai < 2; ++ai)
#pragma unroll
            for (int m = 0; m < 4; ++m) { bf16_t* rowp = O + (size_t)(row0 + ai * 128 + m * 16) * ldc + col0;
#pragma unroll
                for (int bj = 0; bj < 2; ++bj) { const f32x4 v0 = acc[ai][bj][m][0], v1 = acc[ai][bj][m][1];
                    u32x4 w; w.x = pk2(v0[0], v0[1]); w.y = pk2(v0[2], v0[3]); w.z = pk2(v1[0], v1[1]); w.w = pk2(v1[2], v1[3]);
                    *(u32x4*)(rowp + bj * 128) = w; } }
    }
};
struct EpiResid {
    static constexpr bool PERM = false, AFTER_DRAIN = false;
    struct State {}; __device__ __forceinline__ void prefetch(State&, const pg8::Unit&, int, int) const {}
    const float* xin_lat; const float* xin_ctx; float* xo; const float* mod_gate; float wscale;
    __device__ __forceinline__ void operator()(const f32x4 (&acc)[2][2][4][2], const pg8::Unit& u, int wr, int wc, int fr_, int fq_, const State& st) const {
        int fr, fq; epi_lane(fr, fq); (void)fr_; (void)fq_;
        const int row0 = u.pm * 256 + wr * 64 + fr, col0 = u.pn * 256 + wc * 32 + 4 * fq;
        const int mrow = (u.pm < TL / 256) ? (u.pm >> 5) : 4;
        const float* xin = (u.pm < TL / 256) ? xin_lat : (xin_ctx - (size_t)TL * 1024);
        f32x4 gv[2][2];
#pragma unroll
        for (int bj = 0; bj < 2; ++bj)
#pragma unroll
            for (int n = 0; n < 2; ++n) gv[bj][n] = *(const f32x4*)(mod_gate + (size_t)mrow * 6144 + col0 + bj * 128 + n * 16) * wscale;
#pragma unroll
        for (int ai = 0; ai < 2; ++ai)
#pragma unroll
            for (int m = 0; m < 4; ++m) { const size_t off = (size_t)(row0 + ai * 128 + m * 16) * 1024 + col0;
#pragma unroll
                for (int bj = 0; bj < 2; ++bj)
#pragma unroll
                    for (int n = 0; n < 2; ++n) { const f32x4 xi = *(const f32x4*)(xin + off + bj * 128 + n * 16);
                        *(f32x4*)(xo + off + bj * 128 + n * 16) = xi + gv[bj][n] * acc[ai][bj][m][n]; } }
    }
};
struct EpiDelta {
    static constexpr bool PERM = true, AFTER_DRAIN = false;
    struct State { f32x4 gv[2][2]; };
    bf16_t* D; const float* mod_gate; float wscale;
    __device__ __forceinline__ void prefetch(State& st, const pg8::Unit& u, int, int wc) const {
        int fr, fq; epi_lane(fr, fq); const int col0 = u.pn * 256 + wc * 32 + 8 * fq, mrow = (u.pm < TL / 256) ? (u.pm >> 5) : 4;
#pragma unroll
        for (int bj = 0; bj < 2; ++bj)
#pragma unroll
            for (int n = 0; n < 2; ++n) st.gv[bj][n] = *(const f32x4*)(mod_gate + (size_t)mrow * 6144 + col0 + bj * 128 + 4 * n) * wscale;
    }
    __device__ __forceinline__ void operator()(const f32x4 (&acc)[2][2][4][2], const pg8::Unit& u, int wr, int wc, int fr_, int fq_, const State& st) const {
        int fr, fq; epi_lane(fr, fq); (void)fr_; (void)fq_;
        const int row0 = u.pm * 256 + wr * 64 + fr, col0 = u.pn * 256 + wc * 32 + 8 * fq;
#pragma unroll
        for (int ai = 0; ai < 2; ++ai)
#pragma unroll
            for (int m = 0; m < 4; ++m) { bf16_t* rowp = D + (size_t)(row0 + ai * 128 + m * 16) * 1024 + col0;
#pragma unroll
                for (int bj = 0; bj < 2; ++bj) { const f32x4 v0 = acc[ai][bj][m][0] * st.gv[bj][0], v1 = acc[ai][bj][m][1] * st.gv[bj][1];
                    u32x4 w; w.x = pk2(v0[0], v0[1]); w.y = pk2(v0[2], v0[3]); w.z = pk2(v1[0], v1[1]); w.w = pk2(v1[2], v1[3]);
                    *(u32x4*)(rowp + bj * 128) = w; } }
    }
};
__device__ __forceinline__ float swiglu_(float g, float u) {
    g = fminf(g, 7.0f); u = fminf(fmaxf(u, -7.0f), 7.0f);
    return (u + 1.0f) * g * __builtin_amdgcn_rcpf(1.0f + fexp(-1.702f * g));
}
struct EpiGU {
    static constexpr bool PERM = true, AFTER_DRAIN = false;
    struct State { f32x4 bv[2][2]; };
    unsigned char* Act; const float* bias;
    __device__ __forceinline__ void prefetch(State& st, const pg8::Unit& u, int, int wc) const {
        int fr, fq; epi_lane(fr, fq); const int e = u.pn >> 3, pnl = u.pn & 7, col0 = pnl * 256 + wc * 32 + 8 * fq;
#pragma unroll
        for (int bj = 0; bj < 2; ++bj)
#pragma unroll
            for (int n = 0; n < 2; ++n) st.bv[bj][n] = *(const f32x4*)(bias + (size_t)e * 2048 + col0 + bj * 128 + 4 * n);
    }
    __device__ __forceinline__ void operator()(const f32x4 (&acc)[2][2][4][2], const pg8::Unit& u, int wr, int wc, int fr_, int fq_, const State& st) const {
        int fr, fq; epi_lane(fr, fq); (void)fr_; (void)fq_;
        const int pnl = u.pn & 7;
        const int row0 = u.pm * 256 + wr * 64 + fr, col0 = pnl * 256 + wc * 32 + 8 * fq;
#pragma unroll
        for (int ai = 0; ai < 2; ++ai)
#pragma unroll
            for (int m = 0; m < 4; ++m) { unsigned char* rowp = Act + (size_t)(row0 + ai * 128 + m * 16) * 1024 + (col0 >> 1);
#pragma unroll
                for (int bj = 0; bj < 2; ++bj) { const f32x4 v0 = acc[ai][bj][m][0] * 0.03125f + st.bv[bj][0], v1 = acc[ai][bj][m][1] * 0.03125f + st.bv[bj][1];
                    *(unsigned*)(rowp + bj * 64) = pk_fp8x4(swiglu_(v0[0], v0[1]), swiglu_(v0[2], v0[3]), swiglu_(v1[0], v1[1]), swiglu_(v1[2], v1[3])); }
                __builtin_amdgcn_sched_barrier(0); }
    }
};
struct EpiDown {
    static constexpr bool PERM = true, AFTER_DRAIN = false;
    struct State { int a[2][4]; float g[2][4]; f32x4 bv[2][2]; };
    bf16_t* Y; const float* bias; const int* slot_a; const float* slot_g;
    __device__ __forceinline__ void prefetch(State& st, const pg8::Unit& u, int wr, int wc) const {
        int fr, fq; epi_lane(fr, fq); const int row0 = u.pm * 256 + wr * 64 + fr;
        { const int e = u.pn >> 2, pnl = u.pn & 3, col0 = pnl * 256 + wc * 32 + 8 * fq;
#pragma unroll
          for (int bj = 0; bj < 2; ++bj)
#pragma unroll
              for (int n = 0; n < 2; ++n) st.bv[bj][n] = *(const f32x4*)(bias + (size_t)e * 1024 + col0 + bj * 128 + 4 * n); }
#pragma unroll
        for (int ai = 0; ai < 2; ++ai)
#pragma unroll
            for (int m = 0; m < 4; ++m) { const int slot = row0 + ai * 128 + m * 16; st.a[ai][m] = slot_a[slot]; st.g[ai][m] = slot_g[slot]; }
    }
    __device__ __forceinline__ void operator()(const f32x4 (&acc)[2][2][4][2], const pg8::Unit& u, int wr, int wc, int fr_, int fq_, const State& st) const {
        int fr, fq; epi_lane(fr, fq); (void)fr_; (void)fq_; (void)wr;
        const int pnl = u.pn & 3;
        const int col0 = pnl * 256 + wc * 32 + 8 * fq;
#pragma unroll
        for (int ai = 0; ai < 2; ++ai)
#pragma unroll
            for (int m = 0; m < 4; ++m) { const int a = st.a[ai][m]; const float gt = st.g[ai][m];
                if (a >= 0) { bf16_t* rowp = Y + (size_t)a * 1024 + col0;
#pragma unroll
                    for (int bj = 0; bj < 2; ++bj) { const f32x4 v0 = (acc[ai][bj][m][0] * 0.03125f + st.bv[bj][0]) * gt, v1 = (acc[ai][bj][m][1] * 0.03125f + st.bv[bj][1]) * gt;
                        u32x4 w; w.x = pk2(v0[0], v0[1]); w.y = pk2(v0[2], v0[3]); w.z = pk2(v1[0], v1[1]); w.w = pk2(v1[2], v1[3]);
                        *(u32x4*)(rowp + bj * 128) = w; } } }
    }
};
struct MoeOrder {
    const LAS int* tile_e; int ntiles, nN, G, c;
    __device__ __forceinline__ bool next(int i, pg8::Unit& u) const {
        const int x = c & 7, r = c >> 3, j = i * (G >> 3) + r;
        const int pm = x + 8 * (j / nN), pl = j % nN; if (pm >= ntiles) return false;
        u.pm = pm; u.pn = __builtin_amdgcn_readfirstlane(tile_e[pm]) * nN + pl; u.aux = i; return true;
    }
    __device__ __forceinline__ void a_ready(const pg8::Unit&) const {}
    __device__ __forceinline__ void done(const pg8::Unit&) const {}
};

__device__ __forceinline__ void transpose_tile(int wv, const float* __restrict__ src, int ldsrc, int k0, int n0, int nmax, bf16_t* __restrict__ dst, int ldd, LAS unsigned char* lds) {
    LAS bf16_t* T = (LAS bf16_t*)lds;
    const int tid = otid(wv), r = tid >> 4, c4 = (tid & 15) * 4;
#pragma unroll
    for (int pass = 0; pass < 2; ++pass) { const int k = r + 32 * pass;
        f32x4 v = (f32x4){0.f, 0.f, 0.f, 0.f};
        if (n0 + c4 < nmax) v = *(const f32x4*)(src + (size_t)(k0 + k) * ldsrc + n0 + c4);
#pragma unroll
        for (int i = 0; i < 4; ++i) T[(c4 + i) * 66 + k] = f2bf(v[i]); }
    __syncthreads();
    { const int n = tid >> 3, kc = (tid & 7) * 8;
      if (n0 + n < nmax) { const LAS unsigned* tp = (const LAS unsigned*)(T + n * 66 + kc); u32x4 w; w.x = tp[0]; w.y = tp[1]; w.z = tp[2]; w.w = tp[3];
          *(u32x4*)(dst + (size_t)(n0 + n) * ldd + k0 + kc) = w; } }
    __syncthreads();
}

__device__ __forceinline__ void transpose_tile_fp8(int wv, const float* __restrict__ src, int ldsrc, int k0, int n0, unsigned char* __restrict__ dst, int ldd, LAS unsigned char* lds) {
    LAS float* T = (LAS float*)lds;
    const int tid = otid(wv), r = tid >> 4, c4 = (tid & 15) * 4;
#pragma unroll
    for (int pass = 0; pass < 2; ++pass) { const int k = r + 32 * pass;
        const f32x4 v = *(const f32x4*)(src + (size_t)(k0 + k) * ldsrc + n0 + c4);
#pragma unroll
        for (int i = 0; i < 4; ++i) T[(c4 + i) * 65 + k] = v[i] * 32.0f; }
    __syncthreads();
    { const int n = tid >> 3, kc = (tid & 7) * 8; const LAS float* tp = T + n * 65 + kc;
      u32x2 w; w.x = pk_fp8x4(tp[0], tp[1], tp[2], tp[3]); w.y = pk_fp8x4(tp[4], tp[5], tp[6], tp[7]);
      *(u32x2*)(dst + (size_t)(n0 + n) * ldd + k0 + kc) = w; }
    __syncthreads();
}

__device__ __forceinline__ void phase_prologue(int wv, const Params& p, LAS unsigned char* lds) {
    const int tid = otid(wv), bid = blockIdx.x, nblk = gridDim.x;
    unsigned char* ws = opq(p.ws);
    unsigned char* WGU = ws + WS_WGU; unsigned char* WDN = ws + WS_WDN; bf16_t* WOUT = (bf16_t*)(ws + WS_WOUT); bf16_t* WIN = (bf16_t*)(ws + WS_WIN); bf16_t* WRT = (bf16_t*)(ws + WS_WRT);
    float* MOD = (float*)(ws + WS_MOD); float2* RA = (float2*)(ws + WS_RA); float2* RD = (float2*)(ws + WS_RD);
    constexpr int T_WGU = 64 * 16 * 32, T_WDN = 64 * 16 * 16, T_WOUT = 2 * 256, T_WIN = 2 * 16 * 42, T_FOLD = 2 * 64, T_ADA = 2 * 96, T_ROPE = SEQ * 48 / 512, T_WRT = 2 * 32 * 1024 / 512, T_PAD = 2 * 16 * 1024 / 512;
    constexpr int O_WDN = T_WGU, O_WOUT = O_WDN + T_WDN, O_WIN = O_WOUT + T_WOUT, O_FOLD = O_WIN + T_WIN, O_ADA = O_FOLD + T_FOLD, O_ROPE = O_ADA + T_ADA, O_WRT = O_ROPE + T_ROPE, O_PAD = O_WRT + T_WRT, NTASK = O_PAD + T_PAD;
    {
        constexpr int NT_GU = 64 * 8 * 32, NT_DN = 64 * 8 * 16, NT_WO = YM_FP8 ? 2 * 8 * 16 : 0, NT_ALL = NT_GU + NT_DN + NT_WO;
        const int tid = otid(wv), r = tid >> 4, c4 = (tid & 15) * 4, on = tid >> 3, okc = (tid & 7) * 16;
        f32x4 v[4];
        auto tile_src = [&](int tt, const float*& src, int& ldsrc, unsigned char*& dst) {
            if (tt < NT_GU) { const int mat = tt >> 8, t = tt & 255, kt = t >> 5, nt = t & 31; src = p.w_gu + (size_t)mat * 1024 * 2048 + (size_t)kt * 128 * 2048 + nt * 64; ldsrc = 2048; dst = WGU + (size_t)mat * 2048 * 1024 + (size_t)nt * 64 * 1024 + kt * 128; }
            else if (tt >= NT_GU + NT_DN) { const int u = tt - NT_GU - NT_DN, mat = u >> 7, t = u & 127, kt = t >> 4, nt = t & 15; src = p.w_out + (size_t)mat * 1024 * 1024 + (size_t)kt * 128 * 1024 + nt * 64; ldsrc = 1024; dst = (unsigned char*)WOUT + (size_t)mat * 1024 * 1024 + (size_t)nt * 64 * 1024 + kt * 128; }
            else { const int u = tt - NT_GU, mat = u >> 7, t = u & 127, kt = t >> 4, nt = t & 15; src = p.w_down + (size_t)mat * 1024 * 1024 + (size_t)kt * 128 * 1024 + nt * 64; ldsrc = 1024; dst = WDN + (size_t)mat * 1024 * 1024 + (size_t)nt * 64 * 1024 + kt * 128; } };
        int tt = bid; int buf = 0;
        if (tt < NT_ALL) { const float* src; int ld; unsigned char* dst; tile_src(tt, src, ld, dst);
#pragma unroll
            for (int ps = 0; ps < 4; ++ps) v[ps] = *(const f32x4*)(src + (size_t)(r + 32 * ps) * ld + c4); }
        for (; tt < NT_ALL; tt += nblk) {
            LAS float* T = (LAS float*)(lds + buf * 33280);
#pragma unroll
            for (int ps = 0; ps < 4; ++ps)
#pragma unroll
                for (int i = 0; i < 4; ++i) T[(c4 + i) * 130 + r + 32 * ps] = v[ps][i] * 32.0f;
            __syncthreads();
            const float* src; int ld; unsigned char* dst; tile_src(tt, src, ld, dst);
            if (tt + nblk < NT_ALL) { const float* s2; int ld2; unsigned char* d2; tile_src(tt + nblk, s2, ld2, d2);
#pragma unroll
                for (int ps = 0; ps < 4; ++ps) v[ps] = *(const f32x4*)(s2 + (size_t)(r + 32 * ps) * ld2 + c4); }
            const LAS float* tp = T + on * 130 + okc;
            u32x4 w; w.x = pk_fp8x4(tp[0], tp[1], tp[2], tp[3]); w.y = pk_fp8x4(tp[4], tp[5], tp[6], tp[7]); w.z = pk_fp8x4(tp[8], tp[9], tp[10], tp[11]); w.w = pk_fp8x4(tp[12], tp[13], tp[14], tp[15]);
            *(u32x4*)(dst + (size_t)on * 1024 + okc) = w;
            buf ^= 1;
        }
        __syncthreads();
    }
    for (int task = bid + O_WOUT; task < NTASK; task += nblk) {
        if (task < O_WDN) {
            const int mat = task >> 9, t = task & 511, kt = t >> 5, nt = t & 31;
            transpose_tile_fp8(wv, p.w_gu + (size_t)mat * 1024 * 2048, 2048, kt * 64, nt * 64, WGU + (size_t)mat * 2048 * 1024, 1024, lds);
        } else if (task < O_WOUT) {
            const int tt = task - O_WDN, mat = tt >> 8, t = tt & 255, kt = t >> 4, nt = t & 15;
            transpose_tile_fp8(wv, p.w_down + (size_t)mat * 1024 * 1024, 1024, kt * 64, nt * 64, WDN + (size_t)mat * 1024 * 1024, 1024, lds);
        } else if (task < O_WIN) {
            if (YM_FP8) continue;
            const int tt = task - O_WOUT, mat = tt >> 8, t = tt & 255, kt = t >> 4, nt = t & 15;
            transpose_tile(wv, p.w_out + (size_t)mat * 1024 * 1024, 1024, kt * 64, nt * 64, 1024, WOUT + (size_t)mat * 1024 * 1024, 1024, lds);
        } else if (task < O_FOLD) {
            const int tt = task - O_WIN, mat = tt / (16 * 42), t = tt % (16 * 42), kt = t / 42, nt = t % 42;
            transpose_tile(wv, p.w_in + (size_t)mat * 1024 * INC, INC, kt * 64, nt * 64, INC, WIN + (size_t)mat * NP * 1024, 1024, lds);
        } else if (task < O_ADA) {
            const int tt = task - O_FOLD, l = tt >> 6, k0 = (tt & 63) * 16;
            LAS float* Aq = (LAS float*)lds;
            LAS float* Akv = Aq + 16 * 192;
            for (int i = tid; i < 16 * 192; i += NTHR) { const int r = i / 192, j = i % 192; Aq[i] = p.w_in[((size_t)l * 1024 + k0 + r) * INC + PC_DCQ + j] * p.mla_g_q[l * 192 + j]; }
            for (int i = tid; i < 16 * 128; i += NTHR) { const int r = i / 128, j = i % 128; Akv[i] = p.w_in[((size_t)l * 1024 + k0 + r) * INC + PC_DCKV + j] * p.mla_g_kv[l * 128 + j]; }
            __syncthreads();
            for (int n = tid; n < 896; n += NTHR) {
                float acc[16];
#pragma unroll
                for (int r = 0; r < 16; ++r) acc[r] = 0.f;
                if (n < 384) { const float* W = p.mla_w_uq + (size_t)l * 192 * 384 + n;
                    for (int j = 0; j < 192; ++j) { const float wv = W[(size_t)j * 384];
#pragma unroll
                        for (int r = 0; r < 16; ++r) acc[r] += Aq[r * 192 + j] * wv; }
                } else { const float* W = p.mla_w_ukv + (size_t)l * 128 * 512 + (n - 384);
                    for (int j = 0; j < 128; ++j) { const float wv = W[(size_t)j * 512];
#pragma unroll
                        for (int r = 0; r < 16; ++r) acc[r] += Akv[r * 128 + j] * wv; } }
                u32x4 w0, w1; w0.x = pk2(acc[0], acc[1]); w0.y = pk2(acc[2], acc[3]); w0.z = pk2(acc[4], acc[5]); w0.w = pk2(acc[6], acc[7]);
                w1.x = pk2(acc[8], acc[9]); w1.y = pk2(acc[10], acc[11]); w1.z = pk2(acc[12], acc[13]); w1.w = pk2(acc[14], acc[15]);
                bf16_t* d = WIN + ((size_t)l * NP + PC_DQF + n) * 1024 + k0; *(u32x4*)d = w0; *(u32x4*)(d + 8) = w1;
            }
            __syncthreads();
        } else if (task < O_ROPE) {
            const int tt = task - O_ADA, l = tt / 96, n0 = (tt % 96) * 64;
            LAS float* SC = (LAS float*)lds;
            LAS float* RED = SC + 5 * 1024;
            for (int i = tid; i < 5 * 1024; i += NTHR) { const int r = i >> 10, k = i & 1023; const float v = (r < 4) ? p.c[r * 1024 + k] : p.c_ctx[k]; SC[i] = siluf_(v); }
            __syncthreads();
            { const int kc = tid >> 6, col = tid & 63; float a[5] = {0.f, 0.f, 0.f, 0.f, 0.f};
              const float* W = p.w_ada + ((size_t)l * 1024 + kc * 128) * 6144 + n0 + col;
              for (int k = 0; k < 128; ++k) { const float wv = W[(size_t)k * 6144];
#pragma unroll
                  for (int r = 0; r < 5; ++r) a[r] += SC[r * 1024 + kc * 128 + k] * wv; }
#pragma unroll
              for (int r = 0; r < 5; ++r) RED[(kc * 5 + r) * 64 + col] = a[r]; }
            __syncthreads();
            if (tid < 320) { const int r = tid >> 6, col = tid & 63; float s = p.b_ada[l * 6144 + n0 + col];
#pragma unroll
                for (int kc = 0; kc < 8; ++kc) s += RED[(kc * 5 + r) * 64 + col];
                MOD[((size_t)l * 5 + r) * 6144 + n0 + col] = s; }
            __syncthreads();
        } else if (task < O_WRT) {
            const int idx = (task - O_ROPE) * 512 + tid, t = idx / 48, j = idx % 48;
            if (j < 32) { const int i = j & 15; const float inv = powf(10000.0f, -(float)(2 * i) / 32.0f); const float pos = (j < 16) ? (float)(t >> 6) : (float)(t & 63);
                float s, c; sincosf(pos * inv, &s, &c); RA[t * 32 + j] = make_float2(c, s); }
            else { const int jj = j - 32, i = jj & 7; const float inv = powf(10000.0f, -(float)(2 * i) / 16.0f); const float pos = (jj < 8) ? (float)(t >> 6) : (float)(t & 63);
                float s, c; sincosf(pos * inv, &s, &c); RD[t * 16 + jj] = make_float2(c, s); }
        } else if (task < O_PAD) {
            const int idx = (task - O_WRT) * 512 + tid, l = idx >> 15, e = (idx >> 10) & 31, k = idx & 1023;
            const float w = p.w_router[((size_t)l * 1024 + k) * 32 + e]; const unsigned short hi = f2bf(w); const unsigned short lo = f2bf(w - bf2f(hi));
            WRT[(((size_t)l * 2 + 0) * 32 + e) * 1024 + k] = hi; WRT[(((size_t)l * 2 + 1) * 32 + e) * 1024 + k] = lo;
        } else {
            const int idx = (task - O_PAD) * 512 + tid, l = idx >> 14, r = (idx >> 10) & 15, k = idx & 1023;
            WIN[((size_t)l * NP + PC_END + r) * 1024 + k] = 0;
        }
    }
}

__device__ __forceinline__ void phase_norm1_l0(int wv, const Params& p) {
    const int tid = otid(wv), lane = tid & 63, gw = blockIdx.x * NWAVE + (tid >> 6), nw = gridDim.x * NWAVE;
    const float* MOD = (const float*)(p.ws + WS_MOD); bf16_t* HB = (bf16_t*)(p.ws + WS_HB);
    for (int r = gw; r < TA; r += nw) {
        const float* src = (r < TL) ? p.x + (size_t)r * 1024 : p.ctx + (size_t)(r - TL) * 1024;
        const int mrow = (r < TL) ? (r >> 13) : 4; const float* mod = MOD + (size_t)mrow * 6144;
        f32x4 v[4]; row_load(src, lane, v); const float rstd = row_rstd(v);
        row_modulate(v, rstd, p.g_norm1, mod + 1024, mod, lane);
        row_store_bf16(HB + (size_t)r * 1024, lane, v);
    }
}
__device__ __forceinline__ void phase_combine(int wv, const Params& p, int l) {
    const int tid = otid(wv), lane = tid & 63, gw = blockIdx.x * NWAVE + (tid >> 6), nw = gridDim.x * NWAVE;
    const float* MOD = (const float*)(p.ws + WS_MOD); bf16_t* HB = (bf16_t*)(p.ws + WS_HB); const bf16_t* Y = (const bf16_t*)(p.ws + WS_Y);
    const float* XA = (const float*)(p.ws + WS_XA); float* XB = (float*)(p.ws + WS_XB);
    const int T = (l == 0) ? TA : TL;
    for (int r = gw; r < T; r += nw) {
        const int mrow = (r < TL) ? (r >> 13) : 4; const float* mod = MOD + ((size_t)l * 5 + mrow) * 6144;
        f32x4 v[4]; row_load(XA + (size_t)r * 1024, lane, v);
#pragma unroll
        for (int i = 0; i < 4; ++i) {
            f32x4 s = (f32x4){0.f, 0.f, 0.f, 0.f};
#pragma unroll
            for (int k = 0; k < 4; ++k) { const u32x2 w = *(const u32x2*)(Y + ((size_t)r * 4 + k) * 1024 + i * 256 + lane * 4);
                s[0] += bf2f(w.x & 0xffffu); s[1] += bf2f(w.x >> 16); s[2] += bf2f(w.y & 0xffffu); s[3] += bf2f(w.y >> 16); }
            const f32x4 g2 = *(const f32x4*)(mod + 5 * 1024 + i * 256 + lane * 4);
            v[i] = v[i] + g2 * s;
        }
        const float rstd = row_rstd(v);
        if (l == 0) {
#pragma unroll
            for (int i = 0; i < 4; ++i) *(f32x4*)(XB + (size_t)r * 1024 + i * 256 + lane * 4) = v[i];
            const float* mod1 = MOD + ((size_t)5 + mrow) * 6144;
            row_modulate(v, rstd, p.g_norm1 + 1024, mod1 + 1024, mod1, lane);
            row_store_bf16(HB + (size_t)r * 1024, lane, v);
        } else {
#pragma unroll
            for (int i = 0; i < 4; ++i) { const f32x4 gg = *(const f32x4*)(p.g_final + i * 256 + lane * 4);
                *(f32x4*)(p.out + (size_t)r * 1024 + i * 256 + lane * 4) = v[i] * rstd * gg; }
        }
    }
}

__device__ __forceinline__ int cu_index(int b, int tc, int h, int dir) { return ((b * NCHUNK + tc) * 4 + h) * 2 + dir; }
__device__ __forceinline__ float logsigmoidf_(float x) { return fminf(x, 0.f) - log1pf(__expf(-fabsf(x))); }

__device__ __forceinline__ void prep_elem(int wv, const Params& p, int l, LAS unsigned char* lds) {
    const int tid = otid(wv);
    unsigned char* ws = opq(p.ws);
    const bf16_t* P = (const bf16_t*)(ws + WS_P);
    bf16_t* QA = (bf16_t*)(ws + WS_QA); bf16_t* KA = (bf16_t*)(ws + WS_KA); bf16_t* QD = (bf16_t*)(ws + WS_QD); bf16_t* KD = (bf16_t*)(ws + WS_KD); bf16_t* VD = (bf16_t*)(ws + WS_VD);
    bf16_t* QC = (bf16_t*)(ws + WS_QC); bf16_t* KC = (bf16_t*)(ws + WS_KC); float* GATES = (float*)(ws + WS_GATES);
    const float2* RA = (const float2*)(ws + WS_RA); const float2* RD = (const float2*)(ws + WS_RD);
    LAS float* RQ = (LAS float*)lds;
    constexpr int CH = 44;
    const int per = (TA + gridDim.x - 1) / gridDim.x, rbeg = blockIdx.x * per, rend = min(rbeg + per, TA);
    for (int row0 = rbeg; row0 < rend; row0 += CH) {
        const int nr = min(CH, rend - row0);
        for (int itc = tid; itc < ((nr + 3) & ~3) * 16; itc += NTHR) { const int i = itc >> 4, sub = itc & 15; float sq = 0.f, sk = 0.f;
          if (i < nr) { const bf16_t* pr = P + (size_t)(row0 + i) * NP + PC_DCQ;
              const u32x4 c0 = *(const u32x4*)(pr + sub * 8), c1 = *(const u32x4*)(pr + (sub + 16) * 8); u32x4 c2 = (u32x4){0u, 0u, 0u, 0u}; if (sub < 8) c2 = *(const u32x4*)(pr + (sub + 32) * 8);
#pragma unroll
              for (int q = 0; q < 4; ++q) { const float a0 = bf2f(c0[q] & 0xffffu), a1 = bf2f(c0[q] >> 16), b0 = bf2f(c1[q] & 0xffffu), b1 = bf2f(c1[q] >> 16), d0 = bf2f(c2[q] & 0xffffu), d1 = bf2f(c2[q] >> 16);
                  sq += a0 * a0 + a1 * a1; const float t1 = b0 * b0 + b1 * b1; if (sub < 8) sq += t1; else sk += t1; sk += d0 * d0 + d1 * d1; } }
#pragma unroll
          for (int d = 8; d >= 1; d >>= 1) { sq += __shfl_xor(sq, d); sk += __shfl_xor(sk, d); }
          if (sub == 0 && i < nr) { RQ[i] = rsqrtf(sq * (1.0f / 192.0f) + EPS); RQ[64 + i] = rsqrtf(sk * (1.0f / 128.0f) + EPS); } }
        for (int it = tid; it < nr * 24; it += NTHR) {
            const int i = it / 24, r = it % 24, head = r >> 2, j0 = (r & 3) * 8, row = row0 + i;
            const bf16_t* src = P + (size_t)row * NP + (head < 4 ? PC_AQ + head * 64 : PC_AK + (head - 4) * 64) + j0;
            const u32x4 a = *(const u32x4*)src, bq = *(const u32x4*)(src + 32);
            u32x4 o1, o2;
            if (row >= TL) { o1 = a; o2 = bq; }
            else { const float2* tab = RA + (size_t)(row & (SEQ - 1)) * 32 + j0;
#pragma unroll
                for (int q = 0; q < 4; ++q) { const float x1a = bf2f(a[q] & 0xffffu), x1b = bf2f(a[q] >> 16), x2a = bf2f(bq[q] & 0xffffu), x2b = bf2f(bq[q] >> 16);
                    const float2 ca = tab[2 * q], cb = tab[2 * q + 1];
                    o1[q] = pk2(x1a * ca.x - x2a * ca.y, x1b * cb.x - x2b * cb.y); o2[q] = pk2(x2a * ca.x + x1a * ca.y, x2b * cb.x + x1b * cb.y); } }
            bf16_t* dst = (head < 4) ? QA + (size_t)row * 256 + head * 64 + j0 : KA + (size_t)row * 128 + (head - 4) * 64 + j0;
            *(u32x4*)dst = o1; *(u32x4*)(dst + 32) = o2;
        }
        for (int it = tid; it < nr * 64; it += NTHR) {
            const int i = it >> 6, c0 = (it & 63) * 8, row = row0 + i;
            const bool isc = row >= TL; const int t = isc ? ((row - TL) & (CTXL - 1)) : (row & (SEQ - 1)), nseq = isc ? CTXL : SEQ;
            const bf16_t* src = P + (size_t)row * NP + PC_CQK + c0;
            const u32x4 u1 = *(const u32x4*)src;
            u32x4 u0 = (u32x4){0u, 0u, 0u, 0u}, u2 = (u32x4){0u, 0u, 0u, 0u};
            if (t > 0) u0 = *(const u32x4*)(src - NP);
            if (t + 1 < nseq) u2 = *(const u32x4*)(src + NP);
            const float* cw = p.mlstm_conv + (size_t)l * 3 * 512 + c0;
            const float sc = (c0 >= 256) ? 0.125f : 1.0f;
            u32x4 o;
#pragma unroll
            for (int q = 0; q < 4; ++q) {
                const float ya = cw[2 * q] * bf2f(u0[q] & 0xffffu) + cw[512 + 2 * q] * bf2f(u1[q] & 0xffffu) + cw[1024 + 2 * q] * bf2f(u2[q] & 0xffffu);
                const float yb = cw[2 * q + 1] * bf2f(u0[q] >> 16) + cw[512 + 2 * q + 1] * bf2f(u1[q] >> 16) + cw[1024 + 2 * q + 1] * bf2f(u2[q] >> 16);
                o[q] = pk2(siluf_(ya) * sc, siluf_(yb) * sc); }
            if (c0 < 256) *(u32x4*)(QC + (size_t)row * 256 + c0) = o; else *(u32x4*)(KC + (size_t)row * 256 + (c0 - 256)) = o;
        }
        for (int itc = tid; itc < nr * 16; itc += NTHR) { const int i = itc >> 4, gi = itc & 15;
          { float v = bf2f(P[(size_t)(row0 + i) * NP + PC_CG + gi]) + p.mlstm_gate_bias[l * 16 + gi];
              if ((gi >> 2) & 1) v = logsigmoidf_(v);
              GATES[(size_t)(row0 + i) * 16 + gi] = v; } }
        __syncthreads();
        for (int it = tid; it < nr * 128; it += NTHR) {
            const int i = it >> 7, g = it & 127, row = row0 + i; const bool is_ctx = row >= TL; const int t = row & (SEQ - 1);
            const bf16_t* pr = P + (size_t)row * NP;
            const float rq = RQ[i], rkv = RQ[64 + i];
            u32x4 o;
            if (g < 96) {
                const bool isq = g < 48; const int g2 = isq ? g : g - 48, h = g2 / 12, gg = g2 % 12;
                const float sc = isq ? rq : ((gg < 8) ? rkv : 1.0f);
                const bf16_t* base = isq ? pr + PC_DQF + h * 96 : (gg < 8 ? pr + PC_DKVF + h * 128 : pr + PC_DKR - 64);
                if (gg < 8 || is_ctx) { const u32x4 a = *(const u32x4*)(base + gg * 8);
#pragma unroll
                    for (int q = 0; q < 4; ++q) o[q] = pk2(bf2f(a[q] & 0xffffu) * sc, bf2f(a[q] >> 16) * sc);
                } else { const int jj = (gg & 1) * 8;
                    const u32x4 x1 = *(const u32x4*)(base + 64 + jj), x2 = *(const u32x4*)(base + 80 + jj); const float2* tab = RD + (size_t)t * 16 + jj; const bool first = gg < 10;
#pragma unroll
                    for (int q = 0; q < 4; ++q) { const float x1a = bf2f(x1[q] & 0xffffu), x1b = bf2f(x1[q] >> 16), x2a = bf2f(x2[q] & 0xffffu), x2b = bf2f(x2[q] >> 16); const float2 ca = tab[2 * q], cb = tab[2 * q + 1];
                        const float ra = first ? x1a * ca.x - x2a * ca.y : x2a * ca.x + x1a * ca.y, rb = first ? x1b * cb.x - x2b * cb.y : x2b * cb.x + x1b * cb.y;
                        o[q] = pk2(ra * sc, rb * sc); } }
                bf16_t* dst = (isq ? QD : KD) + (size_t)row * 384 + h * 96 + gg * 8; *(u32x4*)dst = o;
            } else { const int g2 = g - 96, h = g2 >> 3, gg = g2 & 7;
                const u32x4 a = *(const u32x4*)(pr + PC_DKVF + h * 128 + 64 + gg * 8);
#pragma unroll
                for (int q = 0; q < 4; ++q) o[q] = pk2(bf2f(a[q] & 0xffffu) * rkv, bf2f(a[q] >> 16) * rkv);
                *(u32x4*)(VD + (size_t)row * 256 + h * 64 + gg * 8) = o; }
        }
        __syncthreads();
    }
}
__device__ __forceinline__ void prep_state(int wv, const Params& p, int l, LAS unsigned char* lds) {
    const int tid = otid(wv), lane = tid & 63, w = tid >> 6;
    unsigned char* ws = opq(p.ws);
    const bf16_t* P = (const bf16_t*)(ws + WS_P);
    float* DC = (float*)(ws + WS_DC); float* DN = (float*)(ws + WS_DN); float* DFA = (float*)(ws + WS_DFA);
    LAS unsigned char* KW = lds;
    LAS unsigned char* VT = lds + 24576;
    LAS float* KF = (LAS float*)(lds + 36864);
    LAS float* WL = (LAS float*)(lds + 53504);
    constexpr int NU = (TA / 64) * 4;
    for (int un = blockIdx.x; un < NU; un += gridDim.x) {
        const int ch = un >> 2, hd = un & 3;
        const bool is_ctx = ch >= TL / 64; const int cc = ch - TL / 64;
        const int b = is_ctx ? (cc >> 2) : (ch >> 7), tc = is_ctx ? 128 + (cc & 3) : (ch & 127);
        const int row0 = ch * 64, t0 = is_ctx ? (cc & 3) * 64 : (ch & 127) * 64, nseq = is_ctx ? CTXL : SEQ;
        {
            const int s = tid >> 3, part = tid & 7, c0 = 256 + hd * 64 + part * 8, t = t0 + s;
            const bf16_t* src = P + (size_t)(row0 + s) * NP + PC_CQK + c0;
            const u32x4 u1 = *(const u32x4*)src;
            u32x4 u0 = (u32x4){0u, 0u, 0u, 0u}, u2 = (u32x4){0u, 0u, 0u, 0u};
            if (t > 0) u0 = *(const u32x4*)(src - NP);
            if (t + 1 < nseq) u2 = *(const u32x4*)(src + NP);
            const float* cw = p.mlstm_conv + (size_t)l * 3 * 512 + c0;
#pragma unroll
            for (int q = 0; q < 4; ++q) {
                const float ya = cw[2 * q] * bf2f(u0[q] & 0xffffu) + cw[512 + 2 * q] * bf2f(u1[q] & 0xffffu) + cw[1024 + 2 * q] * bf2f(u2[q] & 0xffffu);
                const float yb = cw[2 * q + 1] * bf2f(u0[q] >> 16) + cw[512 + 2 * q + 1] * bf2f(u1[q] >> 16) + cw[1024 + 2 * q + 1] * bf2f(u2[q] >> 16);
                const unsigned pk = pk2(siluf_(ya) * 0.125f, siluf_(yb) * 0.125f);
                KF[s * 65 + part * 8 + 2 * q] = bf2f(pk & 0xffffu); KF[s * 65 + part * 8 + 2 * q + 1] = bf2f(pk >> 16); }
            *(LAS u32x4*)(VT + s * 192 + part * 16) = *(const u32x4*)(P + (size_t)(row0 + s) * NP + PC_CV + hd * 64 + part * 8);
        }
        if (w < 2) {
            const int dir = w, i = dir ? 63 - lane : lane;
            const bf16_t* pg = P + (size_t)(row0 + i) * NP + PC_CG;
            const float ig = bf2f(pg[(dir ? 8 : 0) + hd]) + p.mlstm_gate_bias[l * 16 + (dir ? 8 : 0) + hd];
            const float lf = logsigmoidf_(bf2f(pg[(dir ? 12 : 4) + hd]) + p.mlstm_gate_bias[l * 16 + (dir ? 12 : 4) + hd]);
            const float bc = wave_incl_sum(lf, lane), bend = __shfl(bc, 63);
            const float val = bend - bc + ig, a = wave_max(val);
            WL[dir * 64 + i] = fexp(val - a);
            if (lane == 0) { float* fa = DFA + (size_t)cu_index(b, tc, hd, dir) * 2; fa[0] = bend; fa[1] = a; }
        }
        __syncthreads();
        {
            const int s = tid >> 3, part = tid & 7;
#pragma unroll
            for (int dir = 0; dir < 2; ++dir) { const float wt = WL[dir * 64 + s]; u32x4 o;
#pragma unroll
                for (int q = 0; q < 4; ++q) o[q] = pk2(KF[s * 65 + part * 8 + 2 * q] * wt, KF[s * 65 + part * 8 + 2 * q + 1] * wt);
                *(LAS u32x4*)(KW + dir * 12288 + s * 192 + part * 16) = o; }
        }
        __syncthreads();
        {
            const int dir = w >> 2, dvb = (w >> 1) & 1, dkb = w & 1, hh = lane >> 5, l31 = lane & 31;
            const int q4 = (lane & 15) >> 2, colo = 16 * ((lane >> 4) & 1) + 4 * (lane & 3);
            f32x16 acc = zero16();
#pragma unroll
            for (int ks = 0; ks < 4; ++ks) {
                const int r0 = 16 * ks + 8 * hh + q4;
                const bf16x8 af = cat8(tr_read(VT + r0 * 192 + (32 * dvb + colo) * 2), tr_read(VT + (r0 + 4) * 192 + (32 * dvb + colo) * 2));
                const bf16x8 bfr = cat8(tr_read(KW + dir * 12288 + r0 * 192 + (32 * dkb + colo) * 2), tr_read(KW + dir * 12288 + (r0 + 4) * 192 + (32 * dkb + colo) * 2));
                acc = mfma32(af, bfr, acc);
            }
            float* dc = DC + (size_t)cu_index(b, tc, hd, dir) * 4096;
#pragma unroll
            for (int r = 0; r < 16; ++r) { const int dv = 32 * dvb + (r & 3) + 8 * (r >> 2) + 4 * hh; dc[dv * 64 + 32 * dkb + l31] = acc[r]; }
            { const int d2 = tid >> 8, dk = (tid >> 2) & 63, part = tid & 3; float sm = 0.f;
#pragma unroll 4
              for (int ss = 0; ss < 16; ++ss) sm += bf2f(*(const LAS bf16_t*)(KW + d2 * 12288 + (part * 16 + ss) * 192 + dk * 2));
              sm += __shfl_xor(sm, 1); sm += __shfl_xor(sm, 2);
              if (part == 0) DN[(size_t)cu_index(b, tc, hd, d2) * 64 + dk] = sm; }
        }
        __syncthreads();
    }
}
__device__ __forceinline__ void phase_prep(int wv, const Params& p, int l, LAS unsigned char* lds) {
    prep_elem(wv, p, l, lds);
    __syncthreads();
    prep_state(wv, p, l, lds);
}

__device__ __forceinline__ void phase_scan(int wv, const Params& p, LAS unsigned char* lds) {
    const int tid = otid(wv);
    unsigned char* ws = opq(p.ws);
    const float* DC = (const float*)(ws + WS_DC); const float* DN = (const float*)(ws + WS_DN); const float* DFA = (const float*)(ws + WS_DFA);
    bf16_t* CS = (bf16_t*)(ws + WS_CS); float* NS = (float*)(ws + WS_NS); float* MS = (float*)(ws + WS_MS);
    LAS float* FA = (LAS float*)lds;
    LAS float* AL = FA + 2 * NCHUNK;
    LAS float* BE = AL + NCHUNK;
    LAS int* UI = (LAS int*)(BE + NCHUNK);
    for (int u = blockIdx.x; u < 256; u += gridDim.x) {
        const int slice = u & 7, dir = (u >> 3) & 1, h = (u >> 4) & 3, b = u >> 6;
        if (tid < NCHUNK) { const int j = tid; const int tc = dir ? ((j < 4) ? 128 + (3 - j) : 131 - j) : ((j < 4) ? 128 + j : j - 4);
            const int ui = cu_index(b, tc, h, dir); UI[j] = ui; FA[2 * j] = DFA[(size_t)ui * 2]; FA[2 * j + 1] = DFA[(size_t)ui * 2 + 1]; }
        __syncthreads();
        if (tid == 0) { float m = 0.f;
            for (int j = 0; j < NCHUNK; ++j) { const float F = FA[2 * j], a = FA[2 * j + 1]; const float mn = fmaxf(F + m, a);
                AL[j] = fexp(F + m - mn); BE[j] = fexp(a - mn); if (slice == 0) MS[UI[j]] = m; m = mn; } }
        __syncthreads();
        { const int e = slice * 512 + tid; float c = 0.f;
#pragma unroll 1
          for (int j0 = 0; j0 < NCHUNK; j0 += 12) { float d[12];
#pragma unroll
              for (int jj = 0; jj < 12; ++jj) d[jj] = DC[(size_t)UI[j0 + jj] * 4096 + e];
#pragma unroll
              for (int jj = 0; jj < 12; ++jj) { const int j = j0 + jj; CS[(size_t)UI[j] * 4096 + e] = f2bf(c); c = AL[j] * c + BE[j] * d[jj]; } } }
        if (slice == 0 && tid < 64) { float n = 0.f;
#pragma unroll 1
            for (int j0 = 0; j0 < NCHUNK; j0 += 12) { float d[12];
#pragma unroll
                for (int jj = 0; jj < 12; ++jj) d[jj] = DN[(size_t)UI[j0 + jj] * 64 + tid];
#pragma unroll
                for (int jj = 0; jj < 12; ++jj) { const int j = j0 + jj; NS[(size_t)UI[j] * 64 + tid] = n; n = AL[j] * n + BE[j] * d[jj]; } } }
        __syncthreads();
    }
}

template <int QB, class Pol>
__device__ __forceinline__ void attn_core(int wv, LAS unsigned char* lds, const Pol& pol, int q2off = 0, int o2off = 0) {
    constexpr int DQ = Pol::DQ, KS = DQ / 16, NDMA = (DQ == 96) ? 3 : 2;
    constexpr int KN_OFF = 0, KR_OFF = 8192, V_OFF = (DQ == 96) ? 12288 : 8192, STAGE = V_OFF + 8192;
    const int tid = otid(wv), lane = tid & 63, hh = lane >> 5, l31 = lane & 31;
    bf16x8 qf[QB][KS];
#pragma unroll
    for (int qb = 0; qb < QB; ++qb)
#pragma unroll
        for (int ks = 0; ks < KS; ++ks) { const u32x4 raw = *(const u32x4*)(pol.qrow + (size_t)qb * q2off + 16 * ks + 8 * hh); u32x4 sc;
#pragma unroll
            for (int q = 0; q < 4; ++q) sc[q] = pk2(bf2f(raw[q] & 0xffffu) * pol.qscale, bf2f(raw[q] >> 16) * pol.qscale);
            qf[qb][ks] = as_bf16x8(sc); }
    f32x16 O[QB][2]; float m[QB], lsum[QB];
#pragma unroll
    for (int qb = 0; qb < QB; ++qb) { O[qb][0] = zero16(); O[qb][1] = zero16(); m[qb] = pol.m0; lsum[qb] = (hh == 0) ? pol.l0 : 0.f; }
    const int drow = 8 * wv + (lane >> 3), dpos = lane & 7;
    const int kn_src = ((dpos ^ ((drow >> 1) & 7)) * 8), v_src = ((dpos ^ (((drow >> 1) & 1) << 2)) * 8);
    const int rrow = 16 * (wv & 3) + (lane >> 2), rpos = lane & 3, kr_src = 64 + ((rpos ^ ((rrow >> 2) & 3)) * 8);
    int kn_rd[2], kr_rd[2];
#pragma unroll
    for (int kbk = 0; kbk < 2; ++kbk) { const int key = 32 * kbk + l31; kn_rd[kbk] = KN_OFF + key * 128 + ((hh ^ ((key >> 1) & 7)) * 16); kr_rd[kbk] = KR_OFF + key * 64 + ((hh ^ ((key >> 2) & 3)) * 16); }
    const int q4 = (lane & 15) >> 2;
    const int vchunk = 2 * ((lane >> 4) & 1) + ((lane & 3) >> 1), vsw = ((q4 >> 1) & 1) << 2;
    const int v_rd0 = V_OFF + (4 * hh + q4) * 128 + (((vchunk) ^ vsw) * 16) + 8 * (lane & 1);
    const int v_rd1 = V_OFF + (4 * hh + q4) * 128 + (((vchunk + 4) ^ vsw) * 16) + 8 * (lane & 1);
    const int nt = pol.ntiles;
#define ATT_DMA(t, st) do { const bf16_t* kp_; const bf16_t* vp_; int ks_, vs_; pol.tile_ptrs((t), kp_, ks_, vp_, vs_); LAS unsigned char* sb_ = lds + (st) * STAGE; \
        __builtin_amdgcn_global_load_lds((const unsigned*)(kp_ + (size_t)drow * ks_ + kn_src), (LAS unsigned*)(sb_ + KN_OFF + wv * 1024), 16, 0, 0); \
        __builtin_amdgcn_global_load_lds((const unsigned*)(vp_ + (size_t)drow * vs_ + v_src), (LAS unsigned*)(sb_ + V_OFF + wv * 1024), 16, 0, 0); \
        if (DQ == 96 && wv < 4) __builtin_amdgcn_global_load_lds((const unsigned*)(kp_ + (size_t)rrow * ks_ + kr_src), (LAS unsigned*)(sb_ + KR_OFF + wv * 1024), 16, 0, 0); } while (0)
    asm volatile("s_waitcnt vmcnt(0)" ::: "memory");
    ATT_DMA(0, 0); ATT_DMA(nt > 1 ? 1 : 0, 1);
    int st = 0;
    for (int t = 0; t < nt; ++t) {
        if (NDMA == 3 && wv < 4) asm volatile("s_waitcnt vmcnt(3)" ::: "memory"); else asm volatile("s_waitcnt vmcnt(2)" ::: "memory");
        __builtin_amdgcn_s_barrier(); asm volatile("" ::: "memory");
        { const int tn = (t + 2 < nt) ? t + 2 : nt - 1; const int sn = (st == 0) ? 2 : st - 1; ATT_DMA(tn, sn); }
        if (pol.wave_active(t)) {
            LAS unsigned char* sb = lds + st * STAGE;
            f32x16 s[QB][2];
#pragma unroll
            for (int qb = 0; qb < QB; ++qb) { s[qb][0] = zero16(); s[qb][1] = zero16(); }
#pragma unroll
            for (int ks = 0; ks < KS; ++ks) {
                bf16x8 a0, a1;
                if (ks < 4) { a0 = *(const LAS bf16x8*)(sb + (kn_rd[0] ^ (ks * 32))); a1 = *(const LAS bf16x8*)(sb + (kn_rd[1] ^ (ks * 32))); }
                else { a0 = *(const LAS bf16x8*)(sb + (kr_rd[0] ^ ((ks - 4) * 32))); a1 = *(const LAS bf16x8*)(sb + (kr_rd[1] ^ ((ks - 4) * 32))); }
#pragma unroll
                for (int qb = 0; qb < QB; ++qb) { s[qb][0] = mfma32(a0, qf[qb][ks], s[qb][0]); s[qb][1] = mfma32(a1, qf[qb][ks], s[qb][1]); }
            }
            if (QB == 1 && pol.tile_masked(t)) {
#pragma unroll
                for (int r = 0; r < 16; ++r) { const int e0 = (r & 3) + 8 * (r >> 2); s[0][0][r] = pol.score(s[0][0][r], t, e0, hh); s[0][1][r] = pol.score(s[0][1][r], t, 32 + e0, hh); }
            }
            bf16x8 pf[QB][2][2];
#pragma unroll
            for (int qb = 0; qb < QB; ++qb) {
                float mx = s[qb][0][0];
#pragma unroll
                for (int r = 1; r < 16; ++r) mx = fmaxf(mx, s[qb][0][r]);
#pragma unroll
                for (int r = 0; r < 16; ++r) mx = fmaxf(mx, s[qb][1][r]);
                mx = fmaxf(mx, __shfl_xor(mx, 32));
                if (__any(mx > m[qb])) {
                    const float mn = fmaxf(m[qb], mx), alpha = fexp2(m[qb] - mn); m[qb] = mn; lsum[qb] *= alpha;
#pragma unroll
                    for (int r = 0; r < 16; ++r) { O[qb][0][r] *= alpha; O[qb][1][r] *= alpha; }
                }
                const float mc = m[qb]; float ps = 0.f;
#pragma unroll
                for (int r = 0; r < 16; ++r) { s[qb][0][r] = fexp2(s[qb][0][r] - mc); s[qb][1][r] = fexp2(s[qb][1][r] - mc); ps += s[qb][0][r] + s[qb][1][r]; }
                lsum[qb] += ps;
#pragma unroll
                for (int sx = 0; sx < 2; ++sx) { u32x4 w0, w1;
#pragma unroll
                    for (int q = 0; q < 4; ++q) { w0[q] = pk2(s[qb][0][8 * sx + 2 * q], s[qb][0][8 * sx + 2 * q + 1]); w1[q] = pk2(s[qb][1][8 * sx + 2 * q], s[qb][1][8 * sx + 2 * q + 1]); }
                    pf[qb][0][sx] = as_bf16x8(w0); pf[qb][1][sx] = as_bf16x8(w1); }
            }
            {
                LAS unsigned char* va = sb + v_rd0; LAS unsigned char* vbp = sb + v_rd1;
                u32x2 x0, x1, x2, x3, x4, x5, x6, x7;
#define TRR8(o0, o1, o2, o3, o4, o5, o6, o7) asm volatile( \
                    "ds_read_b64_tr_b16 %0, %8 offset:" #o0 "\n\tds_read_b64_tr_b16 %1, %8 offset:" #o1 "\n\tds_read_b64_tr_b16 %2, %9 offset:" #o2 "\n\tds_read_b64_tr_b16 %3, %9 offset:" #o3 "\n\t" \
                    "ds_read_b64_tr_b16 %4, %8 offset:" #o4 "\n\tds_read_b64_tr_b16 %5, %8 offset:" #o5 "\n\tds_read_b64_tr_b16 %6, %9 offset:" #o6 "\n\tds_read_b64_tr_b16 %7, %9 offset:" #o7 "\n\t" \
                    "s_waitcnt lgkmcnt(0)" \
                    : "=&v"(x0), "=&v"(x1), "=&v"(x2), "=&v"(x3), "=&v"(x4), "=&v"(x5), "=&v"(x6), "=&v"(x7) : "v"(va), "v"(vbp) : "memory")
#define V8(a, b) as_bf16x8((u32x4){(a).x, (a).y, (b).x, (b).y})
                TRR8(0, 1024, 0, 1024, 2048, 3072, 2048, 3072);
#pragma unroll
                for (int qb = 0; qb < QB; ++qb) { O[qb][0] = mfma32(V8(x0, x1), pf[qb][0][0], O[qb][0]); O[qb][1] = mfma32(V8(x2, x3), pf[qb][0][0], O[qb][1]);
                                                  O[qb][0] = mfma32(V8(x4, x5), pf[qb][0][1], O[qb][0]); O[qb][1] = mfma32(V8(x6, x7), pf[qb][0][1], O[qb][1]); }
                TRR8(4096, 5120, 4096, 5120, 6144, 7168, 6144, 7168);
#pragma unroll
                for (int qb = 0; qb < QB; ++qb) { O[qb][0] = mfma32(V8(x0, x1), pf[qb][1][0], O[qb][0]); O[qb][1] = mfma32(V8(x2, x3), pf[qb][1][0], O[qb][1]);
                                                  O[qb][0] = mfma32(V8(x4, x5), pf[qb][1][1], O[qb][0]); O[qb][1] = mfma32(V8(x6, x7), pf[qb][1][1], O[qb][1]); }
#undef V8
#undef TRR8
            }
        }
        st = (st == 2) ? 0 : st + 1;
    }
#undef ATT_DMA
    asm volatile("s_waitcnt vmcnt(0)" ::: "memory");
    __builtin_amdgcn_s_barrier(); asm volatile("" ::: "memory");
#pragma unroll
    for (int qb = 0; qb < QB; ++qb) {
        float ls = lsum[qb]; ls += __shfl_xor(ls, 32);
        const float inv = 1.0f / ls; ym_t* orow = pol.orow + (size_t)qb * o2off;
#pragma unroll
        for (int g = 0; g < 4; ++g) {
            ym_store4(orow + 8 * g + 4 * hh, O[qb][0][4 * g] * inv, O[qb][0][4 * g + 1] * inv, O[qb][0][4 * g + 2] * inv, O[qb][0][4 * g + 3] * inv);
            ym_store4(orow + 32 + 8 * g + 4 * hh, O[qb][1][4 * g] * inv, O[qb][1][4 * g + 1] * inv, O[qb][1][4 * g + 2] * inv, O[qb][1][4 * g + 3] * inv);
        }
    }
}

template <int QB, class Pol>
__device__ __forceinline__ void attn_pp(int wv, LAS unsigned char* lds, const Pol& pol, int q2off = 0, int o2off = 0) {
    constexpr int DQ = Pol::DQ, KS = DQ / 16, NDMA = (DQ == 96) ? 3 : 2;
    constexpr int KN_OFF = 0, KR_OFF = 8192, V_OFF = (DQ == 96) ? 12288 : 8192, STAGE = V_OFF + 8192;
    const int tid = otid(wv), lane = tid & 63, hh = lane >> 5, l31 = lane & 31;
    const int grp = wv >> 2;
    bf16x8 qf[QB][KS];
#pragma unroll
    for (int qb = 0; qb < QB; ++qb)
#pragma unroll
        for (int ks = 0; ks < KS; ++ks) { const u32x4 raw = *(const u32x4*)(pol.qrow + (size_t)qb * q2off + 16 * ks + 8 * hh); u32x4 sc;
#pragma unroll
            for (int q = 0; q < 4; ++q) sc[q] = pk2(bf2f(raw[q] & 0xffffu) * pol.qscale, bf2f(raw[q] >> 16) * pol.qscale);
            qf[qb][ks] = as_bf16x8(sc); }
    f32x16 O[QB][2]; float m[QB], lsum[QB];
#pragma unroll
    for (int qb = 0; qb < QB; ++qb) { O[qb][0] = zero16(); O[qb][1] = zero16(); m[qb] = pol.m0; lsum[qb] = (hh == 0) ? pol.l0 : 0.f; }
    const int drow = 8 * wv + (lane >> 3), dpos = lane & 7;
    const int kn_src = ((dpos ^ ((drow >> 1) & 7)) * 8), v_src = ((dpos ^ (((drow >> 1) & 1) << 2)) * 8);
    const int rrow = 16 * (wv & 3) + (lane >> 2), rpos = lane & 3, kr_src = 64 + ((rpos ^ ((rrow >> 2) & 3)) * 8);
    int kn_rd[2], kr_rd[2];
#pragma unroll
    for (int kbk = 0; kbk < 2; ++kbk) { const int key = 32 * kbk + l31; kn_rd[kbk] = KN_OFF + key * 128 + ((hh ^ ((key >> 1) & 7)) * 16); kr_rd[kbk] = KR_OFF + key * 64 + ((hh ^ ((key >> 2) & 3)) * 16); }
    const int q4 = (lane & 15) >> 2;
    const int vchunk = 2 * ((lane >> 4) & 1) + ((lane & 3) >> 1), vsw = ((q4 >> 1) & 1) << 2;
    const int v_rd0 = V_OFF + (4 * hh + q4) * 128 + (((vchunk) ^ vsw) * 16) + 8 * (lane & 1);
    const int v_rd1 = V_OFF + (4 * hh + q4) * 128 + (((vchunk + 4) ^ vsw) * 16) + 8 * (lane & 1);
    const int nt = pol.ntiles;
#define ATT_DMA(t, st) do { const bf16_t* kp_; const bf16_t* vp_; int ks_, vs_; pol.tile_ptrs((t), kp_, ks_, vp_, vs_); LAS unsigned char* sb_ = lds + (st) * STAGE; \
        __builtin_amdgcn_global_load_lds((const unsigned*)(kp_ + (size_t)drow * ks_ + kn_src), (LAS unsigned*)(sb_ + KN_OFF + wv * 1024), 16, 0, 0); \
        __builtin_amdgcn_global_load_lds((const unsigned*)(vp_ + (size_t)drow * vs_ + v_src), (LAS unsigned*)(sb_ + V_OFF + wv * 1024), 16, 0, 0); \
        if (DQ == 96 && wv < 4) __builtin_amdgcn_global_load_lds((const unsigned*)(kp_ + (size_t)rrow * ks_ + kr_src), (LAS unsigned*)(sb_ + KR_OFF + wv * 1024), 16, 0, 0); } while (0)
#define ATT_WAIT1() do { if (NDMA == 3 && wv < 4) asm volatile("s_waitcnt vmcnt(3)" ::: "memory"); else asm volatile("s_waitcnt vmcnt(2)" ::: "memory"); } while (0)
#define ATT_BAR() do { asm volatile("" ::: "memory"); __builtin_amdgcn_s_barrier(); asm volatile("" ::: "memory"); } while (0)
    asm volatile("s_waitcnt vmcnt(0)" ::: "memory");
    ATT_DMA(0, 0); ATT_DMA(nt > 1 ? 1 : 0, 1);
    ATT_WAIT1();
    if (grp == 1) ATT_BAR();
    f32x16 s[QB][2]; bf16x8 pf[QB][2][2];
    bool act_prev = false;
#pragma unroll
    for (int qb = 0; qb < QB; ++qb) { s[qb][0] = zero16(); s[qb][1] = zero16();
#pragma unroll
        for (int a = 0; a < 2; ++a)
#pragma unroll
            for (int b = 0; b < 2; ++b) pf[qb][a][b] = as_bf16x8((u32x4){0u, 0u, 0u, 0u}); }
    for (int t = 0; t <= nt; ++t) {
        ATT_BAR();
        { const int tn = (t + 2 < nt) ? t + 2 : nt - 1; ATT_DMA(tn, (t + 2) & 3); }
        if (t > 0 && act_prev) {
            LAS unsigned char* sb = lds + ((t - 1) & 3) * STAGE;
            LAS unsigned char* va = sb + v_rd0; LAS unsigned char* vbp = sb + v_rd1;
            u32x2 x0, x1, x2, x3, x4, x5, x6, x7;
#define TRR8(o0, o1, o2, o3, o4, o5, o6, o7) asm volatile( \
                "ds_read_b64_tr_b16 %0, %8 offset:" #o0 "\n\tds_read_b64_tr_b16 %1, %8 offset:" #o1 "\n\tds_read_b64_tr_b16 %2, %9 offset:" #o2 "\n\tds_read_b64_tr_b16 %3, %9 offset:" #o3 "\n\t" \
                "ds_read_b64_tr_b16 %4, %8 offset:" #o4 "\n\tds_read_b64_tr_b16 %5, %8 offset:" #o5 "\n\tds_read_b64_tr_b16 %6, %9 offset:" #o6 "\n\tds_read_b64_tr_b16 %7, %9 offset:" #o7 "\n\t" \
                "s_waitcnt lgkmcnt(0)" \
                : "=&v"(x0), "=&v"(x1), "=&v"(x2), "=&v"(x3), "=&v"(x4), "=&v"(x5), "=&v"(x6), "=&v"(x7) : "v"(va), "v"(vbp) : "memory")
#define V8(a, b) as_bf16x8((u32x4){(a).x, (a).y, (b).x, (b).y})
            TRR8(0, 1024, 0, 1024, 2048, 3072, 2048, 3072);
#pragma unroll
            for (int qb = 0; qb < QB; ++qb) { O[qb][0] = mfma32(V8(x0, x1), pf[qb][0][0], O[qb][0]); O[qb][1] = mfma32(V8(x2, x3), pf[qb][0][0], O[qb][1]);
                                              O[qb][0] = mfma32(V8(x4, x5), pf[qb][0][1], O[qb][0]); O[qb][1] = mfma32(V8(x6, x7), pf[qb][0][1], O[qb][1]); }
            TRR8(4096, 5120, 4096, 5120, 6144, 7168, 6144, 7168);
#pragma unroll
            for (int qb = 0; qb < QB; ++qb) { O[qb][0] = mfma32(V8(x0, x1), pf[qb][1][0], O[qb][0]); O[qb][1] = mfma32(V8(x2, x3), pf[qb][1][0], O[qb][1]);
                                              O[qb][0] = mfma32(V8(x4, x5), pf[qb][1][1], O[qb][0]); O[qb][1] = mfma32(V8(x6, x7), pf[qb][1][1], O[qb][1]); }
#undef V8
#undef TRR8
        }
        const bool act = (t < nt) && pol.wave_active(t);
        if (act) {
            LAS unsigned char* sb = lds + (t & 3) * STAGE;
#pragma unroll
            for (int qb = 0; qb < QB; ++qb) { s[qb][0] = zero16(); s[qb][1] = zero16(); }
#pragma unroll
            for (int ks = 0; ks < KS; ++ks) {
                bf16x8 a0, a1;
                if (ks < 4) { a0 = *(const LAS bf16x8*)(sb + (kn_rd[0] ^ (ks * 32))); a1 = *(const LAS bf16x8*)(sb + (kn_rd[1] ^ (ks * 32))); }
                else { a0 = *(const LAS bf16x8*)(sb + (kr_rd[0] ^ ((ks - 4) * 32))); a1 = *(const LAS bf16x8*)(sb + (kr_rd[1] ^ ((ks - 4) * 32))); }
#pragma unroll
                for (int qb = 0; qb < QB; ++qb) { s[qb][0] = mfma32(a0, qf[qb][ks], s[qb][0]); s[qb][1] = mfma32(a1, qf[qb][ks], s[qb][1]); }
            }
        }
        ATT_WAIT1();
        ATT_BAR();
        if (act) {
            if (QB == 1 && pol.tile_masked(t)) {
#pragma unroll
                for (int r = 0; r < 16; ++r) { const int e0 = (r & 3) + 8 * (r >> 2); s[0][0][r] = pol.score(s[0][0][r], t, e0, hh); s[0][1][r] = pol.score(s[0][1][r], t, 32 + e0, hh); }
            }
#pragma unroll
            for (int qb = 0; qb < QB; ++qb) {
                float mx = s[qb][0][0];
#pragma unroll
                for (int r = 1; r < 16; ++r) mx = fmaxf(mx, s[qb][0][r]);
#pragma unroll
                for (int r = 0; r < 16; ++r) mx = fmaxf(mx, s[qb][1][r]);
                mx = fmaxf(mx, __shfl_xor(mx, 32));
                if (__any(mx > m[qb])) {
                    const float mn = fmaxf(m[qb], mx), alpha = fexp2(m[qb] - mn); m[qb] = mn; lsum[qb] *= alpha;
#pragma unroll
                    for (int r = 0; r < 16; ++r) { O[qb][0][r] *= alpha; O[qb][1][r] *= alpha; }
                }
                const float mc = m[qb]; float ps = 0.f;
#pragma unroll
                for (int r = 0; r < 16; ++r) { s[qb][0][r] = fexp2(s[qb][0][r] - mc); s[qb][1][r] = fexp2(s[qb][1][r] - mc); ps += s[qb][0][r] + s[qb][1][r]; }
                lsum[qb] += ps;
#pragma unroll
                for (int sx = 0; sx < 2; ++sx) { u32x4 w0, w1;
#pragma unroll
                    for (int q = 0; q < 4; ++q) { w0[q] = pk2(s[qb][0][8 * sx + 2 * q], s[qb][0][8 * sx + 2 * q + 1]); w1[q] = pk2(s[qb][1][8 * sx + 2 * q], s[qb][1][8 * sx + 2 * q + 1]); }
                    pf[qb][0][sx] = as_bf16x8(w0); pf[qb][1][sx] = as_bf16x8(w1); }
            }
        }
        act_prev = act;
    }
    if (grp == 0) ATT_BAR();
#undef ATT_DMA
#undef ATT_WAIT1
    asm volatile("s_waitcnt vmcnt(0)" ::: "memory");
    ATT_BAR();
#undef ATT_BAR
#pragma unroll
    for (int qb = 0; qb < QB; ++qb) {
        float ls = lsum[qb]; ls += __shfl_xor(ls, 32);
        const float inv = 1.0f / ls; ym_t* orow = pol.orow + (size_t)qb * o2off;
#pragma unroll
        for (int g = 0; g < 4; ++g) {
            ym_store4(orow + 8 * g + 4 * hh, O[qb][0][4 * g] * inv, O[qb][0][4 * g + 1] * inv, O[qb][0][4 * g + 2] * inv, O[qb][0][4 * g + 3] * inv);
            ym_store4(orow + 32 + 8 * g + 4 * hh, O[qb][1][4 * g] * inv, O[qb][1][4 * g + 1] * inv, O[qb][1][4 * g + 2] * inv, O[qb][1][4 * g + 3] * inv);
        }
    }
}

template <int QB, class Pol>
__device__ __forceinline__ void attn_core_old(int wv, LAS unsigned char* lds, const Pol& pol, int q2off = 0, int o2off = 0) {
    constexpr int DQ = Pol::DQ, KS = DQ / 16, KROW = DQ * 2 + 16, VROW = 192, KBUF = 64 * KROW, VBUF = 64 * VROW, KCH = DQ / 8;
    const int tid = otid(wv), lane = tid & 63, hh = lane >> 5, l31 = lane & 31;
    LAS unsigned char* kb = lds; LAS unsigned char* vb = lds + 2 * KBUF;
    bf16x8 qf[QB][KS];
#pragma unroll
    for (int qb = 0; qb < QB; ++qb)
#pragma unroll
        for (int ks = 0; ks < KS; ++ks) { const u32x4 raw = *(const u32x4*)(pol.qrow + (size_t)qb * q2off + 16 * ks + 8 * hh); u32x4 sc;
#pragma unroll
            for (int q = 0; q < 4; ++q) sc[q] = pk2(bf2f(raw[q] & 0xffffu) * pol.qscale, bf2f(raw[q] >> 16) * pol.qscale);
            qf[qb][ks] = as_bf16x8(sc); }
    f32x16 O[QB][2]; float m[QB], lsum[QB];
#pragma unroll
    for (int qb = 0; qb < QB; ++qb) { O[qb][0] = zero16(); O[qb][1] = zero16(); m[qb] = pol.m0; lsum[qb] = (hh == 0) ? pol.l0 : 0.f; }
    const int kkey0 = tid / KCH, kpart0 = tid % KCH, c1 = tid + NTHR, kkey1 = c1 / KCH, kpart1 = c1 % KCH; const bool has1 = c1 < 64 * KCH;
    const int vkey = tid >> 3, vpart = tid & 7;
    u32x4 kr0, kr1 = (u32x4){0u, 0u, 0u, 0u}, vr;
    const int q4 = (lane & 15) >> 2, colo = 16 * ((lane >> 4) & 1) + 4 * (lane & 3);
    const int nt = pol.ntiles;
#define ATT_GLOAD(t) do { const bf16_t* kp_; const bf16_t* vp_; int ks_, vs_; pol.tile_ptrs((t), kp_, ks_, vp_, vs_); \
        kr0 = *(const u32x4*)(kp_ + (size_t)kkey0 * ks_ + kpart0 * 8); if (has1) kr1 = *(const u32x4*)(kp_ + (size_t)kkey1 * ks_ + kpart1 * 8); \
        vr = *(const u32x4*)(vp_ + (size_t)vkey * vs_ + vpart * 8); } while (0)
#define ATT_LSTORE(buf) do { *(LAS u32x4*)(kb + (buf) * KBUF + kkey0 * KROW + kpart0 * 16) = kr0; if (has1) *(LAS u32x4*)(kb + (buf) * KBUF + kkey1 * KROW + kpart1 * 16) = kr1; \
        *(LAS u32x4*)(vb + (buf) * VBUF + vkey * VROW + vpart * 16) = vr; } while (0)
    ATT_GLOAD(0); ATT_LSTORE(0); __syncthreads();
    for (int t = 0; t < nt; ++t) {
        const int buf = t & 1;
        if (t + 1 < nt) ATT_GLOAD(t + 1);
        if (pol.wave_active(t)) {
            LAS unsigned char* kt = kb + buf * KBUF; LAS unsigned char* vt = vb + buf * VBUF;
            f32x16 s[QB][2];
#pragma unroll
            for (int qb = 0; qb < QB; ++qb) { s[qb][0] = zero16(); s[qb][1] = zero16(); }
#pragma unroll
            for (int ks = 0; ks < KS; ++ks) {
                const bf16x8 a0 = *(const LAS bf16x8*)(kt + l31 * KROW + (16 * ks + 8 * hh) * 2);
                const bf16x8 a1 = *(const LAS bf16x8*)(kt + (32 + l31) * KROW + (16 * ks + 8 * hh) * 2);
#pragma unroll
                for (int qb = 0; qb < QB; ++qb) { s[qb][0] = mfma32(a0, qf[qb][ks], s[qb][0]); s[qb][1] = mfma32(a1, qf[qb][ks], s[qb][1]); }
            }
            if (QB == 1 && pol.tile_masked(t)) {
#pragma unroll
                for (int r = 0; r < 16; ++r) { const int e0 = (r & 3) + 8 * (r >> 2); s[0][0][r] = pol.score(s[0][0][r], t, e0, hh); s[0][1][r] = pol.score(s[0][1][r], t, 32 + e0, hh); }
            }
            bf16x8 pf[QB][2][2];
#pragma unroll
            for (int qb = 0; qb < QB; ++qb) {
                float mx = s[qb][0][0];
#pragma unroll
                for (int r = 1; r < 16; ++r) mx = fmaxf(mx, s[qb][0][r]);
#pragma unroll
                for (int r = 0; r < 16; ++r) mx = fmaxf(mx, s[qb][1][r]);
                mx = fmaxf(mx, __shfl_xor(mx, 32));
                if (__any(mx > m[qb])) {
                    const float mn = fmaxf(m[qb], mx), alpha = fexp2(m[qb] - mn); m[qb] = mn; lsum[qb] *= alpha;
#pragma unroll
                    for (int r = 0; r < 16; ++r) { O[qb][0][r] *= alpha; O[qb][1][r] *= alpha; }
                }
                const float mc = m[qb]; float ps = 0.f;
#pragma unroll
                for (int r = 0; r < 16; ++r) { s[qb][0][r] = fexp2(s[qb][0][r] - mc); s[qb][1][r] = fexp2(s[qb][1][r] - mc); ps += s[qb][0][r] + s[qb][1][r]; }
                lsum[qb] += ps;
#pragma unroll
                for (int sx = 0; sx < 2; ++sx) { u32x4 w0, w1;
#pragma unroll
                    for (int q = 0; q < 4; ++q) { w0[q] = pk2(s[qb][0][8 * sx + 2 * q], s[qb][0][8 * sx + 2 * q + 1]); w1[q] = pk2(s[qb][1][8 * sx + 2 * q], s[qb][1][8 * sx + 2 * q + 1]); }
                    pf[qb][0][sx] = as_bf16x8(w0); pf[qb][1][sx] = as_bf16x8(w1); }
            }
#pragma unroll
            for (int kbk = 0; kbk < 2; ++kbk)
#pragma unroll
                for (int sx = 0; sx < 2; ++sx) {
                    const int r0 = 32 * kbk + 16 * sx + 4 * hh + q4;
                    const bf16x8 v0 = cat8(tr_read(vt + r0 * VROW + colo * 2), tr_read(vt + (r0 + 8) * VROW + colo * 2));
                    const bf16x8 v1 = cat8(tr_read(vt + r0 * VROW + (32 + colo) * 2), tr_read(vt + (r0 + 8) * VROW + (32 + colo) * 2));
#pragma unroll
                    for (int qb = 0; qb < QB; ++qb) { O[qb][0] = mfma32(v0, pf[qb][kbk][sx], O[qb][0]); O[qb][1] = mfma32(v1, pf[qb][kbk][sx], O[qb][1]); }
                }
        }
        if (t + 1 < nt) ATT_LSTORE(buf ^ 1);
        __syncthreads();
    }
#undef ATT_GLOAD
#undef ATT_LSTORE
#pragma unroll
    for (int qb = 0; qb < QB; ++qb) {
        float ls = lsum[qb]; ls += __shfl_xor(ls, 32);
        const float inv = 1.0f / ls; ym_t* orow = pol.orow + (size_t)qb * o2off;
#pragma unroll
        for (int g = 0; g < 4; ++g) {
            ym_store4(orow + 8 * g + 4 * hh, O[qb][0][4 * g] * inv, O[qb][0][4 * g + 1] * inv, O[qb][0][4 * g + 2] * inv, O[qb][0][4 * g + 3] * inv);
            ym_store4(orow + 32 + 8 * g + 4 * hh, O[qb][1][4 * g] * inv, O[qb][1][4 * g + 1] * inv, O[qb][1][4 * g + 2] * inv, O[qb][1][4 * g + 3] * inv);
        }
    }
}

constexpr float NEG_INF = -__builtin_inff();
struct PolD {
    static constexpr int DQ = 96;
    const bf16_t *kbase, *vbase, *kctx, *vctx, *qrow; ym_t* orow; int nloc, ntiles; float qscale, m0, l0;
    __device__ __forceinline__ void tile_ptrs(int t, const bf16_t*& kp, int& ks, const bf16_t*& vp, int& vs) const {
        ks = 384; vs = 256;
        if (t < nloc) { kp = kbase + (size_t)t * 64 * 384; vp = vbase + (size_t)t * 64 * 256; } else { kp = kctx + (size_t)(t - nloc) * 64 * 384; vp = vctx + (size_t)(t - nloc) * 64 * 256; } }
    __device__ __forceinline__ bool wave_active(int) const { return true; }
    __device__ __forceinline__ bool tile_masked(int) const { return false; }
    __device__ __forceinline__ float score(float s, int, int, int) const { return s; }
};
struct PolA {
    static constexpr int DQ = 64;
    const bf16_t *kbase, *vbase, *kctx, *vctx, *qrow; ym_t* orow; int nloc, ntiles; float qscale, m0, l0;
    int kp0, q0, qpos;
    __device__ __forceinline__ void tile_ptrs(int t, const bf16_t*& kp, int& ks, const bf16_t*& vp, int& vs) const {
        ks = 128; vs = NP;
        if (t < nloc) { const int k0 = kp0 + 64 * t; kp = kbase + (size_t)k0 * 128; vp = vbase + (size_t)k0 * NP; } else { kp = kctx + (size_t)(t - nloc) * 64 * 128; vp = vctx + (size_t)(t - nloc) * 64 * NP; } }
    __device__ __forceinline__ bool wave_active(int t) const { const int k0 = kp0 + 64 * t; return t >= nloc || (k0 + 63 >= q0 - 128 && k0 <= q0 + 31 + 128); }
    __device__ __forceinline__ bool tile_masked(int t) const { const int k0 = kp0 + 64 * t; return t < nloc && !(k0 >= q0 + 31 - 128 && k0 + 63 <= q0 + 128); }
    __device__ __forceinline__ float score(float s, int t, int e0, int hh) const { const int d = qpos - (kp0 + 64 * t + e0 + 4 * hh); return (d <= 128 && d >= -128) ? s : NEG_INF; }
};
struct PolB {
    static constexpr int DQ = 64;
    const bf16_t *kbase, *vbase, *kctx, *vctx, *qrow; ym_t* orow; int nloc, ntiles; float qscale, m0, l0;
    int klo, wr0, r, c; const LAS float* rpb;
    unsigned mlo, mhi; int bbase;
    __device__ __forceinline__ void set_lane(int hh) { const int cs = min(max(c - 8, 0), 48); const unsigned long long m = (0xffffull << cs) >> (4 * hh); mlo = (unsigned)m; mhi = (unsigned)(m >> 32); bbase = 15 - c + 4 * hh; }
    __device__ __forceinline__ void tile_ptrs(int t, const bf16_t*& kp, int& ks, const bf16_t*& vp, int& vs) const {
        ks = NP; vs = NP;
        if (t < nloc) { kp = kbase + (size_t)(klo + t) * 64 * NP; vp = vbase + (size_t)(klo + t) * 64 * NP; } else { kp = kctx + (size_t)(t - nloc) * 64 * NP; vp = vctx + (size_t)(t - nloc) * 64 * NP; } }
    __device__ __forceinline__ bool wave_active(int t) const { return t >= nloc || (klo + t >= wr0 && klo + t < wr0 + 8); }
    __device__ __forceinline__ bool tile_masked(int t) const { return t < nloc; }
    __device__ __forceinline__ float score(float s, int t, int e0, int) const {
        const bool ok = ((e0 < 32 ? (mlo >> e0) : (mhi >> (e0 - 32))) & 1u) != 0u;
        const float bias = rpb[(klo + t - r + 7) * 31 + bbase + e0];
        return ok ? s + bias : NEG_INF; }
};

struct XQ { unsigned* heads; int x, per; int dx; };
__device__ __forceinline__ int q_next(int tid, XQ& q, LAS int* slot) {
    for (;;) {
        if (q.dx >= 8) return -1;
        const int xx = (q.x + q.dx) & 7;
        __syncthreads();
        if (tid == 0) *slot = (int)__hip_atomic_fetch_add(q.heads + xx * 64, 1u, __ATOMIC_RELAXED, __HIP_MEMORY_SCOPE_AGENT);
        __syncthreads();
        const int j = *slot;
        if (j < q.per) return xx * q.per + j;
        ++q.dx;
    }
}

__device__ __forceinline__ void mlstm_out_pair(int wv, const Params& p, LAS unsigned char* lds, int l, int u0, int u1) {
    const int tid = otid(wv), lane = tid & 63, w = tid >> 6, hh = lane >> 5, l31 = lane & 31;
    const int half = w >> 2, wl = w & 3;
    unsigned char* ws = opq(p.ws);
    const bf16_t* P = (const bf16_t*)(ws + WS_P); const bf16_t* QC = (const bf16_t*)(ws + WS_QC); const bf16_t* KC = (const bf16_t*)(ws + WS_KC);
    const float* GATES = (const float*)(ws + WS_GATES); const bf16_t* CS = (const bf16_t*)(ws + WS_CS); const float* NS = (const float*)(ws + WS_NS); const float* MS = (const float*)(ws + WS_MS);
    ym_t* YMIX = (ym_t*)(ws + WS_YMIX);
    const bool need_ctx = (l == 0);
    const int u = half ? u1 : u0; const bool valid = u >= 0;
    const int hd = u & 3, v = u >> 2; int b, tc;
    if (need_ctx) { b = v / NCHUNK; tc = v % NCHUNK; } else { b = v >> 7; tc = v & 127; }
    LAS unsigned char* hb = lds + half * 36864;
    LAS unsigned char* VT = hb;
    LAS float* ZU = (LAS float*)(hb + 12288);
    LAS float* ZC = ZU + 128;
    LAS float* ZI = ZC + 128;
    LAS float* ZE = ZI + 128;
    LAS float* ZN = ZE + 128;
    LAS float* ZH = (LAS float*)(hb + 16384);
    const int row0 = (tc < 128) ? b * SEQ + tc * 64 : TL + b * CTXL + (tc - 128) * 64;
    if (valid) {
        if (wl < 2) { const int dir = wl, i = dir ? 63 - lane : lane;
            const float lf = GATES[(size_t)(row0 + i) * 16 + (dir ? 12 : 4) + hd], ig = GATES[(size_t)(row0 + i) * 16 + (dir ? 8 : 0) + hd];
            const float bc = wave_incl_sum(lf, lane), uu = ig - bc, pm = wave_incl_max(uu, lane);
            const float min_ = MS[cu_index(b, tc, hd, dir)], mx = fmaxf(min_, pm);
            ZU[dir * 64 + lane] = uu; ZC[dir * 64 + lane] = -mx; ZI[dir * 64 + lane] = fexp(min_ - mx); ZE[dir * 64 + lane] = fexp(-(bc + mx));
        } else { const int dir = wl - 2; ZN[dir * 64 + lane] = NS[(size_t)cu_index(b, tc, hd, dir) * 64 + lane]; }
        { const int t4 = wl * 64 + lane;
#pragma unroll
          for (int ps = 0; ps < 2; ++ps) { const int c = t4 + 256 * ps, s = c >> 3, part = c & 7; *(LAS u32x4*)(VT + s * 192 + part * 16) = *(const u32x4*)(P + (size_t)(row0 + s) * NP + PC_CV + hd * 64 + part * 8); } }
    }
    __syncthreads();
    const int dir = wl >> 1, tb = wl & 1;
    const int t = 32 * tb + l31, it = dir ? 63 - t : t;
    f32x16 acc[2], acc2[2]; float inter = 0.f, rden = 0.f;
    if (valid) {
        bf16x8 qf[4];
#pragma unroll
        for (int ks = 0; ks < 4; ++ks) qf[ks] = *(const bf16x8*)(QC + (size_t)(row0 + it) * 256 + hd * 64 + 16 * ks + 8 * hh);
        f32x16 st[2];
#pragma unroll
        for (int sb = 0; sb < 2; ++sb) { const int s = 32 * sb + l31, is = dir ? 63 - s : s; st[sb] = zero16();
#pragma unroll
            for (int ks = 0; ks < 4; ++ks) { const bf16x8 a = *(const bf16x8*)(KC + (size_t)(row0 + is) * 256 + hd * 64 + 16 * ks + 8 * hh); st[sb] = mfma32(a, qf[ks], st[sb]); } }
        const float ct = ZC[dir * 64 + t];
        float dsum = 0.f;
#pragma unroll
        for (int sb = 0; sb < 2; ++sb)
#pragma unroll
            for (int r = 0; r < 16; ++r) { const int s = 32 * sb + (r & 3) + 8 * (r >> 2) + 4 * hh;
                const float vv = (s <= t) ? st[sb][r] * fexp(ZU[dir * 64 + s] + ct) : 0.f; st[sb][r] = vv; dsum += vv; }
        dsum += __shfl_xor(dsum, 32);
        acc[0] = zero16(); acc[1] = zero16(); acc2[0] = zero16(); acc2[1] = zero16();
        const int q4 = (lane & 15) >> 2, colo = 16 * ((lane >> 4) & 1) + 4 * (lane & 3);
#pragma unroll
        for (int sb = 0; sb < 2; ++sb)
#pragma unroll
            for (int s2 = 0; s2 < 2; ++s2) { u32x4 wvv;
#pragma unroll
                for (int q = 0; q < 4; ++q) wvv[q] = pk2(st[sb][8 * s2 + 2 * q], st[sb][8 * s2 + 2 * q + 1]);
                const int sa = 32 * sb + 16 * s2 + 4 * hh + q4, sb8 = sa + 8;
                const int ia = dir ? 63 - sa : sa, ib = dir ? 63 - sb8 : sb8;
#pragma unroll
                for (int dvb = 0; dvb < 2; ++dvb) { const bf16x8 vf = cat8(tr_read(VT + ia * 192 + (32 * dvb + colo) * 2), tr_read(VT + ib * 192 + (32 * dvb + colo) * 2));
                    acc[dvb] = mfma32(vf, as_bf16x8(wvv), acc[dvb]); } }
        float qn = 0.f;
#pragma unroll
        for (int ks = 0; ks < 4; ++ks) {
#pragma unroll
            for (int dvb = 0; dvb < 2; ++dvb) { const bf16x8 cf = *(const bf16x8*)(CS + (size_t)cu_index(b, tc, hd, dir) * 4096 + (size_t)(32 * dvb + l31) * 64 + 16 * ks + 8 * hh); acc2[dvb] = mfma32(cf, qf[ks], acc2[dvb]); }
#pragma unroll
            for (int j = 0; j < 8; ++j) qn += bf2f((unsigned)(unsigned short)qf[ks][j]) * ZN[dir * 64 + 16 * ks + 8 * hh + j]; }
        qn += __shfl_xor(qn, 32);
        inter = ZI[dir * 64 + t]; const float den = dsum + inter * qn; rden = 1.0f / fmaxf(fabsf(den), ZE[dir * 64 + t]);
#pragma unroll
        for (int dvb = 0; dvb < 2; ++dvb)
#pragma unroll
            for (int r = 0; r < 16; ++r) acc[dvb][r] = (acc[dvb][r] + inter * acc2[dvb][r]) * rden;
        if (dir == 1) {
#pragma unroll
            for (int dvb = 0; dvb < 2; ++dvb)
#pragma unroll
                for (int r = 0; r < 16; ++r) ZH[it * 65 + 32 * dvb + (r & 3) + 8 * (r >> 2) + 4 * hh] = acc[dvb][r];
        }
    }
    __syncthreads();
    if (valid && dir == 0) {
#pragma unroll
        for (int dvb = 0; dvb < 2; ++dvb)
#pragma unroll
            for (int g = 0; g < 4; ++g) { const int dv = 32 * dvb + 8 * g + 4 * hh;
                const u32x2 ov = *(const u32x2*)(P + (size_t)(row0 + it) * NP + PC_CO + hd * 64 + dv);
                const float o0 = sigmoidf_(bf2f(ov.x & 0xffffu)), o1 = sigmoidf_(bf2f(ov.x >> 16)), o2 = sigmoidf_(bf2f(ov.y & 0xffffu)), o3 = sigmoidf_(bf2f(ov.y >> 16));
                const float h0 = acc[dvb][4 * g] + ZH[it * 65 + dv], h1 = acc[dvb][4 * g + 1] + ZH[it * 65 + dv + 1], h2 = acc[dvb][4 * g + 2] + ZH[it * 65 + dv + 2], h3 = acc[dvb][4 * g + 3] + ZH[it * 65 + dv + 3];
                ym_store4(YMIX + (size_t)(row0 + it) * 1024 + 512 + hd * 64 + dv, o0 * h0, o1 * h1, o2 * h2, o3 * h3); }
    }
    __syncthreads();
}


#define MIX_COMMON \
    const int qo = probe ? 4 : 0; \
    const int tid = otid(wv), lane = tid & 63, w = tid >> 6, l31 = lane & 31; \
    unsigned char* ws = opq(p.ws); \
    unsigned* ctl = (unsigned*)(ws + WS_CTL); \
    LAS int* slot = (LAS int*)(lds + LDS_MISC + 64); \
    const int myx = *(const LAS int*)(lds + LDS_MISC + 72); \
    const bf16_t* P = (const bf16_t*)(ws + WS_P); \
    ym_t* YMIX = (ym_t*)(ws + WS_YMIX); \
    const bool need_ctx = (l == 0); (void)lane; (void)P;

__device__ __forceinline__ void mix_D(int wv, const Params& p, int l, LAS unsigned char* lds, bool probe) {
    MIX_COMMON
    const bf16_t* QD = (const bf16_t*)(ws + WS_QD); const bf16_t* KD = (const bf16_t*)(ws + WS_KD); const bf16_t* VD = (const bf16_t*)(ws + WS_VD);
    const int per = 32 + (need_ctx ? 2 : 0);
    XQ q{ctl + CTL_Q(l, qo + 0, 0), myx, per, 0};
    for (;;) { const int uu = q_next(tid, q, slot); if (uu < 0) break;
        const int xx = uu / per, j = uu % per;
        PolD pol; int b, h, row; const bool lat = j < 32;
        if (lat) { const int pair = xx + 8 * (j >> 4); b = pair >> 2; h = pair & 3; row = b * SEQ + (j & 15) * 512 + 64 * w + l31; pol.nloc = 128; }
        else { const int v = 2 * xx + (j - 32); b = v >> 2; h = v & 3; row = TL + b * CTXL + 32 * w + l31; pol.nloc = 0; }
        pol.ntiles = pol.nloc + 4;
        pol.kbase = KD + (size_t)b * SEQ * 384 + h * 96; pol.vbase = VD + (size_t)b * SEQ * 256 + h * 64;
        pol.kctx = KD + (size_t)(TL + b * CTXL) * 384 + h * 96; pol.vctx = VD + (size_t)(TL + b * CTXL) * 256 + h * 64;
        pol.qrow = QD + (size_t)row * 384 + h * 96; pol.orow = YMIX + (size_t)row * 1024 + 768 + h * 64;
        pol.qscale = 0.10206207261596575f * LOG2E; pol.m0 = -1e30f; pol.l0 = 0.f;
        if (lat) attn_pp<2>(wv, lds, pol, 32 * 384, 32 * 1024); else attn_core<1>(wv, lds, pol); }
}
__device__ __forceinline__ void mix_B(int wv, const Params& p, int l, LAS unsigned char* lds, bool probe) {
    MIX_COMMON
    const int per = 64 + (need_ctx ? 2 : 0);
    XQ q{ctl + CTL_Q(l, qo + 1, 0), myx, per, 0};
    for (;;) { const int uu = q_next(tid, q, slot); if (uu < 0) break;
        const int xx = uu / per, j = uu % per;
        PolB pol; int b, h, row;
        LAS float* rp = (LAS float*)(lds + 65536);
        if (j < 64) { const int pair = xx + 8 * (j >> 5); b = pair >> 2; h = pair & 3; const int R0 = (j & 31) * 4; pol.r = R0 + (w >> 1); pol.c = 32 * (w & 1) + l31; row = b * SEQ + pol.r * 64 + pol.c;
            pol.klo = min(max(R0 - 4, 0), 120); const int khi = min(max(R0 - 1, 0), 120) + 7; pol.nloc = khi - pol.klo + 1; pol.wr0 = min(max(pol.r - 4, 0), 120); }
        else { const int v = 2 * xx + (j - 64); b = v >> 2; h = v & 3; row = TL + b * CTXL + 32 * w + l31; pol.nloc = 0; pol.klo = 0; pol.wr0 = 0; pol.r = 0; pol.c = 0; }
        for (int i = tid; i < 465; i += NTHR) rp[i] = p.nat_rpb[((size_t)l * 4 + h) * 465 + i] * LOG2E;
        __syncthreads();
        pol.rpb = rp; pol.ntiles = pol.nloc + 4; pol.set_lane(lane >> 5);
        pol.kbase = P + (size_t)b * SEQ * NP + PC_BK + h * 64; pol.vbase = P + (size_t)b * SEQ * NP + PC_BV + h * 64;
        pol.kctx = P + (size_t)(TL + b * CTXL) * NP + PC_BK + h * 64; pol.vctx = P + (size_t)(TL + b * CTXL) * NP + PC_BV + h * 64;
        pol.qrow = P + (size_t)row * NP + PC_BQ + h * 64; pol.orow = YMIX + (size_t)row * 1024 + 256 + h * 64;
        pol.qscale = 0.125f * LOG2E; pol.m0 = -1e30f; pol.l0 = 0.f;
        attn_core<1>(wv, lds, pol); }
}
__device__ __forceinline__ void mix_A(int wv, const Params& p, int l, LAS unsigned char* lds, bool probe) {
    MIX_COMMON
    const bf16_t* QA = (const bf16_t*)(ws + WS_QA); const bf16_t* KA = (const bf16_t*)(ws + WS_KA);
    const int per = 64 + (need_ctx ? 2 : 0);
    XQ q{ctl + CTL_Q(l, qo + 2, 0), myx, per, 0};
    for (;;) { const int uu = q_next(tid, q, slot); if (uu < 0) break;
        const int xx = uu / per, j = uu % per;
        PolA pol; int b, hkv, head, row;
        if (j < 64) { b = xx >> 1; hkv = xx & 1; const int qb = j; head = 2 * hkv + (w >> 2); pol.q0 = qb * 128 + (w & 3) * 32; pol.qpos = pol.q0 + l31; row = b * SEQ + pol.qpos;
            const int tlo = (qb == 0) ? 2 : 0, thi = (qb == 63) ? 4 : 6; pol.nloc = thi - tlo; pol.kp0 = (qb - 1) * 128 + 64 * tlo; }
        else { const int v = 2 * xx + (j - 64); b = v >> 2; hkv = (v >> 1) & 1; head = 2 * hkv + (v & 1); row = TL + b * CTXL + 32 * w + l31; pol.nloc = 0; pol.kp0 = 0; pol.q0 = 0; pol.qpos = 0; }
        pol.ntiles = pol.nloc + 4;
        pol.kbase = KA + (size_t)b * SEQ * 128 + hkv * 64; pol.vbase = P + (size_t)b * SEQ * NP + PC_AV + hkv * 64;
        pol.kctx = KA + (size_t)(TL + b * CTXL) * 128 + hkv * 64; pol.vctx = P + (size_t)(TL + b * CTXL) * NP + PC_AV + hkv * 64;
        pol.qrow = QA + (size_t)row * 256 + head * 64; pol.orow = YMIX + (size_t)row * 1024 + head * 64;
        pol.qscale = 0.125f * LOG2E; pol.m0 = p.attn_sink[l * 4 + head] * LOG2E; pol.l0 = 1.0f;
        attn_core<1>(wv, lds, pol); }
}
__device__ __forceinline__ void mix_C(int wv, const Params& p, int l, LAS unsigned char* lds, bool probe) {
    MIX_COMMON
    (void)w; (void)l31; (void)YMIX;
    const int per = NBATCH * (need_ctx ? NCHUNK : 128) * 4 / 16;
    XQ q{ctl + CTL_Q(l, qo + 3, 0), myx, per, 0};
    for (;;) { const int pr = q_next(tid, q, slot); if (pr < 0) break;
        mlstm_out_pair(wv, p, lds, l, 2 * pr, 2 * pr + 1); }
}
#ifndef MIX_MASK
#define MIX_MASK 15
#endif
__device__ __forceinline__ void phase_mixers(int wv, const Params& p, int l, LAS unsigned char* lds) {
    if (MIX_MASK & 1) mix_D(wv, p, l, lds, false);
    if (MIX_MASK & 2) mix_B(wv, p, l, lds, false);
    if (MIX_MASK & 4) mix_A(wv, p, l, lds, false);
    if (MIX_MASK & 8) mix_C(wv, p, l, lds, false);
}
#ifndef PROBE_MIX
#define PROBE_MIX 15
#endif
__device__ __forceinline__ void phase_mixers_probe(int wv, const Params& p, int l, LAS unsigned char* lds) {
    if (PROBE_MIX & 1) mix_D(wv, p, l, lds, true);
    if (PROBE_MIX & 2) mix_B(wv, p, l, lds, true);
    if (PROBE_MIX & 4) mix_A(wv, p, l, lds, true);
    if (PROBE_MIX & 8) mix_C(wv, p, l, lds, true);
}

__device__ __forceinline__ void phase_router(int wv, const Params& p, int l, LAS unsigned char* lds, bool probe = false) {
    const int tid = otid(wv), lane = tid & 63, w = tid >> 6, hh = lane >> 5, l31 = lane & 31;
    unsigned char* ws = opq(p.ws);
    const float* MOD = (const float*)(ws + WS_MOD); float* XA = (float*)(ws + WS_XA); unsigned char* H2F = ws + WS_H2B;
    const bf16_t* DELTA = (const bf16_t*)(ws + WS_HB); const float* XB = (const float*)(ws + WS_XB);
    const bf16_t* WRT = (const bf16_t*)(ws + WS_WRT) + (size_t)l * 2 * 32 * 1024;
    float* GATE = (float*)(ws + WS_GATE); int* LIST = (int*)(ws + WS_LIST); unsigned* ctl = (unsigned*)(ws + WS_CTL);
    constexpr int HROW = 1028;
    LAS float* HT = (LAS float*)lds;
    LAS float* RED = (LAS float*)lds;
    LAS int* LCNT = (LAS int*)(lds + 131584);
    LAS int* LBASE = LCNT + 32;
    LAS int* PA = LBASE + 32;
    LAS int* PE = PA + 640;
    const int T = (l == 0) ? TA : TL, ntile = T / 32, NASSIGN = TA * 4;
    bf16x8 wbh[8], wbl[8];
#pragma unroll
    for (int ks = 0; ks < 8; ++ks) { const int k0 = 128 * w + 16 * ks + 8 * hh; wbh[ks] = *(const bf16x8*)(WRT + (size_t)l31 * 1024 + k0); wbl[ks] = *(const bf16x8*)(WRT + (size_t)(32 + l31) * 1024 + k0); }
    if (tid < 32) LCNT[tid] = 0;
    if (blockIdx.x == 0 && tid < 64) *(u32x4*)(H2F + (size_t)TA * 1024 + tid * 16) = (u32x4){0u, 0u, 0u, 0u};
    __syncthreads();
    int iter = 0;
    for (int tl = blockIdx.x; tl < ntile; tl += gridDim.x, ++iter) {
        const int r0 = tl * 32;
#pragma unroll 1
        for (int i = 0; i < 4; ++i) { const int rl = 4 * w + i, r = r0 + rl;
            const int mrow = (r < TL) ? (r >> 13) : 4; const float* mod = MOD + ((size_t)l * 5 + mrow) * 6144;
            const float* xin = (l == 0) ? ((r < TL) ? p.x + (size_t)r * 1024 : p.ctx + (size_t)(r - TL) * 1024) : XB + (size_t)r * 1024;
            f32x4 v[4]; row_load(xin, lane, v);
#pragma unroll
            for (int q = 0; q < 4; ++q) { const u32x2 dw = *(const u32x2*)(DELTA + (size_t)r * 1024 + q * 256 + lane * 4);
                v[q][0] += bf2f(dw.x & 0xffffu); v[q][1] += bf2f(dw.x >> 16); v[q][2] += bf2f(dw.y & 0xffffu); v[q][3] += bf2f(dw.y >> 16);
                *(f32x4*)(XA + (size_t)r * 1024 + q * 256 + lane * 4) = v[q]; }
            const float rstd = row_rstd(v);
            row_modulate(v, rstd, p.g_norm2 + l * 1024, mod + 4 * 1024, mod + 3 * 1024, lane);
            row_store_fp8(H2F + (size_t)r * 1024, lane, v);
#pragma unroll
            for (int q = 0; q < 4; ++q) *(LAS f32x4*)(HT + rl * HROW + q * 256 + lane * 4) = v[q]; }
        __syncthreads();
        f32x16 acc = zero16();
#pragma unroll
        for (int ks = 0; ks < 8; ++ks) { const int k0 = 128 * w + 16 * ks + 8 * hh;
            const f32x4 x0 = *(const LAS f32x4*)(HT + l31 * HROW + k0), x1 = *(const LAS f32x4*)(HT + l31 * HROW + k0 + 4);
            u32x4 ah, alo; float hf[8] = {x0[0], x0[1], x0[2], x0[3], x1[0], x1[1], x1[2], x1[3]};
#pragma unroll
            for (int q = 0; q < 4; ++q) { const unsigned hp = pk2(hf[2 * q], hf[2 * q + 1]); ah[q] = hp; alo[q] = pk2(hf[2 * q] - bf2f(hp & 0xffffu), hf[2 * q + 1] - bf2f(hp >> 16)); }
            const bf16x8 bh = wbh[ks], bl = wbl[ks];
            acc = mfma32(as_bf16x8(ah), bh, acc); acc = mfma32(as_bf16x8(alo), bh, acc); acc = mfma32(as_bf16x8(ah), bl, acc); }
        __syncthreads();
#pragma unroll
        for (int r = 0; r < 16; ++r) RED[(w * 32 + (r & 3) + 8 * (r >> 2) + 4 * hh) * 33 + l31] = acc[r];
        __syncthreads();
        LAS float* TV = (LAS float*)(lds + 131584 + 8192);
        LAS int* TE = (LAS int*)(TV + 128);
#pragma unroll 1
        for (int ps = 0; ps < 2; ++ps) { const int rl = 4 * w + 2 * ps + hh, e = l31;
            float v = p.b_router[l * 32 + e];
#pragma unroll
            for (int ww = 0; ww < 8; ++ww) v += RED[(ww * 32 + rl) * 33 + e];
            int rank = 0;
#pragma unroll
            for (int d = 1; d < 32; ++d) { const int src = (lane & 32) | ((lane + d) & 31); const float ov = __shfl(v, src); const int oe = (e + d) & 31; rank += (ov > v || (ov == v && oe < e)) ? 1 : 0; }
            if (rank < 4) { TV[(w * 4 + 2 * ps + hh) * 4 + rank] = v; TE[(w * 4 + 2 * ps + hh) * 4 + rank] = e; }
        }
        asm volatile("s_waitcnt lgkmcnt(0)" ::: "memory");
        if (lane < 16) { const int tk = lane >> 2, k = lane & 3, rl = 4 * w + tk, r = r0 + rl;
            const float t0 = TV[(w * 4 + tk) * 4 + 0], t1 = TV[(w * 4 + tk) * 4 + 1], t2 = TV[(w * 4 + tk) * 4 + 2], t3 = TV[(w * 4 + tk) * 4 + 3];
            const float e1 = fexp(t1 - t0), e2 = fexp(t2 - t0), e3 = fexp(t3 - t0), inv = 1.0f / (1.0f + e1 + e2 + e3);
            const float g = (k == 0 ? 1.0f : k == 1 ? e1 : k == 2 ? e2 : e3) * inv; const int e = TE[(w * 4 + tk) * 4 + k];
            const int a = r * 4 + k; GATE[a] = g;
            const int lr = __hip_atomic_fetch_add(&LCNT[e], 1, __ATOMIC_RELAXED, __HIP_MEMORY_SCOPE_WORKGROUP); const int pi = iter * 128 + rl * 4 + k; PA[pi] = a; PE[pi] = (e << 16) | lr; }
        __syncthreads();
    }
    if (tid < 32) LBASE[tid] = (int)__hip_atomic_fetch_add(probe ? ctl + 3456 + tid * 16 : ctl + CTL_CNT(l, tid), (unsigned)LCNT[tid], __ATOMIC_RELAXED, __HIP_MEMORY_SCOPE_AGENT);
    __syncthreads();
    for (int i = tid; i < iter * 128; i += NTHR) { const int pe = PE[i], e = pe >> 16, lr = pe & 0xffff; LIST[(size_t)e * NASSIGN + LBASE[e] + lr] = PA[i]; }
    __syncthreads();
}

__device__ __forceinline__ void phase_gather(int wv, const Params& p, int l, LAS unsigned char* lds) {
    const int tid = otid(wv), lane = tid & 63, gw = blockIdx.x * NWAVE + (tid >> 6), nw = gridDim.x * NWAVE;
    unsigned char* ws = opq(p.ws);
    const unsigned* ctl = (const unsigned*)(ws + WS_CTL); int* SLOTT = (int*)(ws + WS_SLOTT);
    const int* LIST = (const int*)(ws + WS_LIST); const float* GATE = (const float*)(ws + WS_GATE);
    int* SLOTA = (int*)(ws + WS_SLOTA); float* SLOTG = (float*)(ws + WS_SLOTG); int* TILEE = (int*)(ws + WS_TILEE);
    LAS int* CNT = (LAS int*)lds; LAS int* PST = CNT + 32;
    constexpr int NASSIGN = TA * 4;
    if (tid < 32) CNT[tid] = (int)__hip_atomic_load(ctl + CTL_CNT(l, tid), __ATOMIC_RELAXED, __HIP_MEMORY_SCOPE_AGENT);
    __syncthreads();
    if (tid == 0) { int s = 0; for (int e = 0; e < 32; ++e) { PST[e] = s; s += (CNT[e] + 255) & ~255; } PST[32] = s; }
    __syncthreads();
    const int nslot = PST[32], ntiles = nslot >> 8;
    if (blockIdx.x == 0) { for (int t = tid; t < ntiles; t += NTHR) { int e = 0; for (int j = 1; j < 32; ++j) if (PST[j] <= t * 256) e = j; TILEE[t] = e; } if (tid == 0) TILEE[MAXTILE] = ntiles; }
    for (int s = blockIdx.x * NTHR + tid; s < nslot; s += gridDim.x * NTHR) {
        int e = 0;
#pragma unroll
        for (int j = 1; j < 32; ++j) if (PST[j] <= s) e = j;
        const int r = s - PST[e];
        int a = -1;
        if (r < CNT[e]) a = LIST[(size_t)e * NASSIGN + r];
        SLOTA[s] = a; SLOTG[s] = (a >= 0) ? GATE[a] : 0.f; SLOTT[s] = (a >= 0) ? (a >> 2) : TA;
    }
}

#define XB_TMO      128
#define XB_XCNT(j)  (256  + 64 * (j))
#define XB_XSUB(j)  (1280 + 64 * (j))
#define XB_XGEN(j)  (2304 + 64 * (j))
#define XB_TOP      3328
#define XB_TOPGEN   3392
#define XCD_BAR_WORDS 3456
#define XB_SPIN_CAP (1u << 18)
__device__ __forceinline__ unsigned xb_ld(unsigned* p)              { return __hip_atomic_load(p, __ATOMIC_RELAXED, __HIP_MEMORY_SCOPE_AGENT); }
__device__ __forceinline__ unsigned xb_add(unsigned* p, unsigned v) { return __hip_atomic_fetch_add(p, v, __ATOMIC_RELAXED, __HIP_MEMORY_SCOPE_AGENT); }
__device__ __forceinline__ unsigned xb_xcc_id() { return (unsigned)__builtin_amdgcn_s_getreg((3 << 11) | 20) & 0xFu; }
#define XB_SPIN(cond, bar) do { unsigned _sp = 0; while (cond) { __builtin_amdgcn_s_sleep(1); \
    if ((++_sp & 255u) == 0u) { if (xb_ld(&(bar)[XB_TMO])) break; if (_sp > XB_SPIN_CAP) { atomicAdd(&(bar)[XB_TMO], 1u); break; } } } } while (0)
struct XcdBarrier { unsigned* bar; unsigned x; volatile LAS unsigned* st; };
__device__ __forceinline__ XcdBarrier xcd_barrier_post(int tid, unsigned* bar, volatile LAS unsigned* st) {
    XcdBarrier b; b.bar = bar; b.x = xb_xcc_id(); b.st = st;
    if (tid == 0) st[2] = xb_add(&bar[XB_XCNT(b.x)], 1u);
    return b;
}
__device__ __forceinline__ void xcd_barrier_complete(unsigned* bar, unsigned x, unsigned& nloc, unsigned& nx) {
    const unsigned G = gridDim.x * gridDim.y * gridDim.z;
    unsigned sum, cnt, mine, sp = 0u;
    for (;;) {
        sum = 0u; cnt = 0u; mine = 0u;
#pragma unroll
        for (unsigned j = 0; j < 16; ++j) { const unsigned c = xb_ld(&bar[XB_XCNT(j)]); sum += c; cnt += (c > 0u) ? 1u : 0u; mine = (j == x) ? c : mine; }
        if (sum == G) break;
        __builtin_amdgcn_s_sleep(1);
        if ((++sp & 255u) == 0u) { if (xb_ld(&bar[XB_TMO])) break; if (sp > XB_SPIN_CAP) { atomicAdd(&bar[XB_TMO], 1u); break; } }
    }
    nloc = mine > 0u ? mine : 1u; nx = cnt > 0u ? cnt : 1u;
}
__device__ __forceinline__ void xcd_barrier(int wv, const XcdBarrier& b) {
    asm volatile("s_waitcnt vmcnt(0)" ::: "memory");
    __syncthreads();
    if (otid(wv) == 0) {
        unsigned* bar = b.bar;
        __builtin_amdgcn_s_waitcnt(0);
        unsigned nloc = b.st[0], nx = b.st[1];
        if (nloc == 0u) { xcd_barrier_complete(bar, b.x, nloc, nx); b.st[0] = nloc; b.st[1] = nx; }
        const unsigned old = xb_add(&bar[XB_XSUB(b.x)], 1u);
        const unsigned gen = old / nloc;
        if (old + 1u == (gen + 1u) * nloc) {
            __builtin_amdgcn_fence(__ATOMIC_RELEASE, "agent");
            asm volatile("s_waitcnt vmcnt(0)" ::: "memory");
            const unsigned og = xb_add(&bar[XB_TOP], 1u);
            const unsigned tg = og / nx;
            if (og + 1u == (tg + 1u) * nx) xb_add(&bar[XB_TOPGEN], 1u);
            else XB_SPIN(xb_ld(&bar[XB_TOPGEN]) == tg, bar);
            __builtin_amdgcn_fence(__ATOMIC_ACQUIRE, "agent");
            xb_add(&bar[XB_XGEN(b.x)], 1u);
            asm volatile("s_waitcnt vmcnt(0)" ::: "memory");
        } else {
            XB_SPIN(xb_ld(&bar[XB_XGEN(b.x)]) == gen, bar);
            __builtin_amdgcn_fence(__ATOMIC_ACQUIRE, "agent");
            asm volatile("s_waitcnt vmcnt(0)" ::: "memory");
        }
    }
    __syncthreads();
}

constexpr int NPHASE = 23;
extern __shared__ __attribute__((aligned(16))) unsigned char smem_raw[];

#ifndef EN_MASK
#define EN_MASK 0xFFF
#endif
#define EN(k) ((EN_MASK >> (k)) & 1)
#ifndef PROBE_REP
#define PROBE_REP -1
#endif
#define RUN(id) ((id) >= p.phase_lo && (id) < p.phase_hi)
#define SYNC() do { if (p.use_bar) xcd_barrier(wv, bar); } while (0)
template <int l>
__device__ __forceinline__ void run_layer(int wv, const Params& p, LAS unsigned char* lds, const XcdBarrier& bar) {
    unsigned char* ws = opq(p.ws);
    const int cid = __builtin_amdgcn_readfirstlane(*(const LAS int*)(lds + LDS_MISC + 68));
        const int pb = 1 + 11 * l;
        const int T = (l == 0) ? TA : TL;
        if (l == 0) { if (EN(0) && RUN(pb + 0)) phase_norm1_l0(wv, p); SYNC(); if (PROBE_REP == 0) { phase_norm1_l0(wv, p); SYNC(); } }
        if (EN(1) && RUN(pb + 1)) {
            pg8::Gemm g{(const bf16_t*)(ws + WS_HB), (const bf16_t*)(ws + WS_WIN) + (size_t)l * NP * 1024, TA, NP, 1024};
            pg8::StaticOrder S; S.init(TA, NP, gridDim.x, cid);
            EpiStoreBf16 E{(bf16_t*)(ws + WS_P), NP};
            pg8::gemm_phase(wv, lds, g, S, E, nullptr);
        }
        if (PROBE_REP == 21 && l == 0) {
            SYNC();
            struct SameTile : pg8::StaticOrder { __device__ __forceinline__ bool next(int i, pg8::Unit& u) const { pg8::Unit t; const bool ok = pg8::StaticOrder::next(i, t); u.pm = 0; u.pn = 0; return ok; } };
            pg8::Gemm g{(const bf16_t*)(ws + WS_HB), (const bf16_t*)(ws + WS_WIN), TA, NP, 1024};
            SameTile S; S.init(TA, NP, gridDim.x, cid);
            EpiStoreBf16 E{(bf16_t*)(ws + WS_XS), NP};
            pg8::gemm_phase(wv, lds, g, S, E, nullptr);
        }
        if (PROBE_REP == 22 && l == 0) {
            SYNC();
            pg8::Gemm g{(const bf16_t*)(ws + WS_HB), (const bf16_t*)(ws + WS_WIN), TA, NP, 1024};
            pg8::StaticOrder S; S.init(TA, NP, gridDim.x, cid);
            EpiStoreBf16 E{(bf16_t*)(ws + WS_XS), NP};
            pg8::gemm_phase(wv, lds, g, S, E, nullptr);
        }
        SYNC();
        if (EN(2) && RUN(pb + 2)) phase_prep(wv, p, l, lds);
        if (PROBE_REP == 2 && l == 0) { SYNC(); if (PROBE_MIX & 1) prep_elem(wv, p, l, lds); __syncthreads(); if (PROBE_MIX & 2) prep_state(wv, p, l, lds); }
        SYNC();
        if (EN(3) && RUN(pb + 3)) phase_scan(wv, p, lds);
        if (PROBE_REP == 3 && l == 0) { SYNC(); phase_scan(wv, p, lds); }
        SYNC();
        if (EN(4) && RUN(pb + 4)) phase_mixers(wv, p, l, lds);
        if (PROBE_REP == 4 && l == 0) { SYNC(); phase_mixers_probe(wv, p, l, lds); }
        SYNC();
        if (EN(5) && RUN(pb + 5)) {
            pg8::Gemm g{(const bf16_t*)(ws + WS_YMIX), (const bf16_t*)(ws + WS_WOUT + (size_t)l * 1024 * 1024 * (YM_FP8 ? 1 : 2)), T, 1024, YM_FP8 ? 512 : 1024};
            pg8::StaticOrder S; S.init(T, 1024, gridDim.x, cid);
            const float* MOD = (const float*)(ws + WS_MOD);
            EpiDelta E{(bf16_t*)(ws + WS_HB), MOD + (size_t)l * 5 * 6144 + 2 * 1024, YM_FP8 ? 0.03125f : 1.0f};
            pg8::gemm_phase<EpiDelta, pg8::StaticOrder, false, YM_FP8 != 0>(wv, lds, g, S, E, nullptr);
        }
        SYNC();
        if (PROBE_REP == 25 && l == 0) {
            pg8::Gemm g{(const bf16_t*)(ws + WS_YMIX), (const bf16_t*)(ws + WS_WOUT + (size_t)l * 1024 * 1024 * (YM_FP8 ? 1 : 2)), T, 1024, YM_FP8 ? 512 : 1024};
            pg8::StaticOrder S; S.init(T, 1024, gridDim.x, cid);
            const float* MOD = (const float*)(ws + WS_MOD);
            EpiDelta E{(bf16_t*)(ws + WS_HB), MOD + (size_t)l * 5 * 6144 + 2 * 1024, YM_FP8 ? 0.03125f : 1.0f};
            pg8::gemm_phase<EpiDelta, pg8::StaticOrder, false, YM_FP8 != 0>(wv, lds, g, S, E, nullptr);
            SYNC();
        }
        if (EN(6) && RUN(pb + 6)) phase_router(wv, p, l, lds);
        if (PROBE_REP == 6 && l == 0) { SYNC(); phase_router(wv, p, l, lds, true); }
        SYNC();
        if (EN(7) && RUN(pb + 7)) phase_gather(wv, p, l, lds);
        if (PROBE_REP == 7 && l == 0) { SYNC(); phase_gather(wv, p, l, lds); }
        SYNC();
        if (EN(8) && RUN(pb + 8)) {
            const int* TILEE = (const int*)(ws + WS_TILEE);
            pg8::Gemm g{(const bf16_t*)(ws + WS_H2B), (const bf16_t*)(ws + WS_WGU + (size_t)l * 32 * 2048 * 1024), MAXSLOT, 32 * 2048, 512, (const int*)(ws + WS_SLOTT)};
            LAS int* TL_ = (LAS int*)(lds + 131072); const int ntl_ = __builtin_amdgcn_readfirstlane(TILEE[MAXTILE]); for (int i_ = otid(wv); i_ < ntl_; i_ += NTHR) TL_[i_] = TILEE[i_]; __syncthreads();
            MoeOrder S{TL_, ntl_, 8, (int)gridDim.x, cid};
            EpiGU E{ws + WS_ACT, p.b_gu + (size_t)l * 32 * 2048};
            pg8::gemm_phase<EpiGU, MoeOrder, false, true, true>(wv, lds, g, S, E, nullptr);
        }
        SYNC();
        if (PROBE_REP == 23 && l == 0) {
            const int* TILEE = (const int*)(ws + WS_TILEE);
            pg8::Gemm g{(const bf16_t*)(ws + WS_H2B), (const bf16_t*)(ws + WS_WGU + (size_t)l * 32 * 2048 * 1024), MAXSLOT, 32 * 2048, 512, (const int*)(ws + WS_SLOTT)};
            LAS int* TL_ = (LAS int*)(lds + 131072); const int ntl_ = __builtin_amdgcn_readfirstlane(TILEE[MAXTILE]); for (int i_ = otid(wv); i_ < ntl_; i_ += NTHR) TL_[i_] = TILEE[i_]; __syncthreads();
            MoeOrder S{TL_, ntl_, 8, (int)gridDim.x, cid};
            EpiGU E{ws + WS_ACT, p.b_gu + (size_t)l * 32 * 2048};
            pg8::gemm_phase<EpiGU, MoeOrder, false, true, true>(wv, lds, g, S, E, nullptr);
            SYNC();
        }
        if (EN(9) && RUN(pb + 9)) {
            const int* TILEE = (const int*)(ws + WS_TILEE);
            pg8::Gemm g{(const bf16_t*)(ws + WS_ACT), (const bf16_t*)(ws + WS_WDN + (size_t)l * 32 * 1024 * 1024), MAXSLOT, 32 * 1024, 512};
            LAS int* TL_ = (LAS int*)(lds + 131072); const int ntl_ = __builtin_amdgcn_readfirstlane(TILEE[MAXTILE]); for (int i_ = otid(wv); i_ < ntl_; i_ += NTHR) TL_[i_] = TILEE[i_]; __syncthreads();
            MoeOrder S{TL_, ntl_, 4, (int)gridDim.x, cid};
            EpiDown E{(bf16_t*)(ws + WS_Y), p.b_down + (size_t)l * 32 * 1024, (const int*)(ws + WS_SLOTA), (const float*)(ws + WS_SLOTG)};
            pg8::gemm_phase<EpiDown, MoeOrder, false, true>(wv, lds, g, S, E, nullptr);
        }
        SYNC();
        if (PROBE_REP == 24 && l == 0) {
            const int* TILEE = (const int*)(ws + WS_TILEE);
            pg8::Gemm g{(const bf16_t*)(ws + WS_ACT), (const bf16_t*)(ws + WS_WDN + (size_t)l * 32 * 1024 * 1024), MAXSLOT, 32 * 1024, 512};
            LAS int* TL_ = (LAS int*)(lds + 131072); const int ntl_ = __builtin_amdgcn_readfirstlane(TILEE[MAXTILE]); for (int i_ = otid(wv); i_ < ntl_; i_ += NTHR) TL_[i_] = TILEE[i_]; __syncthreads();
            MoeOrder S{TL_, ntl_, 4, (int)gridDim.x, cid};
            EpiDown E{(bf16_t*)(ws + WS_Y), p.b_down + (size_t)l * 32 * 1024, (const int*)(ws + WS_SLOTA), (const float*)(ws + WS_SLOTG)};
            pg8::gemm_phase<EpiDown, MoeOrder, false, true>(wv, lds, g, S, E, nullptr);
            SYNC();
        }
        if (EN(10) && RUN(pb + 10)) phase_combine(wv, p, l);
        if (PROBE_REP == 10 && l == 0) { SYNC(); phase_combine(wv, p, l); }
        if (l == 0) SYNC();
    }

__global__ void __launch_bounds__(NTHR, 2) mk_forward(Params p) {
    LAS unsigned char* lds = (LAS unsigned char*)smem_raw;
    const int wv = __builtin_amdgcn_readfirstlane((int)threadIdx.x >> 6);
    { const int t0 = otid(wv); if (t0 < 32) ((LAS unsigned*)(lds + LDS_MISC))[t0] = 0u; }
    __syncthreads();
    unsigned* ctl = (unsigned*)(p.ws + WS_CTL);
    XcdBarrier bar; bar.bar = ctl; bar.x = 0; bar.st = (volatile LAS unsigned*)(lds + LDS_MISC);
    if (p.use_bar) bar = xcd_barrier_post(otid(wv), ctl, (volatile LAS unsigned*)(lds + LDS_MISC));
    if (EN(11) && RUN(0)) phase_prologue(wv, p, lds);
    SYNC();
    if (PROBE_REP == 11) { phase_prologue(wv, p, lds); SYNC(); }
    if (otid(wv) == 0) { LAS unsigned* ms = (LAS unsigned*)(lds + LDS_MISC); unsigned cid = blockIdx.x;
        if (p.use_bar) { bool ok = (gridDim.x & 7u) == 0u;
            for (unsigned j = 0; j < 16; ++j) { const unsigned c = xb_ld(&ctl[XB_XCNT(j)]); ok = ok && (c == (j < 8 ? gridDim.x >> 3 : 0u)); }
            if (ok) cid = ms[2] * 8u + bar.x; }
        ms[17] = cid; ms[18] = cid & 7u; }
    __syncthreads();
    run_layer<0>(wv, p, lds, bar);
    run_layer<1>(wv, p, lds, bar);
}
#undef RUN
#undef SYNC

extern "C" void kernel_launch(void* const* d_in, const int* in_sizes, int n_in, void* d_out, int out_size, void* d_ws, size_t ws_size, hipStream_t stream) {
    static int grid = 0;
    if (grid == 0) {
        if (n_in != 25 || ws_size < WS_END) { fprintf(stderr, "kernel_launch: expected 25 inputs and >= %zu bytes of workspace, got %d inputs, %zu bytes; nothing launched\n", (size_t)WS_END, n_in, ws_size); grid = -1; return; }
        int dev = 0, cus = 0, per_cu = 0;
        hipGetDevice(&dev); hipDeviceGetAttribute(&cus, hipDeviceAttributeMultiprocessorCount, dev);
        if (hipFuncSetAttribute((const void*)mk_forward, hipFuncAttributeMaxDynamicSharedMemorySize, LDS_BYTES) != hipSuccess) { fprintf(stderr, "kernel_launch: hipFuncSetAttribute failed\n"); grid = -1; return; }
        hipOccupancyMaxActiveBlocksPerMultiprocessor(&per_cu, (const void*)mk_forward, NTHR, LDS_BYTES);
        if (per_cu < 1) fprintf(stderr, "kernel_launch: occupancy query reports %d workgroups per CU\n", per_cu);
        grid = cus > 0 ? cus : 256;
    }
    if (grid < 0) return;
    Params p{};
    const float** pp = (const float**)&p;
    for (int i = 0; i < 25; ++i) pp[i] = (const float*)d_in[i];
    p.out = (float*)d_out; p.ws = (unsigned char*)d_ws; p.pad0 = 0;
    hipMemsetAsync((unsigned char*)d_ws + WS_CTL, 0, CTL_BYTES, stream);
#if MK_LAUNCHES == 1
    p.phase_lo = 0; p.phase_hi = NPHASE; p.use_bar = 1;
    hipLaunchKernelGGL(mk_forward, dim3(grid), dim3(NTHR), LDS_BYTES, stream, p);
#else
    for (int ph = 0; ph < NPHASE; ++ph) { if (ph == 12) continue;
        p.phase_lo = ph; p.phase_hi = ph + 1; p.use_bar = 0;
        hipLaunchKernelGGL(mk_forward, dim3(grid), dim3(NTHR), LDS_BYTES, stream, p); }
#endif
}
```
